# Optimizing an MI355X kernel written in HIP

```python
import jax, jax.numpy as jnp
from jax import lax
import numpy as np

D_MODEL = 1024
BATCH = 8
SEQ = 2048
DEPTH = 4

CHUNK = 64
N_MIXERS = 2

MLSTM_HEADS = 8
QK_HEAD_DIM = D_MODEL // 2 // MLSTM_HEADS
V_HEAD_DIM = D_MODEL // MLSTM_HEADS
QK_WIDTH = MLSTM_HEADS * QK_HEAD_DIM
V_WIDTH = MLSTM_HEADS * V_HEAD_DIM
Q_END = QK_WIDTH
K_END = 2 * QK_WIDTH
V_END = K_END + V_WIDTH
O_END = V_END + V_WIDTH
MLSTM_IN_COLS = O_END + 2 * MLSTM_HEADS
GATE_SOFTCAP = 15.0

POOL_WINDOWS = (2, 4, 8, 16)
POOL_GROUPS = len(POOL_WINDOWS)
POOL_GROUP_DIM = D_MODEL // POOL_GROUPS

D_FF = ((8 * D_MODEL + 3 * 256 - 1) // (3 * 256)) * 256

EPS = 1e-6

kernel_name = "hybrid_mlstm_pool_swiglu_trunk"


def rmsnorm(x, gain):
    xf = x.astype(jnp.float32)
    y = xf * lax.rsqrt(jnp.mean(xf * xf, axis=-1, keepdims=True) + EPS)
    return (y * gain.astype(jnp.float32)).astype(x.dtype)


def mlstm_chunkwise(q, k, v, i_pre, f_pre):
    B, H, S, dk = q.shape
    dv = v.shape[-1]
    nc = S // CHUNK
    q = q.reshape(B, H, nc, CHUNK, dk)
    k = k.reshape(B, H, nc, CHUNK, dk)
    v = v.reshape(B, H, nc, CHUNK, dv)
    i_pre = i_pre.reshape(B, H, nc, CHUNK)
    log_f = jax.nn.log_sigmoid(f_pre).reshape(B, H, nc, CHUNK)
    b = jnp.cumsum(log_f, axis=-1)
    b_last = b[..., -1]

    a = b_last[..., None] - b + i_pre
    m_loc = jnp.max(a, axis=-1)
    w_loc = jnp.exp(a - m_loc[..., None])
    c_loc = jnp.einsum('bhcl,bhclv,bhclk->bhcvk', w_loc, v, k)
    n_loc = jnp.einsum('bhcl,bhclk->bhck', w_loc, k)

    def step(carry, xs):
        c_st, n_st, m_st = carry
        c_l, n_l, m_l, b_l = xs
        m_new = jnp.maximum(b_l + m_st, m_l)
        s_old = jnp.exp(b_l + m_st - m_new)
        s_new = jnp.exp(m_l - m_new)
        c_next = s_old[..., None, None] * c_st + s_new[..., None, None] * c_l
        n_next = s_old[..., None] * n_st + s_new[..., None] * n_l
        return (c_next, n_next, m_new), (c_st, n_st, m_st)

    init = (jnp.zeros((B, H, dv, dk), jnp.float32),
            jnp.zeros((B, H, dk), jnp.float32),
            jnp.zeros((B, H), jnp.float32))
    xs = (jnp.moveaxis(c_loc, 2, 0), jnp.moveaxis(n_loc, 2, 0),
          jnp.moveaxis(m_loc, 2, 0), jnp.moveaxis(b_last, 2, 0))
    _, (c0, n0, m0) = lax.scan(step, init, xs)
    c0 = jnp.moveaxis(c0, 0, 2)
    n0 = jnp.moveaxis(n0, 0, 2)
    m0 = jnp.moveaxis(m0, 0, 2)

    causal = jnp.tril(jnp.ones((CHUNK, CHUNK), dtype=bool))
    d_log = b[..., :, None] - b[..., None, :] + i_pre[..., None, :]
    d_log = jnp.where(causal, d_log, -jnp.inf)
    inter_log = b + m0[..., None]
    m = jnp.maximum(inter_log, jnp.max(d_log, axis=-1))
    d_w = jnp.exp(d_log - m[..., None])
    inter_w = jnp.exp(inter_log - m)
    qk = jnp.einsum('bhcsk,bhcrk->bhcsr', q, k) * d_w
    num = (jnp.einsum('bhcsr,bhcrv->bhcsv', qk, v)
           + inter_w[..., None] * jnp.einsum('bhcvk,bhcsk->bhcsv', c0, q))
    den = jnp.sum(qk, axis=-1) + inter_w * jnp.einsum('bhck,bhcsk->bhcs', n0, q)
    h = num / jnp.maximum(jnp.abs(den), jnp.exp(-m))[..., None]
    return h.reshape(B, H, S, dv)


def mlstm_mixer(h, w_in, gate_bias, head_gain, w_out):
    B, S, _ = h.shape
    proj = h @ w_in
    q, k, v, o, gates = jnp.split(proj, [Q_END, K_END, V_END, O_END], axis=-1)

    def heads(t, d):
        return t.reshape(B, S, MLSTM_HEADS, d).transpose(0, 2, 1, 3).astype(jnp.float32)

    gates = (gates + gate_bias).astype(jnp.float32)
    gates = GATE_SOFTCAP * jnp.tanh(gates / GATE_SOFTCAP)
    i_pre = gates[..., :MLSTM_HEADS].transpose(0, 2, 1)
    f_pre = gates[..., MLSTM_HEADS:].transpose(0, 2, 1)
    hc = mlstm_chunkwise(heads(q, QK_HEAD_DIM),
                         heads(k, QK_HEAD_DIM) * (QK_HEAD_DIM ** -0.5),
                         heads(v, V_HEAD_DIM), i_pre, f_pre)
    hc = hc * lax.rsqrt(jnp.mean(hc * hc, axis=-1, keepdims=True) + EPS)
    hc = hc.transpose(0, 2, 1, 3).reshape(B, S, V_WIDTH) * head_gain.astype(jnp.float32)
    out = (hc * jax.nn.sigmoid(o.astype(jnp.float32))).astype(h.dtype)
    return out @ w_out


def pool_mixer(h, w_group, scale):
    B, S, _ = h.shape
    hf = h.astype(jnp.float32)
    csum = jnp.cumsum(hf, axis=1)
    t = jnp.arange(1, S + 1, dtype=jnp.float32)
    outs = []
    for g, win in enumerate(POOL_WINDOWS):
        sl = slice(g * POOL_GROUP_DIM, (g + 1) * POOL_GROUP_DIM)
        cg = csum[..., sl]
        lag = jnp.pad(cg, ((0, 0), (win, 0), (0, 0)))[:, :S]
        mean = (cg - lag) / jnp.minimum(t, float(win))[None, :, None]
        y = (mean - hf[..., sl]).astype(h.dtype)
        outs.append(jnp.einsum('bsc,cd->bsd', y, w_group[g]))
    return jnp.concatenate(outs, axis=-1) * scale


def swiglu(h, w_gate_up, w_down):
    gu = h @ w_gate_up
    g, u = jnp.split(gu, 2, axis=-1)
    return (jax.nn.silu(g) * u) @ w_down


def setup_inputs(seed: int = 0) -> dict:
    key = jax.random.key(seed)
    ks = jax.random.split(key, 16)
    n_a = (DEPTH + N_MIXERS - 1) // N_MIXERS
    n_b = DEPTH // N_MIXERS
    f32 = jnp.float32

    x = jax.random.normal(ks[0], (BATCH, SEQ, D_MODEL), f32)
    norm_mix = 1.0 + 0.02 * jax.random.normal(ks[1], (DEPTH, D_MODEL), f32)
    norm_ffn = 1.0 + 0.02 * jax.random.normal(ks[2], (DEPTH, D_MODEL), f32)

    mlstm_w_in = jax.random.normal(ks[3], (n_a, D_MODEL, MLSTM_IN_COLS), f32) * D_MODEL ** -0.5
    i_bias = 0.1 * jax.random.normal(ks[4], (n_a, MLSTM_HEADS), f32)
    f_bias = (jnp.linspace(3.0, 6.0, MLSTM_HEADS, dtype=f32)[None, :]
              + 0.1 * jax.random.normal(ks[5], (n_a, MLSTM_HEADS), f32))
    mlstm_gate_bias = jnp.concatenate([i_bias, f_bias], axis=-1)
    mlstm_head_gain = 1.0 + 0.02 * jax.random.normal(ks[6], (n_a, V_WIDTH), f32)
    mlstm_w_out = jax.random.normal(ks[7], (n_a, V_WIDTH, D_MODEL), f32) * V_WIDTH ** -0.5

    pool_w_group = (jax.random.normal(ks[8], (n_b, POOL_GROUPS, POOL_GROUP_DIM, POOL_GROUP_DIM), f32)
                    * POOL_GROUP_DIM ** -0.5)
    pool_scale = 1.0 + 0.1 * jax.random.normal(ks[9], (n_b, D_MODEL), f32)

    ffn_w_gate_up = jax.random.normal(ks[10], (DEPTH, D_MODEL, 2 * D_FF), f32) * D_MODEL ** -0.5
    ffn_w_down = jax.random.normal(ks[11], (DEPTH, D_FF, D_MODEL), f32) * D_FF ** -0.5
    final_norm = 1.0 + 0.02 * jax.random.normal(ks[12], (D_MODEL,), f32)

    return {"x": x, "norm_mix": norm_mix, "norm_ffn": norm_ffn,
            "mlstm_w_in": mlstm_w_in, "mlstm_gate_bias": mlstm_gate_bias,
            "mlstm_head_gain": mlstm_head_gain, "mlstm_w_out": mlstm_w_out,
            "pool_w_group": pool_w_group, "pool_scale": pool_scale,
            "ffn_w_gate_up": ffn_w_gate_up, "ffn_w_down": ffn_w_down,
            "final_norm": final_norm}


def reference(x, norm_mix, norm_ffn, mlstm_w_in, mlstm_gate_bias, mlstm_head_gain,
              mlstm_w_out, pool_w_group, pool_scale, ffn_w_gate_up, ffn_w_down, final_norm):
    for layer in range(DEPTH):
        slot = layer // N_MIXERS
        h = rmsnorm(x, norm_mix[layer])
        if layer % N_MIXERS == 0:
            x = x + mlstm_mixer(h, mlstm_w_in[slot], mlstm_gate_bias[slot],
                                mlstm_head_gain[slot], mlstm_w_out[slot])
        else:
            x = x + pool_mixer(h, pool_w_group[slot], pool_scale[slot])
        x = x + swiglu(rmsnorm(x, norm_ffn[layer]), ffn_w_gate_up[layer], ffn_w_down[layer])
    return rmsnorm(x, final_norm)
```

```cpp
#include <hip/hip_runtime.h>
#include <cstdio>
#include <cstdint>

#ifndef MK_N_LAUNCHES
#define MK_N_LAUNCHES 0
#endif

#define LAS __attribute__((address_space(3)))
typedef unsigned short bf16_t;
typedef short bf16x8 __attribute__((ext_vector_type(8)));
typedef float f32x4 __attribute__((ext_vector_type(4)));
typedef float f32x2 __attribute__((ext_vector_type(2)));
typedef unsigned u32x4 __attribute__((ext_vector_type(4)));
typedef unsigned u32x2 __attribute__((ext_vector_type(2)));

constexpr int BATCH = 8, SEQ = 2048, D = 1024, DEPTH = 4, M = BATCH * SEQ;
constexpr int NH = 8, DK = 64, DV = 128, NQKVO = 3072, NIN = 3088, FF = 2816, GU = 2 * FF, CH = 64, NCH = SEQ / CH;
constexpr int NITEM = BATCH * NH * NCH;
constexpr int STE = (DV + 1) * DK;
constexpr float EPS = 1e-6f, SOFTCAP = 15.0f;

__device__ __forceinline__ unsigned cvt_pk_bf16(float lo, float hi) { unsigned r; asm volatile("v_cvt_pk_bf16_f32 %0, %1, %2" : "=v"(r) : "v"(lo), "v"(hi)); return r; }
__device__ __forceinline__ float bf2f(unsigned short u) { return __uint_as_float((unsigned)u << 16); }
__device__ __forceinline__ float bflo(unsigned u) { return __uint_as_float(u << 16); }
__device__ __forceinline__ float bfhi(unsigned u) { return __uint_as_float(u & 0xffff0000u); }
__device__ __forceinline__ unsigned short f2bf(float f) { unsigned u = __float_as_uint(f); return (unsigned short)((u + 0x7fffu + ((u >> 16) & 1u)) >> 16); }

namespace pg8 {
constexpr int BM = 256, BK = 64, HALF = 128, HTB = HALF * BK * 2, STAGE_BYTES = 8 * HTB, NXCD = 8, WGM = 8;
__host__ __device__ __forceinline__ int lds_byte(int r, int c) { const int st = (r >> 4) * 2 + (c >> 5), rr = r & 15, cc = c & 31, ob = rr * 64 + cc * 2; return st * 1024 + (ob ^ (((ob >> 9) & 1) << 5)); }
__host__ __device__ __forceinline__ void stage_rc(int b, int& R, int& C) { const int st = b / 1024, sb = b % 1024, swz = sb ^ (((sb >> 9) & 1) << 5); R = (st >> 1) * 16 + swz / 64; C = (st & 1) * 32 + (swz % 64) / 2; }
__host__ __device__ __forceinline__ int perm32(int rho) { const int n = rho >> 4, i = rho & 15; return 8 * (i >> 2) + 4 * n + (i & 3); }

struct Unit { int pm, pn, idx; };
struct Gemm { const bf16_t* A; const bf16_t* Bt; };

struct Order {
    int nM, nN, nwg, G, c;
    const float* ssq;
    LAS float* tab;
    __device__ void init(int M_, int N, int G_, int c_, const float* ssq_, LAS float* tab_) { nM = M_ / BM; nN = N / BM; nwg = nM * nN; G = G_; c = c_; ssq = ssq_; tab = tab_; }
    __device__ bool next(int i, Unit& u) const {
        const long L = (long)i * G + c; if (L >= nwg) return false;
        int wgid = (int)L; { const int q = nwg / NXCD, r = nwg % NXCD, xcd = wgid % NXCD, off = wgid / NXCD; wgid = (xcd < r ? xcd * (q + 1) : r * (q + 1) + (xcd - r) * q) + off; }
        const int nig = WGM * nN, gid = wgid / nig, fm = gid * WGM, gsz = (nM - fm) < WGM ? (nM - fm) : WGM;
        u.pm = fm + ((wgid % nig) % gsz); u.pn = (wgid % nig) / gsz; u.idx = i; return true;
    }
    __device__ __forceinline__ void a_ready(const Unit& u) const {
        int t_ = threadIdx.x; asm volatile("" : "+v"(t_));
        if (ssq != nullptr && t_ < 256) {
            const f32x4* p = (const f32x4*)(ssq + (size_t)(u.pm * BM + t_) * 16);
            const f32x4 a = p[0], b = p[1], c4 = p[2], d = p[3];
            const float s = ((a[0] + a[1]) + (a[2] + a[3])) + ((b[0] + b[1]) + (b[2] + b[3])) + ((c4[0] + c4[1]) + (c4[2] + c4[3])) + ((d[0] + d[1]) + (d[2] + d[3]));
            tab[(u.idx & 1) * 256 + t_] = __builtin_amdgcn_rsqf(s * (1.0f / D) + EPS);
        }
    }
    __device__ __forceinline__ void done(const Unit&) const {}
};

__device__ __forceinline__ float sigmoidf_fast(float x) { return __builtin_amdgcn_rcpf(1.0f + __expf(-x)); }

struct EpiProj {
    static constexpr bool PERM = true;
    bf16_t* O; const LAS float* tab;
    __device__ __forceinline__ void operator()(const f32x4 (&acc)[2][2][4][2], const Unit& u, int wr, int wc, int fr, int fq) const {
        const LAS float* t = tab + (u.idx & 1) * 256;
        const bool sig = u.pn >= 8;
        const int row0 = u.pm * BM + wr * 64 + fr, col0 = u.pn * BM + wc * 32 + 8 * fq;
#pragma unroll
        for (int ai = 0; ai < 2; ++ai)
#pragma unroll
            for (int m = 0; m < 4; ++m) {
                const float rs = t[ai * HALF + wr * 64 + m * 16 + fr];
                bf16_t* rowp = O + (size_t)(row0 + ai * HALF + m * 16) * NQKVO + col0;
#pragma unroll
                for (int bj = 0; bj < 2; ++bj) {
                    f32x4 v0 = acc[ai][bj][m][0] * rs, v1 = acc[ai][bj][m][1] * rs;
                    if (sig) {
#pragma unroll
                        for (int i = 0; i < 4; ++i) { v0[i] = sigmoidf_fast(v0[i]); v1[i] = sigmoidf_fast(v1[i]); }
                    }
                    u32x4 w; w.x = cvt_pk_bf16(v0[0], v0[1]); w.y = cvt_pk_bf16(v0[2], v0[3]); w.z = cvt_pk_bf16(v1[0], v1[1]); w.w = cvt_pk_bf16(v1[2], v1[3]);
                    *(u32x4*)(rowp + bj * HALF) = w;
                }
            }
    }
};
struct EpiGU {
    static constexpr bool PERM = true;
    bf16_t* H; const LAS float* tab;
    __device__ __forceinline__ void operator()(const f32x4 (&acc)[2][2][4][2], const Unit& u, int wr, int wc, int fr, int fq) const {
        const LAS float* t = tab + (u.idx & 1) * 256;
        const int row0 = u.pm * BM + wr * 64 + fr, col0 = u.pn * HALF + wc * 32 + 8 * fq;
#pragma unroll
        for (int ai = 0; ai < 2; ++ai)
#pragma unroll
            for (int m = 0; m < 4; ++m) {
                const float rs = t[ai * HALF + wr * 64 + m * 16 + fr];
                float hv[8];
#pragma unroll
                for (int n = 0; n < 2; ++n)
#pragma unroll
                    for (int i = 0; i < 4; ++i) { const float g = acc[ai][0][m][n][i] * rs, uu = acc[ai][1][m][n][i] * rs; hv[n * 4 + i] = g * uu * sigmoidf_fast(g); }
                u32x4 w; w.x = cvt_pk_bf16(hv[0], hv[1]); w.y = cvt_pk_bf16(hv[2], hv[3]); w.z = cvt_pk_bf16(hv[4], hv[5]); w.w = cvt_pk_bf16(hv[6], hv[7]);
                *(u32x4*)(H + (size_t)(row0 + ai * HALF + m * 16) * FF + col0) = w;
            }
    }
};
struct EpiRes {
    static constexpr bool PERM = false;
    float* xf; bf16_t* xb; float* ssq_out;
    __device__ __forceinline__ void operator()(const f32x4 (&acc)[2][2][4][2], const Unit& u, int wr, int wc, int fr, int fq) const {
        const int row0 = u.pm * BM + wr * 64 + fr, col0 = u.pn * BM + wc * 32 + 4 * fq;
#pragma unroll
        for (int ai = 0; ai < 2; ++ai)
#pragma unroll
            for (int m = 0; m < 4; ++m) {
                const int row = row0 + ai * HALF + m * 16; float ss = 0.f;
#pragma unroll
                for (int bj = 0; bj < 2; ++bj)
#pragma unroll
                    for (int n = 0; n < 2; ++n) {
                        const size_t off = (size_t)row * D + col0 + bj * HALF + n * 16;
                        const f32x4 xn = *(const f32x4*)(xf + off) + acc[ai][bj][m][n];
                        *(f32x4*)(xf + off) = xn;
                        u32x2 w; w.x = cvt_pk_bf16(xn[0], xn[1]); w.y = cvt_pk_bf16(xn[2], xn[3]);
                        *(u32x2*)(xb + off) = w;
                        ss += (xn[0] * xn[0] + xn[1] * xn[1]) + (xn[2] * xn[2] + xn[3] * xn[3]);
                    }
                ss += __shfl_xor(ss, 16); ss += __shfl_xor(ss, 32);
                if (fq == 0) ssq_out[(size_t)row * 16 + u.pn * 4 + wc] = ss;
            }
    }
};

template <class Epi, bool ALIGN_EPI, int LDA, int LDB, int KLEN, int ACOL>
__device__ __forceinline__ void gemm_phase(LAS unsigned char* lds, const Gemm g, const Order& S, const Epi& E) {
    int tid_ = threadIdx.x; asm volatile("" : "+v"(tid_));
    const int tid = tid_, wid = __builtin_amdgcn_readfirstlane(tid >> 6), lane = tid & 63, wr = wid >> 2, wc = wid & 3, fr = lane & 15, fq = lane >> 4;
    constexpr int nt = KLEN / BK;
    unsigned voffA[2], voffB[2];
#pragma unroll
    for (int i = 0; i < 2; ++i) { int R, C; stage_rc(tid * 16 + i * 8192, R, C); const int Rb = Epi::PERM ? ((R & ~31) + perm32(R & 31)) : R;
        voffA[i] = (unsigned)(R * LDA + C) * 2u; voffB[i] = (unsigned)(Rb * LDB + C) * 2u; }
    constexpr size_t kstep = (size_t)(BK * 2);
    constexpr size_t hstepA = (size_t)HALF * LDA * 2, tstepA = 2 * hstepA, hstepB = (size_t)HALF * LDB * 2, tstepB = 2 * hstepB;
    constexpr size_t pnstepA = (size_t)ACOL * 2;
    const unsigned ldsw = (unsigned)wid * 1024u;
    const int aoff = lds_byte(wr * 64 + fr, fq * 8), boff = lds_byte(wc * 32 + fr, fq * 8);
#define PG8_SA(b, h) (((b) * 2 + (h)) * HTB)
#define PG8_SB(b, h) ((4 + (b) * 2 + (h)) * HTB)
#define PG8_STAGE(bufoff, gbase, voff) do { _Pragma("unroll") for (int _i = 0; _i < 2; ++_i) \
        __builtin_amdgcn_global_load_lds((const unsigned*)((const char*)(gbase) + (voff)[_i]), (LAS unsigned*)(lds + (bufoff) + ldsw + _i * 8192), 16, 0, 0); } while (0)
#define PG8_LDA(dst, b, h) do { _Pragma("unroll") for (int m = 0; m < 4; ++m) _Pragma("unroll") for (int k = 0; k < 2; ++k) dst[m][k] = *(const LAS bf16x8*)(lds + PG8_SA(b, h) + aoff + m * 2048 + k * 1024); } while (0)
#define PG8_LDB(dst, b, h) do { _Pragma("unroll") for (int n = 0; n < 2; ++n) _Pragma("unroll") for (int k = 0; k < 2; ++k) dst[n][k] = *(const LAS bf16x8*)(lds + PG8_SB(b, h) + boff + n * 2048 + k * 1024); } while (0)
#define PG8_MMA(ai, bj, At, Bt) do { __builtin_amdgcn_s_setprio(1); _Pragma("unroll") for (int m = 0; m < 4; ++m) _Pragma("unroll") for (int n = 0; n < 2; ++n) _Pragma("unroll") for (int k = 0; k < 2; ++k) \
        acc[ai][bj][m][n] = __builtin_amdgcn_mfma_f32_16x16x32_bf16(Bt[n][k], At[m][k], acc[ai][bj][m][n], 0, 0, 0); __builtin_amdgcn_s_setprio(0); } while (0)
#define PG8_WAIT_V(n) asm volatile("s_waitcnt vmcnt(" #n ")" ::: "memory")
#define PG8_WAIT_L(n) asm volatile("s_waitcnt lgkmcnt(" #n ")" ::: "memory")
#define PG8_BAR __builtin_amdgcn_s_barrier()
#define PG8_SCHED __builtin_amdgcn_sched_barrier(0)
    Unit cur, nxt; int ui = 0;
    if (!S.next(0, cur)) return;
    f32x4 acc[2][2][4][2];
#pragma unroll
    for (int a = 0; a < 2; ++a)
#pragma unroll
        for (int b = 0; b < 2; ++b)
#pragma unroll
            for (int m = 0; m < 4; ++m)
#pragma unroll
                for (int n = 0; n < 2; ++n) acc[a][b][m][n] = (f32x4){0.f, 0.f, 0.f, 0.f};
    bf16x8 At[4][2], B0[2][2], B1[2][2];
    const char* cA = (const char*)g.A + (size_t)cur.pm * tstepA + (size_t)cur.pn * pnstepA; const char* cB = (const char*)g.Bt + (size_t)cur.pn * tstepB;
    S.a_ready(cur);
    PG8_STAGE(PG8_SB(0, 0), cB, voffB); PG8_STAGE(PG8_SB(0, 1), cB + hstepB, voffB); PG8_STAGE(PG8_SA(0, 0), cA, voffA); PG8_STAGE(PG8_SA(0, 1), cA + hstepA, voffA);
    if (wr == 1) PG8_BAR;
    PG8_WAIT_V(2); PG8_BAR;
    PG8_STAGE(PG8_SB(1, 0), cB + kstep, voffB); PG8_STAGE(PG8_SA(1, 0), cA + kstep, voffA); PG8_STAGE(PG8_SB(1, 1), cB + hstepB + kstep, voffB);
    PG8_WAIT_V(6); PG8_BAR;
    for (;;) {
        const bool has_next = S.next(ui + 1, nxt);
        const char* nA = has_next ? (const char*)g.A + (size_t)nxt.pm * tstepA + (size_t)nxt.pn * pnstepA : cA; const char* nB = has_next ? (const char*)g.Bt + (size_t)nxt.pn * tstepB : cB;
#pragma unroll 1
        for (int t = 0; t < nt; t += 2) {
            const bool last = (t == nt - 2);
            const char* a1 = cA + (size_t)(t + 1) * kstep;
            const char* a2 = last ? nA : cA + (size_t)(t + 2) * kstep; const char* b2 = last ? nB : cB + (size_t)(t + 2) * kstep;
            const char* a3 = a2 + kstep; const char* b3 = b2 + kstep;
            if (last && has_next) S.a_ready(nxt);
            PG8_LDB(B0, 0, 0); PG8_LDB(B1, 0, 1); PG8_SCHED; PG8_LDA(At, 0, 0); PG8_STAGE(PG8_SA(1, 1), a1 + hstepA, voffA);
            PG8_WAIT_V(8); PG8_WAIT_L(0); PG8_BAR; PG8_MMA(0, 0, At, B0); PG8_MMA(0, 1, At, B1); PG8_BAR; PG8_SCHED;
            PG8_LDA(At, 0, 1); PG8_STAGE(PG8_SB(0, 0), b2, voffB); PG8_STAGE(PG8_SB(0, 1), b2 + hstepB, voffB); PG8_STAGE(PG8_SA(0, 0), a2, voffA);
            PG8_WAIT_V(8); PG8_WAIT_L(0); PG8_BAR; PG8_MMA(1, 0, At, B0); PG8_MMA(1, 1, At, B1); PG8_BAR; PG8_SCHED;
            PG8_LDB(B0, 1, 0); PG8_LDB(B1, 1, 1); PG8_SCHED; PG8_LDA(At, 1, 0); PG8_STAGE(PG8_SA(0, 1), a2 + hstepA, voffA);
            PG8_WAIT_V(8); PG8_WAIT_L(0); PG8_BAR; PG8_MMA(0, 0, At, B0); PG8_MMA(0, 1, At, B1); PG8_BAR; PG8_SCHED;
            PG8_LDA(At, 1, 1); PG8_STAGE(PG8_SB(1, 0), b3, voffB); PG8_STAGE(PG8_SB(1, 1), b3 + hstepB, voffB); PG8_STAGE(PG8_SA(1, 0), a3, voffA);
            PG8_WAIT_V(8); PG8_WAIT_L(0); PG8_BAR; PG8_MMA(1, 0, At, B0); PG8_MMA(1, 1, At, B1); PG8_BAR; PG8_SCHED;
        }
        if constexpr (ALIGN_EPI) { if (wr == 0) PG8_BAR; }
        E(acc, cur, wr, wc, fr, fq); S.done(cur);
        if (!has_next) break;
#pragma unroll
        for (int a = 0; a < 2; ++a)
#pragma unroll
            for (int b = 0; b < 2; ++b)
#pragma unroll
                for (int m = 0; m < 4; ++m)
#pragma unroll
                    for (int n = 0; n < 2; ++n) acc[a][b][m][n] = (f32x4){0.f, 0.f, 0.f, 0.f};
        cur = nxt; cA = nA; cB = nB; ++ui;
        if constexpr (ALIGN_EPI) { if (wr == 1) PG8_BAR; }
    }
    PG8_WAIT_V(0);
    if constexpr (!ALIGN_EPI) { if (wr == 0) PG8_BAR; }
    PG8_BAR;
#undef PG8_SA
#undef PG8_SB
#undef PG8_STAGE
#undef PG8_LDA
#undef PG8_LDB
#undef PG8_MMA
#undef PG8_WAIT_V
#undef PG8_WAIT_L
#undef PG8_BAR
#undef PG8_SCHED
}
}

constexpr size_t MiB = 1u << 20;
constexpr size_t WS_CTL = 0, CTL_ZERO_BYTES = 1 * MiB;
constexpr size_t SZ_WIN = (size_t)NQKVO * D * 2, SZ_WOUT = (size_t)D * D * 2, SZ_WPOOL = (size_t)D * 256 * 2, SZ_WGU = (size_t)GU * D * 2, SZ_WDN = (size_t)D * FF * 2, SZ_WG = (size_t)16 * D * 4;
constexpr size_t WS_WIN = 1 * MiB;
constexpr size_t WS_WOUT = WS_WIN + 2 * SZ_WIN;
constexpr size_t WS_WPOOL = WS_WOUT + 2 * SZ_WOUT;
constexpr size_t WS_WGU = WS_WPOOL + 2 * SZ_WPOOL;
constexpr size_t WS_WDN = WS_WGU + 4 * SZ_WGU;
constexpr size_t WS_WG = WS_WDN + 4 * SZ_WDN;
constexpr size_t WS_SSQ = WS_WG + 2 * SZ_WG;
constexpr size_t SZ_SSQ = (size_t)M * 16 * 4;
constexpr size_t WS_GATES = WS_SSQ + 9 * SZ_SSQ;
constexpr size_t WS_DECAY = WS_GATES + SZ_SSQ;
constexpr size_t WS_XB = ((WS_DECAY + NITEM * 4 + MiB - 1) / MiB) * MiB;
constexpr size_t WS_XF = WS_XB + (size_t)M * D * 2;
constexpr size_t WS_BIG = WS_XF + (size_t)M * D * 4;
constexpr size_t WS_ST = WS_BIG + (size_t)M * NQKVO * 2;
constexpr size_t WS_END = WS_ST + (size_t)NITEM * STE * 4;
static_assert(WS_END <= 352 * MiB, "d_ws map must fit the guaranteed workspace");
static_assert((size_t)M * FF * 2 <= (size_t)M * NQKVO * 2, "H overlays q|k|v|o");

constexpr int CW_BAR = 4096;
constexpr int RING_OFF = 0, RING_BYTES = 131072;
constexpr int LDSCTL_OFF = RING_BYTES, MISC_OFF = LDSCTL_OFF + 320;
constexpr int RSTD_OFF = RING_BYTES + 1024;
constexpr int LDS_BYTES = 147456;
constexpr int NWAVES = 8, NT = NWAVES * 64;

#define VM_WAIT() asm volatile("s_waitcnt vmcnt(0)" ::: "memory")
#define LDS_WAIT() asm volatile("s_waitcnt lgkmcnt(0)" ::: "memory")

#define XB_TMO      128
#define XB_XCNT(j)  (256  + 64 * (j))
#define XB_XSUB(j)  (1280 + 64 * (j))
#define XB_XGEN(j)  (2304 + 64 * (j))
#define XB_TOP      3328
#define XB_TOPGEN   3392
#define XCD_BAR_WORDS 3456
#define XB_SPIN_CAP (1u << 18)
__device__ __forceinline__ unsigned xb_ld(unsigned* p)              { return __hip_atomic_load(p, __ATOMIC_RELAXED, __HIP_MEMORY_SCOPE_AGENT); }
__device__ __forceinline__ unsigned xb_add(unsigned* p, unsigned v) { return __hip_atomic_fetch_add(p, v, __ATOMIC_RELAXED, __HIP_MEMORY_SCOPE_AGENT); }
__device__ __forceinline__ unsigned xb_xcc_id() { return (unsigned)__builtin_amdgcn_s_getreg((3 << 11) | 20) & 0xFu; }
#define XB_SPIN(cond, bar) do { unsigned _sp = 0; while (cond) { __builtin_amdgcn_s_sleep(1); \
    if ((++_sp & 255u) == 0u) { if (xb_ld(&(bar)[XB_TMO])) break; if (_sp > XB_SPIN_CAP) { atomicAdd(&(bar)[XB_TMO], 1u); break; } } } } while (0)
struct XcdBarrier { unsigned* bar; unsigned x; volatile LAS unsigned* st; };
__device__ __forceinline__ XcdBarrier xcd_barrier_post(unsigned* bar, volatile LAS unsigned* st) {
    XcdBarrier b; b.bar = bar; b.x = xb_xcc_id(); b.st = st;
    if (threadIdx.x == 0) (void)xb_add(&bar[XB_XCNT(b.x)], 1u);
    return b;
}
__device__ __forceinline__ void xcd_barrier_complete(unsigned* bar, unsigned x, unsigned& nloc, unsigned& nx) {
    const unsigned G = gridDim.x * gridDim.y * gridDim.z;
    unsigned sum, cnt, mine, sp = 0u;
    for (;;) {
        sum = 0u; cnt = 0u; mine = 0u;
#pragma unroll
        for (unsigned j = 0; j < 16; ++j) { const unsigned c = xb_ld(&bar[XB_XCNT(j)]); sum += c; cnt += (c > 0u) ? 1u : 0u; mine = (j == x) ? c : mine; }
        if (sum == G) break;
        __builtin_amdgcn_s_sleep(1);
        if ((++sp & 255u) == 0u) { if (xb_ld(&bar[XB_TMO])) break; if (sp > XB_SPIN_CAP) { atomicAdd(&bar[XB_TMO], 1u); break; } }
    }
    nloc = mine > 0u ? mine : 1u; nx = cnt > 0u ? cnt : 1u;
}
__device__ __forceinline__ void xcd_barrier(const XcdBarrier& b) {
    asm volatile("s_waitcnt vmcnt(0)" ::: "memory");
    __syncthreads();
    if (threadIdx.x == 0) {
        unsigned* bar = b.bar;
        __builtin_amdgcn_s_waitcnt(0);
        unsigned nloc = b.st[0], nx = b.st[1];
        if (nloc == 0u) { xcd_barrier_complete(bar, b.x, nloc, nx); b.st[0] = nloc; b.st[1] = nx; }
        const unsigned old = xb_add(&bar[XB_XSUB(b.x)], 1u);
        const unsigned gen = old / nloc;
        if (old + 1u == (gen + 1u) * nloc) {
            __builtin_amdgcn_fence(__ATOMIC_RELEASE, "agent");
            asm volatile("s_waitcnt vmcnt(0)" ::: "memory");
            const unsigned og = xb_add(&bar[XB_TOP], 1u);
            const unsigned tg = og / nx;
            if (og + 1u == (tg + 1u) * nx) xb_add(&bar[XB_TOPGEN], 1u);
            else XB_SPIN(xb_ld(&bar[XB_TOPGEN]) == tg, bar);
            __builtin_amdgcn_fence(__ATOMIC_ACQUIRE, "agent");
            xb_add(&bar[XB_XGEN(b.x)], 1u);
            asm volatile("s_waitcnt vmcnt(0)" ::: "memory");
        } else {
            XB_SPIN(xb_ld(&bar[XB_XGEN(b.x)]) == gen, bar);
            __builtin_amdgcn_fence(__ATOMIC_ACQUIRE, "agent");
            asm volatile("s_waitcnt vmcnt(0)" ::: "memory");
        }
    }
    __syncthreads();
}

__device__ __forceinline__ float wave_sum(float v) {
#pragma unroll
    for (int o = 1; o < 64; o <<= 1) v += __shfl_xor(v, o);
    return v;
}
__device__ __forceinline__ float log_sigmoidf(float x) { return fminf(x, 0.f) - log1pf(expf(-fabsf(x))); }
__device__ __forceinline__ float rstd_of(const float* ssq_row) {
    const f32x4* p = (const f32x4*)ssq_row; const f32x4 a = p[0], b = p[1], c = p[2], d = p[3];
    const float s = ((a[0] + a[1]) + (a[2] + a[3])) + ((b[0] + b[1]) + (b[2] + b[3])) + ((c[0] + c[1]) + (c[2] + c[3])) + ((d[0] + d[1]) + (d[2] + d[3]));
    return 1.0f / sqrtf(s * (1.0f / D) + EPS);
}

__device__ __forceinline__ void tr_item(const float* W, int ldW, int k0, int c0, bf16_t* WT, int ldT, int r0, const float* kg, const float* cg, float mul, LAS float* scr, int lane) {
    const int cc = lane & 31; const float cmul = (cg ? cg[c0 + cc] : 1.0f) * mul;
#pragma unroll 8
    for (int i = 0; i < 32; ++i) { const int kk = 2 * i + (lane >> 5); float v = W[(size_t)(k0 + kk) * ldW + c0 + cc] * cmul; if (kg) v *= kg[k0 + kk]; scr[kk * 33 + cc] = v; }
    LDS_WAIT(); asm volatile("" ::: "memory");
    const int c = lane & 7;
#pragma unroll
    for (int j = 0; j < 4; ++j) { const int n = (lane >> 3) + 8 * j; const LAS float* s = scr + (8 * c) * 33 + n;
        u32x4 o; o.x = cvt_pk_bf16(s[0 * 33], s[1 * 33]); o.y = cvt_pk_bf16(s[2 * 33], s[3 * 33]); o.z = cvt_pk_bf16(s[4 * 33], s[5 * 33]); o.w = cvt_pk_bf16(s[6 * 33], s[7 * 33]);
        *(u32x4*)(WT + (size_t)(r0 + n) * ldT + k0 + 8 * c) = o; }
    LDS_WAIT(); asm volatile("" ::: "memory");
}

struct Args { const float* in[12]; float* out; unsigned char* ws; int ph_lo, ph_hi; };
constexpr int N_PHASES = 24;

__global__ void __launch_bounds__(NT, 2) fwd_kernel(Args args) {
    extern __shared__ __attribute__((aligned(16))) unsigned char lds_raw[];
    LAS unsigned char* lds = (LAS unsigned char*)lds_raw;
    volatile LAS unsigned* MISC = (volatile LAS unsigned*)(lds + MISC_OFF);
    LAS float* rtab = (LAS float*)(lds + RSTD_OFF);
    int tid = threadIdx.x, lane = tid & 63, wave = __builtin_amdgcn_readfirstlane(tid >> 6);
#define FRESH_TID() do { tid = threadIdx.x; asm volatile("" : "+v"(tid)); lane = tid & 63; wave = __builtin_amdgcn_readfirstlane(tid >> 6); } while (0)
    const int G = gridDim.x, bid = blockIdx.x;
    unsigned char* const ws = args.ws;
#define x_in       (args.in[0])
#define norm_mix   (args.in[1])
#define norm_ffn   (args.in[2])
#define w_in       (args.in[3])
#define gate_bias  (args.in[4])
#define head_gain  (args.in[5])
#define w_out      (args.in[6])
#define pool_w     (args.in[7])
#define pool_scale (args.in[8])
#define w_gu       (args.in[9])
#define w_dn       (args.in[10])
#define final_norm (args.in[11])
#define Win_t   ((bf16_t*)(ws + WS_WIN))
#define Wout_t  ((bf16_t*)(ws + WS_WOUT))
#define Wpool_t ((bf16_t*)(ws + WS_WPOOL))
#define Wgu_t   ((bf16_t*)(ws + WS_WGU))
#define Wdn_t   ((bf16_t*)(ws + WS_WDN))
#define Wg      ((float*)(ws + WS_WG))
#define ssq     ((float*)(ws + WS_SSQ))
#define gates   ((float*)(ws + WS_GATES))
#define decay   ((float*)(ws + WS_DECAY))
#define xb      ((bf16_t*)(ws + WS_XB))
#define xf      ((float*)(ws + WS_XF))
#define BIG     ((bf16_t*)(ws + WS_BIG))
#define ST      ((float*)(ws + WS_ST))

    for (int u = tid; u < (LDS_BYTES - LDSCTL_OFF) / 4; u += NT) ((LAS unsigned*)(lds + LDSCTL_OFF))[u] = 0u;
    __syncthreads();
    XcdBarrier bar; bar.bar = (unsigned*)(ws + WS_CTL) + CW_BAR; bar.x = 0; bar.st = nullptr;
    if (MK_N_LAUNCHES == 1) bar = xcd_barrier_post((unsigned*)(ws + WS_CTL) + CW_BAR, MISC + 8);

    const int lo = args.ph_lo, hi = args.ph_hi;
    int ph = 0;
#define IN_PH() (lo <= ph && ph < hi)
#define BEGIN_PH() FRESH_TID()
#define END_PH() do { if (lo <= ph && ph + 1 < hi) xcd_barrier(bar); ++ph; } while (0)

    if (IN_PH()) { BEGIN_PH();
        LAS float* scr = (LAS float*)(lds + RING_OFF + wave * 16384);
        const int gw = bid * NWAVES + wave, NGW = G * NWAVES;
        constexpr int I_IN = 16 * 96, I_OUT = 16 * 32, I_POOL = 4 * 4 * 8, I_GU = 16 * 176, I_DN = 44 * 32;
        constexpr int NITEMS = 2 * I_IN + 2 * I_OUT + 2 * I_POOL + 4 * I_GU + 4 * I_DN;
        for (int it = gw; it < NITEMS; it += NGW) {
            int r = it;
            if (r < 2 * I_IN) { const int l = r / I_IN; r -= l * I_IN; const int kb = r / 96, nb = r % 96, r0 = nb * 32;
                tr_item(w_in + (size_t)l * D * NIN, NIN, kb * 64, r0, Win_t + (size_t)l * NQKVO * D, D, r0, norm_mix + (2 * l) * D, nullptr, (r0 >= 512 && r0 < 1024) ? 0.125f : 1.0f, scr, lane); continue; }
            r -= 2 * I_IN;
            if (r < 2 * I_OUT) { const int l = r / I_OUT; r -= l * I_OUT; const int kb = r / 32, nb = r % 32;
                tr_item(w_out + (size_t)l * D * D, D, kb * 64, nb * 32, Wout_t + (size_t)l * D * D, D, nb * 32, head_gain + l * D, nullptr, 1.0f, scr, lane); continue; }
            r -= 2 * I_OUT;
            if (r < 2 * I_POOL) { const int l = r / I_POOL; r -= l * I_POOL; const int gi = r / 32; r -= gi * 32; const int kb = r / 8, nb = r % 8;
                tr_item(pool_w + (size_t)(l * 4 + gi) * 256 * 256, 256, kb * 64, nb * 32, Wpool_t + (size_t)l * D * 256 + (size_t)gi * 256 * 256, 256, nb * 32,
                        norm_mix + (2 * l + 1) * D + gi * 256, pool_scale + l * D + gi * 256, 1.0f, scr, lane); continue; }
            r -= 2 * I_POOL;
            if (r < 4 * I_GU) { const int l = r / I_GU; r -= l * I_GU; const int kb = r / 176, nb = r % 176, r0 = nb * 32, pn = r0 >> 8, j = r0 & 255;
                const int c0 = (j < 128) ? pn * 128 + j : FF + pn * 128 + (j - 128);
                tr_item(w_gu + (size_t)l * D * GU, GU, kb * 64, c0, Wgu_t + (size_t)l * GU * D, D, r0, norm_ffn + l * D, nullptr, 1.0f, scr, lane); continue; }
            r -= 4 * I_GU;
            { const int l = r / I_DN; r -= l * I_DN; const int kb = r / 32, nb = r % 32;
                tr_item(w_dn + (size_t)l * FF * D, D, kb * 64, nb * 32, Wdn_t + (size_t)l * D * FF, FF, nb * 32, nullptr, nullptr, 1.0f, scr, lane); }
        }
        for (int e = bid * NT + tid; e < 2 * 16 * D; e += G * NT) { const int l = e / (16 * D), rem = e % (16 * D), k = rem >> 4, j = rem & 15;
            Wg[(size_t)l * 16 * D + j * D + k] = w_in[(size_t)l * D * NIN + (size_t)k * NIN + NQKVO + j] * norm_mix[(2 * l) * D + k]; }
        for (int m = gw; m < M; m += NGW) {
            const f32x4* xr = (const f32x4*)(x_in + (size_t)m * D) + lane; f32x4 v[4]; float s = 0.f;
#pragma unroll
            for (int j = 0; j < 4; ++j) { v[j] = xr[64 * j]; s += (v[j][0] * v[j][0] + v[j][1] * v[j][1]) + (v[j][2] * v[j][2] + v[j][3] * v[j][3]); }
            s = wave_sum(s);
#pragma unroll
            for (int j = 0; j < 4; ++j) { ((f32x4*)(xf + (size_t)m * D))[64 * j + lane] = v[j];
                u32x2 w; w.x = cvt_pk_bf16(v[j][0], v[j][1]); w.y = cvt_pk_bf16(v[j][2], v[j][3]); ((u32x2*)(xb + (size_t)m * D))[64 * j + lane] = w; }
            if (lane < 16) ssq[(size_t)m * 16 + lane] = (lane == 0) ? s : 0.f;
        }
    }
    END_PH();

    for (int layer = 0; layer < DEPTH; ++layer) {
        const int slot = layer >> 1;
        float* ssq_a = ssq + (size_t)(2 * layer) * M * 16;
        float* ssq_b = ssq_a + (size_t)M * 16;
        float* ssq_c = ssq_b + (size_t)M * 16;
        if ((layer & 1) == 0) {
            if (IN_PH()) { BEGIN_PH();
                const float* wg = Wg + (size_t)slot * 16 * D;
                for (int rb = bid; rb < M / 64; rb += G) {
                    const int row = rb * 64 + (tid >> 3), j2 = tid & 7;
                    const float rs = rstd_of(ssq_a + (size_t)row * 16);
                    const u32x4* xr = (const u32x4*)(xb + (size_t)row * D);
                    const f32x4* w0 = (const f32x4*)(wg + (size_t)(2 * j2) * D); const f32x4* w1 = (const f32x4*)(wg + (size_t)(2 * j2 + 1) * D);
                    float a0 = 0.f, a1 = 0.f;
                    for (int k8 = 0; k8 < D / 8; ++k8) {
                        const u32x4 xv = xr[k8]; const f32x4 p0 = w0[2 * k8], p1 = w0[2 * k8 + 1], q0 = w1[2 * k8], q1 = w1[2 * k8 + 1];
                        const float x0 = bflo(xv.x), x1 = bfhi(xv.x), x2 = bflo(xv.y), x3 = bfhi(xv.y), x4 = bflo(xv.z), x5 = bfhi(xv.z), x6 = bflo(xv.w), x7 = bfhi(xv.w);
                        a0 += x0 * p0[0] + x1 * p0[1] + x2 * p0[2] + x3 * p0[3] + x4 * p1[0] + x5 * p1[1] + x6 * p1[2] + x7 * p1[3];
                        a1 += x0 * q0[0] + x1 * q0[1] + x2 * q0[2] + x3 * q0[3] + x4 * q1[0] + x5 * q1[1] + x6 * q1[2] + x7 * q1[3];
                    }
                    const float g0 = a0 * rs + gate_bias[slot * 16 + 2 * j2], g1 = a1 * rs + gate_bias[slot * 16 + 2 * j2 + 1];
                    gates[(size_t)row * 16 + 2 * j2] = SOFTCAP * tanhf(g0 * (1.0f / SOFTCAP)); gates[(size_t)row * 16 + 2 * j2 + 1] = SOFTCAP * tanhf(g1 * (1.0f / SOFTCAP));
                }
                pg8::Gemm g{xb, Win_t + (size_t)slot * NQKVO * D}; pg8::Order S; S.init(M, NQKVO, G, bid, ssq_a, rtab);
                pg8::EpiProj E{BIG, rtab};
                pg8::gemm_phase<pg8::EpiProj, true, D, D, D, 0>(lds + RING_OFF, g, S, E);
            }
            END_PH();
            if (IN_PH()) { BEGIN_PH();
                LAS float* kw = (LAS float*)lds; LAS float* vf = kw + 64 * 65; LAS float* wv = vf + 64 * 129;
                for (int item = bid; item < NITEM; item += G) {
                    const int b = item >> 8, h = (item >> 5) & 7, c = item & 31, row0 = b * SEQ + c * CH;
                    __syncthreads();
                    if (wave == 0) {
                        const float f = gates[(size_t)(row0 + lane) * 16 + 8 + h], ig = gates[(size_t)(row0 + lane) * 16 + h];
                        float s = log_sigmoidf(f);
#pragma unroll
                        for (int o = 1; o < 64; o <<= 1) { const float t = __shfl_up(s, o); if (lane >= o) s += t; }
                        const float bl = __shfl(s, 63);
                        wv[lane] = expf(bl - s + ig);
                        if (lane == 63) decay[item] = expf(bl);
                    }
                    __syncthreads();
                    for (int e = tid; e < 64 * 64; e += NT) { const int r = e >> 6, d = e & 63; kw[r * 65 + d] = bf2f(BIG[(size_t)(row0 + r) * NQKVO + 512 + h * DK + d]) * wv[r]; }
                    for (int e = tid; e < 64 * 128; e += NT) { const int r = e >> 7, v = e & 127; vf[r * 129 + v] = bf2f(BIG[(size_t)(row0 + r) * NQKVO + 1024 + h * DV + v]); }
                    __syncthreads();
                    float acc[16]; float accn = 0.f;
#pragma unroll
                    for (int j = 0; j < 16; ++j) acc[j] = 0.f;
                    for (int r = 0; r < 64; ++r) { const float kk = kw[r * 65 + lane];
#pragma unroll
                        for (int j = 0; j < 16; ++j) acc[j] += vf[r * 129 + wave * 16 + j] * kk;
                        accn += kk; }
                    float* st = ST + (size_t)item * STE;
#pragma unroll
                    for (int j = 0; j < 16; ++j) st[(wave * 16 + j) * 64 + lane] = acc[j];
                    if (wave == 0) st[128 * 64 + lane] = accn;
                }
            }
            END_PH();
            if (IN_PH()) { BEGIN_PH();
                for (int e = bid * NT + tid; e < BATCH * NH * STE; e += G * NT) {
                    const int bh = e / STE, el = e % STE; float st = 0.f;
                    for (int c = 0; c < NCH; ++c) { const size_t idx = (size_t)(bh * NCH + c) * STE + el; const float u = ST[idx]; ST[idx] = st; st = decay[bh * NCH + c] * st + u; }
                }
            }
            END_PH();
            if (IN_PH()) { BEGIN_PH();
                LAS float* qf = (LAS float*)lds; LAS float* kf = qf + 64 * 65; LAS float* vf = kf + 64 * 65; LAS float* Cf = vf + 64 * 129; LAS float* P = Cf + 129 * 65; LAS float* bv = P + 64 * 65; LAS float* iv = bv + 64;
                for (int item = bid; item < NITEM; item += G) {
                    const int b = item >> 8, h = (item >> 5) & 7, c = item & 31, row0 = b * SEQ + c * CH;
                    __syncthreads();
                    if (wave == 0) {
                        const float f = gates[(size_t)(row0 + lane) * 16 + 8 + h], ig = gates[(size_t)(row0 + lane) * 16 + h];
                        float s = log_sigmoidf(f);
#pragma unroll
                        for (int o = 1; o < 64; o <<= 1) { const float t = __shfl_up(s, o); if (lane >= o) s += t; }
                        bv[lane] = s; iv[lane] = ig;
                    }
                    for (int e = tid; e < 64 * 64; e += NT) { const int r = e >> 6, d = e & 63; qf[r * 65 + d] = bf2f(BIG[(size_t)(row0 + r) * NQKVO + h * DK + d]); kf[r * 65 + d] = bf2f(BIG[(size_t)(row0 + r) * NQKVO + 512 + h * DK + d]); }
                    for (int e = tid; e < 64 * 128; e += NT) { const int r = e >> 7, v = e & 127; vf[r * 129 + v] = bf2f(BIG[(size_t)(row0 + r) * NQKVO + 1024 + h * DV + v]); }
                    { const float* st = ST + (size_t)item * STE; for (int e = tid; e < STE; e += NT) { const int v = e >> 6, d = e & 63; Cf[v * 65 + d] = st[e]; } }
                    __syncthreads();
                    { const int s = tid >> 3, rg = tid & 7; float sa[8];
#pragma unroll
                        for (int j = 0; j < 8; ++j) sa[j] = 0.f;
                        for (int d = 0; d < 64; ++d) { const float qv = qf[s * 65 + d];
#pragma unroll
                            for (int j = 0; j < 8; ++j) sa[j] += qv * kf[(rg * 8 + j) * 65 + d]; }
                        const float bs = bv[s];
#pragma unroll
                        for (int j = 0; j < 8; ++j) { const int r = rg * 8 + j; P[s * 65 + r] = (r <= s) ? sa[j] * expf(bs - bv[r] + iv[r]) : 0.f; } }
                    __syncthreads();
                    for (int js = 0; js < 8; ++js) {
                        const int s = wave * 8 + js; float a0 = 0.f, a1 = 0.f, ad = 0.f, c0 = 0.f, c1 = 0.f, cd = 0.f;
                        for (int r = 0; r <= s; ++r) { const float p = P[s * 65 + r]; a0 += p * vf[r * 129 + lane]; a1 += p * vf[r * 129 + lane + 64]; ad += p; }
                        for (int d = 0; d < 64; ++d) { const float qv = qf[s * 65 + d]; c0 += qv * Cf[lane * 65 + d]; c1 += qv * Cf[(lane + 64) * 65 + d]; cd += qv * Cf[128 * 65 + d]; }
                        const float eb = expf(bv[s]); const float den = ad + eb * cd, dd = fmaxf(fabsf(den), 1.0f);
                        const float h0 = (a0 + eb * c0) / dd, h1 = (a1 + eb * c1) / dd;
                        const float ms = wave_sum(h0 * h0 + h1 * h1) * (1.0f / DV); const float rs = 1.0f / sqrtf(ms + EPS);
                        bf16_t* op = BIG + (size_t)(row0 + s) * NQKVO + 2048 + h * DV;
                        const float o0 = bf2f(op[lane]), o1 = bf2f(op[lane + 64]);
                        op[lane] = f2bf(h0 * rs * o0); op[lane + 64] = f2bf(h1 * rs * o1);
                    }
                }
            }
            END_PH();
        } else {
            if (IN_PH()) { BEGIN_PH();
                LAS float* rsv = (LAS float*)lds;
                for (int item = bid; item < BATCH * (SEQ / 64); item += G) {
                    const int b = item >> 5, t0 = (item & 31) * 64;
                    __syncthreads();
                    if (tid < 80) { const int t = t0 - 16 + tid; rsv[tid] = (t >= 0) ? rstd_of(ssq_a + (size_t)(b * SEQ + t) * 16) : 0.f; }
                    __syncthreads();
                    const int w = 2 << (tid >> 7);
                    const unsigned* xcol = (const unsigned*)(xb + (size_t)b * SEQ * D) + tid;
                    unsigned* ycol = (unsigned*)(BIG + (size_t)b * SEQ * D) + tid;
                    for (int t = t0; t < t0 + 64; ++t) {
                        float s0 = 0.f, s1 = 0.f; const int jlo = (t - w + 1 > 0) ? t - w + 1 : 0;
                        for (int j = jlo; j <= t; ++j) { const unsigned xv = xcol[(size_t)j * (D / 2)]; const float r = rsv[j - t0 + 16]; s0 += bflo(xv) * r; s1 += bfhi(xv) * r; }
                        const unsigned xv = xcol[(size_t)t * (D / 2)]; const float r = rsv[t - t0 + 16]; const float inv = 1.0f / (float)(t - jlo + 1);
                        ycol[(size_t)t * (D / 2)] = cvt_pk_bf16(s0 * inv - bflo(xv) * r, s1 * inv - bfhi(xv) * r);
                    }
                }
            }
            END_PH();
        }
        if (IN_PH()) { BEGIN_PH();
            pg8::Order S; S.init(M, D, G, bid, nullptr, rtab);
            pg8::EpiRes E{xf, xb, ssq_b};
            if ((layer & 1) == 0) { pg8::Gemm g{BIG + 2048, Wout_t + (size_t)slot * D * D}; pg8::gemm_phase<pg8::EpiRes, false, NQKVO, D, D, 0>(lds + RING_OFF, g, S, E); }
            else                  { pg8::Gemm g{BIG, Wpool_t + (size_t)slot * D * 256};      pg8::gemm_phase<pg8::EpiRes, false, D, 256, 256, 256>(lds + RING_OFF, g, S, E); }
        }
        END_PH();
        if (IN_PH()) { BEGIN_PH();
            pg8::Gemm g{xb, Wgu_t + (size_t)layer * GU * D}; pg8::Order S; S.init(M, GU, G, bid, ssq_b, rtab);
            pg8::EpiGU E{BIG, rtab};
            pg8::gemm_phase<pg8::EpiGU, true, D, D, D, 0>(lds + RING_OFF, g, S, E);
        }
        END_PH();
        if (IN_PH()) { BEGIN_PH();
            pg8::Gemm g{BIG, Wdn_t + (size_t)layer * D * FF}; pg8::Order S; S.init(M, D, G, bid, nullptr, rtab);
            pg8::EpiRes E{xf, xb, ssq_c};
            pg8::gemm_phase<pg8::EpiRes, false, FF, FF, FF, 0>(lds + RING_OFF, g, S, E);
        }
        END_PH();
    }
    if (IN_PH()) { BEGIN_PH();
        const int gw = bid * NWAVES + wave, NGW = G * NWAVES;
        for (int m = gw; m < M; m += NGW) {
            const f32x4* xr = (const f32x4*)(xf + (size_t)m * D) + lane; f32x4 v[4]; float s = 0.f;
#pragma unroll
            for (int j = 0; j < 4; ++j) { v[j] = xr[64 * j]; s += (v[j][0] * v[j][0] + v[j][1] * v[j][1]) + (v[j][2] * v[j][2] + v[j][3] * v[j][3]); }
            const float rs = 1.0f / sqrtf(wave_sum(s) * (1.0f / D) + EPS);
#pragma unroll
            for (int j = 0; j < 4; ++j) { const f32x4 gn = ((const f32x4*)final_norm)[64 * j + lane]; ((f32x4*)(args.out + (size_t)m * D))[64 * j + lane] = v[j] * rs * gn; }
        }
    }
#undef IN_PH
#undef END_PH
}

extern "C" void kernel_launch(void* const* d_in, const int* in_sizes, int n_in, void* d_out, int out_size, void* d_ws, size_t ws_size, hipStream_t stream) {
    static int grid = 0;
    if (grid == 0) {
        if (n_in != 12 || in_sizes[0] != M * D || out_size != M * D || ws_size < WS_END) { fprintf(stderr, "kernel_launch: unexpected shapes / workspace (n_in %d, ws %zu, need %zu)\n", n_in, ws_size, (size_t)WS_END); grid = -1; return; }
        int dev = 0, cus = 0, per_cu = 0;
        if (hipGetDevice(&dev) != hipSuccess || hipDeviceGetAttribute(&cus, hipDeviceAttributeMultiprocessorCount, dev) != hipSuccess) { grid = -1; return; }
        if (hipFuncSetAttribute((const void*)fwd_kernel, hipFuncAttributeMaxDynamicSharedMemorySize, LDS_BYTES) != hipSuccess) { fprintf(stderr, "kernel_launch: hipFuncSetAttribute failed\n"); grid = -1; return; }
        if (hipOccupancyMaxActiveBlocksPerMultiprocessor(&per_cu, (const void*)fwd_kernel, NT, LDS_BYTES) != hipSuccess || per_cu < 1) { fprintf(stderr, "kernel_launch: occupancy query says %d blocks per CU\n", per_cu); grid = -1; (void)hipGetLastError(); return; }
        grid = cus;
    }
    if (grid < 0) return;
    Args a{};
    for (int i = 0; i < 12; ++i) a.in[i] = (const float*)d_in[i];
    a.out = (float*)d_out; a.ws = (unsigned char*)d_ws;
#if MK_N_LAUNCHES == 1
    (void)hipMemsetAsync((char*)d_ws + WS_CTL, 0, CTL_ZERO_BYTES, stream);
    a.ph_lo = 0; a.ph_hi = N_PHASES;
    void* kargs[] = {&a};
    hipError_t e = hipLaunchCooperativeKernel((const void*)fwd_kernel, dim3(grid), dim3(NT), kargs, LDS_BYTES, stream);
    if (e != hipSuccess) fprintf(stderr, "cooperative launch failed: %s (grid %d)\n", hipGetErrorString(e), grid);
#else
    for (int p = 0; p < N_PHASES; ++p) {
        a.ph_lo = p; a.ph_hi = p + 1;
        hipLaunchKernelGGL(fwd_kernel, dim3(grid), dim3(NT), LDS_BYTES, stream, a);
    }
#endif
}
```

```cpp
#include <hip/hip_runtime.h>
#include <cstdio>
#include <cstdint>

#ifndef MK_N_LAUNCHES
#define MK_N_LAUNCHES 1
#endif

#define LAS __attribute__((address_space(3)))
typedef unsigned short bf16_t;
typedef short bf16x8 __attribute__((ext_vector_type(8)));
typedef float f32x4 __attribute__((ext_vector_type(4)));
typedef float f32x2 __attribute__((ext_vector_type(2)));
typedef unsigned u32x4 __attribute__((ext_vector_type(4)));
typedef unsigned u32x2 __attribute__((ext_vector_type(2)));

constexpr int BATCH = 8, SEQ = 2048, D = 1024, DEPTH = 4, M = BATCH * SEQ;
constexpr int NH = 8, DK = 64, DV = 128, NQKVO = 3072, NIN = 3088, FF = 2816, GU = 2 * FF, CH = 64, NCH = SEQ / CH;
constexpr int NITEM = BATCH * NH * NCH;
constexpr int STE = (DV + 1) * DK;
constexpr float EPS = 1e-6f, SOFTCAP = 15.0f;

__device__ __forceinline__ unsigned cvt_pk_bf16(float lo, float hi) { unsigned r; asm volatile("v_cvt_pk_bf16_f32 %0, %1, %2" : "=v"(r) : "v"(lo), "v"(hi)); return r; }
__device__ __forceinline__ float bf2f(unsigned short u) { return __uint_as_float((unsigned)u << 16); }
__device__ __forceinline__ float bflo(unsigned u) { return __uint_as_float(u << 16); }
__device__ __forceinline__ float bfhi(unsigned u) { return __uint_as_float(u & 0xffff0000u); }
__device__ __forceinline__ unsigned short f2bf(float f) { unsigned u = __float_as_uint(f); return (unsigned short)((u + 0x7fffu + ((u >> 16) & 1u)) >> 16); }

namespace pg8 {
constexpr int BM = 256, BK = 64, HALF = 128, HTB = HALF * BK * 2, STAGE_BYTES = 8 * HTB, NXCD = 8, WGM = 8;
__host__ __device__ __forceinline__ int lds_byte(int r, int c) { const int st = (r >> 4) * 2 + (c >> 5), rr = r & 15, cc = c & 31, ob = rr * 64 + cc * 2; return st * 1024 + (ob ^ (((ob >> 9) & 1) << 5)); }
__host__ __device__ __forceinline__ void stage_rc(int b, int& R, int& C) { const int st = b / 1024, sb = b % 1024, swz = sb ^ (((sb >> 9) & 1) << 5); R = (st >> 1) * 16 + swz / 64; C = (st & 1) * 32 + (swz % 64) / 2; }
__host__ __device__ __forceinline__ int perm32(int rho) { const int n = rho >> 4, i = rho & 15; return 8 * (i >> 2) + 4 * n + (i & 3); }

struct Unit { int pm, pn, idx; };
struct Gemm { const bf16_t* A; const bf16_t* Bt; };

struct Order {
    int nM, nN, nwg, G, c;
    const float* ssq;
    LAS float* tab;
    __device__ void init(int M_, int N, int G_, int c_, const float* ssq_, LAS float* tab_) { nM = M_ / BM; nN = N / BM; nwg = nM * nN; G = G_; c = c_; ssq = ssq_; tab = tab_; }
    __device__ bool next(int i, Unit& u) const {
        const long L = (long)i * G + c; if (L >= nwg) return false;
        int wgid = (int)L; { const int q = nwg / NXCD, r = nwg % NXCD, xcd = wgid % NXCD, off = wgid / NXCD; wgid = (xcd < r ? xcd * (q + 1) : r * (q + 1) + (xcd - r) * q) + off; }
        const int nig = WGM * nN, gid = wgid / nig, fm = gid * WGM, gsz = (nM - fm) < WGM ? (nM - fm) : WGM;
        u.pm = fm + ((wgid % nig) % gsz); u.pn = (wgid % nig) / gsz; u.idx = i; return true;
    }
    __device__ __forceinline__ void a_ready(const Unit& u) const {
        int t_ = threadIdx.x; asm volatile("" : "+v"(t_));
        if (ssq != nullptr && t_ < 256) {
            const f32x4* p = (const f32x4*)(ssq + (size_t)(u.pm * BM + t_) * 16);
            const f32x4 a = p[0], b = p[1], c4 = p[2], d = p[3];
            const float s = ((a[0] + a[1]) + (a[2] + a[3])) + ((b[0] + b[1]) + (b[2] + b[3])) + ((c4[0] + c4[1]) + (c4[2] + c4[3])) + ((d[0] + d[1]) + (d[2] + d[3]));
            tab[(u.idx & 1) * 256 + t_] = __builtin_amdgcn_rsqf(s * (1.0f / D) + EPS);
        }
    }
    __device__ __forceinline__ void done(const Unit&) const {}
};

__device__ __forceinline__ float sigmoidf_fast(float x) { return __builtin_amdgcn_rcpf(1.0f + __expf(-x)); }

struct EpiProj {
    static constexpr bool PERM = true;
    bf16_t* O; const LAS float* tab;
    __device__ __forceinline__ void operator()(const f32x4 (&acc)[2][2][4][2], const Unit& u, int wr, int wc, int fr, int fq) const {
        const LAS float* t = tab + (u.idx & 1) * 256;
        const bool sig = u.pn >= 8;
        const int row0 = u.pm * BM + wr * 64 + fr, col0 = u.pn * BM + wc * 32 + 8 * fq;
#pragma unroll
        for (int ai = 0; ai < 2; ++ai)
#pragma unroll
            for (int m = 0; m < 4; ++m) {
                const float rs = t[ai * HALF + wr * 64 + m * 16 + fr];
                bf16_t* rowp = O + (size_t)(row0 + ai * HALF + m * 16) * NQKVO + col0;
#pragma unroll
                for (int bj = 0; bj < 2; ++bj) {
                    f32x4 v0 = acc[ai][bj][m][0] * rs, v1 = acc[ai][bj][m][1] * rs;
                    if (sig) {
#pragma unroll
                        for (int i = 0; i < 4; ++i) { v0[i] = sigmoidf_fast(v0[i]); v1[i] = sigmoidf_fast(v1[i]); }
                    }
                    u32x4 w; w.x = cvt_pk_bf16(v0[0], v0[1]); w.y = cvt_pk_bf16(v0[2], v0[3]); w.z = cvt_pk_bf16(v1[0], v1[1]); w.w = cvt_pk_bf16(v1[2], v1[3]);
                    *(u32x4*)(rowp + bj * HALF) = w;
                }
            }
    }
};
struct EpiGU {
    static constexpr bool PERM = true;
    bf16_t* H; const LAS float* tab;
    __device__ __forceinline__ void operator()(const f32x4 (&acc)[2][2][4][2], const Unit& u, int wr, int wc, int fr, int fq) const {
        const LAS float* t = tab + (u.idx & 1) * 256;
        const int row0 = u.pm * BM + wr * 64 + fr, col0 = u.pn * HALF + wc * 32 + 8 * fq;
#pragma unroll
        for (int ai = 0; ai < 2; ++ai)
#pragma unroll
            for (int m = 0; m < 4; ++m) {
                const float rs = t[ai * HALF + wr * 64 + m * 16 + fr];
                float hv[8];
#pragma unroll
                for (int n = 0; n < 2; ++n)
#pragma unroll
                    for (int i = 0; i < 4; ++i) { const float g = acc[ai][0][m][n][i] * rs, uu = acc[ai][1][m][n][i] * rs; hv[n * 4 + i] = g * uu * sigmoidf_fast(g); }
                u32x4 w; w.x = cvt_pk_bf16(hv[0], hv[1]); w.y = cvt_pk_bf16(hv[2], hv[3]); w.z = cvt_pk_bf16(hv[4], hv[5]); w.w = cvt_pk_bf16(hv[6], hv[7]);
                *(u32x4*)(H + (size_t)(row0 + ai * HALF + m * 16) * FF + col0) = w;
            }
    }
};
struct EpiRes {
    static constexpr bool PERM = false;
    float* xf; bf16_t* xb; float* ssq_out;
    __device__ __forceinline__ void operator()(const f32x4 (&acc)[2][2][4][2], const Unit& u, int wr, int wc, int fr, int fq) const {
        const int row0 = u.pm * BM + wr * 64 + fr, col0 = u.pn * BM + wc * 32 + 4 * fq;
#pragma unroll
        for (int ai = 0; ai < 2; ++ai)
#pragma unroll
            for (int m = 0; m < 4; ++m) {
                const int row = row0 + ai * HALF + m * 16; float ss = 0.f;
#pragma unroll
                for (int bj = 0; bj < 2; ++bj)
#pragma unroll
                    for (int n = 0; n < 2; ++n) {
                        const size_t off = (size_t)row * D + col0 + bj * HALF + n * 16;
                        const f32x4 xn = *(const f32x4*)(xf + off) + acc[ai][bj][m][n];
                        *(f32x4*)(xf + off) = xn;
                        u32x2 w; w.x = cvt_pk_bf16(xn[0], xn[1]); w.y = cvt_pk_bf16(xn[2], xn[3]);
                        *(u32x2*)(xb + off) = w;
                        ss += (xn[0] * xn[0] + xn[1] * xn[1]) + (xn[2] * xn[2] + xn[3] * xn[3]);
                    }
                ss += __shfl_xor(ss, 16); ss += __shfl_xor(ss, 32);
                if (fq == 0) ssq_out[(size_t)row * 16 + u.pn * 4 + wc] = ss;
            }
    }
};

template <class Epi, bool ALIGN_EPI, int LDA, int LDB, int KLEN, int ACOL>
__device__ __forceinline__ void gemm_phase(LAS unsigned char* lds, const Gemm g, const Order& S, const Epi& E) {
    int tid_ = threadIdx.x; asm volatile("" : "+v"(tid_));
    const int tid = tid_, wid = __builtin_amdgcn_readfirstlane(tid >> 6), lane = tid & 63, wr = wid >> 2, wc = wid & 3, fr = lane & 15, fq = lane >> 4;
    constexpr int nt = KLEN / BK;
    unsigned voffA[2], voffB[2];
#pragma unroll
    for (int i = 0; i < 2; ++i) { int R, C; stage_rc(tid * 16 + i * 8192, R, C); const int Rb = Epi::PERM ? ((R & ~31) + perm32(R & 31)) : R;
        voffA[i] = (unsigned)(R * LDA + C) * 2u; voffB[i] = (unsigned)(Rb * LDB + C) * 2u; }
    constexpr size_t kstep = (size_t)(BK * 2);
    constexpr size_t hstepA = (size_t)HALF * LDA * 2, tstepA = 2 * hstepA, hstepB = (size_t)HALF * LDB * 2, tstepB = 2 * hstepB;
    constexpr size_t pnstepA = (size_t)ACOL * 2;
    const unsigned ldsw = (unsigned)wid * 1024u;
    const int aoff = lds_byte(wr * 64 + fr, fq * 8), boff = lds_byte(wc * 32 + fr, fq * 8);
#define PG8_SA(b, h) (((b) * 2 + (h)) * HTB)
#define PG8_SB(b, h) ((4 + (b) * 2 + (h)) * HTB)
#define PG8_STAGE(bufoff, gbase, voff) do { _Pragma("unroll") for (int _i = 0; _i < 2; ++_i) \
        __builtin_amdgcn_global_load_lds((const unsigned*)((const char*)(gbase) + (voff)[_i]), (LAS unsigned*)(lds + (bufoff) + ldsw + _i * 8192), 16, 0, 0); } while (0)
#define PG8_LDA(dst, b, h) do { _Pragma("unroll") for (int m = 0; m < 4; ++m) _Pragma("unroll") for (int k = 0; k < 2; ++k) dst[m][k] = *(const LAS bf16x8*)(lds + PG8_SA(b, h) + aoff + m * 2048 + k * 1024); } while (0)
#define PG8_LDB(dst, b, h) do { _Pragma("unroll") for (int n = 0; n < 2; ++n) _Pragma("unroll") for (int k = 0; k < 2; ++k) dst[n][k] = *(const LAS bf16x8*)(lds + PG8_SB(b, h) + boff + n * 2048 + k * 1024); } while (0)
#define PG8_MMA(ai, bj, At, Bt) do { __builtin_amdgcn_s_setprio(1); _Pragma("unroll") for (int m = 0; m < 4; ++m) _Pragma("unroll") for (int n = 0; n < 2; ++n) _Pragma("unroll") for (int k = 0; k < 2; ++k) \
        acc[ai][bj][m][n] = __builtin_amdgcn_mfma_f32_16x16x32_bf16(Bt[n][k], At[m][k], acc[ai][bj][m][n], 0, 0, 0); __builtin_amdgcn_s_setprio(0); } while (0)
#define PG8_WAIT_V(n) asm volatile("s_waitcnt vmcnt(" #n ")" ::: "memory")
#define PG8_WAIT_L(n) asm volatile("s_waitcnt lgkmcnt(" #n ")" ::: "memory")
#define PG8_BAR __builtin_amdgcn_s_barrier()
#define PG8_SCHED __builtin_amdgcn_sched_barrier(0)
    Unit cur, nxt; int ui = 0;
    if (!S.next(0, cur)) return;
    f32x4 acc[2][2][4][2];
#pragma unroll
    for (int a = 0; a < 2; ++a)
#pragma unroll
        for (int b = 0; b < 2; ++b)
#pragma unroll
            for (int m = 0; m < 4; ++m)
#pragma unroll
                for (int n = 0; n < 2; ++n) acc[a][b][m][n] = (f32x4){0.f, 0.f, 0.f, 0.f};
    bf16x8 At[4][2], B0[2][2], B1[2][2];
    const char* cA = (const char*)g.A + (size_t)cur.pm * tstepA + (size_t)cur.pn * pnstepA; const char* cB = (const char*)g.Bt + (size_t)cur.pn * tstepB;
    S.a_ready(cur);
    PG8_STAGE(PG8_SB(0, 0), cB, voffB); PG8_STAGE(PG8_SB(0, 1), cB + hstepB, voffB); PG8_STAGE(PG8_SA(0, 0), cA, voffA); PG8_STAGE(PG8_SA(0, 1), cA + hstepA, voffA);
    if (wr == 1) PG8_BAR;
    PG8_WAIT_V(2); PG8_BAR;
    PG8_STAGE(PG8_SB(1, 0), cB + kstep, voffB); PG8_STAGE(PG8_SA(1, 0), cA + kstep, voffA); PG8_STAGE(PG8_SB(1, 1), cB + hstepB + kstep, voffB);
    PG8_WAIT_V(6); PG8_BAR;
    for (;;) {
        const bool has_next = S.next(ui + 1, nxt);
        const char* nA = has_next ? (const char*)g.A + (size_t)nxt.pm * tstepA + (size_t)nxt.pn * pnstepA : cA; const char* nB = has_next ? (const char*)g.Bt + (size_t)nxt.pn * tstepB : cB;
#pragma unroll 1
        for (int t = 0; t < nt; t += 2) {
            const bool last = (t == nt - 2);
            const char* a1 = cA + (size_t)(t + 1) * kstep;
            const char* a2 = last ? nA : cA + (size_t)(t + 2) * kstep; const char* b2 = last ? nB : cB + (size_t)(t + 2) * kstep;
            const char* a3 = a2 + kstep; const char* b3 = b2 + kstep;
            if (last && has_next) S.a_ready(nxt);
            PG8_LDB(B0, 0, 0); PG8_LDB(B1, 0, 1); PG8_SCHED; PG8_LDA(At, 0, 0); PG8_STAGE(PG8_SA(1, 1), a1 + hstepA, voffA);
            PG8_WAIT_V(8); PG8_WAIT_L(0); PG8_BAR; PG8_MMA(0, 0, At, B0); PG8_MMA(0, 1, At, B1); PG8_BAR; PG8_SCHED;
            PG8_LDA(At, 0, 1); PG8_STAGE(PG8_SB(0, 0), b2, voffB); PG8_STAGE(PG8_SB(0, 1), b2 + hstepB, voffB); PG8_STAGE(PG8_SA(0, 0), a2, voffA);
            PG8_WAIT_V(8); PG8_WAIT_L(0); PG8_BAR; PG8_MMA(1, 0, At, B0); PG8_MMA(1, 1, At, B1); PG8_BAR; PG8_SCHED;
            PG8_LDB(B0, 1, 0); PG8_LDB(B1, 1, 1); PG8_SCHED; PG8_LDA(At, 1, 0); PG8_STAGE(PG8_SA(0, 1), a2 + hstepA, voffA);
            PG8_WAIT_V(8); PG8_WAIT_L(0); PG8_BAR; PG8_MMA(0, 0, At, B0); PG8_MMA(0, 1, At, B1); PG8_BAR; PG8_SCHED;
            PG8_LDA(At, 1, 1); PG8_STAGE(PG8_SB(1, 0), b3, voffB); PG8_STAGE(PG8_SB(1, 1), b3 + hstepB, voffB); PG8_STAGE(PG8_SA(1, 0), a3, voffA);
            PG8_WAIT_V(8); PG8_WAIT_L(0); PG8_BAR; PG8_MMA(1, 0, At, B0); PG8_MMA(1, 1, At, B1); PG8_BAR; PG8_SCHED;
        }
        if constexpr (ALIGN_EPI) { if (wr == 0) PG8_BAR; }
        E(acc, cur, wr, wc, fr, fq); S.done(cur);
        if (!has_next) break;
#pragma unroll
        for (int a = 0; a < 2; ++a)
#pragma unroll
            for (int b = 0; b < 2; ++b)
#pragma unroll
                for (int m = 0; m < 4; ++m)
#pragma unroll
                    for (int n = 0; n < 2; ++n) acc[a][b][m][n] = (f32x4){0.f, 0.f, 0.f, 0.f};
        cur = nxt; cA = nA; cB = nB; ++ui;
        if constexpr (ALIGN_EPI) { if (wr == 1) PG8_BAR; }
    }
    PG8_WAIT_V(0);
    if constexpr (!ALIGN_EPI) { if (wr == 0) PG8_BAR; }
    PG8_BAR;
#undef PG8_SA
#undef PG8_SB
#undef PG8_STAGE
#undef PG8_LDA
#undef PG8_LDB
#undef PG8_MMA
#undef PG8_WAIT_V
#undef PG8_WAIT_L
#undef PG8_BAR
#undef PG8_SCHED
}
}

constexpr size_t MiB = 1u << 20;
constexpr size_t WS_CTL = 0, CTL_ZERO_BYTES = 1 * MiB;
constexpr size_t SZ_WIN = (size_t)NQKVO * D * 2, SZ_WOUT = (size_t)D * D * 2, SZ_WPOOL = (size_t)D * 256 * 2, SZ_WGU = (size_t)GU * D * 2, SZ_WDN = (size_t)D * FF * 2, SZ_WG = (size_t)16 * D * 4;
constexpr size_t WS_WIN = 1 * MiB;
constexpr size_t WS_WOUT = WS_WIN + 2 * SZ_WIN;
constexpr size_t WS_WPOOL = WS_WOUT + 2 * SZ_WOUT;
constexpr size_t WS_WGU = WS_WPOOL + 2 * SZ_WPOOL;
constexpr size_t WS_WDN = WS_WGU + 4 * SZ_WGU;
constexpr size_t WS_WG = WS_WDN + 4 * SZ_WDN;
constexpr size_t WS_SSQ = WS_WG + 2 * SZ_WG;
constexpr size_t SZ_SSQ = (size_t)M * 16 * 4;
constexpr size_t WS_GATES = WS_SSQ + 9 * SZ_SSQ;
constexpr size_t WS_DECAY = WS_GATES + SZ_SSQ;
constexpr size_t WS_XB = ((WS_DECAY + NITEM * 4 + MiB - 1) / MiB) * MiB;
constexpr size_t WS_XF = WS_XB + (size_t)M * D * 2;
constexpr size_t WS_BIG = WS_XF + (size_t)M * D * 4;
constexpr size_t WS_ST = WS_BIG + (size_t)M * NQKVO * 2;
constexpr size_t WS_END = WS_ST + (size_t)NITEM * STE * 4;
static_assert(WS_END <= 352 * MiB, "d_ws map must fit the guaranteed workspace");
static_assert((size_t)M * FF * 2 <= (size_t)M * NQKVO * 2, "H overlays q|k|v|o");

constexpr int CW_BAR = 4096;
constexpr int RING_OFF = 0, RING_BYTES = 131072;
constexpr int LDSCTL_OFF = RING_BYTES, MISC_OFF = LDSCTL_OFF + 320;
constexpr int RSTD_OFF = RING_BYTES + 1024;
constexpr int LDS_BYTES = 147456;
constexpr int NWAVES = 8, NT = NWAVES * 64;

#define VM_WAIT() asm volatile("s_waitcnt vmcnt(0)" ::: "memory")
#define LDS_WAIT() asm volatile("s_waitcnt lgkmcnt(0)" ::: "memory")

#define XB_TMO      128
#define XB_XCNT(j)  (256  + 64 * (j))
#define XB_XSUB(j)  (1280 + 64 * (j))
#define XB_XGEN(j)  (2304 + 64 * (j))
#define XB_TOP      3328
#define XB_TOPGEN   3392
#define XCD_BAR_WORDS 3456
#define XB_SPIN_CAP (1u << 18)
__device__ __forceinline__ unsigned xb_ld(unsigned* p)              { return __hip_atomic_load(p, __ATOMIC_RELAXED, __HIP_MEMORY_SCOPE_AGENT); }
__device__ __forceinline__ unsigned xb_add(unsigned* p, unsigned v) { return __hip_atomic_fetch_add(p, v, __ATOMIC_RELAXED, __HIP_MEMORY_SCOPE_AGENT); }
__device__ __forceinline__ unsigned xb_xcc_id() { return (unsigned)__builtin_amdgcn_s_getreg((3 << 11) | 20) & 0xFu; }
#define XB_SPIN(cond, bar) do { unsigned _sp = 0; while (cond) { __builtin_amdgcn_s_sleep(1); \
    if ((++_sp & 255u) == 0u) { if (xb_ld(&(bar)[XB_TMO])) break; if (_sp > XB_SPIN_CAP) { atomicAdd(&(bar)[XB_TMO], 1u); break; } } } } while (0)
struct XcdBarrier { unsigned* bar; unsigned x; volatile LAS unsigned* st; };
__device__ __forceinline__ XcdBarrier xcd_barrier_post(unsigned* bar, volatile LAS unsigned* st) {
    XcdBarrier b; b.bar = bar; b.x = xb_xcc_id(); b.st = st;
    if (threadIdx.x == 0) (void)xb_add(&bar[XB_XCNT(b.x)], 1u);
    return b;
}
__device__ __forceinline__ void xcd_barrier_complete(unsigned* bar, unsigned x, unsigned& nloc, unsigned& nx) {
    const unsigned G = gridDim.x * gridDim.y * gridDim.z;
    unsigned sum, cnt, mine, sp = 0u;
    for (;;) {
        sum = 0u; cnt = 0u; mine = 0u;
#pragma unroll
        for (unsigned j = 0; j < 16; ++j) { const unsigned c = xb_ld(&bar[XB_XCNT(j)]); sum += c; cnt += (c > 0u) ? 1u : 0u; mine = (j == x) ? c : mine; }
        if (sum == G) break;
        __builtin_amdgcn_s_sleep(1);
        if ((++sp & 255u) == 0u) { if (xb_ld(&bar[XB_TMO])) break; if (sp > XB_SPIN_CAP) { atomicAdd(&bar[XB_TMO], 1u); break; } }
    }
    nloc = mine > 0u ? mine : 1u; nx = cnt > 0u ? cnt : 1u;
}
__device__ __forceinline__ void xcd_barrier(const XcdBarrier& b) {
    asm volatile("s_waitcnt vmcnt(0)" ::: "memory");
    __syncthreads();
    if (threadIdx.x == 0) {
        unsigned* bar = b.bar;
        __builtin_amdgcn_s_waitcnt(0);
        unsigned nloc = b.st[0], nx = b.st[1];
        if (nloc == 0u) { xcd_barrier_complete(bar, b.x, nloc, nx); b.st[0] = nloc; b.st[1] = nx; }
        const unsigned old = xb_add(&bar[XB_XSUB(b.x)], 1u);
        const unsigned gen = old / nloc;
        if (old + 1u == (gen + 1u) * nloc) {
            __builtin_amdgcn_fence(__ATOMIC_RELEASE, "agent");
            asm volatile("s_waitcnt vmcnt(0)" ::: "memory");
            const unsigned og = xb_add(&bar[XB_TOP], 1u);
            const unsigned tg = og / nx;
            if (og + 1u == (tg + 1u) * nx) xb_add(&bar[XB_TOPGEN], 1u);
            else XB_SPIN(xb_ld(&bar[XB_TOPGEN]) == tg, bar);
            __builtin_amdgcn_fence(__ATOMIC_ACQUIRE, "agent");
            xb_add(&bar[XB_XGEN(b.x)], 1u);
            asm volatile("s_waitcnt vmcnt(0)" ::: "memory");
        } else {
            XB_SPIN(xb_ld(&bar[XB_XGEN(b.x)]) == gen, bar);
            __builtin_amdgcn_fence(__ATOMIC_ACQUIRE, "agent");
            asm volatile("s_waitcnt vmcnt(0)" ::: "memory");
        }
    }
    __syncthreads();
}

__device__ __forceinline__ float wave_sum(float v) {
#pragma unroll
    for (int o = 1; o < 64; o <<= 1) v += __shfl_xor(v, o);
    return v;
}
__device__ __forceinline__ float log_sigmoidf(float x) { return fminf(x, 0.f) - log1pf(expf(-fabsf(x))); }
__device__ __forceinline__ float rstd_of(const float* ssq_row) {
    const f32x4* p = (const f32x4*)ssq_row; const f32x4 a = p[0], b = p[1], c = p[2], d = p[3];
    const float s = ((a[0] + a[1]) + (a[2] + a[3])) + ((b[0] + b[1]) + (b[2] + b[3])) + ((c[0] + c[1]) + (c[2] + c[3])) + ((d[0] + d[1]) + (d[2] + d[3]));
    return 1.0f / sqrtf(s * (1.0f / D) + EPS);
}

__device__ __forceinline__ void tr_item(const float* W, int ldW, int k0, int c0, bf16_t* WT, int ldT, int r0, const float* kg, const float* cg, float mul, LAS float* scr, int lane) {
    const int cc = lane & 31; const float cmul = (cg ? cg[c0 + cc] : 1.0f) * mul;
#pragma unroll 8
    for (int i = 0; i < 32; ++i) { const int kk = 2 * i + (lane >> 5); float v = W[(size_t)(k0 + kk) * ldW + c0 + cc] * cmul; if (kg) v *= kg[k0 + kk]; scr[kk * 33 + cc] = v; }
    LDS_WAIT(); asm volatile("" ::: "memory");
    const int c = lane & 7;
#pragma unroll
    for (int j = 0; j < 4; ++j) { const int n = (lane >> 3) + 8 * j; const LAS float* s = scr + (8 * c) * 33 + n;
        u32x4 o; o.x = cvt_pk_bf16(s[0 * 33], s[1 * 33]); o.y = cvt_pk_bf16(s[2 * 33], s[3 * 33]); o.z = cvt_pk_bf16(s[4 * 33], s[5 * 33]); o.w = cvt_pk_bf16(s[6 * 33], s[7 * 33]);
        *(u32x4*)(WT + (size_t)(r0 + n) * ldT + k0 + 8 * c) = o; }
    LDS_WAIT(); asm volatile("" ::: "memory");
}

struct Args { const float* in[12]; float* out; unsigned char* ws; int ph_lo, ph_hi; };
constexpr int N_PHASES = 24;

__global__ void __launch_bounds__(NT, 2) fwd_kernel(Args args) {
    extern __shared__ __attribute__((aligned(16))) unsigned char lds_raw[];
    LAS unsigned char* lds = (LAS unsigned char*)lds_raw;
    volatile LAS unsigned* MISC = (volatile LAS unsigned*)(lds + MISC_OFF);
    LAS float* rtab = (LAS float*)(lds + RSTD_OFF);
    int tid = threadIdx.x, lane = tid & 63, wave = __builtin_amdgcn_readfirstlane(tid >> 6);
#define FRESH_TID() do { tid = threadIdx.x; asm volatile("" : "+v"(tid)); lane = tid & 63; wave = __builtin_amdgcn_readfirstlane(tid >> 6); } while (0)
    const int G = gridDim.x, bid = blockIdx.x;
    unsigned char* const ws = args.ws;
#define x_in       (args.in[0])
#define norm_mix   (args.in[1])
#define norm_ffn   (args.in[2])
#define w_in       (args.in[3])
#define gate_bias  (args.in[4])
#define head_gain  (args.in[5])
#define w_out      (args.in[6])
#define pool_w     (args.in[7])
#define pool_scale (args.in[8])
#define w_gu       (args.in[9])
#define w_dn       (args.in[10])
#define final_norm (args.in[11])
#define Win_t   ((bf16_t*)(ws + WS_WIN))
#define Wout_t  ((bf16_t*)(ws + WS_WOUT))
#define Wpool_t ((bf16_t*)(ws + WS_WPOOL))
#define Wgu_t   ((bf16_t*)(ws + WS_WGU))
#define Wdn_t   ((bf16_t*)(ws + WS_WDN))
#define Wg      ((float*)(ws + WS_WG))
#define ssq     ((float*)(ws + WS_SSQ))
#define gates   ((float*)(ws + WS_GATES))
#define decay   ((float*)(ws + WS_DECAY))
#define xb      ((bf16_t*)(ws + WS_XB))
#define xf      ((float*)(ws + WS_XF))
#define BIG     ((bf16_t*)(ws + WS_BIG))
#define ST      ((float*)(ws + WS_ST))

    for (int u = tid; u < (LDS_BYTES - LDSCTL_OFF) / 4; u += NT) ((LAS unsigned*)(lds + LDSCTL_OFF))[u] = 0u;
    __syncthreads();
    XcdBarrier bar; bar.bar = (unsigned*)(ws + WS_CTL) + CW_BAR; bar.x = 0; bar.st = nullptr;
    if (MK_N_LAUNCHES == 1) bar = xcd_barrier_post((unsigned*)(ws + WS_CTL) + CW_BAR, MISC + 8);

    const int lo = args.ph_lo, hi = args.ph_hi;
    int ph = 0;
#define IN_PH() (lo <= ph && ph < hi)
#define BEGIN_PH() FRESH_TID()
#define END_PH() do { if (lo <= ph && ph + 1 < hi) xcd_barrier(bar); ++ph; } while (0)

    if (IN_PH()) { BEGIN_PH();
        LAS float* scr = (LAS float*)(lds + RING_OFF + wave * 16384);
        const int gw = bid * NWAVES + wave, NGW = G * NWAVES;
        constexpr int I_IN = 16 * 96, I_OUT = 16 * 32, I_POOL = 4 * 4 * 8, I_GU = 16 * 176, I_DN = 44 * 32;
        constexpr int NITEMS = 2 * I_IN + 2 * I_OUT + 2 * I_POOL + 4 * I_GU + 4 * I_DN;
        for (int it = gw; it < NITEMS; it += NGW) {
            int r = it;
            if (r < 2 * I_IN) { const int l = r / I_IN; r -= l * I_IN; const int kb = r / 96, nb = r % 96, r0 = nb * 32;
                tr_item(w_in + (size_t)l * D * NIN, NIN, kb * 64, r0, Win_t + (size_t)l * NQKVO * D, D, r0, norm_mix + (2 * l) * D, nullptr, (r0 >= 512 && r0 < 1024) ? 0.125f : 1.0f, scr, lane); continue; }
            r -= 2 * I_IN;
            if (r < 2 * I_OUT) { const int l = r / I_OUT; r -= l * I_OUT; const int kb = r / 32, nb = r % 32;
                tr_item(w_out + (size_t)l * D * D, D, kb * 64, nb * 32, Wout_t + (size_t)l * D * D, D, nb * 32, head_gain + l * D, nullptr, 1.0f, scr, lane); continue; }
            r -= 2 * I_OUT;
            if (r < 2 * I_POOL) { const int l = r / I_POOL; r -= l * I_POOL; const int gi = r / 32; r -= gi * 32; const int kb = r / 8, nb = r % 8;
                tr_item(pool_w + (size_t)(l * 4 + gi) * 256 * 256, 256, kb * 64, nb * 32, Wpool_t + (size_t)l * D * 256 + (size_t)gi * 256 * 256, 256, nb * 32,
                        norm_mix + (2 * l + 1) * D + gi * 256, pool_scale + l * D + gi * 256, 1.0f, scr, lane); continue; }
            r -= 2 * I_POOL;
            if (r < 4 * I_GU) { const int l = r / I_GU; r -= l * I_GU; const int kb = r / 176, nb = r % 176, r0 = nb * 32, pn = r0 >> 8, j = r0 & 255;
                const int c0 = (j < 128) ? pn * 128 + j : FF + pn * 128 + (j - 128);
                tr_item(w_gu + (size_t)l * D * GU, GU, kb * 64, c0, Wgu_t + (size_t)l * GU * D, D, r0, norm_ffn + l * D, nullptr, 1.0f, scr, lane); continue; }
            r -= 4 * I_GU;
            { const int l = r / I_DN; r -= l * I_DN; const int kb = r / 32, nb = r % 32;
                tr_item(w_dn + (size_t)l * FF * D, D, kb * 64, nb * 32, Wdn_t + (size_t)l * D * FF, FF, nb * 32, nullptr, nullptr, 1.0f, scr, lane); }
        }
        for (int e = bid * NT + tid; e < 2 * 16 * D; e += G * NT) { const int l = e / (16 * D), rem = e % (16 * D), k = rem >> 4, j = rem & 15;
            Wg[(size_t)l * 16 * D + j * D + k] = w_in[(size_t)l * D * NIN + (size_t)k * NIN + NQKVO + j] * norm_mix[(2 * l) * D + k]; }
        for (int m = gw; m < M; m += NGW) {
            const f32x4* xr = (const f32x4*)(x_in + (size_t)m * D) + lane; f32x4 v[4]; float s = 0.f;
#pragma unroll
            for (int j = 0; j < 4; ++j) { v[j] = xr[64 * j]; s += (v[j][0] * v[j][0] + v[j][1] * v[j][1]) + (v[j][2] * v[j][2] + v[j][3] * v[j][3]); }
            s = wave_sum(s);
#pragma unroll
            for (int j = 0; j < 4; ++j) { ((f32x4*)(xf + (size_t)m * D))[64 * j + lane] = v[j];
                u32x2 w; w.x = cvt_pk_bf16(v[j][0], v[j][1]); w.y = cvt_pk_bf16(v[j][2], v[j][3]); ((u32x2*)(xb + (size_t)m * D))[64 * j + lane] = w; }
            if (lane < 16) ssq[(size_t)m * 16 + lane] = (lane == 0) ? s : 0.f;
        }
    }
    END_PH();

    for (int layer = 0; layer < DEPTH; ++layer) {
        const int slot = layer >> 1;
        float* ssq_a = ssq + (size_t)(2 * layer) * M * 16;
        float* ssq_b = ssq_a + (size_t)M * 16;
        float* ssq_c = ssq_b + (size_t)M * 16;
        if ((layer & 1) == 0) {
            if (IN_PH()) { BEGIN_PH();
                const float* wg = Wg + (size_t)slot * 16 * D;
                for (int rb = bid; rb < M / 64; rb += G) {
                    const int row = rb * 64 + (tid >> 3), j2 = tid & 7;
                    const float rs = rstd_of(ssq_a + (size_t)row * 16);
                    const u32x4* xr = (const u32x4*)(xb + (size_t)row * D);
                    const f32x4* w0 = (const f32x4*)(wg + (size_t)(2 * j2) * D); const f32x4* w1 = (const f32x4*)(wg + (size_t)(2 * j2 + 1) * D);
                    float a0 = 0.f, a1 = 0.f;
                    for (int k8 = 0; k8 < D / 8; ++k8) {
                        const u32x4 xv = xr[k8]; const f32x4 p0 = w0[2 * k8], p1 = w0[2 * k8 + 1], q0 = w1[2 * k8], q1 = w1[2 * k8 + 1];
                        const float x0 = bflo(xv.x), x1 = bfhi(xv.x), x2 = bflo(xv.y), x3 = bfhi(xv.y), x4 = bflo(xv.z), x5 = bfhi(xv.z), x6 = bflo(xv.w), x7 = bfhi(xv.w);
                        a0 += x0 * p0[0] + x1 * p0[1] + x2 * p0[2] + x3 * p0[3] + x4 * p1[0] + x5 * p1[1] + x6 * p1[2] + x7 * p1[3];
                        a1 += x0 * q0[0] + x1 * q0[1] + x2 * q0[2] + x3 * q0[3] + x4 * q1[0] + x5 * q1[1] + x6 * q1[2] + x7 * q1[3];
                    }
                    const float g0 = a0 * rs + gate_bias[slot * 16 + 2 * j2], g1 = a1 * rs + gate_bias[slot * 16 + 2 * j2 + 1];
                    gates[(size_t)row * 16 + 2 * j2] = SOFTCAP * tanhf(g0 * (1.0f / SOFTCAP)); gates[(size_t)row * 16 + 2 * j2 + 1] = SOFTCAP * tanhf(g1 * (1.0f / SOFTCAP));
                }
                pg8::Gemm g{xb, Win_t + (size_t)slot * NQKVO * D}; pg8::Order S; S.init(M, NQKVO, G, bid, ssq_a, rtab);
                pg8::EpiProj E{BIG, rtab};
                pg8::gemm_phase<pg8::EpiProj, true, D, D, D, 0>(lds + RING_OFF, g, S, E);
            }
            END_PH();
            if (IN_PH()) { BEGIN_PH();
                LAS float* kw = (LAS float*)lds; LAS float* vf = kw + 64 * 65; LAS float* wv = vf + 64 * 129;
                for (int item = bid; item < NITEM; item += G) {
                    const int b = item >> 8, h = (item >> 5) & 7, c = item & 31, row0 = b * SEQ + c * CH;
                    __syncthreads();
                    if (wave == 0) {
                        const float f = gates[(size_t)(row0 + lane) * 16 + 8 + h], ig = gates[(size_t)(row0 + lane) * 16 + h];
                        float s = log_sigmoidf(f);
#pragma unroll
                        for (int o = 1; o < 64; o <<= 1) { const float t = __shfl_up(s, o); if (lane >= o) s += t; }
                        const float bl = __shfl(s, 63);
                        wv[lane] = expf(bl - s + ig);
                        if (lane == 63) decay[item] = expf(bl);
                    }
                    __syncthreads();
                    for (int e = tid; e < 64 * 64; e += NT) { const int r = e >> 6, d = e & 63; kw[r * 65 + d] = bf2f(BIG[(size_t)(row0 + r) * NQKVO + 512 + h * DK + d]) * wv[r]; }
                    for (int e = tid; e < 64 * 128; e += NT) { const int r = e >> 7, v = e & 127; vf[r * 129 + v] = bf2f(BIG[(size_t)(row0 + r) * NQKVO + 1024 + h * DV + v]); }
                    __syncthreads();
                    float acc[16]; float accn = 0.f;
#pragma unroll
                    for (int j = 0; j < 16; ++j) acc[j] = 0.f;
                    for (int r = 0; r < 64; ++r) { const float kk = kw[r * 65 + lane];
#pragma unroll
                        for (int j = 0; j < 16; ++j) acc[j] += vf[r * 129 + wave * 16 + j] * kk;
                        accn += kk; }
                    float* st = ST + (size_t)item * STE;
#pragma unroll
                    for (int j = 0; j < 16; ++j) st[(wave * 16 + j) * 64 + lane] = acc[j];
                    if (wave == 0) st[128 * 64 + lane] = accn;
                }
            }
            END_PH();
            if (IN_PH()) { BEGIN_PH();
                for (int e = bid * NT + tid; e < BATCH * NH * STE; e += G * NT) {
                    const int bh = e / STE, el = e % STE; float st = 0.f;
                    for (int c = 0; c < NCH; ++c) { const size_t idx = (size_t)(bh * NCH + c) * STE + el; const float u = ST[idx]; ST[idx] = st; st = decay[bh * NCH + c] * st + u; }
                }
            }
            END_PH();
            if (IN_PH()) { BEGIN_PH();
                LAS float* qf = (LAS float*)lds; LAS float* kf = qf + 64 * 65; LAS float* vf = kf + 64 * 65; LAS float* Cf = vf + 64 * 129; LAS float* P = Cf + 129 * 65; LAS float* bv = P + 64 * 65; LAS float* iv = bv + 64;
                for (int item = bid; item < NITEM; item += G) {
                    const int b = item >> 8, h = (item >> 5) & 7, c = item & 31, row0 = b * SEQ + c * CH;
                    __syncthreads();
                    if (wave == 0) {
                        const float f = gates[(size_t)(row0 + lane) * 16 + 8 + h], ig = gates[(size_t)(row0 + lane) * 16 + h];
                        float s = log_sigmoidf(f);
#pragma unroll
                        for (int o = 1; o < 64; o <<= 1) { const float t = __shfl_up(s, o); if (lane >= o) s += t; }
                        bv[lane] = s; iv[lane] = ig;
                    }
                    for (int e = tid; e < 64 * 64; e += NT) { const int r = e >> 6, d = e & 63; qf[r * 65 + d] = bf2f(BIG[(size_t)(row0 + r) * NQKVO + h * DK + d]); kf[r * 65 + d] = bf2f(BIG[(size_t)(row0 + r) * NQKVO + 512 + h * DK + d]); }
                    for (int e = tid; e < 64 * 128; e += NT) { const int r = e >> 7, v = e & 127; vf[r * 129 + v] = bf2f(BIG[(size_t)(row0 + r) * NQKVO + 1024 + h * DV + v]); }
                    { const float* st = ST + (size_t)item * STE; for (int e = tid; e < STE; e += NT) { const int v = e >> 6, d = e & 63; Cf[v * 65 + d] = st[e]; } }
                    __syncthreads();
                    { const int s = tid >> 3, rg = tid & 7; float sa[8];
#pragma unroll
                        for (int j = 0; j < 8; ++j) sa[j] = 0.f;
                        for (int d = 0; d < 64; ++d) { const float qv = qf[s * 65 + d];
#pragma unroll
                            for (int j = 0; j < 8; ++j) sa[j] += qv * kf[(rg * 8 + j) * 65 + d]; }
                        const float bs = bv[s];
#pragma unroll
                        for (int j = 0; j < 8; ++j) { const int r = rg * 8 + j; P[s * 65 + r] = (r <= s) ? sa[j] * expf(bs - bv[r] + iv[r]) : 0.f; } }
                    __syncthreads();
                    for (int js = 0; js < 8; ++js) {
                        const int s = wave * 8 + js; float a0 = 0.f, a1 = 0.f, ad = 0.f, c0 = 0.f, c1 = 0.f, cd = 0.f;
                        for (int r = 0; r <= s; ++r) { const float p = P[s * 65 + r]; a0 += p * vf[r * 129 + lane]; a1 += p * vf[r * 129 + lane + 64]; ad += p; }
                        for (int d = 0; d < 64; ++d) { const float qv = qf[s * 65 + d]; c0 += qv * Cf[lane * 65 + d]; c1 += qv * Cf[(lane + 64) * 65 + d]; cd += qv * Cf[128 * 65 + d]; }
                        const float eb = expf(bv[s]); const float den = ad + eb * cd, dd = fmaxf(fabsf(den), 1.0f);
                        const float h0 = (a0 + eb * c0) / dd, h1 = (a1 + eb * c1) / dd;
                        const float ms = wave_sum(h0 * h0 + h1 * h1) * (1.0f / DV); const float rs = 1.0f / sqrtf(ms + EPS);
                        bf16_t* op = BIG + (size_t)(row0 + s) * NQKVO + 2048 + h * DV;
                        const float o0 = bf2f(op[lane]), o1 = bf2f(op[lane + 64]);
                        op[lane] = f2bf(h0 * rs * o0); op[lane + 64] = f2bf(h1 * rs * o1);
                    }
                }
            }
            END_PH();
        } else {
            if (IN_PH()) { BEGIN_PH();
                LAS float* rsv = (LAS float*)lds;
                for (int item = bid; item < BATCH * (SEQ / 64); item += G) {
                    const int b = item >> 5, t0 = (item & 31) * 64;
                    __syncthreads();
                    if (tid < 80) { const int t = t0 - 16 + tid; rsv[tid] = (t >= 0) ? rstd_of(ssq_a + (size_t)(b * SEQ + t) * 16) : 0.f; }
                    __syncthreads();
                    const int w = 2 << (tid >> 7);
                    const unsigned* xcol = (const unsigned*)(xb + (size_t)b * SEQ * D) + tid;
                    unsigned* ycol = (unsigned*)(BIG + (size_t)b * SEQ * D) + tid;
                    for (int t = t0; t < t0 + 64; ++t) {
                        float s0 = 0.f, s1 = 0.f; const int jlo = (t - w + 1 > 0) ? t - w + 1 : 0;
                        for (int j = jlo; j <= t; ++j) { const unsigned xv = xcol[(size_t)j * (D / 2)]; const float r = rsv[j - t0 + 16]; s0 += bflo(xv) * r; s1 += bfhi(xv) * r; }
                        const unsigned xv = xcol[(size_t)t * (D / 2)]; const float r = rsv[t - t0 + 16]; const float inv = 1.0f / (float)(t - jlo + 1);
                        ycol[(size_t)t * (D / 2)] = cvt_pk_bf16(s0 * inv - bflo(xv) * r, s1 * inv - bfhi(xv) * r);
                    }
                }
            }
            END_PH();
        }
        if (IN_PH()) { BEGIN_PH();
            pg8::Order S; S.init(M, D, G, bid, nullptr, rtab);
            pg8::EpiRes E{xf, xb, ssq_b};
            if ((layer & 1) == 0) { pg8::Gemm g{BIG + 2048, Wout_t + (size_t)slot * D * D}; pg8::gemm_phase<pg8::EpiRes, false, NQKVO, D, D, 0>(lds + RING_OFF, g, S, E); }
            else                  { pg8::Gemm g{BIG, Wpool_t + (size_t)slot * D * 256};      pg8::gemm_phase<pg8::EpiRes, false, D, 256, 256, 256>(lds + RING_OFF, g, S, E); }
        }
        END_PH();
        if (IN_PH()) { BEGIN_PH();
            pg8::Gemm g{xb, Wgu_t + (size_t)layer * GU * D}; pg8::Order S; S.init(M, GU, G, bid, ssq_b, rtab);
            pg8::EpiGU E{BIG, rtab};
            pg8::gemm_phase<pg8::EpiGU, true, D, D, D, 0>(lds + RING_OFF, g, S, E);
        }
        END_PH();
        if (IN_PH()) { BEGIN_PH();
            pg8::Gemm g{BIG, Wdn_t + (size_t)layer * D * FF}; pg8::Order S; S.init(M, D, G, bid, nullptr, rtab);
            pg8::EpiRes E{xf, xb, ssq_c};
            pg8::gemm_phase<pg8::EpiRes, false, FF, FF, FF, 0>(lds + RING_OFF, g, S, E);
        }
        END_PH();
    }
    if (IN_PH()) { BEGIN_PH();
        const int gw = bid * NWAVES + wave, NGW = G * NWAVES;
        for (int m = gw; m < M; m += NGW) {
            const f32x4* xr = (const f32x4*)(xf + (size_t)m * D) + lane; f32x4 v[4]; float s = 0.f;
#pragma unroll
            for (int j = 0; j < 4; ++j) { v[j] = xr[64 * j]; s += (v[j][0] * v[j][0] + v[j][1] * v[j][1]) + (v[j][2] * v[j][2] + v[j][3] * v[j][3]); }
            const float rs = 1.0f / sqrtf(wave_sum(s) * (1.0f / D) + EPS);
#pragma unroll
            for (int j = 0; j < 4; ++j) { const f32x4 gn = ((const f32x4*)final_norm)[64 * j + lane]; ((f32x4*)(args.out + (size_t)m * D))[64 * j + lane] = v[j] * rs * gn; }
        }
    }
#undef IN_PH
#undef END_PH
}

extern "C" void kernel_launch(void* const* d_in, const int* in_sizes, int n_in, void* d_out, int out_size, void* d_ws, size_t ws_size, hipStream_t stream) {
    static int grid = 0;
    if (grid == 0) {
        if (n_in != 12 || in_sizes[0] != M * D || out_size != M * D || ws_size < WS_END) { fprintf(stderr, "kernel_launch: unexpected shapes / workspace (n_in %d, ws %zu, need %zu)\n", n_in, ws_size, (size_t)WS_END); grid = -1; return; }
        int dev = 0, cus = 0, per_cu = 0;
        if (hipGetDevice(&dev) != hipSuccess || hipDeviceGetAttribute(&cus, hipDeviceAttributeMultiprocessorCount, dev) != hipSuccess) { grid = -1; return; }
        if (hipFuncSetAttribute((const void*)fwd_kernel, hipFuncAttributeMaxDynamicSharedMemorySize, LDS_BYTES) != hipSuccess) { fprintf(stderr, "kernel_launch: hipFuncSetAttribute failed\n"); grid = -1; return; }
        if (hipOccupancyMaxActiveBlocksPerMultiprocessor(&per_cu, (const void*)fwd_kernel, NT, LDS_BYTES) != hipSuccess || per_cu < 1) { fprintf(stderr, "kernel_launch: occupancy query says %d blocks per CU\n", per_cu); grid = -1; (void)hipGetLastError(); return; }
        grid = cus;
    }
    if (grid < 0) return;
    Args a{};
    for (int i = 0; i < 12; ++i) a.in[i] = (const float*)d_in[i];
    a.out = (float*)d_out; a.ws = (unsigned char*)d_ws;
#if MK_N_LAUNCHES == 1
    (void)hipMemsetAsync((char*)d_ws + WS_CTL, 0, CTL_ZERO_BYTES, stream);
    a.ph_lo = 0; a.ph_hi = N_PHASES;
    void* kargs[] = {&a};
    hipError_t e = hipLaunchCooperativeKernel((const void*)fwd_kernel, dim3(grid), dim3(NT), kargs, LDS_BYTES, stream);
    if (e != hipSuccess) fprintf(stderr, "cooperative launch failed: %s (grid %d)\n", hipGetErrorString(e), grid);
#else
    for (int p = 0; p < N_PHASES; ++p) {
        a.ph_lo = p; a.ph_hi = p + 1;
        hipLaunchKernelGGL(fwd_kernel, dim3(grid), dim3(NT), LDS_BYTES, stream, a);
    }
#endif
}
```

```cpp
#include <hip/hip_runtime.h>
#include <cstdio>
#include <cstdint>

#ifndef MK_N_LAUNCHES
#define MK_N_LAUNCHES 1
#endif

#define LAS __attribute__((address_space(3)))
typedef unsigned short bf16_t;
typedef short bf16x8 __attribute__((ext_vector_type(8)));
typedef float f32x4 __attribute__((ext_vector_type(4)));
typedef float f32x2 __attribute__((ext_vector_type(2)));
typedef unsigned u32x4 __attribute__((ext_vector_type(4)));
typedef unsigned u32x2 __attribute__((ext_vector_type(2)));

constexpr int BATCH = 8, SEQ = 2048, D = 1024, DEPTH = 4, M = BATCH * SEQ;
constexpr int NH = 8, DK = 64, DV = 128, NQKVO = 3072, NIN = 3088, FF = 2816, GU = 2 * FF, CH = 64, NCH = SEQ / CH;
constexpr int NITEM = BATCH * NH * NCH;
constexpr int STE = (DV + 1) * DK;
constexpr float EPS = 1e-6f, SOFTCAP = 15.0f;

__device__ __forceinline__ unsigned cvt_pk_bf16(float lo, float hi) { unsigned r; asm volatile("v_cvt_pk_bf16_f32 %0, %1, %2" : "=v"(r) : "v"(lo), "v"(hi)); return r; }
__device__ __forceinline__ float bf2f(unsigned short u) { return __uint_as_float((unsigned)u << 16); }
__device__ __forceinline__ float bflo(unsigned u) { return __uint_as_float(u << 16); }
__device__ __forceinline__ float bfhi(unsigned u) { return __uint_as_float(u & 0xffff0000u); }
__device__ __forceinline__ unsigned short f2bf(float f) { unsigned u = __float_as_uint(f); return (unsigned short)((u + 0x7fffu + ((u >> 16) & 1u)) >> 16); }


typedef short s16x4 __attribute__((ext_vector_type(4)));
typedef float f32x16 __attribute__((ext_vector_type(16)));
__device__ __forceinline__ unsigned pack2(float a, float b) { typedef __bf16 bf2 __attribute__((ext_vector_type(2))); f32x2 v = {a, b}; bf2 r = __builtin_convertvector(v, bf2); return __builtin_bit_cast(unsigned, r); }
__device__ __forceinline__ bf16x8 tr_pair(LAS unsigned char* p, int delta) {
    const s16x4 lo = __builtin_amdgcn_ds_read_tr16_b64_v4i16((LAS s16x4*)p), hi = __builtin_amdgcn_ds_read_tr16_b64_v4i16((LAS s16x4*)(p + delta));
    return __builtin_shufflevector(lo, hi, 0, 1, 2, 3, 4, 5, 6, 7);
}
#define MFMA32(a, b, c) __builtin_amdgcn_mfma_f32_32x32x16_bf16((a), (b), (c), 0, 0, 0)
__device__ __forceinline__ f32x16 zero16() { f32x16 z; for (int i = 0; i < 16; ++i) z[i] = 0.f; return z; }

namespace pg8 {
constexpr int BM = 256, BK = 64, HALF = 128, HTB = HALF * BK * 2, STAGE_BYTES = 8 * HTB, NXCD = 8, WGM = 8;
__host__ __device__ __forceinline__ int lds_byte(int r, int c) { const int st = (r >> 4) * 2 + (c >> 5), rr = r & 15, cc = c & 31, ob = rr * 64 + cc * 2; return st * 1024 + (ob ^ (((ob >> 9) & 1) << 5)); }
__host__ __device__ __forceinline__ void stage_rc(int b, int& R, int& C) { const int st = b / 1024, sb = b % 1024, swz = sb ^ (((sb >> 9) & 1) << 5); R = (st >> 1) * 16 + swz / 64; C = (st & 1) * 32 + (swz % 64) / 2; }
__host__ __device__ __forceinline__ int perm32(int rho) { const int n = rho >> 4, i = rho & 15; return 8 * (i >> 2) + 4 * n + (i & 3); }

struct Unit { int pm, pn, idx; };
struct Gemm { const bf16_t* A; const bf16_t* Bt; };

struct Order {
    int nM, nN, nwg, G, c;
    const float* ssq;
    LAS float* tab;
    __device__ void init(int M_, int N, int G_, int c_, const float* ssq_, LAS float* tab_) { nM = M_ / BM; nN = N / BM; nwg = nM * nN; G = G_; c = c_; ssq = ssq_; tab = tab_; }
    __device__ bool next(int i, Unit& u) const {
        const long L = (long)i * G + c; if (L >= nwg) return false;
        int wgid = (int)L; { const int q = nwg / NXCD, r = nwg % NXCD, xcd = wgid % NXCD, off = wgid / NXCD; wgid = (xcd < r ? xcd * (q + 1) : r * (q + 1) + (xcd - r) * q) + off; }
        const int nig = WGM * nN, gid = wgid / nig, fm = gid * WGM, gsz = (nM - fm) < WGM ? (nM - fm) : WGM;
        u.pm = fm + ((wgid % nig) % gsz); u.pn = (wgid % nig) / gsz; u.idx = i; return true;
    }
    __device__ __forceinline__ void a_ready(const Unit& u) const {
        int t_ = threadIdx.x; asm volatile("" : "+v"(t_));
        if (ssq != nullptr && t_ < 256) {
            const f32x4* p = (const f32x4*)(ssq + (size_t)(u.pm * BM + t_) * 16);
            const f32x4 a = p[0], b = p[1], c4 = p[2], d = p[3];
            const float s = ((a[0] + a[1]) + (a[2] + a[3])) + ((b[0] + b[1]) + (b[2] + b[3])) + ((c4[0] + c4[1]) + (c4[2] + c4[3])) + ((d[0] + d[1]) + (d[2] + d[3]));
            tab[(u.idx & 1) * 256 + t_] = __builtin_amdgcn_rsqf(s * (1.0f / D) + EPS);
        }
    }
    __device__ __forceinline__ void done(const Unit&) const {}
};

__device__ __forceinline__ float sigmoidf_fast(float x) { return __builtin_amdgcn_rcpf(1.0f + __expf(-x)); }

struct EpiProj {
    static constexpr bool PERM = true;
    bf16_t* O; const LAS float* tab;
    __device__ __forceinline__ void operator()(const f32x4 (&acc)[2][2][4][2], const Unit& u, int wr, int wc, int fr, int fq) const {
        const LAS float* t = tab + (u.idx & 1) * 256;
        const bool sig = u.pn >= 8;
        const int row0 = u.pm * BM + wr * 64 + fr, col0 = u.pn * BM + wc * 32 + 8 * fq;
#pragma unroll
        for (int ai = 0; ai < 2; ++ai)
#pragma unroll
            for (int m = 0; m < 4; ++m) {
                const float rs = t[ai * HALF + wr * 64 + m * 16 + fr];
                bf16_t* rowp = O + (size_t)(row0 + ai * HALF + m * 16) * NQKVO + col0;
#pragma unroll
                for (int bj = 0; bj < 2; ++bj) {
                    f32x4 v0 = acc[ai][bj][m][0] * rs, v1 = acc[ai][bj][m][1] * rs;
                    if (sig) {
#pragma unroll
                        for (int i = 0; i < 4; ++i) { v0[i] = sigmoidf_fast(v0[i]); v1[i] = sigmoidf_fast(v1[i]); }
                    }
                    u32x4 w; w.x = cvt_pk_bf16(v0[0], v0[1]); w.y = cvt_pk_bf16(v0[2], v0[3]); w.z = cvt_pk_bf16(v1[0], v1[1]); w.w = cvt_pk_bf16(v1[2], v1[3]);
                    *(u32x4*)(rowp + bj * HALF) = w;
                }
            }
    }
};
struct EpiGU {
    static constexpr bool PERM = true;
    bf16_t* H; const LAS float* tab;
    __device__ __forceinline__ void operator()(const f32x4 (&acc)[2][2][4][2], const Unit& u, int wr, int wc, int fr, int fq) const {
        const LAS float* t = tab + (u.idx & 1) * 256;
        const int row0 = u.pm * BM + wr * 64 + fr, col0 = u.pn * HALF + wc * 32 + 8 * fq;
#pragma unroll
        for (int ai = 0; ai < 2; ++ai)
#pragma unroll
            for (int m = 0; m < 4; ++m) {
                const float rs = t[ai * HALF + wr * 64 + m * 16 + fr];
                float hv[8];
#pragma unroll
                for (int n = 0; n < 2; ++n)
#pragma unroll
                    for (int i = 0; i < 4; ++i) { const float g = acc[ai][0][m][n][i] * rs, uu = acc[ai][1][m][n][i] * rs; hv[n * 4 + i] = g * uu * sigmoidf_fast(g); }
                u32x4 w; w.x = cvt_pk_bf16(hv[0], hv[1]); w.y = cvt_pk_bf16(hv[2], hv[3]); w.z = cvt_pk_bf16(hv[4], hv[5]); w.w = cvt_pk_bf16(hv[6], hv[7]);
                *(u32x4*)(H + (size_t)(row0 + ai * HALF + m * 16) * FF + col0) = w;
            }
    }
};
struct EpiRes {
    static constexpr bool PERM = false;
    float* xf; bf16_t* xb; float* ssq_out;
    __device__ __forceinline__ void operator()(const f32x4 (&acc)[2][2][4][2], const Unit& u, int wr, int wc, int fr, int fq) const {
        const int row0 = u.pm * BM + wr * 64 + fr, col0 = u.pn * BM + wc * 32 + 4 * fq;
#pragma unroll
        for (int ai = 0; ai < 2; ++ai)
#pragma unroll
            for (int m = 0; m < 4; ++m) {
                const int row = row0 + ai * HALF + m * 16; float ss = 0.f;
#pragma unroll
                for (int bj = 0; bj < 2; ++bj)
#pragma unroll
                    for (int n = 0; n < 2; ++n) {
                        const size_t off = (size_t)row * D + col0 + bj * HALF + n * 16;
                        const f32x4 xn = *(const f32x4*)(xf + off) + acc[ai][bj][m][n];
                        *(f32x4*)(xf + off) = xn;
                        u32x2 w; w.x = cvt_pk_bf16(xn[0], xn[1]); w.y = cvt_pk_bf16(xn[2], xn[3]);
                        *(u32x2*)(xb + off) = w;
                        ss += (xn[0] * xn[0] + xn[1] * xn[1]) + (xn[2] * xn[2] + xn[3] * xn[3]);
                    }
                ss += __shfl_xor(ss, 16); ss += __shfl_xor(ss, 32);
                if (fq == 0) ssq_out[(size_t)row * 16 + u.pn * 4 + wc] = ss;
            }
    }
};

template <class Epi, bool ALIGN_EPI, int LDA, int LDB, int KLEN, int ACOL>
__device__ __forceinline__ void gemm_phase(LAS unsigned char* lds, const Gemm g, const Order& S, const Epi& E) {
    int tid_ = threadIdx.x; asm volatile("" : "+v"(tid_));
    const int tid = tid_, wid = __builtin_amdgcn_readfirstlane(tid >> 6), lane = tid & 63, wr = wid >> 2, wc = wid & 3, fr = lane & 15, fq = lane >> 4;
    constexpr int nt = KLEN / BK;
    unsigned voffA[2], voffB[2];
#pragma unroll
    for (int i = 0; i < 2; ++i) { int R, C; stage_rc(tid * 16 + i * 8192, R, C); const int Rb = Epi::PERM ? ((R & ~31) + perm32(R & 31)) : R;
        voffA[i] = (unsigned)(R * LDA + C) * 2u; voffB[i] = (unsigned)(Rb * LDB + C) * 2u; }
    constexpr size_t kstep = (size_t)(BK * 2);
    constexpr size_t hstepA = (size_t)HALF * LDA * 2, tstepA = 2 * hstepA, hstepB = (size_t)HALF * LDB * 2, tstepB = 2 * hstepB;
    constexpr size_t pnstepA = (size_t)ACOL * 2;
    const unsigned ldsw = (unsigned)wid * 1024u;
    const int aoff = lds_byte(wr * 64 + fr, fq * 8), boff = lds_byte(wc * 32 + fr, fq * 8);
#define PG8_SA(b, h) (((b) * 2 + (h)) * HTB)
#define PG8_SB(b, h) ((4 + (b) * 2 + (h)) * HTB)
#define PG8_STAGE(bufoff, gbase, voff) do { _Pragma("unroll") for (int _i = 0; _i < 2; ++_i) \
        __builtin_amdgcn_global_load_lds((const unsigned*)((const char*)(gbase) + (voff)[_i]), (LAS unsigned*)(lds + (bufoff) + ldsw + _i * 8192), 16, 0, 0); } while (0)
#define PG8_LDA(dst, b, h) do { _Pragma("unroll") for (int m = 0; m < 4; ++m) _Pragma("unroll") for (int k = 0; k < 2; ++k) dst[m][k] = *(const LAS bf16x8*)(lds + PG8_SA(b, h) + aoff + m * 2048 + k * 1024); } while (0)
#define PG8_LDB(dst, b, h) do { _Pragma("unroll") for (int n = 0; n < 2; ++n) _Pragma("unroll") for (int k = 0; k < 2; ++k) dst[n][k] = *(const LAS bf16x8*)(lds + PG8_SB(b, h) + boff + n * 2048 + k * 1024); } while (0)
#define PG8_MMA(ai, bj, At, Bt) do { __builtin_amdgcn_s_setprio(1); _Pragma("unroll") for (int m = 0; m < 4; ++m) _Pragma("unroll") for (int n = 0; n < 2; ++n) _Pragma("unroll") for (int k = 0; k < 2; ++k) \
        acc[ai][bj][m][n] = __builtin_amdgcn_mfma_f32_16x16x32_bf16(Bt[n][k], At[m][k], acc[ai][bj][m][n], 0, 0, 0); __builtin_amdgcn_s_setprio(0); } while (0)
#define PG8_WAIT_V(n) asm volatile("s_waitcnt vmcnt(" #n ")" ::: "memory")
#define PG8_WAIT_L(n) asm volatile("s_waitcnt lgkmcnt(" #n ")" ::: "memory")
#define PG8_BAR __builtin_amdgcn_s_barrier()
#define PG8_SCHED __builtin_amdgcn_sched_barrier(0)
    Unit cur, nxt; int ui = 0;
    if (!S.next(0, cur)) return;
    f32x4 acc[2][2][4][2];
#pragma unroll
    for (int a = 0; a < 2; ++a)
#pragma unroll
        for (int b = 0; b < 2; ++b)
#pragma unroll
            for (int m = 0; m < 4; ++m)
#pragma unroll
                for (int n = 0; n < 2; ++n) acc[a][b][m][n] = (f32x4){0.f, 0.f, 0.f, 0.f};
    bf16x8 At[4][2], B0[2][2], B1[2][2];
    const char* cA = (const char*)g.A + (size_t)cur.pm * tstepA + (size_t)cur.pn * pnstepA; const char* cB = (const char*)g.Bt + (size_t)cur.pn * tstepB;
    S.a_ready(cur);
    PG8_STAGE(PG8_SB(0, 0), cB, voffB); PG8_STAGE(PG8_SB(0, 1), cB + hstepB, voffB); PG8_STAGE(PG8_SA(0, 0), cA, voffA); PG8_STAGE(PG8_SA(0, 1), cA + hstepA, voffA);
    if (wr == 1) PG8_BAR;
    PG8_WAIT_V(2); PG8_BAR;
    PG8_STAGE(PG8_SB(1, 0), cB + kstep, voffB); PG8_STAGE(PG8_SA(1, 0), cA + kstep, voffA); PG8_STAGE(PG8_SB(1, 1), cB + hstepB + kstep, voffB);
    PG8_WAIT_V(6); PG8_BAR;
    for (;;) {
        const bool has_next = S.next(ui + 1, nxt);
        const char* nA = has_next ? (const char*)g.A + (size_t)nxt.pm * tstepA + (size_t)nxt.pn * pnstepA : cA; const char* nB = has_next ? (const char*)g.Bt + (size_t)nxt.pn * tstepB : cB;
#pragma unroll 1
        for (int t = 0; t < nt; t += 2) {
            const bool last = (t == nt - 2);
            const char* a1 = cA + (size_t)(t + 1) * kstep;
            const char* a2 = last ? nA : cA + (size_t)(t + 2) * kstep; const char* b2 = last ? nB : cB + (size_t)(t + 2) * kstep;
            const char* a3 = a2 + kstep; const char* b3 = b2 + kstep;
            if (last && has_next) S.a_ready(nxt);
            PG8_LDB(B0, 0, 0); PG8_LDB(B1, 0, 1); PG8_SCHED; PG8_LDA(At, 0, 0); PG8_STAGE(PG8_SA(1, 1), a1 + hstepA, voffA);
            PG8_WAIT_V(8); PG8_WAIT_L(0); PG8_BAR; PG8_MMA(0, 0, At, B0); PG8_MMA(0, 1, At, B1); PG8_BAR; PG8_SCHED;
            PG8_LDA(At, 0, 1); PG8_STAGE(PG8_SB(0, 0), b2, voffB); PG8_STAGE(PG8_SB(0, 1), b2 + hstepB, voffB); PG8_STAGE(PG8_SA(0, 0), a2, voffA);
            PG8_WAIT_V(8); PG8_WAIT_L(0); PG8_BAR; PG8_MMA(1, 0, At, B0); PG8_MMA(1, 1, At, B1); PG8_BAR; PG8_SCHED;
            PG8_LDB(B0, 1, 0); PG8_LDB(B1, 1, 1); PG8_SCHED; PG8_LDA(At, 1, 0); PG8_STAGE(PG8_SA(0, 1), a2 + hstepA, voffA);
            PG8_WAIT_V(8); PG8_WAIT_L(0); PG8_BAR; PG8_MMA(0, 0, At, B0); PG8_MMA(0, 1, At, B1); PG8_BAR; PG8_SCHED;
            PG8_LDA(At, 1, 1); PG8_STAGE(PG8_SB(1, 0), b3, voffB); PG8_STAGE(PG8_SB(1, 1), b3 + hstepB, voffB); PG8_STAGE(PG8_SA(1, 0), a3, voffA);
            PG8_WAIT_V(8); PG8_WAIT_L(0); PG8_BAR; PG8_MMA(1, 0, At, B0); PG8_MMA(1, 1, At, B1); PG8_BAR; PG8_SCHED;
        }
        if constexpr (ALIGN_EPI) { if (wr == 0) PG8_BAR; }
        E(acc, cur, wr, wc, fr, fq); S.done(cur);
        if (!has_next) break;
#pragma unroll
        for (int a = 0; a < 2; ++a)
#pragma unroll
            for (int b = 0; b < 2; ++b)
#pragma unroll
                for (int m = 0; m < 4; ++m)
#pragma unroll
                    for (int n = 0; n < 2; ++n) acc[a][b][m][n] = (f32x4){0.f, 0.f, 0.f, 0.f};
        cur = nxt; cA = nA; cB = nB; ++ui;
        if constexpr (ALIGN_EPI) { if (wr == 1) PG8_BAR; }
    }
    PG8_WAIT_V(0);
    if constexpr (!ALIGN_EPI) { if (wr == 0) PG8_BAR; }
    PG8_BAR;
#undef PG8_SA
#undef PG8_SB
#undef PG8_STAGE
#undef PG8_LDA
#undef PG8_LDB
#undef PG8_MMA
#undef PG8_WAIT_V
#undef PG8_WAIT_L
#undef PG8_BAR
#undef PG8_SCHED
}
}

constexpr size_t MiB = 1u << 20;
constexpr size_t WS_CTL = 0, CTL_ZERO_BYTES = 1 * MiB;
constexpr size_t SZ_WIN = (size_t)NQKVO * D * 2, SZ_WOUT = (size_t)D * D * 2, SZ_WPOOL = (size_t)D * 256 * 2, SZ_WGU = (size_t)GU * D * 2, SZ_WDN = (size_t)D * FF * 2, SZ_WG = (size_t)16 * D * 4;
constexpr size_t WS_WIN = 1 * MiB;
constexpr size_t WS_WOUT = WS_WIN + 2 * SZ_WIN;
constexpr size_t WS_WPOOL = WS_WOUT + 2 * SZ_WOUT;
constexpr size_t WS_WGU = WS_WPOOL + 2 * SZ_WPOOL;
constexpr size_t WS_WDN = WS_WGU + 4 * SZ_WGU;
constexpr size_t WS_WG = WS_WDN + 4 * SZ_WDN;
constexpr size_t WS_SSQ = WS_WG + 2 * SZ_WG;
constexpr size_t SZ_SSQ = (size_t)M * 16 * 4;
constexpr size_t WS_GATES = WS_SSQ + 9 * SZ_SSQ;
constexpr size_t WS_DECAY = WS_GATES + SZ_SSQ;
constexpr size_t WS_XB = ((WS_DECAY + NITEM * 4 + MiB - 1) / MiB) * MiB;
constexpr size_t WS_XF = WS_XB + (size_t)M * D * 2;
constexpr size_t WS_BIG = WS_XF + (size_t)M * D * 4;
constexpr size_t WS_ST = WS_BIG + (size_t)M * NQKVO * 2;
constexpr size_t WS_END = WS_ST + (size_t)NITEM * STE * 4;
static_assert(WS_END <= 352 * MiB, "d_ws map must fit the guaranteed workspace");
static_assert((size_t)M * FF * 2 <= (size_t)M * NQKVO * 2, "H overlays q|k|v|o");

constexpr int CW_BAR = 4096;
constexpr int RING_OFF = 0, RING_BYTES = 131072;
constexpr int LDSCTL_OFF = RING_BYTES, MISC_OFF = LDSCTL_OFF + 320;
constexpr int RSTD_OFF = RING_BYTES + 1024;
constexpr int LDS_BYTES = 147456;
constexpr int NWAVES = 8, NT = NWAVES * 64;

#define VM_WAIT() asm volatile("s_waitcnt vmcnt(0)" ::: "memory")
#define LDS_WAIT() asm volatile("s_waitcnt lgkmcnt(0)" ::: "memory")

#define XB_TMO      128
#define XB_XCNT(j)  (256  + 64 * (j))
#define XB_XSUB(j)  (1280 + 64 * (j))
#define XB_XGEN(j)  (2304 + 64 * (j))
#define XB_TOP      3328
#define XB_TOPGEN   3392
#define XCD_BAR_WORDS 3456
#define XB_SPIN_CAP (1u << 18)
__device__ __forceinline__ unsigned xb_ld(unsigned* p)              { return __hip_atomic_load(p, __ATOMIC_RELAXED, __HIP_MEMORY_SCOPE_AGENT); }
__device__ __forceinline__ unsigned xb_add(unsigned* p, unsigned v) { return __hip_atomic_fetch_add(p, v, __ATOMIC_RELAXED, __HIP_MEMORY_SCOPE_AGENT); }
__device__ __forceinline__ unsigned xb_xcc_id() { return (unsigned)__builtin_amdgcn_s_getreg((3 << 11) | 20) & 0xFu; }
#define XB_SPIN(cond, bar) do { unsigned _sp = 0; while (cond) { __builtin_amdgcn_s_sleep(1); \
    if ((++_sp & 255u) == 0u) { if (xb_ld(&(bar)[XB_TMO])) break; if (_sp > XB_SPIN_CAP) { atomicAdd(&(bar)[XB_TMO], 1u); break; } } } } while (0)
struct XcdBarrier { unsigned* bar; unsigned x; volatile LAS unsigned* st; };
__device__ __forceinline__ XcdBarrier xcd_barrier_post(unsigned* bar, volatile LAS unsigned* st) {
    XcdBarrier b; b.bar = bar; b.x = xb_xcc_id(); b.st = st;
    if (threadIdx.x == 0) (void)xb_add(&bar[XB_XCNT(b.x)], 1u);
    return b;
}
__device__ __forceinline__ void xcd_barrier_complete(unsigned* bar, unsigned x, unsigned& nloc, unsigned& nx) {
    const unsigned G = gridDim.x * gridDim.y * gridDim.z;
    unsigned sum, cnt, mine, sp = 0u;
    for (;;) {
        sum = 0u; cnt = 0u; mine = 0u;
#pragma unroll
        for (unsigned j = 0; j < 16; ++j) { const unsigned c = xb_ld(&bar[XB_XCNT(j)]); sum += c; cnt += (c > 0u) ? 1u : 0u; mine = (j == x) ? c : mine; }
        if (sum == G) break;
        __builtin_amdgcn_s_sleep(1);
        if ((++sp & 255u) == 0u) { if (xb_ld(&bar[XB_TMO])) break; if (sp > XB_SPIN_CAP) { atomicAdd(&bar[XB_TMO], 1u); break; } }
    }
    nloc = mine > 0u ? mine : 1u; nx = cnt > 0u ? cnt : 1u;
}
__device__ __forceinline__ void xcd_barrier(const XcdBarrier& b) {
    asm volatile("s_waitcnt vmcnt(0)" ::: "memory");
    __syncthreads();
    if (threadIdx.x == 0) {
        unsigned* bar = b.bar;
        __builtin_amdgcn_s_waitcnt(0);
        unsigned nloc = b.st[0], nx = b.st[1];
        if (nloc == 0u) { xcd_barrier_complete(bar, b.x, nloc, nx); b.st[0] = nloc; b.st[1] = nx; }
        const unsigned old = xb_add(&bar[XB_XSUB(b.x)], 1u);
        const unsigned gen = old / nloc;
        if (old + 1u == (gen + 1u) * nloc) {
            __builtin_amdgcn_fence(__ATOMIC_RELEASE, "agent");
            asm volatile("s_waitcnt vmcnt(0)" ::: "memory");
            const unsigned og = xb_add(&bar[XB_TOP], 1u);
            const unsigned tg = og / nx;
            if (og + 1u == (tg + 1u) * nx) xb_add(&bar[XB_TOPGEN], 1u);
            else XB_SPIN(xb_ld(&bar[XB_TOPGEN]) == tg, bar);
            __builtin_amdgcn_fence(__ATOMIC_ACQUIRE, "agent");
            xb_add(&bar[XB_XGEN(b.x)], 1u);
            asm volatile("s_waitcnt vmcnt(0)" ::: "memory");
        } else {
            XB_SPIN(xb_ld(&bar[XB_XGEN(b.x)]) == gen, bar);
            __builtin_amdgcn_fence(__ATOMIC_ACQUIRE, "agent");
            asm volatile("s_waitcnt vmcnt(0)" ::: "memory");
        }
    }
    __syncthreads();
}

__device__ __forceinline__ float wave_sum(float v) {
#pragma unroll
    for (int o = 1; o < 64; o <<= 1) v += __shfl_xor(v, o);
    return v;
}
__device__ __forceinline__ float log_sigmoidf(float x) { return fminf(x, 0.f) - log1pf(expf(-fabsf(x))); }
__device__ __forceinline__ float rstd_of(const float* ssq_row) {
    const f32x4* p = (const f32x4*)ssq_row; const f32x4 a = p[0], b = p[1], c = p[2], d = p[3];
    const float s = ((a[0] + a[1]) + (a[2] + a[3])) + ((b[0] + b[1]) + (b[2] + b[3])) + ((c[0] + c[1]) + (c[2] + c[3])) + ((d[0] + d[1]) + (d[2] + d[3]));
    return 1.0f / sqrtf(s * (1.0f / D) + EPS);
}

__device__ __forceinline__ void tr_item(const float* W, int ldW, int k0, int c0, bf16_t* WT, int ldT, int r0, const float* kg, const float* cg, float mul, LAS float* scr, int lane) {
    const int cc = lane & 31; const float cmul = (cg ? cg[c0 + cc] : 1.0f) * mul;
#pragma unroll 8
    for (int i = 0; i < 32; ++i) { const int kk = 2 * i + (lane >> 5); float v = W[(size_t)(k0 + kk) * ldW + c0 + cc] * cmul; if (kg) v *= kg[k0 + kk]; scr[kk * 33 + cc] = v; }
    LDS_WAIT(); asm volatile("" ::: "memory");
    const int c = lane & 7;
#pragma unroll
    for (int j = 0; j < 4; ++j) { const int n = (lane >> 3) + 8 * j; const LAS float* s = scr + (8 * c) * 33 + n;
        u32x4 o; o.x = cvt_pk_bf16(s[0 * 33], s[1 * 33]); o.y = cvt_pk_bf16(s[2 * 33], s[3 * 33]); o.z = cvt_pk_bf16(s[4 * 33], s[5 * 33]); o.w = cvt_pk_bf16(s[6 * 33], s[7 * 33]);
        *(u32x4*)(WT + (size_t)(r0 + n) * ldT + k0 + 8 * c) = o; }
    LDS_WAIT(); asm volatile("" ::: "memory");
}

struct Args { const float* in[12]; float* out; unsigned char* ws; int ph_lo, ph_hi; };
constexpr int N_PHASES = 24;

__global__ void __launch_bounds__(NT, 2) fwd_kernel(Args args) {
    extern __shared__ __attribute__((aligned(16))) unsigned char lds_raw[];
    LAS unsigned char* lds = (LAS unsigned char*)lds_raw;
    volatile LAS unsigned* MISC = (volatile LAS unsigned*)(lds + MISC_OFF);
    LAS float* rtab = (LAS float*)(lds + RSTD_OFF);
    int tid = threadIdx.x, lane = tid & 63, wave = __builtin_amdgcn_readfirstlane(tid >> 6);
#define FRESH_TID() do { tid = threadIdx.x; asm volatile("" : "+v"(tid)); lane = tid & 63; wave = __builtin_amdgcn_readfirstlane(tid >> 6); } while (0)
    const int G = gridDim.x, bid = blockIdx.x;
    unsigned char* const ws = args.ws;
#define x_in       (args.in[0])
#define norm_mix   (args.in[1])
#define norm_ffn   (args.in[2])
#define w_in       (args.in[3])
#define gate_bias  (args.in[4])
#define head_gain  (args.in[5])
#define w_out      (args.in[6])
#define pool_w     (args.in[7])
#define pool_scale (args.in[8])
#define w_gu       (args.in[9])
#define w_dn       (args.in[10])
#define final_norm (args.in[11])
#define Win_t   ((bf16_t*)(ws + WS_WIN))
#define Wout_t  ((bf16_t*)(ws + WS_WOUT))
#define Wpool_t ((bf16_t*)(ws + WS_WPOOL))
#define Wgu_t   ((bf16_t*)(ws + WS_WGU))
#define Wdn_t   ((bf16_t*)(ws + WS_WDN))
#define Wg      ((float*)(ws + WS_WG))
#define ssq     ((float*)(ws + WS_SSQ))
#define gates   ((float*)(ws + WS_GATES))
#define decay   ((float*)(ws + WS_DECAY))
#define xb      ((bf16_t*)(ws + WS_XB))
#define xf      ((float*)(ws + WS_XF))
#define BIG     ((bf16_t*)(ws + WS_BIG))
#define ST      ((float*)(ws + WS_ST))

    for (int u = tid; u < (LDS_BYTES - LDSCTL_OFF) / 4; u += NT) ((LAS unsigned*)(lds + LDSCTL_OFF))[u] = 0u;
    __syncthreads();
    XcdBarrier bar; bar.bar = (unsigned*)(ws + WS_CTL) + CW_BAR; bar.x = 0; bar.st = nullptr;
    if (MK_N_LAUNCHES == 1) bar = xcd_barrier_post((unsigned*)(ws + WS_CTL) + CW_BAR, MISC + 8);

    const int lo = args.ph_lo, hi = args.ph_hi;
    int ph = 0;
#define IN_PH() (lo <= ph && ph < hi)
#define BEGIN_PH() FRESH_TID()
#define END_PH() do { if (lo <= ph && ph + 1 < hi) xcd_barrier(bar); ++ph; } while (0)

    if (IN_PH()) { BEGIN_PH();
        LAS float* scr = (LAS float*)(lds + RING_OFF + wave * 16384);
        const int gw = bid * NWAVES + wave, NGW = G * NWAVES;
        constexpr int I_IN = 16 * 96, I_OUT = 16 * 32, I_POOL = 4 * 4 * 8, I_GU = 16 * 176, I_DN = 44 * 32;
        constexpr int NITEMS = 2 * I_IN + 2 * I_OUT + 2 * I_POOL + 4 * I_GU + 4 * I_DN;
        for (int it = gw; it < NITEMS; it += NGW) {
            int r = it;
            if (r < 2 * I_IN) { const int l = r / I_IN; r -= l * I_IN; const int kb = r / 96, nb = r % 96, r0 = nb * 32;
                tr_item(w_in + (size_t)l * D * NIN, NIN, kb * 64, r0, Win_t + (size_t)l * NQKVO * D, D, r0, norm_mix + (2 * l) * D, nullptr, (r0 >= 512 && r0 < 1024) ? 0.125f : 1.0f, scr, lane); continue; }
            r -= 2 * I_IN;
            if (r < 2 * I_OUT) { const int l = r / I_OUT; r -= l * I_OUT; const int kb = r / 32, nb = r % 32;
                tr_item(w_out + (size_t)l * D * D, D, kb * 64, nb * 32, Wout_t + (size_t)l * D * D, D, nb * 32, head_gain + l * D, nullptr, 1.0f, scr, lane); continue; }
            r -= 2 * I_OUT;
            if (r < 2 * I_POOL) { const int l = r / I_POOL; r -= l * I_POOL; const int gi = r / 32; r -= gi * 32; const int kb = r / 8, nb = r % 8;
                tr_item(pool_w + (size_t)(l * 4 + gi) * 256 * 256, 256, kb * 64, nb * 32, Wpool_t + (size_t)l * D * 256 + (size_t)gi * 256 * 256, 256, nb * 32,
                        norm_mix + (2 * l + 1) * D + gi * 256, pool_scale + l * D + gi * 256, 1.0f, scr, lane); continue; }
            r -= 2 * I_POOL;
            if (r < 4 * I_GU) { const int l = r / I_GU; r -= l * I_GU; const int kb = r / 176, nb = r % 176, r0 = nb * 32, pn = r0 >> 8, j = r0 & 255;
                const int c0 = (j < 128) ? pn * 128 + j : FF + pn * 128 + (j - 128);
                tr_item(w_gu + (size_t)l * D * GU, GU, kb * 64, c0, Wgu_t + (size_t)l * GU * D, D, r0, norm_ffn + l * D, nullptr, 1.0f, scr, lane); continue; }
            r -= 4 * I_GU;
            { const int l = r / I_DN; r -= l * I_DN; const int kb = r / 32, nb = r % 32;
                tr_item(w_dn + (size_t)l * FF * D, D, kb * 64, nb * 32, Wdn_t + (size_t)l * D * FF, FF, nb * 32, nullptr, nullptr, 1.0f, scr, lane); }
        }
        for (int e = bid * NT + tid; e < 2 * 16 * D; e += G * NT) { const int l = e / (16 * D), rem = e % (16 * D), k = rem >> 4, j = rem & 15;
            Wg[(size_t)l * 16 * D + j * D + k] = w_in[(size_t)l * D * NIN + (size_t)k * NIN + NQKVO + j] * norm_mix[(2 * l) * D + k]; }
        for (int m = gw; m < M; m += NGW) {
            const f32x4* xr = (const f32x4*)(x_in + (size_t)m * D) + lane; f32x4 v[4]; float s = 0.f;
#pragma unroll
            for (int j = 0; j < 4; ++j) { v[j] = xr[64 * j]; s += (v[j][0] * v[j][0] + v[j][1] * v[j][1]) + (v[j][2] * v[j][2] + v[j][3] * v[j][3]); }
            s = wave_sum(s);
#pragma unroll
            for (int j = 0; j < 4; ++j) { ((f32x4*)(xf + (size_t)m * D))[64 * j + lane] = v[j];
                u32x2 w; w.x = cvt_pk_bf16(v[j][0], v[j][1]); w.y = cvt_pk_bf16(v[j][2], v[j][3]); ((u32x2*)(xb + (size_t)m * D))[64 * j + lane] = w; }
            if (lane < 16) ssq[(size_t)m * 16 + lane] = (lane == 0) ? s : 0.f;
        }
    }
    END_PH();

    for (int layer = 0; layer < DEPTH; ++layer) {
        const int slot = layer >> 1;
        float* ssq_a = ssq + (size_t)(2 * layer) * M * 16;
        float* ssq_b = ssq_a + (size_t)M * 16;
        float* ssq_c = ssq_b + (size_t)M * 16;
        if ((layer & 1) == 0) {
            if (IN_PH()) { BEGIN_PH();
                const float* wg = Wg + (size_t)slot * 16 * D;
                for (int rb = bid; rb < M / 64; rb += G) {
                    const int row = rb * 64 + (tid >> 3), j2 = tid & 7;
                    const float rs = rstd_of(ssq_a + (size_t)row * 16);
                    const u32x4* xr = (const u32x4*)(xb + (size_t)row * D);
                    const f32x4* w0 = (const f32x4*)(wg + (size_t)(2 * j2) * D); const f32x4* w1 = (const f32x4*)(wg + (size_t)(2 * j2 + 1) * D);
                    float a0 = 0.f, a1 = 0.f;
                    for (int k8 = 0; k8 < D / 8; ++k8) {
                        const u32x4 xv = xr[k8]; const f32x4 p0 = w0[2 * k8], p1 = w0[2 * k8 + 1], q0 = w1[2 * k8], q1 = w1[2 * k8 + 1];
                        const float x0 = bflo(xv.x), x1 = bfhi(xv.x), x2 = bflo(xv.y), x3 = bfhi(xv.y), x4 = bflo(xv.z), x5 = bfhi(xv.z), x6 = bflo(xv.w), x7 = bfhi(xv.w);
                        a0 += x0 * p0[0] + x1 * p0[1] + x2 * p0[2] + x3 * p0[3] + x4 * p1[0] + x5 * p1[1] + x6 * p1[2] + x7 * p1[3];
                        a1 += x0 * q0[0] + x1 * q0[1] + x2 * q0[2] + x3 * q0[3] + x4 * q1[0] + x5 * q1[1] + x6 * q1[2] + x7 * q1[3];
                    }
                    const float g0 = a0 * rs + gate_bias[slot * 16 + 2 * j2], g1 = a1 * rs + gate_bias[slot * 16 + 2 * j2 + 1];
                    gates[(size_t)row * 16 + 2 * j2] = SOFTCAP * tanhf(g0 * (1.0f / SOFTCAP)); gates[(size_t)row * 16 + 2 * j2 + 1] = SOFTCAP * tanhf(g1 * (1.0f / SOFTCAP));
                }
                pg8::Gemm g{xb, Win_t + (size_t)slot * NQKVO * D}; pg8::Order S; S.init(M, NQKVO, G, bid, ssq_a, rtab);
                pg8::EpiProj E{BIG, rtab};
                pg8::gemm_phase<pg8::EpiProj, true, D, D, D, 0>(lds + RING_OFF, g, S, E);
            }
            END_PH();
            if (IN_PH()) { BEGIN_PH();
                LAS unsigned char* wl = lds + wave * 12288;
                const int hh = lane >> 5, l31 = lane & 31, g16 = (lane >> 4) & 1, q4 = (lane & 15) >> 2, p4 = lane & 3;
                const int troff = (8 * hh + q4) * 192 + (16 * g16 + 4 * p4) * 2;
                bf16x8 a_one; { const short o = (l31 == 0) ? (short)0x3F80 : (short)0; for (int j = 0; j < 8; ++j) a_one[j] = o; }
                for (int T = bid * NWAVES + wave; T < 2 * NITEM; T += G * NWAVES) {
                    const int item = T >> 1, vh = T & 1, b = item >> 8, h = (item >> 5) & 7, c = item & 31, row0 = b * SEQ + c * CH;
                    const float f = gates[(size_t)(row0 + lane) * 16 + 8 + h], ig = gates[(size_t)(row0 + lane) * 16 + h];
                    float sc = log_sigmoidf(f);
#pragma unroll
                    for (int o = 1; o < 64; o <<= 1) { const float t = __shfl_up(sc, o); if (lane >= o) sc += t; }
                    const float bl = __shfl(sc, 63);
                    const float w = __expf(bl - sc + ig);
                    if (vh == 0 && lane == 63) decay[item] = __expf(bl);
                    f32x16 acc[2][2], accn[2];
#pragma unroll
                    for (int i = 0; i < 2; ++i) { accn[i] = zero16(); acc[i][0] = zero16(); acc[i][1] = zero16(); }
#pragma unroll
                    for (int cr = 0; cr < 2; ++cr) {
                        u32x4 kv[4], vv[4];
#pragma unroll
                        for (int i = 0; i < 4; ++i) { const int id = i * 64 + lane, rho = id >> 3, ch = id & 7; const bf16_t* base = BIG + (size_t)(row0 + 32 * cr + rho) * NQKVO;
                            kv[i] = *(const u32x4*)(base + 512 + h * DK + ch * 8); vv[i] = *(const u32x4*)(base + 1024 + h * DV + 64 * vh + ch * 8); }
#pragma unroll
                        for (int i = 0; i < 4; ++i) { const int id = i * 64 + lane, rho = id >> 3, ch = id & 7; const float wr = __shfl(w, 32 * cr + rho);
                            u32x4 ks; ks.x = pack2(bflo(kv[i].x) * wr, bfhi(kv[i].x) * wr); ks.y = pack2(bflo(kv[i].y) * wr, bfhi(kv[i].y) * wr);
                            ks.z = pack2(bflo(kv[i].z) * wr, bfhi(kv[i].z) * wr); ks.w = pack2(bflo(kv[i].w) * wr, bfhi(kv[i].w) * wr);
                            *(LAS u32x4*)(wl + rho * 192 + ch * 16) = ks; *(LAS u32x4*)(wl + 6144 + rho * 192 + ch * 16) = vv[i]; }
#pragma unroll
                        for (int sp = 0; sp < 2; ++sp) {
                            bf16x8 Bf[2], Af[2];
#pragma unroll
                            for (int t2 = 0; t2 < 2; ++t2) { Bf[t2] = tr_pair(wl + troff + sp * 16 * 192 + t2 * 64, 4 * 192); Af[t2] = tr_pair(wl + 6144 + troff + sp * 16 * 192 + t2 * 64, 4 * 192); }
#pragma unroll
                            for (int dt = 0; dt < 2; ++dt) { acc[0][dt] = MFMA32(Af[0], Bf[dt], acc[0][dt]); acc[1][dt] = MFMA32(Af[1], Bf[dt], acc[1][dt]); accn[dt] = MFMA32(a_one, Bf[dt], accn[dt]); }
                        }
                    }
                    float* st = ST + (size_t)item * STE;
#pragma unroll
                    for (int vt = 0; vt < 2; ++vt)
#pragma unroll
                        for (int dt = 0; dt < 2; ++dt)
#pragma unroll
                            for (int r = 0; r < 16; ++r) st[(64 * vh + 32 * vt + (r & 3) + 8 * (r >> 2) + 4 * hh) * 64 + 32 * dt + l31] = acc[vt][dt][r];
                    if (vh == 0 && hh == 0) { st[128 * 64 + l31] = accn[0][0]; st[128 * 64 + 32 + l31] = accn[1][0]; }
                }
            }
            END_PH();
            if (IN_PH()) { BEGIN_PH();
                for (int e = bid * NT + tid; e < BATCH * NH * STE; e += G * NT) {
                    const int bh = e / STE, el = e % STE; float st = 0.f;
                    for (int c = 0; c < NCH; ++c) { const size_t idx = (size_t)(bh * NCH + c) * STE + el; const float u = ST[idx]; ST[idx] = st; st = decay[bh * NCH + c] * st + u; }
                }
            }
            END_PH();
            if (IN_PH()) { BEGIN_PH();
                LAS unsigned char* wl = lds + wave * 12288;
                LAS float* ctab = (LAS float*)(wl + 10240);
                const int hh = lane >> 5, l31 = lane & 31, g16 = (lane >> 4) & 1, q4 = (lane & 15) >> 2, p4 = lane & 3;
                const int troff = (4 * hh + q4) * 320 + (16 * g16 + 4 * p4) * 2;
                bf16x8 a_one; { const short o = (l31 == 0) ? (short)0x3F80 : (short)0; for (int j = 0; j < 8; ++j) a_one[j] = o; }
                for (int T = bid * NWAVES + wave; T < 2 * NITEM; T += G * NWAVES) {
                    const int item = T >> 1, st = T & 1, b = item >> 8, h = (item >> 5) & 7, c = item & 31, row0 = b * SEQ + c * CH;
                    const float f = gates[(size_t)(row0 + lane) * 16 + 8 + h], ig = gates[(size_t)(row0 + lane) * 16 + h];
                    float sc = log_sigmoidf(f);
#pragma unroll
                    for (int o = 1; o < 64; o <<= 1) { const float t = __shfl_up(sc, o); if (lane >= o) sc += t; }
                    ctab[lane] = ig - sc;
                    const float bs = __shfl(sc, 32 * st + l31), eb = __expf(bs);
                    bf16x8 qf[4];
                    { const bf16_t* qp = BIG + (size_t)(row0 + 32 * st + l31) * NQKVO + h * DK + 8 * hh;
#pragma unroll
                      for (int ks = 0; ks < 4; ++ks) qf[ks] = *(const bf16x8*)(qp + 16 * ks); }
                    f32x16 acc[5];
                    const float* stp = ST + (size_t)item * STE;
#pragma unroll
                    for (int vt = 0; vt < 5; ++vt) {
                        acc[vt] = zero16();
                        const int vrow = (vt < 4) ? 32 * vt + l31 : 128;
                        const float* cp = stp + (size_t)vrow * 64 + 8 * hh;
#pragma unroll
                        for (int ks = 0; ks < 4; ++ks) {
                            const f32x4 c0 = *(const f32x4*)(cp + 16 * ks), c1 = *(const f32x4*)(cp + 16 * ks + 4);
                            u32x4 pk; pk.x = pack2(c0[0], c0[1]); pk.y = pack2(c0[2], c0[3]); pk.z = pack2(c1[0], c1[1]); pk.w = pack2(c1[2], c1[3]);
                            if (vt == 4 && l31 != 0) pk = (u32x4){0u, 0u, 0u, 0u};
                            acc[vt] = MFMA32(__builtin_bit_cast(bf16x8, pk), qf[ks], acc[vt]);
                        }
#pragma unroll
                        for (int r = 0; r < 16; ++r) acc[vt][r] *= eb;
                    }
                    LDS_WAIT();
#pragma unroll
                    for (int rt = 0; rt < 2; ++rt) {
                        if (rt <= st) {
                            f32x16 X = zero16();
                            { const bf16_t* kp = BIG + (size_t)(row0 + 32 * rt + l31) * NQKVO + 512 + h * DK + 8 * hh;
#pragma unroll
                              for (int ks = 0; ks < 4; ++ks) X = MFMA32(*(const bf16x8*)(kp + 16 * ks), qf[ks], X); }
                            u32x4 vv[8];
#pragma unroll
                            for (int i = 0; i < 8; ++i) { const int id = i * 64 + lane, rho = id >> 4, ch = id & 15; vv[i] = *(const u32x4*)(BIG + (size_t)(row0 + 32 * rt + rho) * NQKVO + 1024 + h * DV + ch * 8); }
#pragma unroll
                            for (int i = 0; i < 8; ++i) { const int id = i * 64 + lane, rho = id >> 4, ch = id & 15; *(LAS u32x4*)(wl + rho * 320 + ch * 16) = vv[i]; }
#pragma unroll
                            for (int g4 = 0; g4 < 4; ++g4) {
                                const f32x4 cr = *(const LAS f32x4*)(ctab + 32 * rt + 8 * g4 + 4 * hh);
#pragma unroll
                                for (int e = 0; e < 4; ++e) { float pv = X[4 * g4 + e] * __expf(bs + cr[e]); if (rt == st && (8 * g4 + 4 * hh + e) > l31) pv = 0.f; X[4 * g4 + e] = pv; }
                            }
#pragma unroll
                            for (int sp = 0; sp < 2; ++sp) {
                                u32x4 pk; pk.x = pack2(X[8 * sp + 0], X[8 * sp + 1]); pk.y = pack2(X[8 * sp + 2], X[8 * sp + 3]); pk.z = pack2(X[8 * sp + 4], X[8 * sp + 5]); pk.w = pack2(X[8 * sp + 6], X[8 * sp + 7]);
                                const bf16x8 pf = __builtin_bit_cast(bf16x8, pk);
#pragma unroll
                                for (int vt = 0; vt < 4; ++vt) acc[vt] = MFMA32(tr_pair(wl + troff + sp * 16 * 320 + vt * 64, 8 * 320), pf, acc[vt]);
                                acc[4] = MFMA32(a_one, pf, acc[4]);
                            }
                        }
                    }
                    const float den = __shfl(acc[4][0], l31), dd = fmaxf(fabsf(den), 1.0f);
                    float ss = 0.f;
#pragma unroll
                    for (int vt = 0; vt < 4; ++vt)
#pragma unroll
                        for (int r = 0; r < 16; ++r) ss += acc[vt][r] * acc[vt][r];
                    ss += __shfl_xor(ss, 32);
                    const float idd = 1.0f / dd; const float scale = idd / sqrtf(ss * idd * idd * (1.0f / DV) + EPS);
#pragma unroll
                    for (int vt = 0; vt < 4; ++vt)
#pragma unroll
                        for (int g4 = 0; g4 < 4; ++g4) { u32x2 pk; pk.x = pack2(acc[vt][4 * g4] * scale, acc[vt][4 * g4 + 1] * scale); pk.y = pack2(acc[vt][4 * g4 + 2] * scale, acc[vt][4 * g4 + 3] * scale);
                            *(LAS u32x2*)(wl + l31 * 272 + (32 * vt + 8 * g4 + 4 * hh) * 2) = pk; }
#pragma unroll
                    for (int i = 0; i < 8; ++i) { const int id = i * 64 + lane, rho = id >> 4, ch = id & 15;
                        const u32x4 hv = *(const LAS u32x4*)(wl + rho * 272 + ch * 16);
                        u32x4* op = (u32x4*)(BIG + (size_t)(row0 + 32 * st + rho) * NQKVO + 2048 + h * DV + ch * 8); const u32x4 ov = *op;
                        u32x4 w4; w4.x = pack2(bflo(hv.x) * bflo(ov.x), bfhi(hv.x) * bfhi(ov.x)); w4.y = pack2(bflo(hv.y) * bflo(ov.y), bfhi(hv.y) * bfhi(ov.y));
                        w4.z = pack2(bflo(hv.z) * bflo(ov.z), bfhi(hv.z) * bfhi(ov.z)); w4.w = pack2(bflo(hv.w) * bflo(ov.w), bfhi(hv.w) * bfhi(ov.w));
                        *op = w4; }
                    LDS_WAIT();
                }
            }
            END_PH();
        } else {
            if (IN_PH()) { BEGIN_PH();
                LAS float* rsv = (LAS float*)lds;
                for (int item = bid; item < BATCH * (SEQ / 64); item += G) {
                    const int b = item >> 5, t0 = (item & 31) * 64;
                    __syncthreads();
                    if (tid < 80) { const int t = t0 - 16 + tid; rsv[tid] = (t >= 0) ? rstd_of(ssq_a + (size_t)(b * SEQ + t) * 16) : 0.f; }
                    __syncthreads();
                    const int w = 2 << (tid >> 7);
                    const unsigned* xcol = (const unsigned*)(xb + (size_t)b * SEQ * D) + tid;
                    unsigned* ycol = (unsigned*)(BIG + (size_t)b * SEQ * D) + tid;
                    for (int t = t0; t < t0 + 64; ++t) {
                        float s0 = 0.f, s1 = 0.f; const int jlo = (t - w + 1 > 0) ? t - w + 1 : 0;
                        for (int j = jlo; j <= t; ++j) { const unsigned xv = xcol[(size_t)j * (D / 2)]; const float r = rsv[j - t0 + 16]; s0 += bflo(xv) * r; s1 += bfhi(xv) * r; }
                        const unsigned xv = xcol[(size_t)t * (D / 2)]; const float r = rsv[t - t0 + 16]; const float inv = 1.0f / (float)(t - jlo + 1);
                        ycol[(size_t)t * (D / 2)] = cvt_pk_bf16(s0 * inv - bflo(xv) * r, s1 * inv - bfhi(xv) * r);
                    }
                }
            }
            END_PH();
        }
        if (IN_PH()) { BEGIN_PH();
            pg8::Order S; S.init(M, D, G, bid, nullptr, rtab);
            pg8::EpiRes E{xf, xb, ssq_b};
            if ((layer & 1) == 0) { pg8::Gemm g{BIG + 2048, Wout_t + (size_t)slot * D * D}; pg8::gemm_phase<pg8::EpiRes, false, NQKVO, D, D, 0>(lds + RING_OFF, g, S, E); }
            else                  { pg8::Gemm g{BIG, Wpool_t + (size_t)slot * D * 256};      pg8::gemm_phase<pg8::EpiRes, false, D, 256, 256, 256>(lds + RING_OFF, g, S, E); }
        }
        END_PH();
        if (IN_PH()) { BEGIN_PH();
            pg8::Gemm g{xb, Wgu_t + (size_t)layer * GU * D}; pg8::Order S; S.init(M, GU, G, bid, ssq_b, rtab);
            pg8::EpiGU E{BIG, rtab};
            pg8::gemm_phase<pg8::EpiGU, true, D, D, D, 0>(lds + RING_OFF, g, S, E);
        }
        END_PH();
        if (IN_PH()) { BEGIN_PH();
            pg8::Gemm g{BIG, Wdn_t + (size_t)layer * D * FF}; pg8::Order S; S.init(M, D, G, bid, nullptr, rtab);
            pg8::EpiRes E{xf, xb, ssq_c};
            pg8::gemm_phase<pg8::EpiRes, false, FF, FF, FF, 0>(lds + RING_OFF, g, S, E);
        }
        END_PH();
    }
    if (IN_PH()) { BEGIN_PH();
        const int gw = bid * NWAVES + wave, NGW = G * NWAVES;
        for (int m = gw; m < M; m += NGW) {
            const f32x4* xr = (const f32x4*)(xf + (size_t)m * D) + lane; f32x4 v[4]; float s = 0.f;
#pragma unroll
            for (int j = 0; j < 4; ++j) { v[j] = xr[64 * j]; s += (v[j][0] * v[j][0] + v[j][1] * v[j][1]) + (v[j][2] * v[j][2] + v[j][3] * v[j][3]); }
            const float rs = 1.0f / sqrtf(wave_sum(s) * (1.0f / D) + EPS);
#pragma unroll
            for (int j = 0; j < 4; ++j) { const f32x4 gn = ((const f32x4*)final_norm)[64 * j + lane]; ((f32x4*)(args.out + (size_t)m * D))[64 * j + lane] = v[j] * rs * gn; }
        }
    }
#undef IN_PH
#undef END_PH
}

extern "C" void kernel_launch(void* const* d_in, const int* in_sizes, int n_in, void* d_out, int out_size, void* d_ws, size_t ws_size, hipStream_t stream) {
    static int grid = 0;
    if (grid == 0) {
        if (n_in != 12 || in_sizes[0] != M * D || out_size != M * D || ws_size < WS_END) { fprintf(stderr, "kernel_launch: unexpected shapes / workspace (n_in %d, ws %zu, need %zu)\n", n_in, ws_size, (size_t)WS_END); grid = -1; return; }
        int dev = 0, cus = 0, per_cu = 0;
        if (hipGetDevice(&dev) != hipSuccess || hipDeviceGetAttribute(&cus, hipDeviceAttributeMultiprocessorCount, dev) != hipSuccess) { grid = -1; return; }
        if (hipFuncSetAttribute((const void*)fwd_kernel, hipFuncAttributeMaxDynamicSharedMemorySize, LDS_BYTES) != hipSuccess) { fprintf(stderr, "kernel_launch: hipFuncSetAttribute failed\n"); grid = -1; return; }
        if (hipOccupancyMaxActiveBlocksPerMultiprocessor(&per_cu, (const void*)fwd_kernel, NT, LDS_BYTES) != hipSuccess || per_cu < 1) { fprintf(stderr, "kernel_launch: occupancy query says %d blocks per CU\n", per_cu); grid = -1; (void)hipGetLastError(); return; }
        grid = cus;
    }
    if (grid < 0) return;
    Args a{};
    for (int i = 0; i < 12; ++i) a.in[i] = (const float*)d_in[i];
    a.out = (float*)d_out; a.ws = (unsigned char*)d_ws;
#if MK_N_LAUNCHES == 1
    (void)hipMemsetAsync((char*)d_ws + WS_CTL, 0, CTL_ZERO_BYTES, stream);
    a.ph_lo = 0; a.ph_hi = N_PHASES;
    void* kargs[] = {&a};
    hipError_t e = hipLaunchCooperativeKernel((const void*)fwd_kernel, dim3(grid), dim3(NT), kargs, LDS_BYTES, stream);
    if (e != hipSuccess) fprintf(stderr, "cooperative launch failed: %s (grid %d)\n", hipGetErrorString(e), grid);
#else
    for (int p = 0; p < N_PHASES; ++p) {
        a.ph_lo = p; a.ph_hi = p + 1;
        hipLaunchKernelGGL(fwd_kernel, dim3(grid), dim3(NT), LDS_BYTES, stream, a);
    }
#endif
}
```

```cpp
#include <hip/hip_runtime.h>
#include <cstdio>
#include <cstdint>

#ifndef MK_N_LAUNCHES
#define MK_N_LAUNCHES 1
#endif

#ifndef PROBE_PH
#define PROBE_PH (-1)
#endif
#define PROBE_REP 3
#define PROBE_BARS 0

#define LAS __attribute__((address_space(3)))
typedef unsigned short bf16_t;
typedef short bf16x8 __attribute__((ext_vector_type(8)));
typedef float f32x4 __attribute__((ext_vector_type(4)));
typedef float f32x2 __attribute__((ext_vector_type(2)));
typedef unsigned u32x4 __attribute__((ext_vector_type(4)));
typedef unsigned u32x2 __attribute__((ext_vector_type(2)));

constexpr int BATCH = 8, SEQ = 2048, D = 1024, DEPTH = 4, M = BATCH * SEQ;
constexpr int NH = 8, DK = 64, DV = 128, NQKVO = 3072, NIN = 3088, FF = 2816, GU = 2 * FF, CH = 64, NCH = SEQ / CH;
constexpr int NITEM = BATCH * NH * NCH;
constexpr int STE = (DV + 1) * DK;
constexpr float EPS = 1e-6f, SOFTCAP = 15.0f;

__device__ __forceinline__ unsigned cvt_pk_bf16(float lo, float hi) { unsigned r; asm volatile("v_cvt_pk_bf16_f32 %0, %1, %2" : "=v"(r) : "v"(lo), "v"(hi)); return r; }
__device__ __forceinline__ float bf2f(unsigned short u) { return __uint_as_float((unsigned)u << 16); }
__device__ __forceinline__ float bflo(unsigned u) { return __uint_as_float(u << 16); }
__device__ __forceinline__ float bfhi(unsigned u) { return __uint_as_float(u & 0xffff0000u); }
__device__ __forceinline__ unsigned short f2bf(float f) { unsigned u = __float_as_uint(f); return (unsigned short)((u + 0x7fffu + ((u >> 16) & 1u)) >> 16); }


typedef short s16x4 __attribute__((ext_vector_type(4)));
typedef float f32x16 __attribute__((ext_vector_type(16)));
__device__ __forceinline__ unsigned pack2(float a, float b) { typedef __bf16 bf2 __attribute__((ext_vector_type(2))); f32x2 v = {a, b}; bf2 r = __builtin_convertvector(v, bf2); return __builtin_bit_cast(unsigned, r); }
__device__ __forceinline__ bf16x8 tr_pair(LAS unsigned char* p, int delta) {
    const s16x4 lo = __builtin_amdgcn_ds_read_tr16_b64_v4i16((LAS s16x4*)p), hi = __builtin_amdgcn_ds_read_tr16_b64_v4i16((LAS s16x4*)(p + delta));
    return __builtin_shufflevector(lo, hi, 0, 1, 2, 3, 4, 5, 6, 7);
}
#define MFMA32(a, b, c) __builtin_amdgcn_mfma_f32_32x32x16_bf16((a), (b), (c), 0, 0, 0)
__device__ __forceinline__ f32x16 zero16() { f32x16 z; for (int i = 0; i < 16; ++i) z[i] = 0.f; return z; }

namespace pg8 {
constexpr int BM = 256, BK = 64, HALF = 128, HTB = HALF * BK * 2, STAGE_BYTES = 8 * HTB, NXCD = 8, WGM = 8;
__host__ __device__ __forceinline__ int lds_byte(int r, int c) { const int st = (r >> 4) * 2 + (c >> 5), rr = r & 15, cc = c & 31, ob = rr * 64 + cc * 2; return st * 1024 + (ob ^ (((ob >> 9) & 1) << 5)); }
__host__ __device__ __forceinline__ void stage_rc(int b, int& R, int& C) { const int st = b / 1024, sb = b % 1024, swz = sb ^ (((sb >> 9) & 1) << 5); R = (st >> 1) * 16 + swz / 64; C = (st & 1) * 32 + (swz % 64) / 2; }
__host__ __device__ __forceinline__ int perm32(int rho) { const int n = rho >> 4, i = rho & 15; return 8 * (i >> 2) + 4 * n + (i & 3); }

struct Unit { int pm, pn, idx; };
struct Gemm { const bf16_t* A; const bf16_t* Bt; };

struct Order {
    int nM, nN, nwg, G, c;
    const float* ssq;
    LAS float* tab;
    __device__ void init(int M_, int N, int G_, int c_, const float* ssq_, LAS float* tab_) { nM = M_ / BM; nN = N / BM; nwg = nM * nN; G = G_; c = c_; ssq = ssq_; tab = tab_; }
    __device__ bool next(int i, Unit& u) const {
        const long L = (long)i * G + c; if (L >= nwg) return false;
        int wgid = (int)L; { const int q = nwg / NXCD, r = nwg % NXCD, xcd = wgid % NXCD, off = wgid / NXCD; wgid = (xcd < r ? xcd * (q + 1) : r * (q + 1) + (xcd - r) * q) + off; }
        const int nig = WGM * nN, gid = wgid / nig, fm = gid * WGM, gsz = (nM - fm) < WGM ? (nM - fm) : WGM;
        u.pm = fm + ((wgid % nig) % gsz); u.pn = (wgid % nig) / gsz; u.idx = i; return true;
    }
    __device__ __forceinline__ void a_ready(const Unit& u) const {
        int t_ = threadIdx.x; asm volatile("" : "+v"(t_));
        if (ssq != nullptr && t_ < 256) {
            const f32x4* p = (const f32x4*)(ssq + (size_t)(u.pm * BM + t_) * 16);
            const f32x4 a = p[0], b = p[1], c4 = p[2], d = p[3];
            const float s = ((a[0] + a[1]) + (a[2] + a[3])) + ((b[0] + b[1]) + (b[2] + b[3])) + ((c4[0] + c4[1]) + (c4[2] + c4[3])) + ((d[0] + d[1]) + (d[2] + d[3]));
            tab[(u.idx & 1) * 256 + t_] = __builtin_amdgcn_rsqf(s * (1.0f / D) + EPS);
        }
    }
    __device__ __forceinline__ void done(const Unit&) const {}
};

__device__ __forceinline__ float sigmoidf_fast(float x) { return __builtin_amdgcn_rcpf(1.0f + __expf(-x)); }

struct EpiProj {
    static constexpr bool PERM = true, HAS_INIT = false;
    bf16_t* O; const LAS float* tab;
    __device__ __forceinline__ void operator()(const f32x4 (&acc)[2][2][4][2], const Unit& u, int wr, int wc, int fr, int fq) const {
        const LAS float* t = tab + (u.idx & 1) * 256;
        const bool sig = u.pn >= 8;
        const int row0 = u.pm * BM + wr * 64 + fr, col0 = u.pn * BM + wc * 32 + 8 * fq;
#pragma unroll
        for (int ai = 0; ai < 2; ++ai)
#pragma unroll
            for (int m = 0; m < 4; ++m) {
                const float rs = t[ai * HALF + wr * 64 + m * 16 + fr];
                bf16_t* rowp = O + (size_t)(row0 + ai * HALF + m * 16) * NQKVO + col0;
#pragma unroll
                for (int bj = 0; bj < 2; ++bj) {
                    f32x4 v0 = acc[ai][bj][m][0] * rs, v1 = acc[ai][bj][m][1] * rs;
                    if (sig) {
#pragma unroll
                        for (int i = 0; i < 4; ++i) { v0[i] = sigmoidf_fast(v0[i]); v1[i] = sigmoidf_fast(v1[i]); }
                    }
                    u32x4 w; w.x = cvt_pk_bf16(v0[0], v0[1]); w.y = cvt_pk_bf16(v0[2], v0[3]); w.z = cvt_pk_bf16(v1[0], v1[1]); w.w = cvt_pk_bf16(v1[2], v1[3]);
                    *(u32x4*)(rowp + bj * HALF) = w;
                }
            }
    }
};
struct EpiGU {
    static constexpr bool PERM = true, HAS_INIT = false;
    bf16_t* H; const LAS float* tab;
    __device__ __forceinline__ void operator()(const f32x4 (&acc)[2][2][4][2], const Unit& u, int wr, int wc, int fr, int fq) const {
        const LAS float* t = tab + (u.idx & 1) * 256;
        const int row0 = u.pm * BM + wr * 64 + fr, col0 = u.pn * HALF + wc * 32 + 8 * fq;
#pragma unroll
        for (int ai = 0; ai < 2; ++ai)
#pragma unroll
            for (int m = 0; m < 4; ++m) {
                const float rs = t[ai * HALF + wr * 64 + m * 16 + fr];
                float hv[8];
#pragma unroll
                for (int n = 0; n < 2; ++n)
#pragma unroll
                    for (int i = 0; i < 4; ++i) { const float g = acc[ai][0][m][n][i] * rs, uu = acc[ai][1][m][n][i] * rs; hv[n * 4 + i] = g * uu * sigmoidf_fast(g); }
                u32x4 w; w.x = cvt_pk_bf16(hv[0], hv[1]); w.y = cvt_pk_bf16(hv[2], hv[3]); w.z = cvt_pk_bf16(hv[4], hv[5]); w.w = cvt_pk_bf16(hv[6], hv[7]);
                *(u32x4*)(H + (size_t)(row0 + ai * HALF + m * 16) * FF + col0) = w;
            }
    }
};
struct EpiRes {
    static constexpr bool PERM = true, HAS_INIT = true;
    bf16_t* xb; bf16_t* xo; float* ssq_out;
    __device__ __forceinline__ void init(f32x4 (&acc)[2][2][4][2], const Unit& u, int wr, int wc, int fr, int fq) const {
        const int row0 = u.pm * BM + wr * 64 + fr, col0 = u.pn * BM + wc * 32 + 8 * fq;
        u32x4 t[2][4][2];
#pragma unroll
        for (int ai = 0; ai < 2; ++ai)
#pragma unroll
            for (int m = 0; m < 4; ++m)
#pragma unroll
                for (int bj = 0; bj < 2; ++bj) t[ai][m][bj] = *(const u32x4*)(xb + (size_t)(row0 + ai * HALF + m * 16) * D + col0 + bj * HALF);
#pragma unroll
        for (int ai = 0; ai < 2; ++ai)
#pragma unroll
            for (int m = 0; m < 4; ++m)
#pragma unroll
                for (int bj = 0; bj < 2; ++bj) { const u32x4 v = t[ai][m][bj];
                    acc[ai][bj][m][0] = (f32x4){bflo(v.x), bfhi(v.x), bflo(v.y), bfhi(v.y)}; acc[ai][bj][m][1] = (f32x4){bflo(v.z), bfhi(v.z), bflo(v.w), bfhi(v.w)}; }
    }
    __device__ __forceinline__ void operator()(const f32x4 (&acc)[2][2][4][2], const Unit& u, int wr, int wc, int fr, int fq) const {
        const int row0 = u.pm * BM + wr * 64 + fr, col0 = u.pn * BM + wc * 32 + 8 * fq;
#pragma unroll
        for (int ai = 0; ai < 2; ++ai)
#pragma unroll
            for (int m = 0; m < 4; ++m) {
                const int row = row0 + ai * HALF + m * 16; float ss = 0.f;
#pragma unroll
                for (int bj = 0; bj < 2; ++bj) {
                    const f32x4 v0 = acc[ai][bj][m][0], v1 = acc[ai][bj][m][1];
                    u32x4 w; w.x = cvt_pk_bf16(v0[0], v0[1]); w.y = cvt_pk_bf16(v0[2], v0[3]); w.z = cvt_pk_bf16(v1[0], v1[1]); w.w = cvt_pk_bf16(v1[2], v1[3]);
                    *(u32x4*)(xo + (size_t)row * D + col0 + bj * HALF) = w;
                    ss += ((v0[0] * v0[0] + v0[1] * v0[1]) + (v0[2] * v0[2] + v0[3] * v0[3])) + ((v1[0] * v1[0] + v1[1] * v1[1]) + (v1[2] * v1[2] + v1[3] * v1[3]));
                }
                ss += __shfl_xor(ss, 16); ss += __shfl_xor(ss, 32);
                if (fq == 0) ssq_out[(size_t)row * 16 + u.pn * 4 + wc] = ss;
            }
    }
};

template <class Epi, bool ALIGN_EPI, int LDA, int LDB, int KLEN, int ACOL>
__device__ __forceinline__ void gemm_phase(LAS unsigned char* lds, const Gemm g, const Order& S, const Epi& E) {
    int tid_ = threadIdx.x; asm volatile("" : "+v"(tid_));
    const int tid = tid_, wid = __builtin_amdgcn_readfirstlane(tid >> 6), lane = tid & 63, wr = wid >> 2, wc = wid & 3, fr = lane & 15, fq = lane >> 4;
    constexpr int nt = KLEN / BK;
    unsigned voffA[2], voffB[2];
#pragma unroll
    for (int i = 0; i < 2; ++i) { int R, C; stage_rc(tid * 16 + i * 8192, R, C); const int Rb = Epi::PERM ? ((R & ~31) + perm32(R & 31)) : R;
        voffA[i] = (unsigned)(R * LDA + C) * 2u; voffB[i] = (unsigned)(Rb * LDB + C) * 2u; }
    constexpr size_t kstep = (size_t)(BK * 2);
    constexpr size_t hstepA = (size_t)HALF * LDA * 2, tstepA = 2 * hstepA, hstepB = (size_t)HALF * LDB * 2, tstepB = 2 * hstepB;
    constexpr size_t pnstepA = (size_t)ACOL * 2;
    const unsigned ldsw = (unsigned)wid * 1024u;
    const int aoff = lds_byte(wr * 64 + fr, fq * 8), boff = lds_byte(wc * 32 + fr, fq * 8);
#define PG8_SA(b, h) (((b) * 2 + (h)) * HTB)
#define PG8_SB(b, h) ((4 + (b) * 2 + (h)) * HTB)
#define PG8_STAGE(bufoff, gbase, voff) do { _Pragma("unroll") for (int _i = 0; _i < 2; ++_i) \
        __builtin_amdgcn_global_load_lds((const unsigned*)((const char*)(gbase) + (voff)[_i]), (LAS unsigned*)(lds + (bufoff) + ldsw + _i * 8192), 16, 0, 0); } while (0)
#define PG8_LDA(dst, b, h) do { _Pragma("unroll") for (int m = 0; m < 4; ++m) _Pragma("unroll") for (int k = 0; k < 2; ++k) dst[m][k] = *(const LAS bf16x8*)(lds + PG8_SA(b, h) + aoff + m * 2048 + k * 1024); } while (0)
#define PG8_LDB(dst, b, h) do { _Pragma("unroll") for (int n = 0; n < 2; ++n) _Pragma("unroll") for (int k = 0; k < 2; ++k) dst[n][k] = *(const LAS bf16x8*)(lds + PG8_SB(b, h) + boff + n * 2048 + k * 1024); } while (0)
#define PG8_MMA(ai, bj, At, Bt) do { __builtin_amdgcn_s_setprio(1); _Pragma("unroll") for (int m = 0; m < 4; ++m) _Pragma("unroll") for (int n = 0; n < 2; ++n) _Pragma("unroll") for (int k = 0; k < 2; ++k) \
        acc[ai][bj][m][n] = __builtin_amdgcn_mfma_f32_16x16x32_bf16(Bt[n][k], At[m][k], acc[ai][bj][m][n], 0, 0, 0); __builtin_amdgcn_s_setprio(0); } while (0)
#define PG8_WAIT_V(n) asm volatile("s_waitcnt vmcnt(" #n ")" ::: "memory")
#define PG8_WAIT_L(n) asm volatile("s_waitcnt lgkmcnt(" #n ")" ::: "memory")
#define PG8_BAR __builtin_amdgcn_s_barrier()
#define PG8_SCHED __builtin_amdgcn_sched_barrier(0)
    Unit cur, nxt; int ui = 0;
    if (!S.next(0, cur)) return;
    f32x4 acc[2][2][4][2];
    if constexpr (Epi::HAS_INIT) E.init(acc, cur, wr, wc, fr, fq);
    else {
#pragma unroll
    for (int a = 0; a < 2; ++a)
#pragma unroll
        for (int b = 0; b < 2; ++b)
#pragma unroll
            for (int m = 0; m < 4; ++m)
#pragma unroll
                for (int n = 0; n < 2; ++n) acc[a][b][m][n] = (f32x4){0.f, 0.f, 0.f, 0.f};
    }
    bf16x8 At[4][2], B0[2][2], B1[2][2];
    const char* cA = (const char*)g.A + (size_t)cur.pm * tstepA + (size_t)cur.pn * pnstepA; const char* cB = (const char*)g.Bt + (size_t)cur.pn * tstepB;
    S.a_ready(cur);
    PG8_STAGE(PG8_SB(0, 0), cB, voffB); PG8_STAGE(PG8_SB(0, 1), cB + hstepB, voffB); PG8_STAGE(PG8_SA(0, 0), cA, voffA); PG8_STAGE(PG8_SA(0, 1), cA + hstepA, voffA);
    if (wr == 1) PG8_BAR;
    PG8_WAIT_V(2); PG8_BAR;
    PG8_STAGE(PG8_SB(1, 0), cB + kstep, voffB); PG8_STAGE(PG8_SA(1, 0), cA + kstep, voffA); PG8_STAGE(PG8_SB(1, 1), cB + hstepB + kstep, voffB);
    PG8_WAIT_V(6); PG8_BAR;
    for (;;) {
        const bool has_next = S.next(ui + 1, nxt);
        const char* nA = has_next ? (const char*)g.A + (size_t)nxt.pm * tstepA + (size_t)nxt.pn * pnstepA : cA; const char* nB = has_next ? (const char*)g.Bt + (size_t)nxt.pn * tstepB : cB;
#pragma unroll 1
        for (int t = 0; t < nt; t += 2) {
            const bool last = (t == nt - 2);
            const char* a1 = cA + (size_t)(t + 1) * kstep;
            const char* a2 = last ? nA : cA + (size_t)(t + 2) * kstep; const char* b2 = last ? nB : cB + (size_t)(t + 2) * kstep;
            const char* a3 = a2 + kstep; const char* b3 = b2 + kstep;
            if (last && has_next) S.a_ready(nxt);
            PG8_LDB(B0, 0, 0); PG8_LDB(B1, 0, 1); PG8_SCHED; PG8_LDA(At, 0, 0); PG8_STAGE(PG8_SA(1, 1), a1 + hstepA, voffA);
            PG8_WAIT_V(8); PG8_WAIT_L(0); PG8_BAR; PG8_MMA(0, 0, At, B0); PG8_MMA(0, 1, At, B1); PG8_BAR; PG8_SCHED;
            PG8_LDA(At, 0, 1); PG8_STAGE(PG8_SB(0, 0), b2, voffB); PG8_STAGE(PG8_SB(0, 1), b2 + hstepB, voffB); PG8_STAGE(PG8_SA(0, 0), a2, voffA);
            PG8_WAIT_V(8); PG8_WAIT_L(0); PG8_BAR; PG8_MMA(1, 0, At, B0); PG8_MMA(1, 1, At, B1); PG8_BAR; PG8_SCHED;
            PG8_LDB(B0, 1, 0); PG8_LDB(B1, 1, 1); PG8_SCHED; PG8_LDA(At, 1, 0); PG8_STAGE(PG8_SA(0, 1), a2 + hstepA, voffA);
            PG8_WAIT_V(8); PG8_WAIT_L(0); PG8_BAR; PG8_MMA(0, 0, At, B0); PG8_MMA(0, 1, At, B1); PG8_BAR; PG8_SCHED;
            PG8_LDA(At, 1, 1); PG8_STAGE(PG8_SB(1, 0), b3, voffB); PG8_STAGE(PG8_SB(1, 1), b3 + hstepB, voffB); PG8_STAGE(PG8_SA(1, 0), a3, voffA);
            PG8_WAIT_V(8); PG8_WAIT_L(0); PG8_BAR; PG8_MMA(1, 0, At, B0); PG8_MMA(1, 1, At, B1); PG8_BAR; PG8_SCHED;
        }
        if constexpr (ALIGN_EPI) { if (wr == 0) PG8_BAR; }
        E(acc, cur, wr, wc, fr, fq); S.done(cur);
        if (!has_next) break;
        if constexpr (Epi::HAS_INIT) E.init(acc, nxt, wr, wc, fr, fq);
        else {
#pragma unroll
        for (int a = 0; a < 2; ++a)
#pragma unroll
            for (int b = 0; b < 2; ++b)
#pragma unroll
                for (int m = 0; m < 4; ++m)
#pragma unroll
                    for (int n = 0; n < 2; ++n) acc[a][b][m][n] = (f32x4){0.f, 0.f, 0.f, 0.f};
        }
        cur = nxt; cA = nA; cB = nB; ++ui;
        if constexpr (ALIGN_EPI) { if (wr == 1) PG8_BAR; }
    }
    PG8_WAIT_V(0);
    if constexpr (!ALIGN_EPI) { if (wr == 0) PG8_BAR; }
    PG8_BAR;
#undef PG8_SA
#undef PG8_SB
#undef PG8_STAGE
#undef PG8_LDA
#undef PG8_LDB
#undef PG8_MMA
#undef PG8_WAIT_V
#undef PG8_WAIT_L
#undef PG8_BAR
#undef PG8_SCHED
}
}

constexpr size_t MiB = 1u << 20;
constexpr size_t WS_CTL = 0, CTL_ZERO_BYTES = 1 * MiB;
constexpr size_t SZ_WIN = (size_t)NQKVO * D * 2, SZ_WOUT = (size_t)D * D * 2, SZ_WPOOL = (size_t)D * 256 * 2, SZ_WGU = (size_t)GU * D * 2, SZ_WDN = (size_t)D * FF * 2, SZ_WG = (size_t)16 * D * 2;
constexpr size_t WS_WIN = 1 * MiB;
constexpr size_t WS_WOUT = WS_WIN + 2 * SZ_WIN;
constexpr size_t WS_WPOOL = WS_WOUT + 2 * SZ_WOUT;
constexpr size_t WS_WGU = WS_WPOOL + 2 * SZ_WPOOL;
constexpr size_t WS_WDN = WS_WGU + 4 * SZ_WGU;
constexpr size_t WS_WG = WS_WDN + 4 * SZ_WDN;
constexpr size_t WS_SSQ = WS_WG + 2 * SZ_WG;
constexpr size_t SZ_SSQ = (size_t)M * 16 * 4;
constexpr size_t WS_GATES = WS_SSQ + 9 * SZ_SSQ;
constexpr size_t WS_DECAY = WS_GATES + SZ_SSQ;
constexpr size_t WS_XB = ((WS_DECAY + NITEM * 4 + MiB - 1) / MiB) * MiB;
constexpr size_t WS_BIG = WS_XB + (size_t)M * D * 2;
constexpr size_t WS_ST = WS_BIG + (size_t)M * NQKVO * 2;
constexpr size_t WS_END = WS_ST + (size_t)NITEM * STE * 4;
static_assert(WS_END <= 352 * MiB, "d_ws map must fit the guaranteed workspace");
static_assert((size_t)M * FF * 2 <= (size_t)M * NQKVO * 2, "H overlays q|k|v|o");

constexpr int CW_BAR = 4096;
constexpr int RING_OFF = 0, RING_BYTES = 131072;
constexpr int LDSCTL_OFF = RING_BYTES, MISC_OFF = LDSCTL_OFF + 320;
constexpr int RSTD_OFF = RING_BYTES + 1024;
constexpr int LDS_BYTES = 147456;
constexpr int NWAVES = 8, NT = NWAVES * 64;

#define VM_WAIT() asm volatile("s_waitcnt vmcnt(0)" ::: "memory")
#define LDS_WAIT() asm volatile("s_waitcnt lgkmcnt(0)" ::: "memory")

#define XB_TMO      128
#define XB_XCNT(j)  (256  + 64 * (j))
#define XB_XSUB(j)  (1280 + 64 * (j))
#define XB_XGEN(j)  (2304 + 64 * (j))
#define XB_TOP      3328
#define XB_TOPGEN   3392
#define XCD_BAR_WORDS 3456
#define XB_SPIN_CAP (1u << 18)
__device__ __forceinline__ unsigned xb_ld(unsigned* p)              { return __hip_atomic_load(p, __ATOMIC_RELAXED, __HIP_MEMORY_SCOPE_AGENT); }
__device__ __forceinline__ unsigned xb_add(unsigned* p, unsigned v) { return __hip_atomic_fetch_add(p, v, __ATOMIC_RELAXED, __HIP_MEMORY_SCOPE_AGENT); }
__device__ __forceinline__ unsigned xb_xcc_id() { return (unsigned)__builtin_amdgcn_s_getreg((3 << 11) | 20) & 0xFu; }
#define XB_SPIN(cond, bar) do { unsigned _sp = 0; while (cond) { __builtin_amdgcn_s_sleep(1); \
    if ((++_sp & 255u) == 0u) { if (xb_ld(&(bar)[XB_TMO])) break; if (_sp > XB_SPIN_CAP) { atomicAdd(&(bar)[XB_TMO], 1u); break; } } } } while (0)
struct XcdBarrier { unsigned* bar; unsigned x; volatile LAS unsigned* st; };
__device__ __forceinline__ XcdBarrier xcd_barrier_post(unsigned* bar, volatile LAS unsigned* st) {
    XcdBarrier b; b.bar = bar; b.x = xb_xcc_id(); b.st = st;
    if (threadIdx.x == 0) (void)xb_add(&bar[XB_XCNT(b.x)], 1u);
    return b;
}
__device__ __forceinline__ void xcd_barrier_complete(unsigned* bar, unsigned x, unsigned& nloc, unsigned& nx) {
    const unsigned G = gridDim.x * gridDim.y * gridDim.z;
    unsigned sum, cnt, mine, sp = 0u;
    for (;;) {
        sum = 0u; cnt = 0u; mine = 0u;
#pragma unroll
        for (unsigned j = 0; j < 16; ++j) { const unsigned c = xb_ld(&bar[XB_XCNT(j)]); sum += c; cnt += (c > 0u) ? 1u : 0u; mine = (j == x) ? c : mine; }
        if (sum == G) break;
        __builtin_amdgcn_s_sleep(1);
        if ((++sp & 255u) == 0u) { if (xb_ld(&bar[XB_TMO])) break; if (sp > XB_SPIN_CAP) { atomicAdd(&bar[XB_TMO], 1u); break; } }
    }
    nloc = mine > 0u ? mine : 1u; nx = cnt > 0u ? cnt : 1u;
}
__device__ __forceinline__ void xcd_barrier(const XcdBarrier& b) {
    asm volatile("s_waitcnt vmcnt(0)" ::: "memory");
    __syncthreads();
    if (threadIdx.x == 0) {
        unsigned* bar = b.bar;
        __builtin_amdgcn_s_waitcnt(0);
        unsigned nloc = b.st[0], nx = b.st[1];
        if (nloc == 0u) { xcd_barrier_complete(bar, b.x, nloc, nx); b.st[0] = nloc; b.st[1] = nx; }
        const unsigned old = xb_add(&bar[XB_XSUB(b.x)], 1u);
        const unsigned gen = old / nloc;
        if (old + 1u == (gen + 1u) * nloc) {
            __builtin_amdgcn_fence(__ATOMIC_RELEASE, "agent");
            asm volatile("s_waitcnt vmcnt(0)" ::: "memory");
            const unsigned og = xb_add(&bar[XB_TOP], 1u);
            const unsigned tg = og / nx;
            if (og + 1u == (tg + 1u) * nx) xb_add(&bar[XB_TOPGEN], 1u);
            else XB_SPIN(xb_ld(&bar[XB_TOPGEN]) == tg, bar);
            __builtin_amdgcn_fence(__ATOMIC_ACQUIRE, "agent");
            xb_add(&bar[XB_XGEN(b.x)], 1u);
            asm volatile("s_waitcnt vmcnt(0)" ::: "memory");
        } else {
            XB_SPIN(xb_ld(&bar[XB_XGEN(b.x)]) == gen, bar);
            __builtin_amdgcn_fence(__ATOMIC_ACQUIRE, "agent");
            asm volatile("s_waitcnt vmcnt(0)" ::: "memory");
        }
    }
    __syncthreads();
}

__device__ __forceinline__ float wave_sum(float v) {
#pragma unroll
    for (int o = 1; o < 64; o <<= 1) v += __shfl_xor(v, o);
    return v;
}
__device__ __forceinline__ float log_sigmoidf(float x) { return fminf(x, 0.f) - log1pf(expf(-fabsf(x))); }
__device__ __forceinline__ float rstd_of(const float* ssq_row) {
    const f32x4* p = (const f32x4*)ssq_row; const f32x4 a = p[0], b = p[1], c = p[2], d = p[3];
    const float s = ((a[0] + a[1]) + (a[2] + a[3])) + ((b[0] + b[1]) + (b[2] + b[3])) + ((c[0] + c[1]) + (c[2] + c[3])) + ((d[0] + d[1]) + (d[2] + d[3]));
    return 1.0f / sqrtf(s * (1.0f / D) + EPS);
}

__device__ __forceinline__ void tr_item64(const float* W, int ldW, int k0, int c0, bf16_t* WT, int ldT, int r0, const float* kg, const float* cg, float mul, LAS unsigned* scr, int lane) {
    const int n4 = lane & 15, kq = lane >> 4;
    f32x4 cm = (f32x4){mul, mul, mul, mul}; if (cg) cm = *(const f32x4*)(cg + c0 + 4 * n4) * mul;
    f32x4 va[8], vb[8];
#pragma unroll
    for (int i = 0; i < 8; ++i) { const int kp = kq + 4 * i; const float* p = W + (size_t)(k0 + 2 * kp) * ldW + c0 + 4 * n4; va[i] = *(const f32x4*)p; vb[i] = *(const f32x4*)(p + ldW); }
#pragma unroll
    for (int i = 0; i < 8; ++i) { const int kp = kq + 4 * i; const float g0 = kg ? kg[k0 + 2 * kp] : 1.0f, g1 = kg ? kg[k0 + 2 * kp + 1] : 1.0f;
#pragma unroll
        for (int e = 0; e < 4; ++e) scr[kp * 65 + 4 * n4 + e] = pack2(va[i][e] * cm[e] * g0, vb[i][e] * cm[e] * g1); }
    LDS_WAIT(); asm volatile("" ::: "memory");
    const int j = lane & 7, nl = lane >> 3;
#pragma unroll
    for (int it = 0; it < 8; ++it) { const int n = nl + 8 * it; u32x4 o; o.x = scr[(4 * j + 0) * 65 + n]; o.y = scr[(4 * j + 1) * 65 + n]; o.z = scr[(4 * j + 2) * 65 + n]; o.w = scr[(4 * j + 3) * 65 + n];
        *(u32x4*)(WT + (size_t)(r0 + n) * ldT + k0 + 8 * j) = o; }
    LDS_WAIT(); asm volatile("" ::: "memory");
}

struct Args { const float* in[12]; float* out; unsigned char* ws; int ph_lo, ph_hi; };
constexpr int N_PHASES = 22;

__global__ void __launch_bounds__(NT, 2) fwd_kernel(Args args) {
    extern __shared__ __attribute__((aligned(16))) unsigned char lds_raw[];
    LAS unsigned char* lds = (LAS unsigned char*)lds_raw;
    volatile LAS unsigned* MISC = (volatile LAS unsigned*)(lds + MISC_OFF);
    LAS float* rtab = (LAS float*)(lds + RSTD_OFF);
    int tid = threadIdx.x, lane = tid & 63, wave = __builtin_amdgcn_readfirstlane(tid >> 6);
#define FRESH_TID() do { tid = threadIdx.x; asm volatile("" : "+v"(tid)); lane = tid & 63; wave = __builtin_amdgcn_readfirstlane(tid >> 6); } while (0)
    const int G = gridDim.x, bid = blockIdx.x;
    unsigned char* const ws = args.ws;
#define x_in       (args.in[0])
#define norm_mix   (args.in[1])
#define norm_ffn   (args.in[2])
#define w_in       (args.in[3])
#define gate_bias  (args.in[4])
#define head_gain  (args.in[5])
#define w_out      (args.in[6])
#define pool_w     (args.in[7])
#define pool_scale (args.in[8])
#define w_gu       (args.in[9])
#define w_dn       (args.in[10])
#define final_norm (args.in[11])
#define Win_t   ((bf16_t*)(ws + WS_WIN))
#define Wout_t  ((bf16_t*)(ws + WS_WOUT))
#define Wpool_t ((bf16_t*)(ws + WS_WPOOL))
#define Wgu_t   ((bf16_t*)(ws + WS_WGU))
#define Wdn_t   ((bf16_t*)(ws + WS_WDN))
#define Wg      ((bf16_t*)(ws + WS_WG))
#define ssq     ((float*)(ws + WS_SSQ))
#define gates   ((float*)(ws + WS_GATES))
#define decay   ((float*)(ws + WS_DECAY))
#define xb      ((bf16_t*)(ws + WS_XB))
#define BIG     ((bf16_t*)(ws + WS_BIG))
#define ST      ((float*)(ws + WS_ST))

    for (int u = tid; u < (LDS_BYTES - LDSCTL_OFF) / 4; u += NT) ((LAS unsigned*)(lds + LDSCTL_OFF))[u] = 0u;
    __syncthreads();
    XcdBarrier bar; bar.bar = (unsigned*)(ws + WS_CTL) + CW_BAR; bar.x = 0; bar.st = nullptr;
    if (MK_N_LAUNCHES == 1) bar = xcd_barrier_post((unsigned*)(ws + WS_CTL) + CW_BAR, MISC + 8);

    const int lo = args.ph_lo, hi = args.ph_hi;
    int ph = 0;
#define IN_PH() (lo <= ph && ph < hi)
#define BEGIN_PH() FRESH_TID()
#if PROBE_PH >= 0
#define REPS() ((ph == PROBE_PH) ? PROBE_REP : 1)
#define LAST_REP() (rep_ + 1 == REPS())
#else
#define REPS() 1
#define LAST_REP() true
#endif
#define END_PH() do { if (lo <= ph && ph + 1 < hi) xcd_barrier(bar); ++ph; } while (0)

    if (IN_PH()) for (int rep_ = 0; rep_ < REPS(); ++rep_) { BEGIN_PH();
        LAS unsigned* scr = (LAS unsigned*)(lds + RING_OFF + wave * 8448);
        const int gw = bid * NWAVES + wave, NGW = G * NWAVES;
        constexpr int I_IN = 16 * 48, I_OUT = 16 * 16, I_POOL = 4 * 4 * 4, I_GU = 16 * 88, I_DN = 44 * 16;
        constexpr int NITEMS = 2 * I_IN + 2 * I_OUT + 2 * I_POOL + 4 * I_GU + 4 * I_DN;
        for (int it = gw; it < NITEMS; it += NGW) {
            int r = it;
            if (r < 4 * I_GU) { const int l = r / I_GU; r -= l * I_GU; const int kb = r / 88, nb = r % 88, r0 = nb * 64, pn = r0 >> 8, j = r0 & 255;
                const int c0 = (j < 128) ? pn * 128 + j : FF + pn * 128 + (j - 128);
                tr_item64(w_gu + (size_t)l * D * GU, GU, kb * 64, c0, Wgu_t + (size_t)l * GU * D, D, r0, norm_ffn + l * D, nullptr, 1.0f, scr, lane); continue; }
            r -= 4 * I_GU;
            if (r < 4 * I_DN) { const int l = r / I_DN; r -= l * I_DN; const int kb = r / 16, nb = r % 16;
                tr_item64(w_dn + (size_t)l * FF * D, D, kb * 64, nb * 64, Wdn_t + (size_t)l * D * FF, FF, nb * 64, nullptr, nullptr, 1.0f, scr, lane); continue; }
            r -= 4 * I_DN;
            if (r < 2 * I_IN) { const int l = r / I_IN; r -= l * I_IN; const int kb = r / 48, nb = r % 48, r0 = nb * 64;
                tr_item64(w_in + (size_t)l * D * NIN, NIN, kb * 64, r0, Win_t + (size_t)l * NQKVO * D, D, r0, norm_mix + (2 * l) * D, nullptr, (r0 >= 512 && r0 < 1024) ? 0.125f : 1.0f, scr, lane); continue; }
            r -= 2 * I_IN;
            if (r < 2 * I_OUT) { const int l = r / I_OUT; r -= l * I_OUT; const int kb = r / 16, nb = r % 16;
                tr_item64(w_out + (size_t)l * D * D, D, kb * 64, nb * 64, Wout_t + (size_t)l * D * D, D, nb * 64, head_gain + l * D, nullptr, 1.0f, scr, lane); continue; }
            r -= 2 * I_OUT;
            { const int l = r / I_POOL; r -= l * I_POOL; const int gi = r / 16; r -= gi * 16; const int kb = r / 4, nb = r % 4;
                tr_item64(pool_w + (size_t)(l * 4 + gi) * 256 * 256, 256, kb * 64, nb * 64, Wpool_t + (size_t)l * D * 256 + (size_t)gi * 256 * 256, 256, nb * 64,
                          norm_mix + (2 * l + 1) * D + gi * 256, pool_scale + l * D + gi * 256, 1.0f, scr, lane); }
        }
        for (int e = bid * NT + tid; e < 2 * 16 * D; e += G * NT) { const int l = e / (16 * D), rem = e % (16 * D), k = rem >> 4, j = rem & 15;
            Wg[(size_t)l * 16 * D + j * D + k] = f2bf(w_in[(size_t)l * D * NIN + (size_t)k * NIN + NQKVO + j] * norm_mix[(2 * l) * D + k]); }
        for (int m = 2 * gw; m < M; m += 2 * NGW) {
            const f32x4* xr = (const f32x4*)(x_in + (size_t)m * D) + lane; f32x4 v[8]; float s0 = 0.f, s1 = 0.f;
#pragma unroll
            for (int j = 0; j < 8; ++j) v[j] = xr[64 * j];
#pragma unroll
            for (int j = 0; j < 4; ++j) { s0 += (v[j][0] * v[j][0] + v[j][1] * v[j][1]) + (v[j][2] * v[j][2] + v[j][3] * v[j][3]);
                                          s1 += (v[j + 4][0] * v[j + 4][0] + v[j + 4][1] * v[j + 4][1]) + (v[j + 4][2] * v[j + 4][2] + v[j + 4][3] * v[j + 4][3]); }
            s0 = wave_sum(s0); s1 = wave_sum(s1);
#pragma unroll
            for (int j = 0; j < 8; ++j) { u32x2 w; w.x = cvt_pk_bf16(v[j][0], v[j][1]); w.y = cvt_pk_bf16(v[j][2], v[j][3]); ((u32x2*)(xb + (size_t)m * D))[64 * j + lane] = w; }
            if (lane < 32) ssq[(size_t)m * 16 + lane] = (lane == 0) ? s0 : (lane == 16) ? s1 : 0.f;
        }
    }
    END_PH();
#if PROBE_BARS > 0
    if (MK_N_LAUNCHES == 1) for (int i_ = 0; i_ < PROBE_BARS; ++i_) xcd_barrier(bar);
#endif

    for (int layer = 0; layer < DEPTH; ++layer) {
        const int slot = layer >> 1;
        float* ssq_a = ssq + (size_t)(2 * layer) * M * 16;
        float* ssq_b = ssq_a + (size_t)M * 16;
        float* ssq_c = ssq_b + (size_t)M * 16;
        if ((layer & 1) == 0) {
            if (IN_PH()) for (int rep_ = 0; rep_ < REPS(); ++rep_) { BEGIN_PH();
                {
                    const bf16_t* wgb = Wg + (size_t)slot * 16 * D;
                    LAS float* red = (LAS float*)lds;
                    const int rbk = wave & 3, kh = wave >> 2, fr = lane & 15, fq = lane >> 4;
                    for (int rb = bid; rb < M / 64; rb += G) {
                        const bf16_t* ap = xb + (size_t)(rb * 64 + rbk * 16 + fr) * D + kh * 512 + 8 * fq;
                        const bf16_t* bp = wgb + (size_t)fr * D + kh * 512 + 8 * fq;
                        f32x4 ga = (f32x4){0.f, 0.f, 0.f, 0.f};
#pragma unroll
                        for (int ks = 0; ks < 16; ++ks) ga = __builtin_amdgcn_mfma_f32_16x16x32_bf16(*(const bf16x8*)(ap + 32 * ks), *(const bf16x8*)(bp + 32 * ks), ga, 0, 0, 0);
                        if (kh == 1) *(LAS f32x4*)(red + (rbk * 64 + lane) * 4) = ga;
                        __syncthreads();
                        if (kh == 0) {
                            ga += *(const LAS f32x4*)(red + (rbk * 64 + lane) * 4);
                            const float gb = gate_bias[slot * 16 + fr];
#pragma unroll
                            for (int r = 0; r < 4; ++r) { const int row = rb * 64 + rbk * 16 + 4 * fq + r; const float gv = ga[r] * rstd_of(ssq_a + (size_t)row * 16) + gb;
                                gates[(size_t)row * 16 + fr] = SOFTCAP * tanhf(gv * (1.0f / SOFTCAP)); }
                        }
                        __syncthreads();
                    }
                }
                pg8::Gemm g{xb, Win_t + (size_t)slot * NQKVO * D}; pg8::Order S; S.init(M, NQKVO, G, bid, ssq_a, rtab);
                pg8::EpiProj E{BIG, rtab};
                pg8::gemm_phase<pg8::EpiProj, true, D, D, D, 0>(lds + RING_OFF, g, S, E);
            }
            END_PH();
            if (IN_PH()) for (int rep_ = 0; rep_ < REPS(); ++rep_) { BEGIN_PH();
                LAS unsigned char* wl = lds + wave * 12288;
                const int hh = lane >> 5, l31 = lane & 31, g16 = (lane >> 4) & 1, q4 = (lane & 15) >> 2, p4 = lane & 3;
                const int troff = (8 * hh + q4) * 192 + (16 * g16 + 4 * p4) * 2;
                bf16x8 a_one; { const short o = (l31 == 0) ? (short)0x3F80 : (short)0; for (int j = 0; j < 8; ++j) a_one[j] = o; }
                for (int T = bid * NWAVES + wave; T < 2 * NITEM; T += G * NWAVES) {
                    const int item = T >> 1, vh = T & 1, b = item >> 8, h = (item >> 5) & 7, c = item & 31, row0 = b * SEQ + c * CH;
                    const float f = gates[(size_t)(row0 + lane) * 16 + 8 + h], ig = gates[(size_t)(row0 + lane) * 16 + h];
                    float sc = log_sigmoidf(f);
#pragma unroll
                    for (int o = 1; o < 64; o <<= 1) { const float t = __shfl_up(sc, o); if (lane >= o) sc += t; }
                    const float bl = __shfl(sc, 63);
                    const float w = __expf(bl - sc + ig);
                    if (vh == 0 && lane == 63) decay[item] = __expf(bl);
                    f32x16 acc[2][2], accn[2];
#pragma unroll
                    for (int i = 0; i < 2; ++i) { accn[i] = zero16(); acc[i][0] = zero16(); acc[i][1] = zero16(); }
#pragma unroll
                    for (int cr = 0; cr < 2; ++cr) {
                        u32x4 kv[4], vv[4];
#pragma unroll
                        for (int i = 0; i < 4; ++i) { const int id = i * 64 + lane, rho = id >> 3, ch = id & 7; const bf16_t* base = BIG + (size_t)(row0 + 32 * cr + rho) * NQKVO;
                            kv[i] = *(const u32x4*)(base + 512 + h * DK + ch * 8); vv[i] = *(const u32x4*)(base + 1024 + h * DV + 64 * vh + ch * 8); }
#pragma unroll
                        for (int i = 0; i < 4; ++i) { const int id = i * 64 + lane, rho = id >> 3, ch = id & 7; const float wr = __shfl(w, 32 * cr + rho);
                            u32x4 ks; ks.x = pack2(bflo(kv[i].x) * wr, bfhi(kv[i].x) * wr); ks.y = pack2(bflo(kv[i].y) * wr, bfhi(kv[i].y) * wr);
                            ks.z = pack2(bflo(kv[i].z) * wr, bfhi(kv[i].z) * wr); ks.w = pack2(bflo(kv[i].w) * wr, bfhi(kv[i].w) * wr);
                            *(LAS u32x4*)(wl + rho * 192 + ch * 16) = ks; *(LAS u32x4*)(wl + 6144 + rho * 192 + ch * 16) = vv[i]; }
#pragma unroll
                        for (int sp = 0; sp < 2; ++sp) {
                            bf16x8 Bf[2], Af[2];
#pragma unroll
                            for (int t2 = 0; t2 < 2; ++t2) { Bf[t2] = tr_pair(wl + troff + sp * 16 * 192 + t2 * 64, 4 * 192); Af[t2] = tr_pair(wl + 6144 + troff + sp * 16 * 192 + t2 * 64, 4 * 192); }
#pragma unroll
                            for (int dt = 0; dt < 2; ++dt) { acc[0][dt] = MFMA32(Af[0], Bf[dt], acc[0][dt]); acc[1][dt] = MFMA32(Af[1], Bf[dt], acc[1][dt]); accn[dt] = MFMA32(a_one, Bf[dt], accn[dt]); }
                        }
                    }
                    float* st = ST + (size_t)item * STE;
#pragma unroll
                    for (int vt = 0; vt < 2; ++vt)
#pragma unroll
                        for (int dt = 0; dt < 2; ++dt)
#pragma unroll
                            for (int r = 0; r < 16; ++r) st[(64 * vh + 32 * vt + (r & 3) + 8 * (r >> 2) + 4 * hh) * 64 + 32 * dt + l31] = acc[vt][dt][r];
                    if (vh == 0 && hh == 0) { st[128 * 64 + l31] = accn[0][0]; st[128 * 64 + 32 + l31] = accn[1][0]; }
                }
            }
            END_PH();
            if (IN_PH()) for (int rep_ = 0; rep_ < REPS(); ++rep_) { BEGIN_PH();
                for (int e = bid * NT + tid; e < BATCH * NH * STE; e += G * NT) {
                    const int bh = e / STE, el = e % STE; float st = 0.f;
                    for (int c = 0; c < NCH; ++c) { const size_t idx = (size_t)(bh * NCH + c) * STE + el; const float u = ST[idx]; ST[idx] = st; st = decay[bh * NCH + c] * st + u; }
                }
            }
            END_PH();
            if (IN_PH()) for (int rep_ = 0; rep_ < REPS(); ++rep_) { BEGIN_PH();
                LAS unsigned char* wl = lds + wave * 12288;
                LAS float* ctab = (LAS float*)(wl + 10240);
                const int hh = lane >> 5, l31 = lane & 31, g16 = (lane >> 4) & 1, q4 = (lane & 15) >> 2, p4 = lane & 3;
                const int troff = (4 * hh + q4) * 320 + (16 * g16 + 4 * p4) * 2;
                bf16x8 a_one; { const short o = (l31 == 0) ? (short)0x3F80 : (short)0; for (int j = 0; j < 8; ++j) a_one[j] = o; }
                for (int T = bid * NWAVES + wave; T < 2 * NITEM; T += G * NWAVES) {
                    const int item = T >> 1, st = T & 1, b = item >> 8, h = (item >> 5) & 7, c = item & 31, row0 = b * SEQ + c * CH;
                    const float f = gates[(size_t)(row0 + lane) * 16 + 8 + h], ig = gates[(size_t)(row0 + lane) * 16 + h];
                    float sc = log_sigmoidf(f);
#pragma unroll
                    for (int o = 1; o < 64; o <<= 1) { const float t = __shfl_up(sc, o); if (lane >= o) sc += t; }
                    ctab[lane] = ig - sc;
                    const float bs = __shfl(sc, 32 * st + l31), eb = __expf(bs);
                    bf16x8 qf[4];
                    { const bf16_t* qp = BIG + (size_t)(row0 + 32 * st + l31) * NQKVO + h * DK + 8 * hh;
#pragma unroll
                      for (int ks = 0; ks < 4; ++ks) qf[ks] = *(const bf16x8*)(qp + 16 * ks); }
                    f32x16 acc[5];
                    const float* stp = ST + (size_t)item * STE;
#pragma unroll
                    for (int vt = 0; vt < 5; ++vt) {
                        acc[vt] = zero16();
                        const int vrow = (vt < 4) ? 32 * vt + l31 : 128;
                        const float* cp = stp + (size_t)vrow * 64 + 8 * hh;
#pragma unroll
                        for (int ks = 0; ks < 4; ++ks) {
                            const f32x4 c0 = *(const f32x4*)(cp + 16 * ks), c1 = *(const f32x4*)(cp + 16 * ks + 4);
                            u32x4 pk; pk.x = pack2(c0[0], c0[1]); pk.y = pack2(c0[2], c0[3]); pk.z = pack2(c1[0], c1[1]); pk.w = pack2(c1[2], c1[3]);
                            if (vt == 4 && l31 != 0) pk = (u32x4){0u, 0u, 0u, 0u};
                            acc[vt] = MFMA32(__builtin_bit_cast(bf16x8, pk), qf[ks], acc[vt]);
                        }
#pragma unroll
                        for (int r = 0; r < 16; ++r) acc[vt][r] *= eb;
                    }
                    LDS_WAIT();
#pragma unroll
                    for (int rt = 0; rt < 2; ++rt) {
                        if (rt <= st) {
                            f32x16 X = zero16();
                            { const bf16_t* kp = BIG + (size_t)(row0 + 32 * rt + l31) * NQKVO + 512 + h * DK + 8 * hh;
#pragma unroll
                              for (int ks = 0; ks < 4; ++ks) X = MFMA32(*(const bf16x8*)(kp + 16 * ks), qf[ks], X); }
                            u32x4 vv[8];
#pragma unroll
                            for (int i = 0; i < 8; ++i) { const int id = i * 64 + lane, rho = id >> 4, ch = id & 15; vv[i] = *(const u32x4*)(BIG + (size_t)(row0 + 32 * rt + rho) * NQKVO + 1024 + h * DV + ch * 8); }
#pragma unroll
                            for (int i = 0; i < 8; ++i) { const int id = i * 64 + lane, rho = id >> 4, ch = id & 15; *(LAS u32x4*)(wl + rho * 320 + ch * 16) = vv[i]; }
#pragma unroll
                            for (int g4 = 0; g4 < 4; ++g4) {
                                const f32x4 cr = *(const LAS f32x4*)(ctab + 32 * rt + 8 * g4 + 4 * hh);
#pragma unroll
                                for (int e = 0; e < 4; ++e) { float pv = X[4 * g4 + e] * __expf(bs + cr[e]); if (rt == st && (8 * g4 + 4 * hh + e) > l31) pv = 0.f; X[4 * g4 + e] = pv; }
                            }
#pragma unroll
                            for (int sp = 0; sp < 2; ++sp) {
                                u32x4 pk; pk.x = pack2(X[8 * sp + 0], X[8 * sp + 1]); pk.y = pack2(X[8 * sp + 2], X[8 * sp + 3]); pk.z = pack2(X[8 * sp + 4], X[8 * sp + 5]); pk.w = pack2(X[8 * sp + 6], X[8 * sp + 7]);
                                const bf16x8 pf = __builtin_bit_cast(bf16x8, pk);
#pragma unroll
                                for (int vt = 0; vt < 4; ++vt) acc[vt] = MFMA32(tr_pair(wl + troff + sp * 16 * 320 + vt * 64, 8 * 320), pf, acc[vt]);
                                acc[4] = MFMA32(a_one, pf, acc[4]);
                            }
                        }
                    }
                    const float den = __shfl(acc[4][0], l31), dd = fmaxf(fabsf(den), 1.0f);
                    float ss = 0.f;
#pragma unroll
                    for (int vt = 0; vt < 4; ++vt)
#pragma unroll
                        for (int r = 0; r < 16; ++r) ss += acc[vt][r] * acc[vt][r];
                    ss += __shfl_xor(ss, 32);
                    const float idd = 1.0f / dd; const float scale = idd / sqrtf(ss * idd * idd * (1.0f / DV) + EPS);
#pragma unroll
                    for (int vt = 0; vt < 4; ++vt)
#pragma unroll
                        for (int g4 = 0; g4 < 4; ++g4) { u32x2 pk; pk.x = pack2(acc[vt][4 * g4] * scale, acc[vt][4 * g4 + 1] * scale); pk.y = pack2(acc[vt][4 * g4 + 2] * scale, acc[vt][4 * g4 + 3] * scale);
                            *(LAS u32x2*)(wl + l31 * 272 + (32 * vt + 8 * g4 + 4 * hh) * 2) = pk; }
#pragma unroll
                    for (int i = 0; i < 8; ++i) { const int id = i * 64 + lane, rho = id >> 4, ch = id & 15;
                        const u32x4 hv = *(const LAS u32x4*)(wl + rho * 272 + ch * 16);
                        u32x4* op = (u32x4*)(BIG + (size_t)(row0 + 32 * st + rho) * NQKVO + 2048 + h * DV + ch * 8); const u32x4 ov = *op;
                        u32x4 w4; w4.x = pack2(bflo(hv.x) * bflo(ov.x), bfhi(hv.x) * bfhi(ov.x)); w4.y = pack2(bflo(hv.y) * bflo(ov.y), bfhi(hv.y) * bfhi(ov.y));
                        w4.z = pack2(bflo(hv.z) * bflo(ov.z), bfhi(hv.z) * bfhi(ov.z)); w4.w = pack2(bflo(hv.w) * bflo(ov.w), bfhi(hv.w) * bfhi(ov.w));
                        *op = w4; }
                    LDS_WAIT();
                }
            }
            END_PH();
        }
        if (IN_PH()) for (int rep_ = 0; rep_ < REPS(); ++rep_) { BEGIN_PH();
            pg8::Order S; S.init(M, D, G, bid, nullptr, rtab);
            pg8::EpiRes E{xb, LAST_REP() ? xb : (bf16_t*)args.out, LAST_REP() ? ssq_b : args.out + 8 * 1024 * 1024};
            if ((layer & 1) == 0) { pg8::Gemm g{BIG + 2048, Wout_t + (size_t)slot * D * D}; pg8::gemm_phase<pg8::EpiRes, false, NQKVO, D, D, 0>(lds + RING_OFF, g, S, E); }
            else {
                pg8::Unit u;
                for (int ui = 0; S.next(ui, u); ++ui) {
                    LAS float* hn = (LAS float*)lds;
                    LAS float* rsv = hn + 79 * 256;
                    const int gi = u.pn, w = 2 << gi, R0 = u.pm * 256, bb = R0 / SEQ, t0 = R0 % SEQ;
                    const int cp = tid & 127, rq = tid >> 7;
                    for (int tb = 0; tb < 4; ++tb) {
                        const int ts = t0 + 64 * tb;
                        __syncthreads();
                        if (tid < 79) { const int t = ts - 15 + tid; rsv[tid] = (t >= 0) ? rstd_of(ssq_a + (size_t)(bb * SEQ + t) * 16) : 0.f; }
                        __syncthreads();
                        for (int rho = rq; rho < 79; rho += 4) { const int t = ts - 15 + rho; float h0 = 0.f, h1 = 0.f;
                            if (t >= 0) { const unsigned xv = ((const unsigned*)(xb + (size_t)(bb * SEQ + t) * D))[128 * gi + cp]; const float r = rsv[rho]; h0 = bflo(xv) * r; h1 = bfhi(xv) * r; }
                            *(LAS f32x2*)(hn + rho * 256 + 2 * cp) = (f32x2){h0, h1}; }
                        __syncthreads();
                        { const int tt0 = 16 * rq;
                          float s0 = 0.f, s1 = 0.f;
                          for (int j = 1; j < w; ++j) { const f32x2 v = *(const LAS f32x2*)(hn + (15 + tt0 - j) * 256 + 2 * cp); s0 += v[0]; s1 += v[1]; }
#pragma unroll 4
                          for (int tt = tt0; tt < tt0 + 16; ++tt) {
                              const f32x2 v = *(const LAS f32x2*)(hn + (15 + tt) * 256 + 2 * cp); s0 += v[0]; s1 += v[1];
                              const int tpos = ts + tt; const float inv = 1.0f / (float)((tpos + 1 < w) ? tpos + 1 : w);
                              ((unsigned*)(BIG + (size_t)(R0 + 64 * tb + tt) * D))[128 * gi + cp] = pack2(s0 * inv - v[0], s1 * inv - v[1]);
                              const f32x2 o = *(const LAS f32x2*)(hn + (15 + tt - w + 1) * 256 + 2 * cp); s0 -= o[0]; s1 -= o[1];
                          } }
                    }
                }
                VM_WAIT(); __syncthreads();
                pg8::Gemm g{BIG, Wpool_t + (size_t)slot * D * 256}; pg8::gemm_phase<pg8::EpiRes, false, D, 256, 256, 256>(lds + RING_OFF, g, S, E);
            }
        }
        END_PH();
        if (IN_PH()) for (int rep_ = 0; rep_ < REPS(); ++rep_) { BEGIN_PH();
            pg8::Gemm g{xb, Wgu_t + (size_t)layer * GU * D}; pg8::Order S; S.init(M, GU, G, bid, ssq_b, rtab);
            pg8::EpiGU E{BIG, rtab};
            pg8::gemm_phase<pg8::EpiGU, true, D, D, D, 0>(lds + RING_OFF, g, S, E);
        }
        END_PH();
        if (IN_PH()) for (int rep_ = 0; rep_ < REPS(); ++rep_) { BEGIN_PH();
            pg8::Gemm g{BIG, Wdn_t + (size_t)layer * D * FF}; pg8::Order S; S.init(M, D, G, bid, nullptr, rtab);
            pg8::EpiRes E{xb, LAST_REP() ? xb : (bf16_t*)args.out, LAST_REP() ? ssq_c : args.out + 8 * 1024 * 1024};
            pg8::gemm_phase<pg8::EpiRes, false, FF, FF, FF, 0>(lds + RING_OFF, g, S, E);
        }
        END_PH();
    }
    if (IN_PH()) for (int rep_ = 0; rep_ < REPS(); ++rep_) { BEGIN_PH();
        const int gw = bid * NWAVES + wave, NGW = G * NWAVES;
        for (int m = gw; m < M; m += NGW) {
            const u32x4 a = ((const u32x4*)(xb + (size_t)m * D))[lane], b2 = ((const u32x4*)(xb + (size_t)m * D))[64 + lane];
            float v[16] = {bflo(a.x), bfhi(a.x), bflo(a.y), bfhi(a.y), bflo(a.z), bfhi(a.z), bflo(a.w), bfhi(a.w), bflo(b2.x), bfhi(b2.x), bflo(b2.y), bfhi(b2.y), bflo(b2.z), bfhi(b2.z), bflo(b2.w), bfhi(b2.w)};
            float sq = 0.f;
#pragma unroll
            for (int j = 0; j < 16; ++j) sq += v[j] * v[j];
            const float rs = 1.0f / sqrtf(wave_sum(sq) * (1.0f / D) + EPS);
#pragma unroll
            for (int hpart = 0; hpart < 2; ++hpart)
#pragma unroll
                for (int q = 0; q < 2; ++q) { const int col = hpart * 512 + lane * 8 + q * 4; const f32x4 gn = *(const f32x4*)(final_norm + col);
                    f32x4 o; o[0] = v[hpart * 8 + q * 4 + 0] * rs * gn[0]; o[1] = v[hpart * 8 + q * 4 + 1] * rs * gn[1]; o[2] = v[hpart * 8 + q * 4 + 2] * rs * gn[2]; o[3] = v[hpart * 8 + q * 4 + 3] * rs * gn[3];
                    *(f32x4*)(args.out + (size_t)m * D + col) = o; }
        }
    }
#undef IN_PH
#undef END_PH
}

extern "C" void kernel_launch(void* const* d_in, const int* in_sizes, int n_in, void* d_out, int out_size, void* d_ws, size_t ws_size, hipStream_t stream) {
    static int grid = 0;
    if (grid == 0) {
        if (n_in != 12 || in_sizes[0] != M * D || out_size != M * D || ws_size < WS_END) { fprintf(stderr, "kernel_launch: unexpected shapes / workspace (n_in %d, ws %zu, need %zu)\n", n_in, ws_size, (size_t)WS_END); grid = -1; return; }
        int dev = 0, cus = 0, per_cu = 0;
        if (hipGetDevice(&dev) != hipSuccess || hipDeviceGetAttribute(&cus, hipDeviceAttributeMultiprocessorCount, dev) != hipSuccess) { grid = -1; return; }
        if (hipFuncSetAttribute((const void*)fwd_kernel, hipFuncAttributeMaxDynamicSharedMemorySize, LDS_BYTES) != hipSuccess) { fprintf(stderr, "kernel_launch: hipFuncSetAttribute failed\n"); grid = -1; return; }
        if (hipOccupancyMaxActiveBlocksPerMultiprocessor(&per_cu, (const void*)fwd_kernel, NT, LDS_BYTES) != hipSuccess || per_cu < 1) { fprintf(stderr, "kernel_launch: occupancy query says %d blocks per CU\n", per_cu); grid = -1; (void)hipGetLastError(); return; }
        grid = cus;
    }
    if (grid < 0) return;
    Args a{};
    for (int i = 0; i < 12; ++i) a.in[i] = (const float*)d_in[i];
    a.out = (float*)d_out; a.ws = (unsigned char*)d_ws;
#if MK_N_LAUNCHES == 1
    (void)hipMemsetAsync((char*)d_ws + WS_CTL, 0, CTL_ZERO_BYTES, stream);
    a.ph_lo = 0; a.ph_hi = N_PHASES;
    void* kargs[] = {&a};
    hipError_t e = hipLaunchCooperativeKernel((const void*)fwd_kernel, dim3(grid), dim3(NT), kargs, LDS_BYTES, stream);
    if (e != hipSuccess) fprintf(stderr, "cooperative launch failed: %s (grid %d)\n", hipGetErrorString(e), grid);
#else
    for (int p = 0; p < N_PHASES; ++p) {
        a.ph_lo = p; a.ph_hi = p + 1;
        hipLaunchKernelGGL(fwd_kernel, dim3(grid), dim3(NT), LDS_BYTES, stream, a);
    }
#endif
}
```

```cpp
#include <hip/hip_runtime.h>
#include <cstdio>
#include <cstdint>

#ifndef MK_N_LAUNCHES
#define MK_N_LAUNCHES 1
#endif

#ifndef PROBE_PH
#define PROBE_PH (-1)
#endif
#define PROBE_REP 3
#define PROBE_BARS 0

#define LAS __attribute__((address_space(3)))
typedef unsigned short bf16_t;
typedef short bf16x8 __attribute__((ext_vector_type(8)));
typedef float f32x4 __attribute__((ext_vector_type(4)));
typedef float f32x2 __attribute__((ext_vector_type(2)));
typedef unsigned u32x4 __attribute__((ext_vector_type(4)));
typedef unsigned u32x2 __attribute__((ext_vector_type(2)));

constexpr int BATCH = 8, SEQ = 2048, D = 1024, DEPTH = 4, M = BATCH * SEQ;
constexpr int NH = 8, DK = 64, DV = 128, NQKVO = 3072, NIN = 3088, FF = 2816, GU = 2 * FF, CH = 64, NCH = SEQ / CH;
constexpr int NITEM = BATCH * NH * NCH;
constexpr int STE = (DV + 1) * DK;
constexpr float EPS = 1e-6f, SOFTCAP = 15.0f;

__device__ __forceinline__ unsigned cvt_pk_bf16(float lo, float hi) { unsigned r; asm volatile("v_cvt_pk_bf16_f32 %0, %1, %2" : "=v"(r) : "v"(lo), "v"(hi)); return r; }
__device__ __forceinline__ float bf2f(unsigned short u) { return __uint_as_float((unsigned)u << 16); }
__device__ __forceinline__ float bflo(unsigned u) { return __uint_as_float(u << 16); }
__device__ __forceinline__ float bfhi(unsigned u) { return __uint_as_float(u & 0xffff0000u); }
__device__ __forceinline__ unsigned short f2bf(float f) { unsigned u = __float_as_uint(f); return (unsigned short)((u + 0x7fffu + ((u >> 16) & 1u)) >> 16); }


typedef short s16x4 __attribute__((ext_vector_type(4)));
typedef float f32x16 __attribute__((ext_vector_type(16)));
__device__ __forceinline__ unsigned pack2(float a, float b) { typedef __bf16 bf2 __attribute__((ext_vector_type(2))); f32x2 v = {a, b}; bf2 r = __builtin_convertvector(v, bf2); return __builtin_bit_cast(unsigned, r); }
__device__ __forceinline__ bf16x8 tr_pair(LAS unsigned char* p, int delta) {
    const s16x4 lo = __builtin_amdgcn_ds_read_tr16_b64_v4i16((LAS s16x4*)p), hi = __builtin_amdgcn_ds_read_tr16_b64_v4i16((LAS s16x4*)(p + delta));
    return __builtin_shufflevector(lo, hi, 0, 1, 2, 3, 4, 5, 6, 7);
}
#define MFMA32(a, b, c) __builtin_amdgcn_mfma_f32_32x32x16_bf16((a), (b), (c), 0, 0, 0)
__device__ __forceinline__ f32x16 zero16() { f32x16 z; for (int i = 0; i < 16; ++i) z[i] = 0.f; return z; }

namespace pg8 {
constexpr int BM = 256, BK = 64, HALF = 128, HTB = HALF * BK * 2, STAGE_BYTES = 8 * HTB, NXCD = 8, WGM = 8;
__host__ __device__ __forceinline__ int lds_byte(int r, int c) { const int st = (r >> 4) * 2 + (c >> 5), rr = r & 15, cc = c & 31, ob = rr * 64 + cc * 2; return st * 1024 + (ob ^ (((ob >> 9) & 1) << 5)); }
__host__ __device__ __forceinline__ void stage_rc(int b, int& R, int& C) { const int st = b / 1024, sb = b % 1024, swz = sb ^ (((sb >> 9) & 1) << 5); R = (st >> 1) * 16 + swz / 64; C = (st & 1) * 32 + (swz % 64) / 2; }
__host__ __device__ __forceinline__ int perm32(int rho) { const int n = rho >> 4, i = rho & 15; return 8 * (i >> 2) + 4 * n + (i & 3); }

struct Unit { int pm, pn, idx; };
struct Gemm { const bf16_t* A; const bf16_t* Bt; };

struct Order {
    int nM, nN, nwg, G, c;
    const float* ssq;
    LAS float* tab;
    __device__ void init(int M_, int N, int G_, int c_, const float* ssq_, LAS float* tab_) { nM = M_ / BM; nN = N / BM; nwg = nM * nN; G = G_; c = c_; ssq = ssq_; tab = tab_; }
    __device__ bool next(int i, Unit& u) const {
        const long L = (long)i * G + c; if (L >= nwg) return false;
        int wgid = (int)L; { const int q = nwg / NXCD, r = nwg % NXCD, xcd = wgid % NXCD, off = wgid / NXCD; wgid = (xcd < r ? xcd * (q + 1) : r * (q + 1) + (xcd - r) * q) + off; }
        const int nig = WGM * nN, gid = wgid / nig, fm = gid * WGM, gsz = (nM - fm) < WGM ? (nM - fm) : WGM;
        u.pm = fm + ((wgid % nig) % gsz); u.pn = (wgid % nig) / gsz; u.idx = i; return true;
    }
    __device__ __forceinline__ void a_ready(const Unit& u) const {
        int t_ = threadIdx.x; asm volatile("" : "+v"(t_));
        if (ssq != nullptr && t_ < 256) {
            const f32x4* p = (const f32x4*)(ssq + (size_t)(u.pm * BM + t_) * 16);
            const f32x4 a = p[0], b = p[1], c4 = p[2], d = p[3];
            const float s = ((a[0] + a[1]) + (a[2] + a[3])) + ((b[0] + b[1]) + (b[2] + b[3])) + ((c4[0] + c4[1]) + (c4[2] + c4[3])) + ((d[0] + d[1]) + (d[2] + d[3]));
            tab[(u.idx & 1) * 256 + t_] = __builtin_amdgcn_rsqf(s * (1.0f / D) + EPS);
        }
    }
    __device__ __forceinline__ void done(const Unit&) const {}
};

__device__ __forceinline__ float sigmoidf_fast(float x) { return __builtin_amdgcn_rcpf(1.0f + __expf(-x)); }

struct EpiProj {
    static constexpr bool PERM = true, HAS_INIT = false;
    bf16_t* O; const LAS float* tab;
    __device__ __forceinline__ void operator()(const f32x4 (&acc)[2][2][4][2], const Unit& u, int wr, int wc, int fr, int fq) const {
        const LAS float* t = tab + (u.idx & 1) * 256;
        const bool sig = u.pn >= 8;
        const int row0 = u.pm * BM + wr * 64 + fr, col0 = u.pn * BM + wc * 32 + 8 * fq;
#pragma unroll
        for (int ai = 0; ai < 2; ++ai)
#pragma unroll
            for (int m = 0; m < 4; ++m) {
                const float rs = t[ai * HALF + wr * 64 + m * 16 + fr];
                bf16_t* rowp = O + (size_t)(row0 + ai * HALF + m * 16) * NQKVO + col0;
#pragma unroll
                for (int bj = 0; bj < 2; ++bj) {
                    f32x4 v0 = acc[ai][bj][m][0] * rs, v1 = acc[ai][bj][m][1] * rs;
                    if (sig) {
#pragma unroll
                        for (int i = 0; i < 4; ++i) { v0[i] = sigmoidf_fast(v0[i]); v1[i] = sigmoidf_fast(v1[i]); }
                    }
                    u32x4 w; w.x = cvt_pk_bf16(v0[0], v0[1]); w.y = cvt_pk_bf16(v0[2], v0[3]); w.z = cvt_pk_bf16(v1[0], v1[1]); w.w = cvt_pk_bf16(v1[2], v1[3]);
                    *(u32x4*)(rowp + bj * HALF) = w;
                }
            }
    }
};
struct EpiGU {
    static constexpr bool PERM = true, HAS_INIT = false;
    bf16_t* H; const LAS float* tab;
    __device__ __forceinline__ void operator()(const f32x4 (&acc)[2][2][4][2], const Unit& u, int wr, int wc, int fr, int fq) const {
        const LAS float* t = tab + (u.idx & 1) * 256;
        const int row0 = u.pm * BM + wr * 64 + fr, col0 = u.pn * HALF + wc * 32 + 8 * fq;
#pragma unroll
        for (int ai = 0; ai < 2; ++ai)
#pragma unroll
            for (int m = 0; m < 4; ++m) {
                const float rs = t[ai * HALF + wr * 64 + m * 16 + fr];
                const float c1 = rs * -1.4426950408889634f, rs2 = rs * rs;
                float hv[8];
#pragma unroll
                for (int n = 0; n < 2; ++n)
#pragma unroll
                    for (int i = 0; i < 4; ++i) { const float g = acc[ai][0][m][n][i], uu = acc[ai][1][m][n][i]; hv[n * 4 + i] = (g * uu) * (rs2 * __builtin_amdgcn_rcpf(1.0f + __builtin_amdgcn_exp2f(g * c1))); }
                u32x4 w; w.x = cvt_pk_bf16(hv[0], hv[1]); w.y = cvt_pk_bf16(hv[2], hv[3]); w.z = cvt_pk_bf16(hv[4], hv[5]); w.w = cvt_pk_bf16(hv[6], hv[7]);
                *(u32x4*)(H + (size_t)(row0 + ai * HALF + m * 16) * FF + col0) = w;
            }
    }
};
struct EpiRes {
    static constexpr bool PERM = true, HAS_INIT = true;
    bf16_t* xb; bf16_t* xo; float* ssq_out;
    __device__ __forceinline__ void init(f32x4 (&acc)[2][2][4][2], const Unit& u, int wr, int wc, int fr, int fq) const {
        const int row0 = u.pm * BM + wr * 64 + fr, col0 = u.pn * BM + wc * 32 + 8 * fq;
        u32x4 t[2][4][2];
#pragma unroll
        for (int ai = 0; ai < 2; ++ai)
#pragma unroll
            for (int m = 0; m < 4; ++m)
#pragma unroll
                for (int bj = 0; bj < 2; ++bj) t[ai][m][bj] = *(const u32x4*)(xb + (size_t)(row0 + ai * HALF + m * 16) * D + col0 + bj * HALF);
#pragma unroll
        for (int ai = 0; ai < 2; ++ai)
#pragma unroll
            for (int m = 0; m < 4; ++m)
#pragma unroll
                for (int bj = 0; bj < 2; ++bj) { const u32x4 v = t[ai][m][bj];
                    acc[ai][bj][m][0] = (f32x4){bflo(v.x), bfhi(v.x), bflo(v.y), bfhi(v.y)}; acc[ai][bj][m][1] = (f32x4){bflo(v.z), bfhi(v.z), bflo(v.w), bfhi(v.w)}; }
    }
    __device__ __forceinline__ void operator()(const f32x4 (&acc)[2][2][4][2], const Unit& u, int wr, int wc, int fr, int fq) const {
        const int row0 = u.pm * BM + wr * 64 + fr, col0 = u.pn * BM + wc * 32 + 8 * fq;
#pragma unroll
        for (int ai = 0; ai < 2; ++ai)
#pragma unroll
            for (int m = 0; m < 4; ++m) {
                const int row = row0 + ai * HALF + m * 16; float ss = 0.f;
#pragma unroll
                for (int bj = 0; bj < 2; ++bj) {
                    const f32x4 v0 = acc[ai][bj][m][0], v1 = acc[ai][bj][m][1];
                    u32x4 w; w.x = cvt_pk_bf16(v0[0], v0[1]); w.y = cvt_pk_bf16(v0[2], v0[3]); w.z = cvt_pk_bf16(v1[0], v1[1]); w.w = cvt_pk_bf16(v1[2], v1[3]);
                    *(u32x4*)(xo + (size_t)row * D + col0 + bj * HALF) = w;
                    ss += ((v0[0] * v0[0] + v0[1] * v0[1]) + (v0[2] * v0[2] + v0[3] * v0[3])) + ((v1[0] * v1[0] + v1[1] * v1[1]) + (v1[2] * v1[2] + v1[3] * v1[3]));
                }
                ss += __shfl_xor(ss, 16); ss += __shfl_xor(ss, 32);
                if (fq == 0) ssq_out[(size_t)row * 16 + u.pn * 4 + wc] = ss;
            }
    }
};

template <class Epi, bool ALIGN_EPI, int LDA, int LDB, int KLEN, int ACOL>
__device__ __forceinline__ void gemm_phase(LAS unsigned char* lds, const Gemm g, const Order& S, const Epi& E) {
    int tid_ = threadIdx.x; asm volatile("" : "+v"(tid_));
    const int tid = tid_, wid = __builtin_amdgcn_readfirstlane(tid >> 6), lane = tid & 63, wr = wid >> 2, wc = wid & 3, fr = lane & 15, fq = lane >> 4;
    constexpr int nt = KLEN / BK;
    unsigned voffA[2], voffB[2];
#pragma unroll
    for (int i = 0; i < 2; ++i) { int R, C; stage_rc(tid * 16 + i * 8192, R, C); const int Rb = Epi::PERM ? ((R & ~31) + perm32(R & 31)) : R;
        voffA[i] = (unsigned)(R * LDA + C) * 2u; voffB[i] = (unsigned)(Rb * LDB + C) * 2u; }
    constexpr size_t kstep = (size_t)(BK * 2);
    constexpr size_t hstepA = (size_t)HALF * LDA * 2, tstepA = 2 * hstepA, hstepB = (size_t)HALF * LDB * 2, tstepB = 2 * hstepB;
    constexpr size_t pnstepA = (size_t)ACOL * 2;
    const unsigned ldsw = (unsigned)wid * 1024u;
    const int aoff = lds_byte(wr * 64 + fr, fq * 8), boff = lds_byte(wc * 32 + fr, fq * 8);
#define PG8_SA(b, h) (((b) * 2 + (h)) * HTB)
#define PG8_SB(b, h) ((4 + (b) * 2 + (h)) * HTB)
#define PG8_STAGE(bufoff, gbase, voff) do { _Pragma("unroll") for (int _i = 0; _i < 2; ++_i) \
        __builtin_amdgcn_global_load_lds((const unsigned*)((const char*)(gbase) + (voff)[_i]), (LAS unsigned*)(lds + (bufoff) + ldsw + _i * 8192), 16, 0, 0); } while (0)
#define PG8_LDA(dst, b, h) do { _Pragma("unroll") for (int m = 0; m < 4; ++m) _Pragma("unroll") for (int k = 0; k < 2; ++k) dst[m][k] = *(const LAS bf16x8*)(lds + PG8_SA(b, h) + aoff + m * 2048 + k * 1024); } while (0)
#define PG8_LDB(dst, b, h) do { _Pragma("unroll") for (int n = 0; n < 2; ++n) _Pragma("unroll") for (int k = 0; k < 2; ++k) dst[n][k] = *(const LAS bf16x8*)(lds + PG8_SB(b, h) + boff + n * 2048 + k * 1024); } while (0)
#define PG8_MMA(ai, bj, At, Bt) do { __builtin_amdgcn_s_setprio(1); _Pragma("unroll") for (int m = 0; m < 4; ++m) _Pragma("unroll") for (int n = 0; n < 2; ++n) _Pragma("unroll") for (int k = 0; k < 2; ++k) \
        acc[ai][bj][m][n] = __builtin_amdgcn_mfma_f32_16x16x32_bf16(Bt[n][k], At[m][k], acc[ai][bj][m][n], 0, 0, 0); __builtin_amdgcn_s_setprio(0); } while (0)
#define PG8_WAIT_V(n) asm volatile("s_waitcnt vmcnt(" #n ")" ::: "memory")
#define PG8_WAIT_L(n) asm volatile("s_waitcnt lgkmcnt(" #n ")" ::: "memory")
#define PG8_BAR __builtin_amdgcn_s_barrier()
#define PG8_SCHED __builtin_amdgcn_sched_barrier(0)
    Unit cur, nxt; int ui = 0;
    if (!S.next(0, cur)) return;
    f32x4 acc[2][2][4][2];
    if constexpr (Epi::HAS_INIT) E.init(acc, cur, wr, wc, fr, fq);
    else {
#pragma unroll
    for (int a = 0; a < 2; ++a)
#pragma unroll
        for (int b = 0; b < 2; ++b)
#pragma unroll
            for (int m = 0; m < 4; ++m)
#pragma unroll
                for (int n = 0; n < 2; ++n) acc[a][b][m][n] = (f32x4){0.f, 0.f, 0.f, 0.f};
    }
    bf16x8 At[4][2], B0[2][2], B1[2][2];
    const char* cA = (const char*)g.A + (size_t)cur.pm * tstepA + (size_t)cur.pn * pnstepA; const char* cB = (const char*)g.Bt + (size_t)cur.pn * tstepB;
    S.a_ready(cur);
    PG8_STAGE(PG8_SB(0, 0), cB, voffB); PG8_STAGE(PG8_SB(0, 1), cB + hstepB, voffB); PG8_STAGE(PG8_SA(0, 0), cA, voffA); PG8_STAGE(PG8_SA(0, 1), cA + hstepA, voffA);
    if (wr == 1) PG8_BAR;
    PG8_WAIT_V(2); PG8_BAR;
    PG8_STAGE(PG8_SB(1, 0), cB + kstep, voffB); PG8_STAGE(PG8_SA(1, 0), cA + kstep, voffA); PG8_STAGE(PG8_SB(1, 1), cB + hstepB + kstep, voffB);
    PG8_WAIT_V(6); PG8_BAR;
    for (;;) {
        const bool has_next = S.next(ui + 1, nxt);
        const char* nA = has_next ? (const char*)g.A + (size_t)nxt.pm * tstepA + (size_t)nxt.pn * pnstepA : cA; const char* nB = has_next ? (const char*)g.Bt + (size_t)nxt.pn * tstepB : cB;
#pragma unroll 1
        for (int t = 0; t < nt; t += 2) {
            const bool last = (t == nt - 2);
            const char* a1 = cA + (size_t)(t + 1) * kstep;
            const char* a2 = last ? nA : cA + (size_t)(t + 2) * kstep; const char* b2 = last ? nB : cB + (size_t)(t + 2) * kstep;
            const char* a3 = a2 + kstep; const char* b3 = b2 + kstep;
            if (last && has_next) S.a_ready(nxt);
            PG8_LDB(B0, 0, 0); PG8_LDB(B1, 0, 1); PG8_SCHED; PG8_LDA(At, 0, 0); PG8_STAGE(PG8_SA(1, 1), a1 + hstepA, voffA);
            PG8_WAIT_V(8); PG8_WAIT_L(0); PG8_BAR; PG8_MMA(0, 0, At, B0); PG8_MMA(0, 1, At, B1); PG8_BAR; PG8_SCHED;
            PG8_LDA(At, 0, 1); PG8_STAGE(PG8_SB(0, 0), b2, voffB); PG8_STAGE(PG8_SB(0, 1), b2 + hstepB, voffB); PG8_STAGE(PG8_SA(0, 0), a2, voffA);
            PG8_WAIT_V(8); PG8_WAIT_L(0); PG8_BAR; PG8_MMA(1, 0, At, B0); PG8_MMA(1, 1, At, B1); PG8_BAR; PG8_SCHED;
            PG8_LDB(B0, 1, 0); PG8_LDB(B1, 1, 1); PG8_SCHED; PG8_LDA(At, 1, 0); PG8_STAGE(PG8_SA(0, 1), a2 + hstepA, voffA);
            PG8_WAIT_V(8); PG8_WAIT_L(0); PG8_BAR; PG8_MMA(0, 0, At, B0); PG8_MMA(0, 1, At, B1); PG8_BAR; PG8_SCHED;
            PG8_LDA(At, 1, 1); PG8_STAGE(PG8_SB(1, 0), b3, voffB); PG8_STAGE(PG8_SB(1, 1), b3 + hstepB, voffB); PG8_STAGE(PG8_SA(1, 0), a3, voffA);
            PG8_WAIT_V(8); PG8_WAIT_L(0); PG8_BAR; PG8_MMA(1, 0, At, B0); PG8_MMA(1, 1, At, B1); PG8_BAR; PG8_SCHED;
        }
        if constexpr (ALIGN_EPI) { if (wr == 0) PG8_BAR; }
        E(acc, cur, wr, wc, fr, fq);
#if defined(PROBE_EPI2)
        E(acc, cur, wr, wc, fr, fq); E(acc, cur, wr, wc, fr, fq);
#endif
        S.done(cur);
        if (!has_next) break;
        if constexpr (Epi::HAS_INIT) E.init(acc, nxt, wr, wc, fr, fq);
        else {
#pragma unroll
        for (int a = 0; a < 2; ++a)
#pragma unroll
            for (int b = 0; b < 2; ++b)
#pragma unroll
                for (int m = 0; m < 4; ++m)
#pragma unroll
                    for (int n = 0; n < 2; ++n) acc[a][b][m][n] = (f32x4){0.f, 0.f, 0.f, 0.f};
        }
        cur = nxt; cA = nA; cB = nB; ++ui;
        if constexpr (ALIGN_EPI) { if (wr == 1) PG8_BAR; }
    }
    PG8_WAIT_V(0);
    if constexpr (!ALIGN_EPI) { if (wr == 0) PG8_BAR; }
    PG8_BAR;
#undef PG8_SA
#undef PG8_SB
#undef PG8_STAGE
#undef PG8_LDA
#undef PG8_LDB
#undef PG8_MMA
#undef PG8_WAIT_V
#undef PG8_WAIT_L
#undef PG8_BAR
#undef PG8_SCHED
}
}

constexpr size_t MiB = 1u << 20;
constexpr size_t WS_CTL = 0, CTL_ZERO_BYTES = 1 * MiB;
constexpr size_t SZ_WIN = (size_t)NQKVO * D * 2, SZ_WOUT = (size_t)D * D * 2, SZ_WPOOL = (size_t)D * 256 * 2, SZ_WGU = (size_t)GU * D * 2, SZ_WDN = (size_t)D * FF * 2, SZ_WG = (size_t)16 * D * 2;
constexpr size_t WS_WIN = 1 * MiB;
constexpr size_t WS_WOUT = WS_WIN + 2 * SZ_WIN;
constexpr size_t WS_WPOOL = WS_WOUT + 2 * SZ_WOUT;
constexpr size_t WS_WGU = WS_WPOOL + 2 * SZ_WPOOL;
constexpr size_t WS_WDN = WS_WGU + 4 * SZ_WGU;
constexpr size_t WS_WG = WS_WDN + 4 * SZ_WDN;
constexpr size_t WS_SSQ = WS_WG + 2 * SZ_WG;
constexpr size_t SZ_SSQ = (size_t)M * 16 * 4;
constexpr size_t WS_GATES = WS_SSQ + 9 * SZ_SSQ;
constexpr size_t WS_DECAY = WS_GATES + SZ_SSQ;
constexpr size_t WS_XB = ((WS_DECAY + NITEM * 4 + MiB - 1) / MiB) * MiB;
constexpr size_t WS_BIG = WS_XB + (size_t)M * D * 2;
constexpr size_t WS_ST = WS_BIG + (size_t)M * NQKVO * 2;
constexpr size_t WS_END = WS_ST + (size_t)NITEM * STE * 2;
static_assert(WS_END <= 352 * MiB, "d_ws map must fit the guaranteed workspace");
static_assert((size_t)M * FF * 2 <= (size_t)M * NQKVO * 2, "H overlays q|k|v|o");

constexpr int CW_BAR = 4096;
constexpr int RING_OFF = 0, RING_BYTES = 131072;
constexpr int LDSCTL_OFF = RING_BYTES, MISC_OFF = LDSCTL_OFF + 320;
constexpr int RSTD_OFF = RING_BYTES + 1024;
constexpr int LDS_BYTES = 147456;
constexpr int NWAVES = 8, NT = NWAVES * 64;

#define VM_WAIT() asm volatile("s_waitcnt vmcnt(0)" ::: "memory")
#define LDS_WAIT() asm volatile("s_waitcnt lgkmcnt(0)" ::: "memory")

#define XB_TMO      128
#define XB_XCNT(j)  (256  + 64 * (j))
#define XB_XSUB(j)  (1280 + 64 * (j))
#define XB_XGEN(j)  (2304 + 64 * (j))
#define XB_TOP      3328
#define XB_TOPGEN   3392
#define XCD_BAR_WORDS 3456
#define XB_SPIN_CAP (1u << 18)
__device__ __forceinline__ unsigned xb_ld(unsigned* p)              { return __hip_atomic_load(p, __ATOMIC_RELAXED, __HIP_MEMORY_SCOPE_AGENT); }
__device__ __forceinline__ unsigned xb_add(unsigned* p, unsigned v) { return __hip_atomic_fetch_add(p, v, __ATOMIC_RELAXED, __HIP_MEMORY_SCOPE_AGENT); }
__device__ __forceinline__ unsigned xb_xcc_id() { return (unsigned)__builtin_amdgcn_s_getreg((3 << 11) | 20) & 0xFu; }
#define XB_SPIN(cond, bar) do { unsigned _sp = 0; while (cond) { __builtin_amdgcn_s_sleep(1); \
    if ((++_sp & 255u) == 0u) { if (xb_ld(&(bar)[XB_TMO])) break; if (_sp > XB_SPIN_CAP) { atomicAdd(&(bar)[XB_TMO], 1u); break; } } } } while (0)
struct XcdBarrier { unsigned* bar; unsigned x; volatile LAS unsigned* st; };
__device__ __forceinline__ XcdBarrier xcd_barrier_post(unsigned* bar, volatile LAS unsigned* st) {
    XcdBarrier b; b.bar = bar; b.x = xb_xcc_id(); b.st = st;
    if (threadIdx.x == 0) (void)xb_add(&bar[XB_XCNT(b.x)], 1u);
    return b;
}
__device__ __forceinline__ void xcd_barrier_complete(unsigned* bar, unsigned x, unsigned& nloc, unsigned& nx) {
    const unsigned G = gridDim.x * gridDim.y * gridDim.z;
    unsigned sum, cnt, mine, sp = 0u;
    for (;;) {
        sum = 0u; cnt = 0u; mine = 0u;
#pragma unroll
        for (unsigned j = 0; j < 16; ++j) { const unsigned c = xb_ld(&bar[XB_XCNT(j)]); sum += c; cnt += (c > 0u) ? 1u : 0u; mine = (j == x) ? c : mine; }
        if (sum == G) break;
        __builtin_amdgcn_s_sleep(1);
        if ((++sp & 255u) == 0u) { if (xb_ld(&bar[XB_TMO])) break; if (sp > XB_SPIN_CAP) { atomicAdd(&bar[XB_TMO], 1u); break; } }
    }
    nloc = mine > 0u ? mine : 1u; nx = cnt > 0u ? cnt : 1u;
}
__device__ __forceinline__ void xcd_barrier(const XcdBarrier& b) {
    asm volatile("s_waitcnt vmcnt(0)" ::: "memory");
    __syncthreads();
    if (threadIdx.x == 0) {
        unsigned* bar = b.bar;
        __builtin_amdgcn_s_waitcnt(0);
        unsigned nloc = b.st[0], nx = b.st[1];
        if (nloc == 0u) { xcd_barrier_complete(bar, b.x, nloc, nx); b.st[0] = nloc; b.st[1] = nx; }
        const unsigned old = xb_add(&bar[XB_XSUB(b.x)], 1u);
        const unsigned gen = old / nloc;
        if (old + 1u == (gen + 1u) * nloc) {
            __builtin_amdgcn_fence(__ATOMIC_RELEASE, "agent");
            asm volatile("s_waitcnt vmcnt(0)" ::: "memory");
            const unsigned og = xb_add(&bar[XB_TOP], 1u);
            const unsigned tg = og / nx;
            if (og + 1u == (tg + 1u) * nx) xb_add(&bar[XB_TOPGEN], 1u);
            else XB_SPIN(xb_ld(&bar[XB_TOPGEN]) == tg, bar);
            __builtin_amdgcn_fence(__ATOMIC_ACQUIRE, "agent");
            xb_add(&bar[XB_XGEN(b.x)], 1u);
            asm volatile("s_waitcnt vmcnt(0)" ::: "memory");
        } else {
            XB_SPIN(xb_ld(&bar[XB_XGEN(b.x)]) == gen, bar);
            __builtin_amdgcn_fence(__ATOMIC_ACQUIRE, "agent");
            asm volatile("s_waitcnt vmcnt(0)" ::: "memory");
        }
    }
    __syncthreads();
}

__device__ __forceinline__ float wave_sum(float v) {
#pragma unroll
    for (int o = 1; o < 64; o <<= 1) v += __shfl_xor(v, o);
    return v;
}
__device__ __forceinline__ float log_sigmoidf(float x) { return fminf(x, 0.f) - log1pf(expf(-fabsf(x))); }
__device__ __forceinline__ float rstd_of(const float* ssq_row) {
    const f32x4* p = (const f32x4*)ssq_row; const f32x4 a = p[0], b = p[1], c = p[2], d = p[3];
    const float s = ((a[0] + a[1]) + (a[2] + a[3])) + ((b[0] + b[1]) + (b[2] + b[3])) + ((c[0] + c[1]) + (c[2] + c[3])) + ((d[0] + d[1]) + (d[2] + d[3]));
    return 1.0f / sqrtf(s * (1.0f / D) + EPS);
}

__device__ __forceinline__ void tr_item64(const float* W, int ldW, int k0, int c0, bf16_t* WT, int ldT, int r0, const float* kg, const float* cg, float mul, LAS unsigned* scr, int lane) {
    const int n4 = lane & 15, kq = lane >> 4;
    f32x4 cm = (f32x4){mul, mul, mul, mul}; if (cg) cm = *(const f32x4*)(cg + c0 + 4 * n4) * mul;
    f32x4 va[8], vb[8];
#pragma unroll
    for (int i = 0; i < 8; ++i) { const int kp = kq + 4 * i; const float* p = W + (size_t)(k0 + 2 * kp) * ldW + c0 + 4 * n4; va[i] = *(const f32x4*)p; vb[i] = *(const f32x4*)(p + ldW); }
#pragma unroll
    for (int i = 0; i < 8; ++i) { const int kp = kq + 4 * i; const float g0 = kg ? kg[k0 + 2 * kp] : 1.0f, g1 = kg ? kg[k0 + 2 * kp + 1] : 1.0f;
#pragma unroll
        for (int e = 0; e < 4; ++e) scr[kp * 65 + 4 * n4 + e] = pack2(va[i][e] * cm[e] * g0, vb[i][e] * cm[e] * g1); }
    LDS_WAIT(); asm volatile("" ::: "memory");
    const int j = lane & 7, nl = lane >> 3;
#pragma unroll
    for (int it = 0; it < 8; ++it) { const int n = nl + 8 * it; u32x4 o; o.x = scr[(4 * j + 0) * 65 + n]; o.y = scr[(4 * j + 1) * 65 + n]; o.z = scr[(4 * j + 2) * 65 + n]; o.w = scr[(4 * j + 3) * 65 + n];
        *(u32x4*)(WT + (size_t)(r0 + n) * ldT + k0 + 8 * j) = o; }
    LDS_WAIT(); asm volatile("" ::: "memory");
}

struct Args { const float* in[12]; float* out; unsigned char* ws; int ph_lo, ph_hi; };
constexpr int N_PHASES = 22;

__global__ void __launch_bounds__(NT, 2) fwd_kernel(Args args) {
    extern __shared__ __attribute__((aligned(16))) unsigned char lds_raw[];
    LAS unsigned char* lds = (LAS unsigned char*)lds_raw;
    volatile LAS unsigned* MISC = (volatile LAS unsigned*)(lds + MISC_OFF);
    LAS float* rtab = (LAS float*)(lds + RSTD_OFF);
    int tid = threadIdx.x, lane = tid & 63, wave = __builtin_amdgcn_readfirstlane(tid >> 6);
#define FRESH_TID() do { tid = threadIdx.x; asm volatile("" : "+v"(tid)); lane = tid & 63; wave = __builtin_amdgcn_readfirstlane(tid >> 6); } while (0)
    const int G = gridDim.x, bid = blockIdx.x;
    unsigned char* const ws = args.ws;
#define x_in       (args.in[0])
#define norm_mix   (args.in[1])
#define norm_ffn   (args.in[2])
#define w_in       (args.in[3])
#define gate_bias  (args.in[4])
#define head_gain  (args.in[5])
#define w_out      (args.in[6])
#define pool_w     (args.in[7])
#define pool_scale (args.in[8])
#define w_gu       (args.in[9])
#define w_dn       (args.in[10])
#define final_norm (args.in[11])
#define Win_t   ((bf16_t*)(ws + WS_WIN))
#define Wout_t  ((bf16_t*)(ws + WS_WOUT))
#define Wpool_t ((bf16_t*)(ws + WS_WPOOL))
#define Wgu_t   ((bf16_t*)(ws + WS_WGU))
#define Wdn_t   ((bf16_t*)(ws + WS_WDN))
#define Wg      ((bf16_t*)(ws + WS_WG))
#define ssq     ((float*)(ws + WS_SSQ))
#define gates   ((float*)(ws + WS_GATES))
#define decay   ((float*)(ws + WS_DECAY))
#define xb      ((bf16_t*)(ws + WS_XB))
#define BIG     ((bf16_t*)(ws + WS_BIG))
#define ST      ((bf16_t*)(ws + WS_ST))

    for (int u = tid; u < (LDS_BYTES - LDSCTL_OFF) / 4; u += NT) ((LAS unsigned*)(lds + LDSCTL_OFF))[u] = 0u;
    __syncthreads();
    XcdBarrier bar; bar.bar = (unsigned*)(ws + WS_CTL) + CW_BAR; bar.x = 0; bar.st = nullptr;
    if (MK_N_LAUNCHES == 1) bar = xcd_barrier_post((unsigned*)(ws + WS_CTL) + CW_BAR, MISC + 8);

    const int lo = args.ph_lo, hi = args.ph_hi;
    int ph = 0;
#define IN_PH() (lo <= ph && ph < hi)
#define BEGIN_PH() FRESH_TID()
#if PROBE_PH >= 0
#define REPS() ((ph == PROBE_PH) ? PROBE_REP : 1)
#define LAST_REP() (rep_ + 1 == REPS())
#else
#define REPS() 1
#define LAST_REP() true
#endif
#define END_PH() do { if (lo <= ph && ph + 1 < hi) xcd_barrier(bar); ++ph; } while (0)

    if (IN_PH()) for (int rep_ = 0; rep_ < REPS(); ++rep_) { BEGIN_PH();
        LAS unsigned* scr = (LAS unsigned*)(lds + RING_OFF + wave * 8448);
        const int gw = bid * NWAVES + wave, NGW = G * NWAVES;
        constexpr int I_IN = 16 * 48, I_OUT = 16 * 16, I_POOL = 4 * 4 * 4, I_GU = 16 * 88, I_DN = 44 * 16;
        constexpr int NITEMS = 2 * I_IN + 2 * I_OUT + 2 * I_POOL + 4 * I_GU + 4 * I_DN;
        for (int it = gw; it < NITEMS; it += NGW) {
            int r = it;
            if (r < 4 * I_GU) { const int l = r / I_GU; r -= l * I_GU; const int kb = r / 88, nb = r % 88, r0 = nb * 64, pn = r0 >> 8, j = r0 & 255;
                const int c0 = (j < 128) ? pn * 128 + j : FF + pn * 128 + (j - 128);
                tr_item64(w_gu + (size_t)l * D * GU, GU, kb * 64, c0, Wgu_t + (size_t)l * GU * D, D, r0, norm_ffn + l * D, nullptr, 1.0f, scr, lane); continue; }
            r -= 4 * I_GU;
            if (r < 4 * I_DN) { const int l = r / I_DN; r -= l * I_DN; const int kb = r / 16, nb = r % 16;
                tr_item64(w_dn + (size_t)l * FF * D, D, kb * 64, nb * 64, Wdn_t + (size_t)l * D * FF, FF, nb * 64, nullptr, nullptr, 1.0f, scr, lane); continue; }
            r -= 4 * I_DN;
            if (r < 2 * I_IN) { const int l = r / I_IN; r -= l * I_IN; const int kb = r / 48, nb = r % 48, r0 = nb * 64;
                tr_item64(w_in + (size_t)l * D * NIN, NIN, kb * 64, r0, Win_t + (size_t)l * NQKVO * D, D, r0, norm_mix + (2 * l) * D, nullptr, (r0 >= 512 && r0 < 1024) ? 0.125f : 1.0f, scr, lane); continue; }
            r -= 2 * I_IN;
            if (r < 2 * I_OUT) { const int l = r / I_OUT; r -= l * I_OUT; const int kb = r / 16, nb = r % 16;
                tr_item64(w_out + (size_t)l * D * D, D, kb * 64, nb * 64, Wout_t + (size_t)l * D * D, D, nb * 64, head_gain + l * D, nullptr, 1.0f, scr, lane); continue; }
            r -= 2 * I_OUT;
            { const int l = r / I_POOL; r -= l * I_POOL; const int gi = r / 16; r -= gi * 16; const int kb = r / 4, nb = r % 4;
                tr_item64(pool_w + (size_t)(l * 4 + gi) * 256 * 256, 256, kb * 64, nb * 64, Wpool_t + (size_t)l * D * 256 + (size_t)gi * 256 * 256, 256, nb * 64,
                          norm_mix + (2 * l + 1) * D + gi * 256, pool_scale + l * D + gi * 256, 1.0f, scr, lane); }
        }
        for (int e = bid * NT + tid; e < 2 * 16 * D; e += G * NT) { const int l = e / (16 * D), rem = e % (16 * D), k = rem >> 4, j = rem & 15;
            Wg[(size_t)l * 16 * D + j * D + k] = f2bf(w_in[(size_t)l * D * NIN + (size_t)k * NIN + NQKVO + j] * norm_mix[(2 * l) * D + k]); }
        for (int m = 2 * gw; m < M; m += 2 * NGW) {
            const f32x4* xr = (const f32x4*)(x_in + (size_t)m * D) + lane; f32x4 v[8]; float s0 = 0.f, s1 = 0.f;
#pragma unroll
            for (int j = 0; j < 8; ++j) v[j] = xr[64 * j];
#pragma unroll
            for (int j = 0; j < 4; ++j) { s0 += (v[j][0] * v[j][0] + v[j][1] * v[j][1]) + (v[j][2] * v[j][2] + v[j][3] * v[j][3]);
                                          s1 += (v[j + 4][0] * v[j + 4][0] + v[j + 4][1] * v[j + 4][1]) + (v[j + 4][2] * v[j + 4][2] + v[j + 4][3] * v[j + 4][3]); }
            s0 = wave_sum(s0); s1 = wave_sum(s1);
#pragma unroll
            for (int j = 0; j < 8; ++j) { u32x2 w; w.x = cvt_pk_bf16(v[j][0], v[j][1]); w.y = cvt_pk_bf16(v[j][2], v[j][3]); ((u32x2*)(xb + (size_t)m * D))[64 * j + lane] = w; }
            if (lane < 32) ssq[(size_t)m * 16 + lane] = (lane == 0) ? s0 : (lane == 16) ? s1 : 0.f;
        }
    }
    END_PH();
#if PROBE_BARS > 0
    if (MK_N_LAUNCHES == 1) for (int i_ = 0; i_ < PROBE_BARS; ++i_) xcd_barrier(bar);
#endif

    for (int layer = 0; layer < DEPTH; ++layer) {
        const int slot = layer >> 1;
        float* ssq_a = ssq + (size_t)(2 * layer) * M * 16;
        float* ssq_b = ssq_a + (size_t)M * 16;
        float* ssq_c = ssq_b + (size_t)M * 16;
        if ((layer & 1) == 0) {
            if (IN_PH()) for (int rep_ = 0; rep_ < REPS(); ++rep_) { BEGIN_PH();
                {
                    const bf16_t* wgb = Wg + (size_t)slot * 16 * D;
                    LAS float* red = (LAS float*)lds;
                    const int rbk = wave & 3, kh = wave >> 2, fr = lane & 15, fq = lane >> 4;
                    for (int rb = bid; rb < M / 64; rb += G) {
                        const bf16_t* ap = xb + (size_t)(rb * 64 + rbk * 16 + fr) * D + kh * 512 + 8 * fq;
                        const bf16_t* bp = wgb + (size_t)fr * D + kh * 512 + 8 * fq;
                        f32x4 ga = (f32x4){0.f, 0.f, 0.f, 0.f};
#pragma unroll
                        for (int ks = 0; ks < 16; ++ks) ga = __builtin_amdgcn_mfma_f32_16x16x32_bf16(*(const bf16x8*)(ap + 32 * ks), *(const bf16x8*)(bp + 32 * ks), ga, 0, 0, 0);
                        if (kh == 1) *(LAS f32x4*)(red + (rbk * 64 + lane) * 4) = ga;
                        __syncthreads();
                        if (kh == 0) {
                            ga += *(const LAS f32x4*)(red + (rbk * 64 + lane) * 4);
                            const float gb = gate_bias[slot * 16 + fr];
#pragma unroll
                            for (int r = 0; r < 4; ++r) { const int row = rb * 64 + rbk * 16 + 4 * fq + r; const float gv = ga[r] * rstd_of(ssq_a + (size_t)row * 16) + gb;
                                gates[(size_t)row * 16 + fr] = SOFTCAP * tanhf(gv * (1.0f / SOFTCAP)); }
                        }
                        __syncthreads();
                    }
                }
                pg8::Gemm g{xb, Win_t + (size_t)slot * NQKVO * D}; pg8::Order S; S.init(M, NQKVO, G, bid, ssq_a, rtab);
                pg8::EpiProj E{BIG, rtab};
                pg8::gemm_phase<pg8::EpiProj, true, D, D, D, 0>(lds + RING_OFF, g, S, E);
            }
            END_PH();
            if (IN_PH()) for (int rep_ = 0; rep_ < REPS(); ++rep_) { BEGIN_PH();
                LAS unsigned char* wl = lds + wave * 12288;
                const int hh = lane >> 5, l31 = lane & 31, g16 = (lane >> 4) & 1, q4 = (lane & 15) >> 2, p4 = lane & 3;
                const int troff = (8 * hh + q4) * 192 + (16 * g16 + 4 * p4) * 2;
                bf16x8 a_one; { const short o = (l31 == 0) ? (short)0x3F80 : (short)0; for (int j = 0; j < 8; ++j) a_one[j] = o; }
                for (int T = bid * NWAVES + wave; T < 2 * NITEM; T += G * NWAVES) {
                    const int item = T >> 1, vh = T & 1, b = item >> 8, h = (item >> 5) & 7, c = item & 31, row0 = b * SEQ + c * CH;
                    const float f = gates[(size_t)(row0 + lane) * 16 + 8 + h], ig = gates[(size_t)(row0 + lane) * 16 + h];
                    float sc = log_sigmoidf(f);
#pragma unroll
                    for (int o = 1; o < 64; o <<= 1) { const float t = __shfl_up(sc, o); if (lane >= o) sc += t; }
                    const float bl = __shfl(sc, 63);
                    const float w = __expf(bl - sc + ig);
                    if (vh == 0 && lane == 63) decay[item] = __expf(bl);
                    f32x16 acc[2][2], accn[2];
#pragma unroll
                    for (int i = 0; i < 2; ++i) { accn[i] = zero16(); acc[i][0] = zero16(); acc[i][1] = zero16(); }
#pragma unroll
                    for (int cr = 0; cr < 2; ++cr) {
                        u32x4 kv[4], vv[4];
#pragma unroll
                        for (int i = 0; i < 4; ++i) { const int id = i * 64 + lane, rho = id >> 3, ch = id & 7; const bf16_t* base = BIG + (size_t)(row0 + 32 * cr + rho) * NQKVO;
                            kv[i] = *(const u32x4*)(base + 512 + h * DK + ch * 8); vv[i] = *(const u32x4*)(base + 1024 + h * DV + 64 * vh + ch * 8); }
#pragma unroll
                        for (int i = 0; i < 4; ++i) { const int id = i * 64 + lane, rho = id >> 3, ch = id & 7; const float wr = __shfl(w, 32 * cr + rho);
                            u32x4 ks; ks.x = pack2(bflo(kv[i].x) * wr, bfhi(kv[i].x) * wr); ks.y = pack2(bflo(kv[i].y) * wr, bfhi(kv[i].y) * wr);
                            ks.z = pack2(bflo(kv[i].z) * wr, bfhi(kv[i].z) * wr); ks.w = pack2(bflo(kv[i].w) * wr, bfhi(kv[i].w) * wr);
                            *(LAS u32x4*)(wl + rho * 192 + ch * 16) = ks; *(LAS u32x4*)(wl + 6144 + rho * 192 + ch * 16) = vv[i]; }
#pragma unroll
                        for (int sp = 0; sp < 2; ++sp) {
                            bf16x8 Bf[2], Af[2];
#pragma unroll
                            for (int t2 = 0; t2 < 2; ++t2) { Bf[t2] = tr_pair(wl + troff + sp * 16 * 192 + t2 * 64, 4 * 192); Af[t2] = tr_pair(wl + 6144 + troff + sp * 16 * 192 + t2 * 64, 4 * 192); }
#pragma unroll
                            for (int dt = 0; dt < 2; ++dt) { acc[0][dt] = MFMA32(Bf[dt], Af[0], acc[0][dt]); acc[1][dt] = MFMA32(Bf[dt], Af[1], acc[1][dt]); accn[dt] = MFMA32(Bf[dt], a_one, accn[dt]); }
                        }
                    }
                    bf16_t* st = ST + (size_t)item * STE;
#pragma unroll
                    for (int vt = 0; vt < 2; ++vt)
#pragma unroll
                        for (int dt = 0; dt < 2; ++dt)
#pragma unroll
                            for (int g4 = 0; g4 < 4; ++g4) { u32x2 pk; pk.x = pack2(acc[vt][dt][4 * g4], acc[vt][dt][4 * g4 + 1]); pk.y = pack2(acc[vt][dt][4 * g4 + 2], acc[vt][dt][4 * g4 + 3]);
                                *(u32x2*)(st + (size_t)(64 * vh + 32 * vt + l31) * 64 + 32 * dt + 8 * g4 + 4 * hh) = pk; }
                    if (vh == 0 && l31 == 0) {
#pragma unroll
                        for (int dt = 0; dt < 2; ++dt)
#pragma unroll
                            for (int g4 = 0; g4 < 4; ++g4) { u32x2 pk; pk.x = pack2(accn[dt][4 * g4], accn[dt][4 * g4 + 1]); pk.y = pack2(accn[dt][4 * g4 + 2], accn[dt][4 * g4 + 3]);
                                *(u32x2*)(st + 128 * 64 + 32 * dt + 8 * g4 + 4 * hh) = pk; }
                    }
                }
            }
            END_PH();
            if (IN_PH()) for (int rep_ = 0; rep_ < REPS(); ++rep_) { BEGIN_PH();
                for (int e = bid * NT + tid; e < BATCH * NH * (STE / 4); e += G * NT) {
                    const int bh = e / (STE / 4), el = e % (STE / 4); f32x4 stv = (f32x4){0.f, 0.f, 0.f, 0.f};
                    u32x2* p = (u32x2*)(ST + (size_t)bh * NCH * STE) + el;
#pragma unroll 8
                    for (int c = 0; c < NCH; ++c) { const u32x2 u = p[(size_t)c * (STE / 4)]; u32x2 o; o.x = pack2(stv[0], stv[1]); o.y = pack2(stv[2], stv[3]); p[(size_t)c * (STE / 4)] = o;
                        const float dc = decay[bh * NCH + c]; stv[0] = dc * stv[0] + bflo(u.x); stv[1] = dc * stv[1] + bfhi(u.x); stv[2] = dc * stv[2] + bflo(u.y); stv[3] = dc * stv[3] + bfhi(u.y); }
                }
            }
            END_PH();
            if (IN_PH()) for (int rep_ = 0; rep_ < REPS(); ++rep_) { BEGIN_PH();
                LAS unsigned char* wl = lds + wave * 12288;
                LAS float* ctab = (LAS float*)(wl + 10240);
                const int hh = lane >> 5, l31 = lane & 31, g16 = (lane >> 4) & 1, q4 = (lane & 15) >> 2, p4 = lane & 3;
                const int troff = (4 * hh + q4) * 320 + (16 * g16 + 4 * p4) * 2;
                bf16x8 a_one; { const short o = (l31 == 0) ? (short)0x3F80 : (short)0; for (int j = 0; j < 8; ++j) a_one[j] = o; }
                for (int T = bid * NWAVES + wave; T < 2 * NITEM; T += G * NWAVES) {
                    const int item = T >> 1, st = T & 1, b = item >> 8, h = (item >> 5) & 7, c = item & 31, row0 = b * SEQ + c * CH;
                    const float f = gates[(size_t)(row0 + lane) * 16 + 8 + h], ig = gates[(size_t)(row0 + lane) * 16 + h];
                    float sc = log_sigmoidf(f);
#pragma unroll
                    for (int o = 1; o < 64; o <<= 1) { const float t = __shfl_up(sc, o); if (lane >= o) sc += t; }
                    ctab[lane] = ig - sc;
                    const float bs = __shfl(sc, 32 * st + l31), eb = __expf(bs);
                    bf16x8 qf[4];
                    { const bf16_t* qp = BIG + (size_t)(row0 + 32 * st + l31) * NQKVO + h * DK + 8 * hh;
#pragma unroll
                      for (int ks = 0; ks < 4; ++ks) qf[ks] = *(const bf16x8*)(qp + 16 * ks); }
                    f32x16 acc[5];
                    const bf16_t* stp = ST + (size_t)item * STE;
#pragma unroll
                    for (int vt = 0; vt < 5; ++vt) {
                        acc[vt] = zero16();
                        const int vrow = (vt < 4) ? 32 * vt + l31 : 128;
                        const bf16_t* cp = stp + (size_t)vrow * 64 + 8 * hh;
#pragma unroll
                        for (int ks = 0; ks < 4; ++ks) {
                            u32x4 pk = *(const u32x4*)(cp + 16 * ks);
                            if (vt == 4 && l31 != 0) pk = (u32x4){0u, 0u, 0u, 0u};
                            acc[vt] = MFMA32(__builtin_bit_cast(bf16x8, pk), qf[ks], acc[vt]);
                        }
#pragma unroll
                        for (int r = 0; r < 16; ++r) acc[vt][r] *= eb;
                    }
                    LDS_WAIT();
#pragma unroll
                    for (int rt = 0; rt < 2; ++rt) {
                        if (rt <= st) {
                            f32x16 X = zero16();
                            { const bf16_t* kp = BIG + (size_t)(row0 + 32 * rt + l31) * NQKVO + 512 + h * DK + 8 * hh;
#pragma unroll
                              for (int ks = 0; ks < 4; ++ks) X = MFMA32(*(const bf16x8*)(kp + 16 * ks), qf[ks], X); }
                            u32x4 vv[8];
#pragma unroll
                            for (int i = 0; i < 8; ++i) { const int id = i * 64 + lane, rho = id >> 4, ch = id & 15; vv[i] = *(const u32x4*)(BIG + (size_t)(row0 + 32 * rt + rho) * NQKVO + 1024 + h * DV + ch * 8); }
#pragma unroll
                            for (int i = 0; i < 8; ++i) { const int id = i * 64 + lane, rho = id >> 4, ch = id & 15; *(LAS u32x4*)(wl + rho * 320 + ch * 16) = vv[i]; }
#pragma unroll
                            for (int g4 = 0; g4 < 4; ++g4) {
                                const f32x4 cr = *(const LAS f32x4*)(ctab + 32 * rt + 8 * g4 + 4 * hh);
#pragma unroll
                                for (int e = 0; e < 4; ++e) { float pv = X[4 * g4 + e] * __expf(bs + cr[e]); if (rt == st && (8 * g4 + 4 * hh + e) > l31) pv = 0.f; X[4 * g4 + e] = pv; }
                            }
#pragma unroll
                            for (int sp = 0; sp < 2; ++sp) {
                                u32x4 pk; pk.x = pack2(X[8 * sp + 0], X[8 * sp + 1]); pk.y = pack2(X[8 * sp + 2], X[8 * sp + 3]); pk.z = pack2(X[8 * sp + 4], X[8 * sp + 5]); pk.w = pack2(X[8 * sp + 6], X[8 * sp + 7]);
                                const bf16x8 pf = __builtin_bit_cast(bf16x8, pk);
#pragma unroll
                                for (int vt = 0; vt < 4; ++vt) acc[vt] = MFMA32(tr_pair(wl + troff + sp * 16 * 320 + vt * 64, 8 * 320), pf, acc[vt]);
                                acc[4] = MFMA32(a_one, pf, acc[4]);
                            }
                        }
                    }
                    const float den = __shfl(acc[4][0], l31), dd = fmaxf(fabsf(den), 1.0f);
                    float ss = 0.f;
#pragma unroll
                    for (int vt = 0; vt < 4; ++vt)
#pragma unroll
                        for (int r = 0; r < 16; ++r) ss += acc[vt][r] * acc[vt][r];
                    ss += __shfl_xor(ss, 32);
                    const float idd = 1.0f / dd; const float scale = idd / sqrtf(ss * idd * idd * (1.0f / DV) + EPS);
#pragma unroll
                    for (int vt = 0; vt < 4; ++vt)
#pragma unroll
                        for (int g4 = 0; g4 < 4; ++g4) { u32x2 pk; pk.x = pack2(acc[vt][4 * g4] * scale, acc[vt][4 * g4 + 1] * scale); pk.y = pack2(acc[vt][4 * g4 + 2] * scale, acc[vt][4 * g4 + 3] * scale);
                            *(LAS u32x2*)(wl + l31 * 272 + (32 * vt + 8 * g4 + 4 * hh) * 2) = pk; }
#pragma unroll
                    for (int i = 0; i < 8; ++i) { const int id = i * 64 + lane, rho = id >> 4, ch = id & 15;
                        const u32x4 hv = *(const LAS u32x4*)(wl + rho * 272 + ch * 16);
                        u32x4* op = (u32x4*)(BIG + (size_t)(row0 + 32 * st + rho) * NQKVO + 2048 + h * DV + ch * 8); const u32x4 ov = *op;
                        u32x4 w4; w4.x = pack2(bflo(hv.x) * bflo(ov.x), bfhi(hv.x) * bfhi(ov.x)); w4.y = pack2(bflo(hv.y) * bflo(ov.y), bfhi(hv.y) * bfhi(ov.y));
                        w4.z = pack2(bflo(hv.z) * bflo(ov.z), bfhi(hv.z) * bfhi(ov.z)); w4.w = pack2(bflo(hv.w) * bflo(ov.w), bfhi(hv.w) * bfhi(ov.w));
                        *op = w4; }
                    LDS_WAIT();
                }
            }
            END_PH();
        }
        if (IN_PH()) for (int rep_ = 0; rep_ < REPS(); ++rep_) { BEGIN_PH();
            pg8::Order S; S.init(M, D, G, bid, nullptr, rtab);
            pg8::EpiRes E{xb, LAST_REP() ? xb : (bf16_t*)args.out, LAST_REP() ? ssq_b : args.out + 8 * 1024 * 1024};
            if ((layer & 1) == 0) { pg8::Gemm g{BIG + 2048, Wout_t + (size_t)slot * D * D}; pg8::gemm_phase<pg8::EpiRes, false, NQKVO, D, D, 0>(lds + RING_OFF, g, S, E); }
            else {
                pg8::Unit u;
                for (int ui = 0; S.next(ui, u); ++ui) {
                    LAS float* hn = (LAS float*)lds;
                    LAS float* rsv = hn + 79 * 256;
                    const int gi = u.pn, w = 2 << gi, R0 = u.pm * 256, bb = R0 / SEQ, t0 = R0 % SEQ;
                    const int c16 = tid & 31, rp = tid >> 5;
                    const int c4 = tid & 63, tg = tid >> 6;
                    for (int tb = 0; tb < 4; ++tb) {
                        const int ts = t0 + 64 * tb;
                        __syncthreads();
                        if (tid < 79) { const int t = ts - 15 + tid; rsv[tid] = (t >= 0) ? rstd_of(ssq_a + (size_t)(bb * SEQ + t) * 16) : 0.f; }
                        u32x4 xv[5];
#pragma unroll
                        for (int ps = 0; ps < 5; ++ps) { const int rho = rp + 16 * ps, t = ts - 15 + rho; xv[ps] = (u32x4){0u, 0u, 0u, 0u};
                            if (rho < 79 && t >= 0) xv[ps] = *(const u32x4*)(xb + (size_t)(bb * SEQ + t) * D + 256 * gi + 8 * c16); }
                        __syncthreads();
#pragma unroll
                        for (int ps = 0; ps < 5; ++ps) { const int rho = rp + 16 * ps;
                            if (rho < 79) { const float r = rsv[rho]; LAS f32x4* dst = (LAS f32x4*)(hn + rho * 256 + 8 * c16);
                                dst[0] = (f32x4){bflo(xv[ps].x) * r, bfhi(xv[ps].x) * r, bflo(xv[ps].y) * r, bfhi(xv[ps].y) * r};
                                dst[1] = (f32x4){bflo(xv[ps].z) * r, bfhi(xv[ps].z) * r, bflo(xv[ps].w) * r, bfhi(xv[ps].w) * r}; } }
                        __syncthreads();
                        { const int tt0 = 8 * tg; f32x4 sw = (f32x4){0.f, 0.f, 0.f, 0.f};
                          for (int j = 1; j < w; ++j) sw += *(const LAS f32x4*)(hn + (15 + tt0 - j) * 256 + 4 * c4);
#pragma unroll
                          for (int tt = tt0; tt < tt0 + 8; ++tt) {
                              const f32x4 v = *(const LAS f32x4*)(hn + (15 + tt) * 256 + 4 * c4); sw += v;
                              const int tpos = ts + tt; const float inv = 1.0f / (float)((tpos + 1 < w) ? tpos + 1 : w);
                              u32x2 o; o.x = pack2(sw[0] * inv - v[0], sw[1] * inv - v[1]); o.y = pack2(sw[2] * inv - v[2], sw[3] * inv - v[3]);
                              *(u32x2*)(BIG + (size_t)(R0 + 64 * tb + tt) * D + 256 * gi + 4 * c4) = o;
                              sw -= *(const LAS f32x4*)(hn + (15 + tt - w + 1) * 256 + 4 * c4);
                          } }
                    }
                }
                VM_WAIT(); __syncthreads();
                pg8::Gemm g{BIG, Wpool_t + (size_t)slot * D * 256}; pg8::gemm_phase<pg8::EpiRes, false, D, 256, 256, 256>(lds + RING_OFF, g, S, E);
            }
        }
        END_PH();
        if (IN_PH()) for (int rep_ = 0; rep_ < REPS(); ++rep_) { BEGIN_PH();
            pg8::Gemm g{xb, Wgu_t + (size_t)layer * GU * D}; pg8::Order S; S.init(M, GU, G, bid, ssq_b, rtab);
            pg8::EpiGU E{BIG, rtab};
            pg8::gemm_phase<pg8::EpiGU, true, D, D, D, 0>(lds + RING_OFF, g, S, E);
        }
        END_PH();
        if (IN_PH()) for (int rep_ = 0; rep_ < REPS(); ++rep_) { BEGIN_PH();
            pg8::Gemm g{BIG, Wdn_t + (size_t)layer * D * FF}; pg8::Order S; S.init(M, D, G, bid, nullptr, rtab);
            pg8::EpiRes E{xb, LAST_REP() ? xb : (bf16_t*)args.out, LAST_REP() ? ssq_c : args.out + 8 * 1024 * 1024};
            pg8::gemm_phase<pg8::EpiRes, false, FF, FF, FF, 0>(lds + RING_OFF, g, S, E);
        }
        END_PH();
    }
    if (IN_PH()) for (int rep_ = 0; rep_ < REPS(); ++rep_) { BEGIN_PH();
        const int gw = bid * NWAVES + wave, NGW = G * NWAVES;
        for (int m = gw; m < M; m += NGW) {
            const u32x4 a = ((const u32x4*)(xb + (size_t)m * D))[lane], b2 = ((const u32x4*)(xb + (size_t)m * D))[64 + lane];
            float v[16] = {bflo(a.x), bfhi(a.x), bflo(a.y), bfhi(a.y), bflo(a.z), bfhi(a.z), bflo(a.w), bfhi(a.w), bflo(b2.x), bfhi(b2.x), bflo(b2.y), bfhi(b2.y), bflo(b2.z), bfhi(b2.z), bflo(b2.w), bfhi(b2.w)};
            float sq = 0.f;
#pragma unroll
            for (int j = 0; j < 16; ++j) sq += v[j] * v[j];
            const float rs = 1.0f / sqrtf(wave_sum(sq) * (1.0f / D) + EPS);
#pragma unroll
            for (int hpart = 0; hpart < 2; ++hpart)
#pragma unroll
                for (int q = 0; q < 2; ++q) { const int col = hpart * 512 + lane * 8 + q * 4; const f32x4 gn = *(const f32x4*)(final_norm + col);
                    f32x4 o; o[0] = v[hpart * 8 + q * 4 + 0] * rs * gn[0]; o[1] = v[hpart * 8 + q * 4 + 1] * rs * gn[1]; o[2] = v[hpart * 8 + q * 4 + 2] * rs * gn[2]; o[3] = v[hpart * 8 + q * 4 + 3] * rs * gn[3];
                    *(f32x4*)(args.out + (size_t)m * D + col) = o; }
        }
    }
#undef IN_PH
#undef END_PH
}

extern "C" void kernel_launch(void* const* d_in, const int* in_sizes, int n_in, void* d_out, int out_size, void* d_ws, size_t ws_size, hipStream_t stream) {
    static int grid = 0;
    if (grid == 0) {
        if (n_in != 12 || in_sizes[0] != M * D || out_size != M * D || ws_size < WS_END) { fprintf(stderr, "kernel_launch: unexpected shapes / workspace (n_in %d, ws %zu, need %zu)\n", n_in, ws_size, (size_t)WS_END); grid = -1; return; }
        int dev = 0, cus = 0, per_cu = 0;
        if (hipGetDevice(&dev) != hipSuccess || hipDeviceGetAttribute(&cus, hipDeviceAttributeMultiprocessorCount, dev) != hipSuccess) { grid = -1; return; }
        if (hipFuncSetAttribute((const void*)fwd_kernel, hipFuncAttributeMaxDynamicSharedMemorySize, LDS_BYTES) != hipSuccess) { fprintf(stderr, "kernel_launch: hipFuncSetAttribute failed\n"); grid = -1; return; }
        if (hipOccupancyMaxActiveBlocksPerMultiprocessor(&per_cu, (const void*)fwd_kernel, NT, LDS_BYTES) != hipSuccess || per_cu < 1) { fprintf(stderr, "kernel_launch: occupancy query says %d blocks per CU\n", per_cu); grid = -1; (void)hipGetLastError(); return; }
        grid = cus;
    }
    if (grid < 0) return;
    Args a{};
    for (int i = 0; i < 12; ++i) a.in[i] = (const float*)d_in[i];
    a.out = (float*)d_out; a.ws = (unsigned char*)d_ws;
#if MK_N_LAUNCHES == 1
    (void)hipMemsetAsync((char*)d_ws + WS_CTL, 0, CTL_ZERO_BYTES, stream);
    a.ph_lo = 0; a.ph_hi = N_PHASES;
    void* kargs[] = {&a};
    hipError_t e = hipLaunchCooperativeKernel((const void*)fwd_kernel, dim3(grid), dim3(NT), kargs, LDS_BYTES, stream);
    if (e != hipSuccess) fprintf(stderr, "cooperative launch failed: %s (grid %d)\n", hipGetErrorString(e), grid);
#else
    for (int p = 0; p < N_PHASES; ++p) {
        a.ph_lo = p; a.ph_hi = p + 1;
        hipLaunchKernelGGL(fwd_kernel, dim3(grid), dim3(NT), LDS_BYTES, stream, a);
    }
#endif
}
```

```cpp
#include <hip/hip_runtime.h>
#include <cstdio>
#include <cstdint>

#ifndef MK_N_LAUNCHES
#define MK_N_LAUNCHES 1
#endif

#ifndef PROBE_PH
#define PROBE_PH (-1)
#endif
#define PROBE_REP 3
#define PROBE_BARS 0

#define LAS __attribute__((address_space(3)))
typedef unsigned short bf16_t;
typedef short bf16x8 __attribute__((ext_vector_type(8)));
typedef float f32x4 __attribute__((ext_vector_type(4)));
typedef float f32x2 __attribute__((ext_vector_type(2)));
typedef unsigned u32x4 __attribute__((ext_vector_type(4)));
typedef unsigned u32x2 __attribute__((ext_vector_type(2)));
typedef unsigned long long ssq_t;
__device__ __forceinline__ ssq_t ssq_fix(float s) { return (ssq_t)(fminf(s, 1.0e12f) * 1048576.0f); }
__device__ __forceinline__ float ssq_val(ssq_t v) { return (float)v * (1.0f / 1048576.0f); }

constexpr int BATCH = 8, SEQ = 2048, D = 1024, DEPTH = 4, M = BATCH * SEQ;
constexpr int NH = 8, DK = 64, DV = 128, NQKVO = 3072, NIN = 3088, FF = 2816, GU = 2 * FF, CH = 64, NCH = SEQ / CH;
constexpr int NITEM = BATCH * NH * NCH;
constexpr int STE = (DV + 1) * DK;
constexpr float EPS = 1e-6f, SOFTCAP = 15.0f;

__device__ __forceinline__ unsigned cvt_pk_bf16(float lo, float hi) { unsigned r; asm volatile("v_cvt_pk_bf16_f32 %0, %1, %2" : "=v"(r) : "v"(lo), "v"(hi)); return r; }
__device__ __forceinline__ float bf2f(unsigned short u) { return __uint_as_float((unsigned)u << 16); }
__device__ __forceinline__ float bflo(unsigned u) { return __uint_as_float(u << 16); }
__device__ __forceinline__ float bfhi(unsigned u) { return __uint_as_float(u & 0xffff0000u); }
__device__ __forceinline__ unsigned short f2bf(float f) { unsigned u = __float_as_uint(f); return (unsigned short)((u + 0x7fffu + ((u >> 16) & 1u)) >> 16); }


typedef short s16x4 __attribute__((ext_vector_type(4)));
typedef float f32x16 __attribute__((ext_vector_type(16)));
__device__ __forceinline__ unsigned pack2(float a, float b) { typedef __bf16 bf2 __attribute__((ext_vector_type(2))); f32x2 v = {a, b}; bf2 r = __builtin_convertvector(v, bf2); return __builtin_bit_cast(unsigned, r); }
__device__ __forceinline__ bf16x8 tr_pair(LAS unsigned char* p, int delta) {
    const s16x4 lo = __builtin_amdgcn_ds_read_tr16_b64_v4i16((LAS s16x4*)p), hi = __builtin_amdgcn_ds_read_tr16_b64_v4i16((LAS s16x4*)(p + delta));
    return __builtin_shufflevector(lo, hi, 0, 1, 2, 3, 4, 5, 6, 7);
}
#define MFMA32(a, b, c) __builtin_amdgcn_mfma_f32_32x32x16_bf16((a), (b), (c), 0, 0, 0)
__device__ __forceinline__ f32x16 zero16() { f32x16 z; for (int i = 0; i < 16; ++i) z[i] = 0.f; return z; }

namespace pg8 {
constexpr int BM = 256, BK = 64, HALF = 128, HTB = HALF * BK * 2, STAGE_BYTES = 8 * HTB, NXCD = 8, WGM = 8;
__host__ __device__ __forceinline__ int lds_byte(int r, int c) { const int st = (r >> 4) * 2 + (c >> 5), rr = r & 15, cc = c & 31, ob = rr * 64 + cc * 2; return st * 1024 + (ob ^ (((ob >> 9) & 1) << 5)); }
__host__ __device__ __forceinline__ void stage_rc(int b, int& R, int& C) { const int st = b / 1024, sb = b % 1024, swz = sb ^ (((sb >> 9) & 1) << 5); R = (st >> 1) * 16 + swz / 64; C = (st & 1) * 32 + (swz % 64) / 2; }
__host__ __device__ __forceinline__ int perm32(int rho) { const int n = rho >> 4, i = rho & 15; return 8 * (i >> 2) + 4 * n + (i & 3); }

struct Unit { int pm, pn, idx, hm; };
struct Gemm { const bf16_t* A; const bf16_t* Bt; };

struct Order {
    int nM, nN, nwg, G, c, nsplit;
    const ssq_t* ssq;
    LAS float* tab;
    __device__ __forceinline__ void init(int M_, int N, int G_, int c_, const ssq_t* ssq_, LAS float* tab_) { nM = M_ / BM; nN = N / BM; nwg = nM * nN; G = G_; c = c_; ssq = ssq_; tab = tab_; nsplit = 0; }
    __device__ __forceinline__ void split_tail(int ns) { if (G == 256 && nM == 64 && ns == 2) { nsplit = ns; nN -= ns; nwg = nM * nN; } }
    __device__ __forceinline__ bool next(int i, Unit& u) const {
        const long L = (long)i * G + c;
        const bool tail = L >= nwg;
        if (tail && (nsplit == 0 || L >= nwg + G)) return false;
        int wgid = tail ? 0 : (int)L; { const int q = nwg / NXCD, r = nwg % NXCD, xcd = wgid % NXCD, off = wgid / NXCD; wgid = (xcd < r ? xcd * (q + 1) : r * (q + 1) + (xcd - r) * q) + off; }
        const int nig = WGM * nN, gid = wgid / nig, fm = gid * WGM, gsz = (nM - fm) < WGM ? (nM - fm) : WGM;
        const int x = c & 7, j = c >> 3;
        const int pm = tail ? 8 * x + (j & 7) : fm + ((wgid % nig) % gsz);
        const int pn = tail ? nN + ((j >> 3) & 1) : (wgid % nig) / gsz;
        const int hm = tail ? (j >> 4) : -1;
        u.pm = pm; u.pn = pn; u.idx = i; u.hm = hm; return true;
    }
    __device__ __forceinline__ void a_ready(const Unit& u) const {
        int t_ = threadIdx.x; asm volatile("" : "+v"(t_));
        if (ssq != nullptr && t_ < 256) {
            const float s = ssq_val(ssq[(size_t)(u.pm * BM + (u.hm > 0 ? HALF : 0) + t_)]);
            tab[(u.idx & 1) * 256 + t_] = __builtin_amdgcn_rsqf(s * (1.0f / D) + EPS);
        }
    }
    __device__ __forceinline__ void done(const Unit&) const {}
};

__device__ __forceinline__ float sigmoidf_fast(float x) { return __builtin_amdgcn_rcpf(1.0f + __expf(-x)); }

struct EpiProj {
    static constexpr bool PERM = true, HAS_INIT = false;
    bf16_t* O; const LAS float* tab;
    __device__ __forceinline__ void operator()(const f32x4 (&acc)[2][2][4][2], const Unit& u, int wr, int wc, int fr, int fq) const {
        const LAS float* t = tab + (u.idx & 1) * 256;
        const bool sig = u.pn >= 8;
        const int row0 = u.pm * BM + wr * 64 + fr, col0 = u.pn * BM + wc * 32 + 8 * fq;
#pragma unroll
        for (int ai = 0; ai < 2; ++ai)
#pragma unroll
            for (int m = 0; m < 4; ++m) {
                const float rs = t[ai * HALF + wr * 64 + m * 16 + fr];
                bf16_t* rowp = O + (size_t)(row0 + ai * HALF + m * 16) * NQKVO + col0;
#pragma unroll
                for (int bj = 0; bj < 2; ++bj) {
                    f32x4 v0 = acc[ai][bj][m][0] * rs, v1 = acc[ai][bj][m][1] * rs;
                    if (sig) {
#pragma unroll
                        for (int i = 0; i < 4; ++i) { v0[i] = sigmoidf_fast(v0[i]); v1[i] = sigmoidf_fast(v1[i]); }
                    }
                    u32x4 w; w.x = cvt_pk_bf16(v0[0], v0[1]); w.y = cvt_pk_bf16(v0[2], v0[3]); w.z = cvt_pk_bf16(v1[0], v1[1]); w.w = cvt_pk_bf16(v1[2], v1[3]);
                    *(u32x4*)(rowp + bj * HALF) = w;
                }
            }
    }
};
struct EpiGU {
    static constexpr bool PERM = true, HAS_INIT = false;
    bf16_t* H; const LAS float* tab;
    __device__ __forceinline__ void operator()(const f32x4 (&acc)[2][2][4][2], const Unit& u, int wr, int wc, int fr, int fq) const {
        const LAS float* t = tab + (u.idx & 1) * 256;
        const int row0 = u.pm * BM + (u.hm > 0 ? HALF : 0) + wr * 64 + fr, col0 = u.pn * HALF + wc * 32 + 8 * fq;
#pragma unroll
        for (int ai = 0; ai < 2; ++ai) { if (ai == 1 && u.hm >= 0) break;
#pragma unroll
            for (int m = 0; m < 4; ++m) {
                const float rs = t[ai * HALF + wr * 64 + m * 16 + fr];
                const float c1 = rs * -1.4426950408889634f, rs2 = rs * rs;
                float hv[8];
#pragma unroll
                for (int n = 0; n < 2; ++n)
#pragma unroll
                    for (int i = 0; i < 4; ++i) { const float g = acc[ai][0][m][n][i], uu = acc[ai][1][m][n][i]; hv[n * 4 + i] = (g * uu) * (rs2 * __builtin_amdgcn_rcpf(1.0f + __builtin_amdgcn_exp2f(g * c1))); }
                u32x4 w; w.x = cvt_pk_bf16(hv[0], hv[1]); w.y = cvt_pk_bf16(hv[2], hv[3]); w.z = cvt_pk_bf16(hv[4], hv[5]); w.w = cvt_pk_bf16(hv[6], hv[7]);
                *(u32x4*)(H + (size_t)(row0 + ai * HALF + m * 16) * FF + col0) = w;
            }
        }
    }
};
struct EpiRes {
    static constexpr bool PERM = true, HAS_INIT = true;
    bf16_t* xb; bf16_t* xo; ssq_t* ssq_out;
    __device__ __forceinline__ void init(f32x4 (&acc)[2][2][4][2], const Unit& u, int wr, int wc, int fr, int fq) const {
        const int row0 = u.pm * BM + wr * 64 + fr, col0 = u.pn * BM + wc * 32 + 8 * fq;
        u32x4 t[2][4][2];
#pragma unroll
        for (int ai = 0; ai < 2; ++ai)
#pragma unroll
            for (int m = 0; m < 4; ++m)
#pragma unroll
                for (int bj = 0; bj < 2; ++bj) t[ai][m][bj] = *(const u32x4*)(xb + (size_t)(row0 + ai * HALF + m * 16) * D + col0 + bj * HALF);
#pragma unroll
        for (int ai = 0; ai < 2; ++ai)
#pragma unroll
            for (int m = 0; m < 4; ++m)
#pragma unroll
                for (int bj = 0; bj < 2; ++bj) { const u32x4 v = t[ai][m][bj];
                    acc[ai][bj][m][0] = (f32x4){bflo(v.x), bfhi(v.x), bflo(v.y), bfhi(v.y)}; acc[ai][bj][m][1] = (f32x4){bflo(v.z), bfhi(v.z), bflo(v.w), bfhi(v.w)}; }
    }
    __device__ __forceinline__ void operator()(const f32x4 (&acc)[2][2][4][2], const Unit& u, int wr, int wc, int fr, int fq) const {
        const int row0 = u.pm * BM + wr * 64 + fr, col0 = u.pn * BM + wc * 32 + 8 * fq;
#pragma unroll
        for (int ai = 0; ai < 2; ++ai)
#pragma unroll
            for (int m = 0; m < 4; ++m) {
                const int row = row0 + ai * HALF + m * 16; float ss = 0.f;
#pragma unroll
                for (int bj = 0; bj < 2; ++bj) {
                    const f32x4 v0 = acc[ai][bj][m][0], v1 = acc[ai][bj][m][1];
                    u32x4 w; w.x = cvt_pk_bf16(v0[0], v0[1]); w.y = cvt_pk_bf16(v0[2], v0[3]); w.z = cvt_pk_bf16(v1[0], v1[1]); w.w = cvt_pk_bf16(v1[2], v1[3]);
                    *(u32x4*)(xo + (size_t)row * D + col0 + bj * HALF) = w;
                    ss += ((v0[0] * v0[0] + v0[1] * v0[1]) + (v0[2] * v0[2] + v0[3] * v0[3])) + ((v1[0] * v1[0] + v1[1] * v1[1]) + (v1[2] * v1[2] + v1[3] * v1[3]));
                }
                ss += __shfl_xor(ss, 16); ss += __shfl_xor(ss, 32);
                if (fq == 0) atomicAdd(ssq_out + row, ssq_fix(ss));
            }
    }
};

template <class Epi, bool ALIGN_EPI, int LDA, int LDB, int KLEN, int ACOL, bool HALFU = false>
__device__ __forceinline__ void gemm_phase(LAS unsigned char* lds, const Gemm g, const Order& S, const Epi& E) {
    int tid_ = threadIdx.x; asm volatile("" : "+v"(tid_));
    const int tid = tid_, wid = __builtin_amdgcn_readfirstlane(tid >> 6), lane = tid & 63, wr = wid >> 2, wc = wid & 3, fr = lane & 15, fq = lane >> 4;
    constexpr int nt = KLEN / BK;
    unsigned voffA[2], voffB[2];
#pragma unroll
    for (int i = 0; i < 2; ++i) { int R, C; stage_rc(tid * 16 + i * 8192, R, C); const int Rb = Epi::PERM ? ((R & ~31) + perm32(R & 31)) : R;
        voffA[i] = (unsigned)(R * LDA + C) * 2u; voffB[i] = (unsigned)(Rb * LDB + C) * 2u; }
    constexpr size_t kstep = (size_t)(BK * 2);
    constexpr size_t hstepA = (size_t)HALF * LDA * 2, tstepA = 2 * hstepA, hstepB = (size_t)HALF * LDB * 2, tstepB = 2 * hstepB;
    constexpr size_t pnstepA = (size_t)ACOL * 2;
    const unsigned ldsw = (unsigned)wid * 1024u;
    const int aoff = lds_byte(wr * 64 + fr, fq * 8), boff = lds_byte(wc * 32 + fr, fq * 8);
#define PG8_SA(b, h) (((b) * 2 + (h)) * HTB)
#define PG8_SB(b, h) ((4 + (b) * 2 + (h)) * HTB)
#define PG8_STAGE(bufoff, gbase, voff) do { _Pragma("unroll") for (int _i = 0; _i < 2; ++_i) \
        __builtin_amdgcn_global_load_lds((const unsigned*)((const char*)(gbase) + (voff)[_i]), (LAS unsigned*)(lds + (bufoff) + ldsw + _i * 8192), 16, 0, 0); } while (0)
#define PG8_LDA(dst, b, h) do { _Pragma("unroll") for (int m = 0; m < 4; ++m) _Pragma("unroll") for (int k = 0; k < 2; ++k) dst[m][k] = *(const LAS bf16x8*)(lds + PG8_SA(b, h) + aoff + m * 2048 + k * 1024); } while (0)
#define PG8_LDB(dst, b, h) do { _Pragma("unroll") for (int n = 0; n < 2; ++n) _Pragma("unroll") for (int k = 0; k < 2; ++k) dst[n][k] = *(const LAS bf16x8*)(lds + PG8_SB(b, h) + boff + n * 2048 + k * 1024); } while (0)
#define PG8_MMA(ai, bj, At, Bt) do { __builtin_amdgcn_s_setprio(1); _Pragma("unroll") for (int m = 0; m < 4; ++m) _Pragma("unroll") for (int n = 0; n < 2; ++n) _Pragma("unroll") for (int k = 0; k < 2; ++k) \
        acc[ai][bj][m][n] = __builtin_amdgcn_mfma_f32_16x16x32_bf16(Bt[n][k], At[m][k], acc[ai][bj][m][n], 0, 0, 0); __builtin_amdgcn_s_setprio(0); } while (0)
#define PG8_WAIT_V(n) asm volatile("s_waitcnt vmcnt(" #n ")" ::: "memory")
#define PG8_WAIT_L(n) asm volatile("s_waitcnt lgkmcnt(" #n ")" ::: "memory")
#define PG8_BAR __builtin_amdgcn_s_barrier()
#define PG8_SCHED __builtin_amdgcn_sched_barrier(0)
    Unit cur, nxt; int ui = 0;
    if (!S.next(0, cur)) return;
    f32x4 acc[2][2][4][2];
    if constexpr (Epi::HAS_INIT) E.init(acc, cur, wr, wc, fr, fq);
    else {
#pragma unroll
    for (int a = 0; a < 2; ++a)
#pragma unroll
        for (int b = 0; b < 2; ++b)
#pragma unroll
            for (int m = 0; m < 4; ++m)
#pragma unroll
                for (int n = 0; n < 2; ++n) acc[a][b][m][n] = (f32x4){0.f, 0.f, 0.f, 0.f};
    }
    bf16x8 At[4][2], B0[2][2], B1[2][2];
    const char* cA = (const char*)g.A + (size_t)cur.pm * tstepA + (size_t)cur.pn * pnstepA + ((HALFU && cur.hm > 0) ? hstepA : 0); const char* cB = (const char*)g.Bt + (size_t)cur.pn * tstepB;
    S.a_ready(cur);
    PG8_STAGE(PG8_SB(0, 0), cB, voffB); PG8_STAGE(PG8_SB(0, 1), cB + hstepB, voffB); PG8_STAGE(PG8_SA(0, 0), cA, voffA); PG8_STAGE(PG8_SA(0, 1), cA + hstepA, voffA);
    if (wr == 1) PG8_BAR;
    PG8_WAIT_V(2); PG8_BAR;
    PG8_STAGE(PG8_SB(1, 0), cB + kstep, voffB); PG8_STAGE(PG8_SA(1, 0), cA + kstep, voffA); PG8_STAGE(PG8_SB(1, 1), cB + hstepB + kstep, voffB);
    PG8_WAIT_V(6); PG8_BAR;
    for (;;) {
        const bool has_next = S.next(ui + 1, nxt);
        const char* nA = has_next ? (const char*)g.A + (size_t)nxt.pm * tstepA + (size_t)nxt.pn * pnstepA + ((HALFU && nxt.hm > 0) ? hstepA : 0) : cA;
        const bool full = !HALFU || cur.hm < 0;
        const char* nB = has_next ? (const char*)g.Bt + (size_t)nxt.pn * tstepB : cB;
#pragma unroll 1
        for (int t = 0; t < nt; t += 2) {
            const bool last = (t == nt - 2);
            const char* a1 = cA + (size_t)(t + 1) * kstep;
            const char* a2 = last ? nA : cA + (size_t)(t + 2) * kstep; const char* b2 = last ? nB : cB + (size_t)(t + 2) * kstep;
            const char* a3 = a2 + kstep; const char* b3 = b2 + kstep;
            if (last && has_next) S.a_ready(nxt);
            PG8_LDB(B0, 0, 0); PG8_LDB(B1, 0, 1); PG8_SCHED; PG8_LDA(At, 0, 0); PG8_STAGE(PG8_SA(1, 1), a1 + hstepA, voffA);
            PG8_WAIT_V(8); PG8_WAIT_L(0); PG8_BAR; PG8_MMA(0, 0, At, B0); PG8_MMA(0, 1, At, B1); PG8_BAR; PG8_SCHED;
            PG8_LDA(At, 0, 1); PG8_STAGE(PG8_SB(0, 0), b2, voffB); PG8_STAGE(PG8_SB(0, 1), b2 + hstepB, voffB); PG8_STAGE(PG8_SA(0, 0), a2, voffA);
            PG8_WAIT_V(8); PG8_WAIT_L(0); PG8_BAR; if (full) { PG8_MMA(1, 0, At, B0); PG8_MMA(1, 1, At, B1); } PG8_BAR; PG8_SCHED;
            PG8_LDB(B0, 1, 0); PG8_LDB(B1, 1, 1); PG8_SCHED; PG8_LDA(At, 1, 0); PG8_STAGE(PG8_SA(0, 1), a2 + hstepA, voffA);
            PG8_WAIT_V(8); PG8_WAIT_L(0); PG8_BAR; PG8_MMA(0, 0, At, B0); PG8_MMA(0, 1, At, B1); PG8_BAR; PG8_SCHED;
            PG8_LDA(At, 1, 1); PG8_STAGE(PG8_SB(1, 0), b3, voffB); PG8_STAGE(PG8_SB(1, 1), b3 + hstepB, voffB); PG8_STAGE(PG8_SA(1, 0), a3, voffA);
            PG8_WAIT_V(8); PG8_WAIT_L(0); PG8_BAR; if (full) { PG8_MMA(1, 0, At, B0); PG8_MMA(1, 1, At, B1); } PG8_BAR; PG8_SCHED;
        }
        if constexpr (ALIGN_EPI) { if (wr == 0) PG8_BAR; }
        E(acc, cur, wr, wc, fr, fq);
#if defined(PROBE_EPI2)
        E(acc, cur, wr, wc, fr, fq); E(acc, cur, wr, wc, fr, fq);
#endif
        S.done(cur);
        if (!has_next) break;
        if constexpr (Epi::HAS_INIT) E.init(acc, nxt, wr, wc, fr, fq);
        else {
#pragma unroll
        for (int a = 0; a < 2; ++a)
#pragma unroll
            for (int b = 0; b < 2; ++b)
#pragma unroll
                for (int m = 0; m < 4; ++m)
#pragma unroll
                    for (int n = 0; n < 2; ++n) acc[a][b][m][n] = (f32x4){0.f, 0.f, 0.f, 0.f};
        }
        cur = nxt; cA = nA; cB = nB; ++ui;
        if constexpr (ALIGN_EPI) { if (wr == 1) PG8_BAR; }
    }
    PG8_WAIT_V(0);
    if constexpr (!ALIGN_EPI) { if (wr == 0) PG8_BAR; }
    PG8_BAR;
#undef PG8_SA
#undef PG8_SB
#undef PG8_STAGE
#undef PG8_LDA
#undef PG8_LDB
#undef PG8_MMA
#undef PG8_WAIT_V
#undef PG8_WAIT_L
#undef PG8_BAR
#undef PG8_SCHED
}
}

constexpr size_t MiB = 1u << 20;
constexpr size_t WS_CTL = 0, CTL_ZERO_BYTES = 1 * MiB;
constexpr size_t SZ_WIN = (size_t)NQKVO * D * 2, SZ_WOUT = (size_t)D * D * 2, SZ_WPOOL = (size_t)D * 256 * 2, SZ_WGU = (size_t)GU * D * 2, SZ_WDN = (size_t)D * FF * 2, SZ_WG = (size_t)16 * D * 2;
constexpr size_t WS_WIN = 1 * MiB;
constexpr size_t WS_WOUT = WS_WIN + 2 * SZ_WIN;
constexpr size_t WS_WPOOL = WS_WOUT + 2 * SZ_WOUT;
constexpr size_t WS_WGU = WS_WPOOL + 2 * SZ_WPOOL;
constexpr size_t WS_WDN = WS_WGU + 4 * SZ_WGU;
constexpr size_t WS_WG = WS_WDN + 4 * SZ_WDN;
constexpr size_t WS_SSQ = WS_WG + 2 * SZ_WG;
constexpr size_t SZ_SSQ = (size_t)M * 8;
constexpr size_t WS_GATES = WS_SSQ + 9 * SZ_SSQ;
constexpr size_t WS_DECAY = WS_GATES + (size_t)M * 16 * 4;
constexpr size_t WS_XB = ((WS_DECAY + NITEM * 4 + MiB - 1) / MiB) * MiB;
constexpr size_t WS_BIG = WS_XB + (size_t)M * D * 2;
constexpr size_t WS_ST = WS_BIG + (size_t)M * NQKVO * 2;
constexpr size_t WS_END = WS_ST + (size_t)NITEM * STE * 2;
static_assert(WS_END <= 352 * MiB, "d_ws map must fit the guaranteed workspace");
static_assert((size_t)M * FF * 2 <= (size_t)M * NQKVO * 2, "H overlays q|k|v|o");

constexpr int CW_BAR = 4096;
constexpr int RING_OFF = 0, RING_BYTES = 131072;
constexpr int LDSCTL_OFF = RING_BYTES, MISC_OFF = LDSCTL_OFF + 320;
constexpr int RSTD_OFF = RING_BYTES + 1024;
constexpr int LDS_BYTES = 147456;
constexpr int NWAVES = 8, NT = NWAVES * 64;

#define VM_WAIT() asm volatile("s_waitcnt vmcnt(0)" ::: "memory")
#define LDS_WAIT() asm volatile("s_waitcnt lgkmcnt(0)" ::: "memory")

#define XB_TMO      128
#define XB_XCNT(j)  (256  + 64 * (j))
#define XB_XSUB(j)  (1280 + 64 * (j))
#define XB_XGEN(j)  (2304 + 64 * (j))
#define XB_TOP      3328
#define XB_TOPGEN   3392
#define XCD_BAR_WORDS 3456
#define XB_SPIN_CAP (1u << 18)
__device__ __forceinline__ unsigned xb_ld(unsigned* p)              { return __hip_atomic_load(p, __ATOMIC_RELAXED, __HIP_MEMORY_SCOPE_AGENT); }
__device__ __forceinline__ unsigned xb_add(unsigned* p, unsigned v) { return __hip_atomic_fetch_add(p, v, __ATOMIC_RELAXED, __HIP_MEMORY_SCOPE_AGENT); }
__device__ __forceinline__ unsigned xb_xcc_id() { return (unsigned)__builtin_amdgcn_s_getreg((3 << 11) | 20) & 0xFu; }
#define XB_SPIN(cond, bar) do { unsigned _sp = 0; while (cond) { __builtin_amdgcn_s_sleep(1); \
    if ((++_sp & 255u) == 0u) { if (xb_ld(&(bar)[XB_TMO])) break; if (_sp > XB_SPIN_CAP) { atomicAdd(&(bar)[XB_TMO], 1u); break; } } } } while (0)
struct XcdBarrier { unsigned* bar; unsigned x; volatile LAS unsigned* st; };
__device__ __forceinline__ XcdBarrier xcd_barrier_post(unsigned* bar, volatile LAS unsigned* st) {
    XcdBarrier b; b.bar = bar; b.x = xb_xcc_id(); b.st = st;
    if (threadIdx.x == 0) (void)xb_add(&bar[XB_XCNT(b.x)], 1u);
    return b;
}
__device__ __forceinline__ void xcd_barrier_complete(unsigned* bar, unsigned x, unsigned& nloc, unsigned& nx) {
    const unsigned G = gridDim.x * gridDim.y * gridDim.z;
    unsigned sum, cnt, mine, sp = 0u;
    for (;;) {
        sum = 0u; cnt = 0u; mine = 0u;
#pragma unroll
        for (unsigned j = 0; j < 16; ++j) { const unsigned c = xb_ld(&bar[XB_XCNT(j)]); sum += c; cnt += (c > 0u) ? 1u : 0u; mine = (j == x) ? c : mine; }
        if (sum == G) break;
        __builtin_amdgcn_s_sleep(1);
        if ((++sp & 255u) == 0u) { if (xb_ld(&bar[XB_TMO])) break; if (sp > XB_SPIN_CAP) { atomicAdd(&bar[XB_TMO], 1u); break; } }
    }
    nloc = mine > 0u ? mine : 1u; nx = cnt > 0u ? cnt : 1u;
}
__device__ __forceinline__ void xcd_barrier(const XcdBarrier& b) {
    asm volatile("s_waitcnt vmcnt(0)" ::: "memory");
    __syncthreads();
    if (threadIdx.x == 0) {
        unsigned* bar = b.bar;
        __builtin_amdgcn_s_waitcnt(0);
        unsigned nloc = b.st[0], nx = b.st[1];
        if (nloc == 0u) { xcd_barrier_complete(bar, b.x, nloc, nx); b.st[0] = nloc; b.st[1] = nx; }
        const unsigned old = xb_add(&bar[XB_XSUB(b.x)], 1u);
        const unsigned gen = old / nloc;
        if (old + 1u == (gen + 1u) * nloc) {
            __builtin_amdgcn_fence(__ATOMIC_RELEASE, "agent");
            asm volatile("s_waitcnt vmcnt(0)" ::: "memory");
            const unsigned og = xb_add(&bar[XB_TOP], 1u);
            const unsigned tg = og / nx;
            if (og + 1u == (tg + 1u) * nx) xb_add(&bar[XB_TOPGEN], 1u);
            else XB_SPIN(xb_ld(&bar[XB_TOPGEN]) == tg, bar);
            __builtin_amdgcn_fence(__ATOMIC_ACQUIRE, "agent");
            xb_add(&bar[XB_XGEN(b.x)], 1u);
            asm volatile("s_waitcnt vmcnt(0)" ::: "memory");
        } else {
            XB_SPIN(xb_ld(&bar[XB_XGEN(b.x)]) == gen, bar);
            __builtin_amdgcn_fence(__ATOMIC_ACQUIRE, "agent");
            asm volatile("s_waitcnt vmcnt(0)" ::: "memory");
        }
    }
    __syncthreads();
}

__device__ __forceinline__ float wave_sum(float v) {
#pragma unroll
    for (int o = 1; o < 64; o <<= 1) v += __shfl_xor(v, o);
    return v;
}
__device__ __forceinline__ float log_sigmoidf(float x) { return fminf(x, 0.f) - log1pf(expf(-fabsf(x))); }
__device__ __forceinline__ float rstd_of(const ssq_t* ssq_row) { return 1.0f / sqrtf(ssq_val(*ssq_row) * (1.0f / D) + EPS); }

__device__ __forceinline__ void tr_item64(const float* W, int ldW, int k0, int c0, bf16_t* WT, int ldT, int r0, const float* kg, const float* cg, float mul, LAS unsigned* scr, int lane) {
    const int n4 = lane & 15, kq = lane >> 4;
    f32x4 cm = (f32x4){mul, mul, mul, mul}; if (cg) cm = *(const f32x4*)(cg + c0 + 4 * n4) * mul;
    f32x4 va[8], vb[8];
#pragma unroll
    for (int i = 0; i < 8; ++i) { const int kp = kq + 4 * i; const float* p = W + (size_t)(k0 + 2 * kp) * ldW + c0 + 4 * n4; va[i] = *(const f32x4*)p; vb[i] = *(const f32x4*)(p + ldW); }
#pragma unroll
    for (int i = 0; i < 8; ++i) { const int kp = kq + 4 * i; const float g0 = kg ? kg[k0 + 2 * kp] : 1.0f, g1 = kg ? kg[k0 + 2 * kp + 1] : 1.0f;
#pragma unroll
        for (int e = 0; e < 4; ++e) scr[kp * 65 + 4 * n4 + e] = pack2(va[i][e] * cm[e] * g0, vb[i][e] * cm[e] * g1); }
    LDS_WAIT(); asm volatile("" ::: "memory");
    const int j = lane & 7, nl = lane >> 3;
#pragma unroll
    for (int it = 0; it < 8; ++it) { const int n = nl + 8 * it; u32x4 o; o.x = scr[(4 * j + 0) * 65 + n]; o.y = scr[(4 * j + 1) * 65 + n]; o.z = scr[(4 * j + 2) * 65 + n]; o.w = scr[(4 * j + 3) * 65 + n];
        *(u32x4*)(WT + (size_t)(r0 + n) * ldT + k0 + 8 * j) = o; }
    LDS_WAIT(); asm volatile("" ::: "memory");
}

struct Args;
constexpr int I_IN = 16 * 48, I_OUT = 16 * 16, I_POOL = 4 * 4 * 4, I_GU = 16 * 88, I_DN = 44 * 16;
constexpr int CV_P0 = I_GU + I_IN + I_OUT, CV_T0 = CV_P0 + I_DN + I_POOL + I_GU + I_OUT, CV_T1 = CV_T0 + I_DN + I_IN + I_GU, CV_T2 = CV_T1 + I_DN + I_POOL + I_GU, CV_END = CV_T2 + I_DN;
struct Args { const float* in[12]; float* out; unsigned char* ws; int ph_lo, ph_hi; };

enum { JT_GU = 0, JT_DN = 1, JT_IN = 2, JT_OUT = 3, JT_POOL = 4 };
__device__ __forceinline__ void convert_one(const Args& args, unsigned char* ws, LAS unsigned* scr, int lane, int type, int l, int r) {
    const float* const* in = args.in;
    if (type == JT_GU) { const int kb = r / 88, nb = r % 88, r0 = nb * 64, pn = r0 >> 8, j = r0 & 255; const int c0 = (j < 128) ? pn * 128 + j : FF + pn * 128 + (j - 128);
        tr_item64(in[9] + (size_t)l * D * GU, GU, kb * 64, c0, (bf16_t*)(ws + WS_WGU) + (size_t)l * GU * D, D, r0, in[2] + l * D, nullptr, 1.0f, scr, lane); }
    else if (type == JT_DN) { const int kb = r / 16, nb = r % 16;
        tr_item64(in[10] + (size_t)l * FF * D, D, kb * 64, nb * 64, (bf16_t*)(ws + WS_WDN) + (size_t)l * D * FF, FF, nb * 64, nullptr, nullptr, 1.0f, scr, lane); }
    else if (type == JT_IN) { const int kb = r / 48, nb = r % 48, r0 = nb * 64;
        tr_item64(in[3] + (size_t)l * D * NIN, NIN, kb * 64, r0, (bf16_t*)(ws + WS_WIN) + (size_t)l * NQKVO * D, D, r0, in[1] + (2 * l) * D, nullptr, (r0 >= 512 && r0 < 1024) ? 0.125f : 1.0f, scr, lane); }
    else if (type == JT_OUT) { const int kb = r / 16, nb = r % 16;
        tr_item64(in[6] + (size_t)l * D * D, D, kb * 64, nb * 64, (bf16_t*)(ws + WS_WOUT) + (size_t)l * D * D, D, nb * 64, in[5] + l * D, nullptr, 1.0f, scr, lane); }
    else { const int gi = r / 16, r2 = r % 16, kb = r2 / 4, nb = r2 % 4;
        tr_item64(in[7] + (size_t)(l * 4 + gi) * 256 * 256, 256, kb * 64, nb * 64, (bf16_t*)(ws + WS_WPOOL) + (size_t)l * D * 256 + (size_t)gi * 256 * 256, 256, nb * 64,
                  in[1] + (2 * l + 1) * D + gi * 256, in[8] + l * D + gi * 256, 1.0f, scr, lane); }
}
__device__ __forceinline__ void convert_items(const Args& args, unsigned char* ws, LAS unsigned* scr, int lane, int lo, int hi, int w, int nw) {
    for (int it = lo + w; it < hi; it += nw) {
        int r = it;
#define CV_JOB(T, L, N) if (r < (N)) { convert_one(args, ws, scr, lane, T, L, r); continue; } r -= (N);
        CV_JOB(JT_GU, 0, I_GU) CV_JOB(JT_IN, 0, I_IN) CV_JOB(JT_OUT, 0, I_OUT)
        CV_JOB(JT_DN, 0, I_DN) CV_JOB(JT_POOL, 0, I_POOL) CV_JOB(JT_GU, 1, I_GU) CV_JOB(JT_OUT, 1, I_OUT)
        CV_JOB(JT_DN, 1, I_DN) CV_JOB(JT_IN, 1, I_IN) CV_JOB(JT_GU, 2, I_GU)
        CV_JOB(JT_DN, 2, I_DN) CV_JOB(JT_POOL, 1, I_POOL) CV_JOB(JT_GU, 3, I_GU)
        CV_JOB(JT_DN, 3, I_DN)
#undef CV_JOB
    }
}
constexpr int N_PHASES = 22;

__global__ void __launch_bounds__(NT, 2) fwd_kernel(Args args) {
    extern __shared__ __attribute__((aligned(16))) unsigned char lds_raw[];
    LAS unsigned char* lds = (LAS unsigned char*)lds_raw;
    volatile LAS unsigned* MISC = (volatile LAS unsigned*)(lds + MISC_OFF);
    LAS float* rtab = (LAS float*)(lds + RSTD_OFF);
    int tid = threadIdx.x, lane = tid & 63, wave = __builtin_amdgcn_readfirstlane(tid >> 6);
#define FRESH_TID() do { tid = threadIdx.x; asm volatile("" : "+v"(tid)); lane = tid & 63; wave = __builtin_amdgcn_readfirstlane(tid >> 6); } while (0)
    const int G = gridDim.x, bid = blockIdx.x;
    unsigned char* const ws = args.ws;
#define x_in       (args.in[0])
#define norm_mix   (args.in[1])
#define norm_ffn   (args.in[2])
#define w_in       (args.in[3])
#define gate_bias  (args.in[4])
#define head_gain  (args.in[5])
#define w_out      (args.in[6])
#define pool_w     (args.in[7])
#define pool_scale (args.in[8])
#define w_gu       (args.in[9])
#define w_dn       (args.in[10])
#define final_norm (args.in[11])
#define Win_t   ((bf16_t*)(ws + WS_WIN))
#define Wout_t  ((bf16_t*)(ws + WS_WOUT))
#define Wpool_t ((bf16_t*)(ws + WS_WPOOL))
#define Wgu_t   ((bf16_t*)(ws + WS_WGU))
#define Wdn_t   ((bf16_t*)(ws + WS_WDN))
#define Wg      ((bf16_t*)(ws + WS_WG))
#define ssq     ((ssq_t*)(ws + WS_SSQ))
#define gates   ((float*)(ws + WS_GATES))
#define decay   ((float*)(ws + WS_DECAY))
#define xb      ((bf16_t*)(ws + WS_XB))
#define BIG     ((bf16_t*)(ws + WS_BIG))
#define ST      ((bf16_t*)(ws + WS_ST))

    for (int u = tid; u < (LDS_BYTES - LDSCTL_OFF) / 4; u += NT) ((LAS unsigned*)(lds + LDSCTL_OFF))[u] = 0u;
    __syncthreads();
    XcdBarrier bar; bar.bar = (unsigned*)(ws + WS_CTL) + CW_BAR; bar.x = 0; bar.st = nullptr;
    if (MK_N_LAUNCHES == 1) bar = xcd_barrier_post((unsigned*)(ws + WS_CTL) + CW_BAR, MISC + 8);

    const int lo = args.ph_lo, hi = args.ph_hi;
    int ph = 0;
#define IN_PH() (lo <= ph && ph < hi)
#define BEGIN_PH() FRESH_TID()
#if PROBE_PH >= 0
#define REPS() ((ph == PROBE_PH) ? PROBE_REP : 1)
#define LAST_REP() (rep_ + 1 == REPS())
#else
#define REPS() 1
#define LAST_REP() true
#endif
#define END_PH() do { if (lo <= ph && ph + 1 < hi) xcd_barrier(bar); ++ph; } while (0)

    if (IN_PH()) for (int rep_ = 0; rep_ < REPS(); ++rep_) { BEGIN_PH();
        LAS unsigned* scr = (LAS unsigned*)(lds + RING_OFF + wave * 8448);
        const int gw = bid * NWAVES + wave, NGW = G * NWAVES;
        convert_items(args, ws, scr, lane, 0, (G == 256) ? CV_P0 : CV_END, gw, NGW);
        for (int e = bid * NT + tid; e < 2 * 16 * D; e += G * NT) { const int l = e / (16 * D), rem = e % (16 * D), k = rem >> 4, j = rem & 15;
            Wg[(size_t)l * 16 * D + j * D + k] = f2bf(w_in[(size_t)l * D * NIN + (size_t)k * NIN + NQKVO + j] * norm_mix[(2 * l) * D + k]); }
        for (int e = bid * NT + tid; e < 8 * M; e += G * NT) ssq[M + e] = 0ull;
        for (int m = 2 * gw; m < M; m += 2 * NGW) {
            const f32x4* xr = (const f32x4*)(x_in + (size_t)m * D) + lane; f32x4 v[8]; float s0 = 0.f, s1 = 0.f;
#pragma unroll
            for (int j = 0; j < 8; ++j) v[j] = xr[64 * j];
#pragma unroll
            for (int j = 0; j < 4; ++j) { s0 += (v[j][0] * v[j][0] + v[j][1] * v[j][1]) + (v[j][2] * v[j][2] + v[j][3] * v[j][3]);
                                          s1 += (v[j + 4][0] * v[j + 4][0] + v[j + 4][1] * v[j + 4][1]) + (v[j + 4][2] * v[j + 4][2] + v[j + 4][3] * v[j + 4][3]); }
            s0 = wave_sum(s0); s1 = wave_sum(s1);
#pragma unroll
            for (int j = 0; j < 8; ++j) { u32x2 w; w.x = cvt_pk_bf16(v[j][0], v[j][1]); w.y = cvt_pk_bf16(v[j][2], v[j][3]); ((u32x2*)(xb + (size_t)m * D))[64 * j + lane] = w; }
            if (lane < 2) ssq[m + lane] = ssq_fix((lane == 0) ? s0 : s1);
        }
    }
    END_PH();
#if PROBE_BARS > 0
    if (MK_N_LAUNCHES == 1) for (int i_ = 0; i_ < PROBE_BARS; ++i_) xcd_barrier(bar);
#endif

    for (int layer = 0; layer < DEPTH; ++layer) {
        const int slot = layer >> 1;
        ssq_t* ssq_a = ssq + (size_t)(2 * layer) * M;
        ssq_t* ssq_b = ssq_a + M;
        ssq_t* ssq_c = ssq_b + M;
        if ((layer & 1) == 0) {
            if (IN_PH()) for (int rep_ = 0; rep_ < REPS(); ++rep_) { BEGIN_PH();
                {
                    const bf16_t* wgb = Wg + (size_t)slot * 16 * D;
                    LAS float* red = (LAS float*)lds;
                    const int rbk = wave & 3, kh = wave >> 2, fr = lane & 15, fq = lane >> 4;
                    for (int rb = bid; rb < M / 64; rb += G) {
                        const bf16_t* ap = xb + (size_t)(rb * 64 + rbk * 16 + fr) * D + kh * 512 + 8 * fq;
                        const bf16_t* bp = wgb + (size_t)fr * D + kh * 512 + 8 * fq;
                        f32x4 ga = (f32x4){0.f, 0.f, 0.f, 0.f};
#pragma unroll
                        for (int ks = 0; ks < 16; ++ks) ga = __builtin_amdgcn_mfma_f32_16x16x32_bf16(*(const bf16x8*)(ap + 32 * ks), *(const bf16x8*)(bp + 32 * ks), ga, 0, 0, 0);
                        if (kh == 1) *(LAS f32x4*)(red + (rbk * 64 + lane) * 4) = ga;
                        __syncthreads();
                        if (kh == 0) {
                            ga += *(const LAS f32x4*)(red + (rbk * 64 + lane) * 4);
                            const float gb = gate_bias[slot * 16 + fr];
#pragma unroll
                            for (int r = 0; r < 4; ++r) { const int row = rb * 64 + rbk * 16 + 4 * fq + r; const float gv = ga[r] * rstd_of(ssq_a + row) + gb;
                                gates[(size_t)row * 16 + fr] = SOFTCAP * tanhf(gv * (1.0f / SOFTCAP)); }
                        }
                        __syncthreads();
                    }
                }
                pg8::Gemm g{xb, Win_t + (size_t)slot * NQKVO * D}; pg8::Order S; S.init(M, NQKVO, G, bid, ssq_a, rtab);
                pg8::EpiProj E{BIG, rtab};
                pg8::gemm_phase<pg8::EpiProj, true, D, D, D, 0>(lds + RING_OFF, g, S, E);
            }
            END_PH();
            if (IN_PH()) for (int rep_ = 0; rep_ < REPS(); ++rep_) { BEGIN_PH();
                LAS unsigned char* wl = lds + wave * 12288;
                const int hh = lane >> 5, l31 = lane & 31, g16 = (lane >> 4) & 1, q4 = (lane & 15) >> 2, p4 = lane & 3;
                const int troff = (8 * hh + q4) * 192 + (16 * g16 + 4 * p4) * 2;
                bf16x8 a_one; { const short o = (l31 == 0) ? (short)0x3F80 : (short)0; for (int j = 0; j < 8; ++j) a_one[j] = o; }
                for (int T = bid * NWAVES + wave; T < 2 * NITEM; T += G * NWAVES) {
                    const int item = T >> 1, vh = T & 1, b = item >> 8, h = (item >> 5) & 7, c = item & 31, row0 = b * SEQ + c * CH;
                    const float f = gates[(size_t)(row0 + lane) * 16 + 8 + h], ig = gates[(size_t)(row0 + lane) * 16 + h];
                    float sc = log_sigmoidf(f);
#pragma unroll
                    for (int o = 1; o < 64; o <<= 1) { const float t = __shfl_up(sc, o); if (lane >= o) sc += t; }
                    const float bl = __shfl(sc, 63);
                    const float w = __expf(bl - sc + ig);
                    if (vh == 0 && lane == 63) decay[item] = __expf(bl);
                    f32x16 acc[2][2], accn[2];
#pragma unroll
                    for (int i = 0; i < 2; ++i) { accn[i] = zero16(); acc[i][0] = zero16(); acc[i][1] = zero16(); }
#pragma unroll
                    for (int cr = 0; cr < 2; ++cr) {
                        u32x4 kv[4], vv[4];
#pragma unroll
                        for (int i = 0; i < 4; ++i) { const int id = i * 64 + lane, rho = id >> 3, ch = id & 7; const bf16_t* base = BIG + (size_t)(row0 + 32 * cr + rho) * NQKVO;
                            kv[i] = *(const u32x4*)(base + 512 + h * DK + ch * 8); vv[i] = *(const u32x4*)(base + 1024 + h * DV + 64 * vh + ch * 8); }
#pragma unroll
                        for (int i = 0; i < 4; ++i) { const int id = i * 64 + lane, rho = id >> 3, ch = id & 7; const float wr = __shfl(w, 32 * cr + rho);
                            u32x4 ks; ks.x = pack2(bflo(kv[i].x) * wr, bfhi(kv[i].x) * wr); ks.y = pack2(bflo(kv[i].y) * wr, bfhi(kv[i].y) * wr);
                            ks.z = pack2(bflo(kv[i].z) * wr, bfhi(kv[i].z) * wr); ks.w = pack2(bflo(kv[i].w) * wr, bfhi(kv[i].w) * wr);
                            *(LAS u32x4*)(wl + rho * 192 + ch * 16) = ks; *(LAS u32x4*)(wl + 6144 + rho * 192 + ch * 16) = vv[i]; }
#pragma unroll
                        for (int sp = 0; sp < 2; ++sp) {
                            bf16x8 Bf[2], Af[2];
#pragma unroll
                            for (int t2 = 0; t2 < 2; ++t2) { Bf[t2] = tr_pair(wl + troff + sp * 16 * 192 + t2 * 64, 4 * 192); Af[t2] = tr_pair(wl + 6144 + troff + sp * 16 * 192 + t2 * 64, 4 * 192); }
#pragma unroll
                            for (int dt = 0; dt < 2; ++dt) { acc[0][dt] = MFMA32(Bf[dt], Af[0], acc[0][dt]); acc[1][dt] = MFMA32(Bf[dt], Af[1], acc[1][dt]); accn[dt] = MFMA32(Bf[dt], a_one, accn[dt]); }
                        }
                    }
                    bf16_t* st = ST + (size_t)item * STE;
#pragma unroll
                    for (int vt = 0; vt < 2; ++vt)
#pragma unroll
                        for (int dt = 0; dt < 2; ++dt)
#pragma unroll
                            for (int g4 = 0; g4 < 4; ++g4) { u32x2 pk; pk.x = pack2(acc[vt][dt][4 * g4], acc[vt][dt][4 * g4 + 1]); pk.y = pack2(acc[vt][dt][4 * g4 + 2], acc[vt][dt][4 * g4 + 3]);
                                *(u32x2*)(st + (size_t)(64 * vh + 32 * vt + l31) * 64 + 32 * dt + 8 * g4 + 4 * hh) = pk; }
                    if (vh == 0 && l31 == 0) {
#pragma unroll
                        for (int dt = 0; dt < 2; ++dt)
#pragma unroll
                            for (int g4 = 0; g4 < 4; ++g4) { u32x2 pk; pk.x = pack2(accn[dt][4 * g4], accn[dt][4 * g4 + 1]); pk.y = pack2(accn[dt][4 * g4 + 2], accn[dt][4 * g4 + 3]);
                                *(u32x2*)(st + 128 * 64 + 32 * dt + 8 * g4 + 4 * hh) = pk; }
                    }
                }
            }
            END_PH();
            if (IN_PH()) for (int rep_ = 0; rep_ < REPS(); ++rep_) { BEGIN_PH();
                for (int e = bid * NT + tid; e < BATCH * NH * (STE / 4); e += G * NT) {
                    const int bh = e / (STE / 4), el = e % (STE / 4); f32x4 stv = (f32x4){0.f, 0.f, 0.f, 0.f};
                    u32x2* p = (u32x2*)(ST + (size_t)bh * NCH * STE) + el;
                    u32x2* q = LAST_REP() ? p : (u32x2*)args.out + (size_t)bh * NCH * (STE / 4) + el;
#pragma unroll 8
                    for (int c = 0; c < NCH; ++c) { const u32x2 u = p[(size_t)c * (STE / 4)]; u32x2 o; o.x = pack2(stv[0], stv[1]); o.y = pack2(stv[2], stv[3]); q[(size_t)c * (STE / 4)] = o;
                        const float dc = decay[bh * NCH + c]; stv[0] = dc * stv[0] + bflo(u.x); stv[1] = dc * stv[1] + bfhi(u.x); stv[2] = dc * stv[2] + bflo(u.y); stv[3] = dc * stv[3] + bfhi(u.y); }
                }
            }
            END_PH();
            if (IN_PH()) for (int rep_ = 0; rep_ < REPS(); ++rep_) { BEGIN_PH();
                LAS unsigned char* wl = lds + wave * 12288;
                LAS float* ctab = (LAS float*)(wl + 10240);
                const int hh = lane >> 5, l31 = lane & 31, g16 = (lane >> 4) & 1, q4 = (lane & 15) >> 2, p4 = lane & 3;
                const int troff = (4 * hh + q4) * 320 + (16 * g16 + 4 * p4) * 2;
                bf16x8 a_one; { const short o = (l31 == 0) ? (short)0x3F80 : (short)0; for (int j = 0; j < 8; ++j) a_one[j] = o; }
                for (int T = bid * NWAVES + wave; T < 2 * NITEM; T += G * NWAVES) {
                    const int item = T >> 1, st = T & 1, b = item >> 8, h = (item >> 5) & 7, c = item & 31, row0 = b * SEQ + c * CH;
                    const float f = gates[(size_t)(row0 + lane) * 16 + 8 + h], ig = gates[(size_t)(row0 + lane) * 16 + h];
                    float sc = log_sigmoidf(f);
#pragma unroll
                    for (int o = 1; o < 64; o <<= 1) { const float t = __shfl_up(sc, o); if (lane >= o) sc += t; }
                    ctab[lane] = ig - sc;
                    const float bs = __shfl(sc, 32 * st + l31), eb = __expf(bs);
                    bf16x8 qf[4];
                    { const bf16_t* qp = BIG + (size_t)(row0 + 32 * st + l31) * NQKVO + h * DK + 8 * hh;
#pragma unroll
                      for (int ks = 0; ks < 4; ++ks) qf[ks] = *(const bf16x8*)(qp + 16 * ks); }
                    f32x16 acc[5];
                    const bf16_t* stp = ST + (size_t)item * STE;
#pragma unroll
                    for (int vt = 0; vt < 5; ++vt) {
                        acc[vt] = zero16();
                        const int vrow = (vt < 4) ? 32 * vt + l31 : 128;
                        const bf16_t* cp = stp + (size_t)vrow * 64 + 8 * hh;
#pragma unroll
                        for (int ks = 0; ks < 4; ++ks) {
                            u32x4 pk = *(const u32x4*)(cp + 16 * ks);
                            if (vt == 4 && l31 != 0) pk = (u32x4){0u, 0u, 0u, 0u};
                            acc[vt] = MFMA32(__builtin_bit_cast(bf16x8, pk), qf[ks], acc[vt]);
                        }
#pragma unroll
                        for (int r = 0; r < 16; ++r) acc[vt][r] *= eb;
                    }
                    LDS_WAIT();
#pragma unroll
                    for (int rt = 0; rt < 2; ++rt) {
                        if (rt <= st) {
                            f32x16 X = zero16();
                            { const bf16_t* kp = BIG + (size_t)(row0 + 32 * rt + l31) * NQKVO + 512 + h * DK + 8 * hh;
#pragma unroll
                              for (int ks = 0; ks < 4; ++ks) X = MFMA32(*(const bf16x8*)(kp + 16 * ks), qf[ks], X); }
                            u32x4 vv[8];
#pragma unroll
                            for (int i = 0; i < 8; ++i) { const int id = i * 64 + lane, rho = id >> 4, ch = id & 15; vv[i] = *(const u32x4*)(BIG + (size_t)(row0 + 32 * rt + rho) * NQKVO + 1024 + h * DV + ch * 8); }
#pragma unroll
                            for (int i = 0; i < 8; ++i) { const int id = i * 64 + lane, rho = id >> 4, ch = id & 15; *(LAS u32x4*)(wl + rho * 320 + ch * 16) = vv[i]; }
#pragma unroll
                            for (int g4 = 0; g4 < 4; ++g4) {
                                const f32x4 cr = *(const LAS f32x4*)(ctab + 32 * rt + 8 * g4 + 4 * hh);
#pragma unroll
                                for (int e = 0; e < 4; ++e) { float pv = X[4 * g4 + e] * __expf(bs + cr[e]); if (rt == st && (8 * g4 + 4 * hh + e) > l31) pv = 0.f; X[4 * g4 + e] = pv; }
                            }
#pragma unroll
                            for (int sp = 0; sp < 2; ++sp) {
                                u32x4 pk; pk.x = pack2(X[8 * sp + 0], X[8 * sp + 1]); pk.y = pack2(X[8 * sp + 2], X[8 * sp + 3]); pk.z = pack2(X[8 * sp + 4], X[8 * sp + 5]); pk.w = pack2(X[8 * sp + 6], X[8 * sp + 7]);
                                const bf16x8 pf = __builtin_bit_cast(bf16x8, pk);
#pragma unroll
                                for (int vt = 0; vt < 4; ++vt) acc[vt] = MFMA32(tr_pair(wl + troff + sp * 16 * 320 + vt * 64, 8 * 320), pf, acc[vt]);
                                acc[4] = MFMA32(a_one, pf, acc[4]);
                            }
                        }
                    }
                    const float den = __shfl(acc[4][0], l31), dd = fmaxf(fabsf(den), 1.0f);
                    float ss = 0.f;
#pragma unroll
                    for (int vt = 0; vt < 4; ++vt)
#pragma unroll
                        for (int r = 0; r < 16; ++r) ss += acc[vt][r] * acc[vt][r];
                    ss += __shfl_xor(ss, 32);
                    const float idd = 1.0f / dd; const float scale = idd / sqrtf(ss * idd * idd * (1.0f / DV) + EPS);
#pragma unroll
                    for (int vt = 0; vt < 4; ++vt)
#pragma unroll
                        for (int g4 = 0; g4 < 4; ++g4) { u32x2 pk; pk.x = pack2(acc[vt][4 * g4] * scale, acc[vt][4 * g4 + 1] * scale); pk.y = pack2(acc[vt][4 * g4 + 2] * scale, acc[vt][4 * g4 + 3] * scale);
                            *(LAS u32x2*)(wl + l31 * 272 + (32 * vt + 8 * g4 + 4 * hh) * 2) = pk; }
#pragma unroll
                    for (int i = 0; i < 8; ++i) { const int id = i * 64 + lane, rho = id >> 4, ch = id & 15;
                        const u32x4 hv = *(const LAS u32x4*)(wl + rho * 272 + ch * 16);
                        u32x4* op = (u32x4*)(BIG + (size_t)(row0 + 32 * st + rho) * NQKVO + 2048 + h * DV + ch * 8); const u32x4 ov = *op;
                        u32x4 w4; w4.x = pack2(bflo(hv.x) * bflo(ov.x), bfhi(hv.x) * bfhi(ov.x)); w4.y = pack2(bflo(hv.y) * bflo(ov.y), bfhi(hv.y) * bfhi(ov.y));
                        w4.z = pack2(bflo(hv.z) * bflo(ov.z), bfhi(hv.z) * bfhi(ov.z)); w4.w = pack2(bflo(hv.w) * bflo(ov.w), bfhi(hv.w) * bfhi(ov.w));
                        *(LAST_REP() ? op : (u32x4*)args.out + ((size_t)(row0 + 32 * st + rho) * 128 + h * 16 + ch)) = w4; }
                    LDS_WAIT();
                }
            }
            END_PH();
        }
        if (IN_PH()) for (int rep_ = 0; rep_ < REPS(); ++rep_) { BEGIN_PH();
            pg8::Order S; S.init(M, D, G, bid, nullptr, rtab);
            pg8::EpiRes E{xb, LAST_REP() ? xb : (bf16_t*)args.out, LAST_REP() ? ssq_b : (ssq_t*)(args.out + 8 * 1024 * 1024) + rep_ * M};
            if ((layer & 1) == 0) { pg8::Gemm g{BIG + 2048, Wout_t + (size_t)slot * D * D}; pg8::gemm_phase<pg8::EpiRes, false, NQKVO, D, D, 0>(lds + RING_OFF, g, S, E); }
            else {
                pg8::Unit u;
                for (int ui = 0; S.next(ui, u); ++ui) {
                    LAS float* hn = (LAS float*)lds;
                    LAS float* rsv = hn + 79 * 256;
                    const int gi = u.pn, w = 2 << gi, R0 = u.pm * 256, bb = R0 / SEQ, t0 = R0 % SEQ;
                    const int c16 = tid & 31, rp = tid >> 5;
                    const int c4 = tid & 63, tg = tid >> 6;
                    for (int tb = 0; tb < 4; ++tb) {
                        const int ts = t0 + 64 * tb;
                        __syncthreads();
                        if (tid < 79) { const int t = ts - 15 + tid; rsv[tid] = (t >= 0) ? rstd_of(ssq_a + (bb * SEQ + t)) : 0.f; }
                        u32x4 xv[5];
#pragma unroll
                        for (int ps = 0; ps < 5; ++ps) { const int rho = rp + 16 * ps, t = ts - 15 + rho; xv[ps] = (u32x4){0u, 0u, 0u, 0u};
                            if (rho < 79 && t >= 0) xv[ps] = *(const u32x4*)(xb + (size_t)(bb * SEQ + t) * D + 256 * gi + 8 * c16); }
                        __syncthreads();
#pragma unroll
                        for (int ps = 0; ps < 5; ++ps) { const int rho = rp + 16 * ps;
                            if (rho < 79) { const float r = rsv[rho]; LAS f32x4* dst = (LAS f32x4*)(hn + rho * 256 + 8 * c16);
                                dst[0] = (f32x4){bflo(xv[ps].x) * r, bfhi(xv[ps].x) * r, bflo(xv[ps].y) * r, bfhi(xv[ps].y) * r};
                                dst[1] = (f32x4){bflo(xv[ps].z) * r, bfhi(xv[ps].z) * r, bflo(xv[ps].w) * r, bfhi(xv[ps].w) * r}; } }
                        __syncthreads();
                        { const int tt0 = 8 * tg; f32x4 sw = (f32x4){0.f, 0.f, 0.f, 0.f};
                          for (int j = 1; j < w; ++j) sw += *(const LAS f32x4*)(hn + (15 + tt0 - j) * 256 + 4 * c4);
#pragma unroll
                          for (int tt = tt0; tt < tt0 + 8; ++tt) {
                              const f32x4 v = *(const LAS f32x4*)(hn + (15 + tt) * 256 + 4 * c4); sw += v;
                              const int tpos = ts + tt; const float inv = 1.0f / (float)((tpos + 1 < w) ? tpos + 1 : w);
                              u32x2 o; o.x = pack2(sw[0] * inv - v[0], sw[1] * inv - v[1]); o.y = pack2(sw[2] * inv - v[2], sw[3] * inv - v[3]);
                              *(u32x2*)(BIG + (size_t)(R0 + 64 * tb + tt) * D + 256 * gi + 4 * c4) = o;
                              sw -= *(const LAS f32x4*)(hn + (15 + tt - w + 1) * 256 + 4 * c4);
                          } }
                    }
                }
                VM_WAIT(); __syncthreads();
                pg8::Gemm g{BIG, Wpool_t + (size_t)slot * D * 256}; pg8::gemm_phase<pg8::EpiRes, false, D, 256, 256, 256>(lds + RING_OFF, g, S, E);
            }
        }
        END_PH();
        if (IN_PH()) for (int rep_ = 0; rep_ < REPS(); ++rep_) { BEGIN_PH();
            pg8::Gemm g{xb, Wgu_t + (size_t)layer * GU * D}; pg8::Order S; S.init(M, GU, G, bid, ssq_b, rtab);
            pg8::EpiGU E{BIG, rtab};
            pg8::gemm_phase<pg8::EpiGU, true, D, D, D, 0>(lds + RING_OFF, g, S, E);
            if (G == 256 && bid >= 128 && LAST_REP()) {
                const int lo_ = (layer == 0) ? CV_P0 : (layer == 1) ? CV_T0 : (layer == 2) ? CV_T1 : CV_T2, hi_ = (layer == 0) ? CV_T0 : (layer == 1) ? CV_T1 : (layer == 2) ? CV_T2 : CV_END;
                convert_items(args, ws, (LAS unsigned*)(lds + RING_OFF + wave * 8448), lane, lo_, hi_, (bid - 128) * NWAVES + wave, 128 * NWAVES);
            }
        }
        END_PH();
        if (IN_PH()) for (int rep_ = 0; rep_ < REPS(); ++rep_) { BEGIN_PH();
            pg8::Gemm g{BIG, Wdn_t + (size_t)layer * D * FF}; pg8::Order S; S.init(M, D, G, bid, nullptr, rtab);
            pg8::EpiRes E{xb, LAST_REP() ? xb : (bf16_t*)args.out, LAST_REP() ? ssq_c : (ssq_t*)(args.out + 8 * 1024 * 1024) + rep_ * M};
            pg8::gemm_phase<pg8::EpiRes, false, FF, FF, FF, 0>(lds + RING_OFF, g, S, E);
        }
        END_PH();
    }
    if (IN_PH()) for (int rep_ = 0; rep_ < REPS(); ++rep_) { BEGIN_PH();
        const int gw = bid * NWAVES + wave, NGW = G * NWAVES;
        for (int m = gw; m < M; m += NGW) {
            const u32x4 a = ((const u32x4*)(xb + (size_t)m * D))[lane], b2 = ((const u32x4*)(xb + (size_t)m * D))[64 + lane];
            float v[16] = {bflo(a.x), bfhi(a.x), bflo(a.y), bfhi(a.y), bflo(a.z), bfhi(a.z), bflo(a.w), bfhi(a.w), bflo(b2.x), bfhi(b2.x), bflo(b2.y), bfhi(b2.y), bflo(b2.z), bfhi(b2.z), bflo(b2.w), bfhi(b2.w)};
            float sq = 0.f;
#pragma unroll
            for (int j = 0; j < 16; ++j) sq += v[j] * v[j];
            const float rs = 1.0f / sqrtf(wave_sum(sq) * (1.0f / D) + EPS);
#pragma unroll
            for (int hpart = 0; hpart < 2; ++hpart)
#pragma unroll
                for (int q = 0; q < 2; ++q) { const int col = hpart * 512 + lane * 8 + q * 4; const f32x4 gn = *(const f32x4*)(final_norm + col);
                    f32x4 o; o[0] = v[hpart * 8 + q * 4 + 0] * rs * gn[0]; o[1] = v[hpart * 8 + q * 4 + 1] * rs * gn[1]; o[2] = v[hpart * 8 + q * 4 + 2] * rs * gn[2]; o[3] = v[hpart * 8 + q * 4 + 3] * rs * gn[3];
                    *(f32x4*)(args.out + (size_t)m * D + col) = o; }
        }
    }
#undef IN_PH
#undef END_PH
}

extern "C" void kernel_launch(void* const* d_in, const int* in_sizes, int n_in, void* d_out, int out_size, void* d_ws, size_t ws_size, hipStream_t stream) {
    static int grid = 0;
    if (grid == 0) {
        if (n_in != 12 || in_sizes[0] != M * D || out_size != M * D || ws_size < WS_END) { fprintf(stderr, "kernel_launch: unexpected shapes / workspace (n_in %d, ws %zu, need %zu)\n", n_in, ws_size, (size_t)WS_END); grid = -1; return; }
        int dev = 0, cus = 0, per_cu = 0;
        if (hipGetDevice(&dev) != hipSuccess || hipDeviceGetAttribute(&cus, hipDeviceAttributeMultiprocessorCount, dev) != hipSuccess) { grid = -1; return; }
        if (hipFuncSetAttribute((const void*)fwd_kernel, hipFuncAttributeMaxDynamicSharedMemorySize, LDS_BYTES) != hipSuccess) { fprintf(stderr, "kernel_launch: hipFuncSetAttribute failed\n"); grid = -1; return; }
        if (hipOccupancyMaxActiveBlocksPerMultiprocessor(&per_cu, (const void*)fwd_kernel, NT, LDS_BYTES) != hipSuccess || per_cu < 1) { fprintf(stderr, "kernel_launch: occupancy query says %d blocks per CU\n", per_cu); grid = -1; (void)hipGetLastError(); return; }
        grid = cus;
    }
    if (grid < 0) return;
    Args a{};
    for (int i = 0; i < 12; ++i) a.in[i] = (const float*)d_in[i];
    a.out = (float*)d_out; a.ws = (unsigned char*)d_ws;
#if MK_N_LAUNCHES == 1
    (void)hipMemsetAsync((char*)d_ws + WS_CTL, 0, CTL_ZERO_BYTES, stream);
    a.ph_lo = 0; a.ph_hi = N_PHASES;
    void* kargs[] = {&a};
    hipError_t e = hipLaunchCooperativeKernel((const void*)fwd_kernel, dim3(grid), dim3(NT), kargs, LDS_BYTES, stream);
    if (e != hipSuccess) fprintf(stderr, "cooperative launch failed: %s (grid %d)\n", hipGetErrorString(e), grid);
#else
    for (int p = 0; p < N_PHASES; ++p) {
        a.ph_lo = p; a.ph_hi = p + 1;
        hipLaunchKernelGGL(fwd_kernel, dim3(grid), dim3(NT), LDS_BYTES, stream, a);
    }
#endif
}
```

```cpp
#include <hip/hip_runtime.h>
#include <cstdio>
#include <cstdint>

#ifndef MK_N_LAUNCHES
#define MK_N_LAUNCHES 1
#endif

#ifndef PROBE_PH
#define PROBE_PH (-1)
#endif
#define PROBE_REP 3
#define PROBE_BARS 0

#define LAS __attribute__((address_space(3)))
typedef unsigned short bf16_t;
typedef short bf16x8 __attribute__((ext_vector_type(8)));
typedef float f32x4 __attribute__((ext_vector_type(4)));
typedef float f32x2 __attribute__((ext_vector_type(2)));
typedef unsigned u32x4 __attribute__((ext_vector_type(4)));
typedef unsigned u32x2 __attribute__((ext_vector_type(2)));
typedef unsigned long long ssq_t;
__device__ __forceinline__ ssq_t ssq_fix(float s) { return (ssq_t)(fminf(s, 1.0e12f) * 1048576.0f); }
__device__ __forceinline__ float ssq_val(ssq_t v) { return (float)v * (1.0f / 1048576.0f); }

constexpr int BATCH = 8, SEQ = 2048, D = 1024, DEPTH = 4, M = BATCH * SEQ;
constexpr int NH = 8, DK = 64, DV = 128, NQKVO = 3072, NIN = 3088, FF = 2816, GU = 2 * FF, CH = 64, NCH = SEQ / CH;
constexpr int BLK = 256, NBLK = BATCH * NH * (SEQ / BLK);
constexpr int NITEM = NBLK;
constexpr int STE = (DV + 1) * DK;
constexpr float EPS = 1e-6f, SOFTCAP = 15.0f;

__device__ __forceinline__ unsigned cvt_pk_bf16(float lo, float hi) { unsigned r; asm volatile("v_cvt_pk_bf16_f32 %0, %1, %2" : "=v"(r) : "v"(lo), "v"(hi)); return r; }
__device__ __forceinline__ float bf2f(unsigned short u) { return __uint_as_float((unsigned)u << 16); }
__device__ __forceinline__ float bflo(unsigned u) { return __uint_as_float(u << 16); }
__device__ __forceinline__ float bfhi(unsigned u) { return __uint_as_float(u & 0xffff0000u); }
__device__ __forceinline__ unsigned short f2bf(float f) { unsigned u = __float_as_uint(f); return (unsigned short)((u + 0x7fffu + ((u >> 16) & 1u)) >> 16); }


typedef short s16x4 __attribute__((ext_vector_type(4)));
typedef float f32x16 __attribute__((ext_vector_type(16)));
__device__ __forceinline__ unsigned pack2(float a, float b) { typedef __bf16 bf2 __attribute__((ext_vector_type(2))); f32x2 v = {a, b}; bf2 r = __builtin_convertvector(v, bf2); return __builtin_bit_cast(unsigned, r); }
__device__ __forceinline__ bf16x8 tr_pair(LAS unsigned char* p, int delta) {
    const s16x4 lo = __builtin_amdgcn_ds_read_tr16_b64_v4i16((LAS s16x4*)p), hi = __builtin_amdgcn_ds_read_tr16_b64_v4i16((LAS s16x4*)(p + delta));
    return __builtin_shufflevector(lo, hi, 0, 1, 2, 3, 4, 5, 6, 7);
}
#define MFMA32(a, b, c) __builtin_amdgcn_mfma_f32_32x32x16_bf16((a), (b), (c), 0, 0, 0)
__device__ __forceinline__ f32x16 zero16() { f32x16 z; for (int i = 0; i < 16; ++i) z[i] = 0.f; return z; }

namespace pg8 {
constexpr int BM = 256, BK = 64, HALF = 128, HTB = HALF * BK * 2, STAGE_BYTES = 8 * HTB, NXCD = 8, WGM = 8;
__host__ __device__ __forceinline__ int lds_byte(int r, int c) { const int st = (r >> 4) * 2 + (c >> 5), rr = r & 15, cc = c & 31, ob = rr * 64 + cc * 2; return st * 1024 + (ob ^ (((ob >> 9) & 1) << 5)); }
__host__ __device__ __forceinline__ void stage_rc(int b, int& R, int& C) { const int st = b / 1024, sb = b % 1024, swz = sb ^ (((sb >> 9) & 1) << 5); R = (st >> 1) * 16 + swz / 64; C = (st & 1) * 32 + (swz % 64) / 2; }
__host__ __device__ __forceinline__ int perm32(int rho) { const int n = rho >> 4, i = rho & 15; return 8 * (i >> 2) + 4 * n + (i & 3); }

struct Unit { int pm, pn, idx, hm; };
struct Gemm { const bf16_t* A; const bf16_t* Bt; };

struct Order {
    int nM, nN, nwg, G, c, nsplit;
    const ssq_t* ssq;
    LAS float* tab;
    __device__ __forceinline__ void init(int M_, int N, int G_, int c_, const ssq_t* ssq_, LAS float* tab_) { nM = M_ / BM; nN = N / BM; nwg = nM * nN; G = G_; c = c_; ssq = ssq_; tab = tab_; nsplit = 0; }
    __device__ __forceinline__ void split_tail(int ns) { if (G == 256 && nM == 64 && ns == 2) { nsplit = ns; nN -= ns; nwg = nM * nN; } }
    __device__ __forceinline__ bool next(int i, Unit& u) const {
        const long L = (long)i * G + c;
        const bool tail = L >= nwg;
        if (tail && (nsplit == 0 || L >= nwg + G)) return false;
        int wgid = tail ? 0 : (int)L; { const int q = nwg / NXCD, r = nwg % NXCD, xcd = wgid % NXCD, off = wgid / NXCD; wgid = (xcd < r ? xcd * (q + 1) : r * (q + 1) + (xcd - r) * q) + off; }
        const int nig = WGM * nN, gid = wgid / nig, fm = gid * WGM, gsz = (nM - fm) < WGM ? (nM - fm) : WGM;
        const int x = c & 7, j = c >> 3;
        const int pm = tail ? 8 * x + (j & 7) : fm + ((wgid % nig) % gsz);
        const int pn = tail ? nN + ((j >> 3) & 1) : (wgid % nig) / gsz;
        const int hm = tail ? (j >> 4) : -1;
        u.pm = pm; u.pn = pn; u.idx = i; u.hm = hm; return true;
    }
    __device__ __forceinline__ void a_ready(const Unit& u) const {
        int t_ = threadIdx.x; asm volatile("" : "+v"(t_));
        if (ssq != nullptr && t_ < 256) {
            const float s = ssq_val(ssq[(size_t)(u.pm * BM + (u.hm > 0 ? HALF : 0) + t_)]);
            tab[(u.idx & 1) * 256 + t_] = __builtin_amdgcn_rsqf(s * (1.0f / D) + EPS);
        }
    }
    __device__ __forceinline__ void done(const Unit&) const {}
};

__device__ __forceinline__ float sigmoidf_fast(float x) { return __builtin_amdgcn_rcpf(1.0f + __expf(-x)); }

struct EpiProj {
    static constexpr bool PERM = true, HAS_INIT = false;
    bf16_t* O; const LAS float* tab;
    __device__ __forceinline__ void operator()(const f32x4 (&acc)[2][2][4][2], const Unit& u, int wr, int wc, int fr, int fq) const {
        const LAS float* t = tab + (u.idx & 1) * 256;
        const bool sig = u.pn >= 8;
        const int row0 = u.pm * BM + wr * 64 + fr, col0 = u.pn * BM + wc * 32 + 8 * fq;
#pragma unroll
        for (int ai = 0; ai < 2; ++ai)
#pragma unroll
            for (int m = 0; m < 4; ++m) {
                const float rs = t[ai * HALF + wr * 64 + m * 16 + fr];
                bf16_t* rowp = O + (size_t)(row0 + ai * HALF + m * 16) * NQKVO + col0;
#pragma unroll
                for (int bj = 0; bj < 2; ++bj) {
                    f32x4 v0 = acc[ai][bj][m][0] * rs, v1 = acc[ai][bj][m][1] * rs;
                    if (sig) {
#pragma unroll
                        for (int i = 0; i < 4; ++i) { v0[i] = sigmoidf_fast(v0[i]); v1[i] = sigmoidf_fast(v1[i]); }
                    }
                    u32x4 w; w.x = cvt_pk_bf16(v0[0], v0[1]); w.y = cvt_pk_bf16(v0[2], v0[3]); w.z = cvt_pk_bf16(v1[0], v1[1]); w.w = cvt_pk_bf16(v1[2], v1[3]);
                    *(u32x4*)(rowp + bj * HALF) = w;
                }
            }
    }
};
struct EpiGU {
    static constexpr bool PERM = true, HAS_INIT = false;
    bf16_t* H; const LAS float* tab;
    __device__ __forceinline__ void operator()(const f32x4 (&acc)[2][2][4][2], const Unit& u, int wr, int wc, int fr, int fq) const {
        const LAS float* t = tab + (u.idx & 1) * 256;
        const int row0 = u.pm * BM + (u.hm > 0 ? HALF : 0) + wr * 64 + fr, col0 = u.pn * HALF + wc * 32 + 8 * fq;
#pragma unroll
        for (int ai = 0; ai < 2; ++ai) { if (ai == 1 && u.hm >= 0) break;
#pragma unroll
            for (int m = 0; m < 4; ++m) {
                const float rs = t[ai * HALF + wr * 64 + m * 16 + fr];
                const float c1 = rs * -1.4426950408889634f, rs2 = rs * rs;
                float hv[8];
#pragma unroll
                for (int n = 0; n < 2; ++n)
#pragma unroll
                    for (int i = 0; i < 4; ++i) { const float g = acc[ai][0][m][n][i], uu = acc[ai][1][m][n][i]; hv[n * 4 + i] = (g * uu) * (rs2 * __builtin_amdgcn_rcpf(1.0f + __builtin_amdgcn_exp2f(g * c1))); }
                u32x4 w; w.x = cvt_pk_bf16(hv[0], hv[1]); w.y = cvt_pk_bf16(hv[2], hv[3]); w.z = cvt_pk_bf16(hv[4], hv[5]); w.w = cvt_pk_bf16(hv[6], hv[7]);
                *(u32x4*)(H + (size_t)(row0 + ai * HALF + m * 16) * FF + col0) = w;
            }
        }
    }
};
struct EpiRes {
    static constexpr bool PERM = true, HAS_INIT = true;
    bf16_t* xb; bf16_t* xo; ssq_t* ssq_out;
    __device__ __forceinline__ void init(f32x4 (&acc)[2][2][4][2], const Unit& u, int wr, int wc, int fr, int fq) const {
        const int row0 = u.pm * BM + wr * 64 + fr, col0 = u.pn * BM + wc * 32 + 8 * fq;
        u32x4 t[2][4][2];
#pragma unroll
        for (int ai = 0; ai < 2; ++ai)
#pragma unroll
            for (int m = 0; m < 4; ++m)
#pragma unroll
                for (int bj = 0; bj < 2; ++bj) t[ai][m][bj] = *(const u32x4*)(xb + (size_t)(row0 + ai * HALF + m * 16) * D + col0 + bj * HALF);
#pragma unroll
        for (int ai = 0; ai < 2; ++ai)
#pragma unroll
            for (int m = 0; m < 4; ++m)
#pragma unroll
                for (int bj = 0; bj < 2; ++bj) { const u32x4 v = t[ai][m][bj];
                    acc[ai][bj][m][0] = (f32x4){bflo(v.x), bfhi(v.x), bflo(v.y), bfhi(v.y)}; acc[ai][bj][m][1] = (f32x4){bflo(v.z), bfhi(v.z), bflo(v.w), bfhi(v.w)}; }
    }
    __device__ __forceinline__ void operator()(const f32x4 (&acc)[2][2][4][2], const Unit& u, int wr, int wc, int fr, int fq) const {
        const int row0 = u.pm * BM + wr * 64 + fr, col0 = u.pn * BM + wc * 32 + 8 * fq;
#pragma unroll
        for (int ai = 0; ai < 2; ++ai)
#pragma unroll
            for (int m = 0; m < 4; ++m) {
                const int row = row0 + ai * HALF + m * 16; float ss = 0.f;
#pragma unroll
                for (int bj = 0; bj < 2; ++bj) {
                    const f32x4 v0 = acc[ai][bj][m][0], v1 = acc[ai][bj][m][1];
                    u32x4 w; w.x = cvt_pk_bf16(v0[0], v0[1]); w.y = cvt_pk_bf16(v0[2], v0[3]); w.z = cvt_pk_bf16(v1[0], v1[1]); w.w = cvt_pk_bf16(v1[2], v1[3]);
                    *(u32x4*)(xo + (size_t)row * D + col0 + bj * HALF) = w;
                    ss += ((v0[0] * v0[0] + v0[1] * v0[1]) + (v0[2] * v0[2] + v0[3] * v0[3])) + ((v1[0] * v1[0] + v1[1] * v1[1]) + (v1[2] * v1[2] + v1[3] * v1[3]));
                }
                ss += __shfl_xor(ss, 16); ss += __shfl_xor(ss, 32);
                if (fq == 0) atomicAdd(ssq_out + row, ssq_fix(ss));
            }
    }
};

template <class Epi, bool ALIGN_EPI, int LDA, int LDB, int KLEN, int ACOL, bool HALFU = false>
__device__ __forceinline__ void gemm_phase(LAS unsigned char* lds, const Gemm g, const Order& S, const Epi& E) {
    int tid_ = threadIdx.x; asm volatile("" : "+v"(tid_));
    const int tid = tid_, wid = __builtin_amdgcn_readfirstlane(tid >> 6), lane = tid & 63, wr = wid >> 2, wc = wid & 3, fr = lane & 15, fq = lane >> 4;
    constexpr int nt = KLEN / BK;
    unsigned voffA[2], voffB[2];
#pragma unroll
    for (int i = 0; i < 2; ++i) { int R, C; stage_rc(tid * 16 + i * 8192, R, C); const int Rb = Epi::PERM ? ((R & ~31) + perm32(R & 31)) : R;
        voffA[i] = (unsigned)(R * LDA + C) * 2u; voffB[i] = (unsigned)(Rb * LDB + C) * 2u; }
    constexpr size_t kstep = (size_t)(BK * 2);
    constexpr size_t hstepA = (size_t)HALF * LDA * 2, tstepA = 2 * hstepA, hstepB = (size_t)HALF * LDB * 2, tstepB = 2 * hstepB;
    constexpr size_t pnstepA = (size_t)ACOL * 2;
    const unsigned ldsw = (unsigned)wid * 1024u;
    const int aoff = lds_byte(wr * 64 + fr, fq * 8), boff = lds_byte(wc * 32 + fr, fq * 8);
#define PG8_SA(b, h) (((b) * 2 + (h)) * HTB)
#define PG8_SB(b, h) ((4 + (b) * 2 + (h)) * HTB)
#define PG8_STAGE(bufoff, gbase, voff) do { _Pragma("unroll") for (int _i = 0; _i < 2; ++_i) \
        __builtin_amdgcn_global_load_lds((const unsigned*)((const char*)(gbase) + (voff)[_i]), (LAS unsigned*)(lds + (bufoff) + ldsw + _i * 8192), 16, 0, 0); } while (0)
#define PG8_LDA(dst, b, h) do { _Pragma("unroll") for (int m = 0; m < 4; ++m) _Pragma("unroll") for (int k = 0; k < 2; ++k) dst[m][k] = *(const LAS bf16x8*)(lds + PG8_SA(b, h) + aoff + m * 2048 + k * 1024); } while (0)
#define PG8_LDB(dst, b, h) do { _Pragma("unroll") for (int n = 0; n < 2; ++n) _Pragma("unroll") for (int k = 0; k < 2; ++k) dst[n][k] = *(const LAS bf16x8*)(lds + PG8_SB(b, h) + boff + n * 2048 + k * 1024); } while (0)
#define PG8_MMA(ai, bj, At, Bt) do { __builtin_amdgcn_s_setprio(1); _Pragma("unroll") for (int m = 0; m < 4; ++m) _Pragma("unroll") for (int n = 0; n < 2; ++n) _Pragma("unroll") for (int k = 0; k < 2; ++k) \
        acc[ai][bj][m][n] = __builtin_amdgcn_mfma_f32_16x16x32_bf16(Bt[n][k], At[m][k], acc[ai][bj][m][n], 0, 0, 0); __builtin_amdgcn_s_setprio(0); } while (0)
#define PG8_WAIT_V(n) asm volatile("s_waitcnt vmcnt(" #n ")" ::: "memory")
#define PG8_WAIT_L(n) asm volatile("s_waitcnt lgkmcnt(" #n ")" ::: "memory")
#define PG8_BAR __builtin_amdgcn_s_barrier()
#define PG8_SCHED __builtin_amdgcn_sched_barrier(0)
    Unit cur, nxt; int ui = 0;
    if (!S.next(0, cur)) return;
    f32x4 acc[2][2][4][2];
    if constexpr (Epi::HAS_INIT) E.init(acc, cur, wr, wc, fr, fq);
    else {
#pragma unroll
    for (int a = 0; a < 2; ++a)
#pragma unroll
        for (int b = 0; b < 2; ++b)
#pragma unroll
            for (int m = 0; m < 4; ++m)
#pragma unroll
                for (int n = 0; n < 2; ++n) acc[a][b][m][n] = (f32x4){0.f, 0.f, 0.f, 0.f};
    }
    bf16x8 At[4][2], B0[2][2], B1[2][2];
    const char* cA = (const char*)g.A + (size_t)cur.pm * tstepA + (size_t)cur.pn * pnstepA + ((HALFU && cur.hm > 0) ? hstepA : 0); const char* cB = (const char*)g.Bt + (size_t)cur.pn * tstepB;
    S.a_ready(cur);
    PG8_STAGE(PG8_SB(0, 0), cB, voffB); PG8_STAGE(PG8_SB(0, 1), cB + hstepB, voffB); PG8_STAGE(PG8_SA(0, 0), cA, voffA); PG8_STAGE(PG8_SA(0, 1), cA + hstepA, voffA);
    if (wr == 1) PG8_BAR;
    PG8_WAIT_V(2); PG8_BAR;
    PG8_STAGE(PG8_SB(1, 0), cB + kstep, voffB); PG8_STAGE(PG8_SA(1, 0), cA + kstep, voffA); PG8_STAGE(PG8_SB(1, 1), cB + hstepB + kstep, voffB);
    PG8_WAIT_V(6); PG8_BAR;
    for (;;) {
        const bool has_next = S.next(ui + 1, nxt);
        const char* nA = has_next ? (const char*)g.A + (size_t)nxt.pm * tstepA + (size_t)nxt.pn * pnstepA + ((HALFU && nxt.hm > 0) ? hstepA : 0) : cA;
        const bool full = !HALFU || cur.hm < 0;
        const char* nB = has_next ? (const char*)g.Bt + (size_t)nxt.pn * tstepB : cB;
#pragma unroll 1
        for (int t = 0; t < nt; t += 2) {
            const bool last = (t == nt - 2);
            const char* a1 = cA + (size_t)(t + 1) * kstep;
            const char* a2 = last ? nA : cA + (size_t)(t + 2) * kstep; const char* b2 = last ? nB : cB + (size_t)(t + 2) * kstep;
            const char* a3 = a2 + kstep; const char* b3 = b2 + kstep;
            if (last && has_next) S.a_ready(nxt);
            PG8_LDB(B0, 0, 0); PG8_LDB(B1, 0, 1); PG8_SCHED; PG8_LDA(At, 0, 0); PG8_STAGE(PG8_SA(1, 1), a1 + hstepA, voffA);
            PG8_WAIT_V(8); PG8_WAIT_L(0); PG8_BAR; PG8_MMA(0, 0, At, B0); PG8_MMA(0, 1, At, B1); PG8_BAR; PG8_SCHED;
            PG8_LDA(At, 0, 1); PG8_STAGE(PG8_SB(0, 0), b2, voffB); PG8_STAGE(PG8_SB(0, 1), b2 + hstepB, voffB); PG8_STAGE(PG8_SA(0, 0), a2, voffA);
            PG8_WAIT_V(8); PG8_WAIT_L(0); PG8_BAR; if (full) { PG8_MMA(1, 0, At, B0); PG8_MMA(1, 1, At, B1); } PG8_BAR; PG8_SCHED;
            PG8_LDB(B0, 1, 0); PG8_LDB(B1, 1, 1); PG8_SCHED; PG8_LDA(At, 1, 0); PG8_STAGE(PG8_SA(0, 1), a2 + hstepA, voffA);
            PG8_WAIT_V(8); PG8_WAIT_L(0); PG8_BAR; PG8_MMA(0, 0, At, B0); PG8_MMA(0, 1, At, B1); PG8_BAR; PG8_SCHED;
            PG8_LDA(At, 1, 1); PG8_STAGE(PG8_SB(1, 0), b3, voffB); PG8_STAGE(PG8_SB(1, 1), b3 + hstepB, voffB); PG8_STAGE(PG8_SA(1, 0), a3, voffA);
            PG8_WAIT_V(8); PG8_WAIT_L(0); PG8_BAR; if (full) { PG8_MMA(1, 0, At, B0); PG8_MMA(1, 1, At, B1); } PG8_BAR; PG8_SCHED;
        }
        if constexpr (ALIGN_EPI) { if (wr == 0) PG8_BAR; }
        E(acc, cur, wr, wc, fr, fq);
#if defined(PROBE_EPI2)
        E(acc, cur, wr, wc, fr, fq); E(acc, cur, wr, wc, fr, fq);
#endif
        S.done(cur);
        if (!has_next) break;
        if constexpr (Epi::HAS_INIT) E.init(acc, nxt, wr, wc, fr, fq);
        else {
#pragma unroll
        for (int a = 0; a < 2; ++a)
#pragma unroll
            for (int b = 0; b < 2; ++b)
#pragma unroll
                for (int m = 0; m < 4; ++m)
#pragma unroll
                    for (int n = 0; n < 2; ++n) acc[a][b][m][n] = (f32x4){0.f, 0.f, 0.f, 0.f};
        }
        cur = nxt; cA = nA; cB = nB; ++ui;
        if constexpr (ALIGN_EPI) { if (wr == 1) PG8_BAR; }
    }
    PG8_WAIT_V(0);
    if constexpr (!ALIGN_EPI) { if (wr == 0) PG8_BAR; }
    PG8_BAR;
#undef PG8_SA
#undef PG8_SB
#undef PG8_STAGE
#undef PG8_LDA
#undef PG8_LDB
#undef PG8_MMA
#undef PG8_WAIT_V
#undef PG8_WAIT_L
#undef PG8_BAR
#undef PG8_SCHED
}
}

constexpr size_t MiB = 1u << 20;
constexpr size_t WS_CTL = 0, CTL_ZERO_BYTES = 1 * MiB;
constexpr size_t SZ_WIN = (size_t)NQKVO * D * 2, SZ_WOUT = (size_t)D * D * 2, SZ_WPOOL = (size_t)D * 256 * 2, SZ_WGU = (size_t)GU * D * 2, SZ_WDN = (size_t)D * FF * 2, SZ_WG = (size_t)16 * D * 2;
constexpr size_t WS_WIN = 1 * MiB;
constexpr size_t WS_WOUT = WS_WIN + 2 * SZ_WIN;
constexpr size_t WS_WPOOL = WS_WOUT + 2 * SZ_WOUT;
constexpr size_t WS_WGU = WS_WPOOL + 2 * SZ_WPOOL;
constexpr size_t WS_WDN = WS_WGU + 4 * SZ_WGU;
constexpr size_t WS_WG = WS_WDN + 4 * SZ_WDN;
constexpr size_t WS_SSQ = WS_WG + 2 * SZ_WG;
constexpr size_t SZ_SSQ = (size_t)M * 8;
constexpr size_t WS_GATES = WS_SSQ + 9 * SZ_SSQ;
constexpr size_t WS_DECAY = WS_GATES + (size_t)M * 16 * 4;
constexpr size_t WS_GT = WS_DECAY + 4096;
constexpr size_t WS_XB = ((WS_GT + (size_t)512 * 512 * 4 + MiB - 1) / MiB) * MiB;
constexpr size_t WS_BIG = WS_XB + (size_t)M * D * 2;
constexpr size_t WS_ST = WS_BIG + (size_t)M * NQKVO * 2;
constexpr size_t WS_END = WS_ST + (size_t)NITEM * STE * 2;
static_assert(WS_END <= 352 * MiB, "d_ws map must fit the guaranteed workspace");
static_assert((size_t)M * FF * 2 <= (size_t)M * NQKVO * 2, "H overlays q|k|v|o");

constexpr int CW_BAR = 4096;
constexpr int RING_OFF = 0, RING_BYTES = 131072;
constexpr int LDSCTL_OFF = RING_BYTES, MISC_OFF = LDSCTL_OFF + 320;
constexpr int RSTD_OFF = RING_BYTES + 1024;
constexpr int TAB_OFF = RING_BYTES + 3072;
constexpr int LDS_BYTES = 147456;
constexpr int NWAVES = 8, NT = NWAVES * 64;

#define VM_WAIT() asm volatile("s_waitcnt vmcnt(0)" ::: "memory")
#define LDS_WAIT() asm volatile("s_waitcnt lgkmcnt(0)" ::: "memory")

#define XB_TMO      128
#define XB_XCNT(j)  (256  + 64 * (j))
#define XB_XSUB(j)  (1280 + 64 * (j))
#define XB_XGEN(j)  (2304 + 64 * (j))
#define XB_TOP      3328
#define XB_TOPGEN   3392
#define XCD_BAR_WORDS 3456
#define XB_SPIN_CAP (1u << 18)
__device__ __forceinline__ unsigned xb_ld(unsigned* p)              { return __hip_atomic_load(p, __ATOMIC_RELAXED, __HIP_MEMORY_SCOPE_AGENT); }
__device__ __forceinline__ unsigned xb_add(unsigned* p, unsigned v) { return __hip_atomic_fetch_add(p, v, __ATOMIC_RELAXED, __HIP_MEMORY_SCOPE_AGENT); }
__device__ __forceinline__ unsigned xb_xcc_id() { return (unsigned)__builtin_amdgcn_s_getreg((3 << 11) | 20) & 0xFu; }
#define XB_SPIN(cond, bar) do { unsigned _sp = 0; while (cond) { __builtin_amdgcn_s_sleep(1); \
    if ((++_sp & 255u) == 0u) { if (xb_ld(&(bar)[XB_TMO])) break; if (_sp > XB_SPIN_CAP) { atomicAdd(&(bar)[XB_TMO], 1u); break; } } } } while (0)
struct XcdBarrier { unsigned* bar; unsigned x; volatile LAS unsigned* st; };
__device__ __forceinline__ XcdBarrier xcd_barrier_post(unsigned* bar, volatile LAS unsigned* st) {
    XcdBarrier b; b.bar = bar; b.x = xb_xcc_id(); b.st = st;
    if (threadIdx.x == 0) (void)xb_add(&bar[XB_XCNT(b.x)], 1u);
    return b;
}
__device__ __forceinline__ void xcd_barrier_complete(unsigned* bar, unsigned x, unsigned& nloc, unsigned& nx) {
    const unsigned G = gridDim.x * gridDim.y * gridDim.z;
    unsigned sum, cnt, mine, sp = 0u;
    for (;;) {
        sum = 0u; cnt = 0u; mine = 0u;
#pragma unroll
        for (unsigned j = 0; j < 16; ++j) { const unsigned c = xb_ld(&bar[XB_XCNT(j)]); sum += c; cnt += (c > 0u) ? 1u : 0u; mine = (j == x) ? c : mine; }
        if (sum == G) break;
        __builtin_amdgcn_s_sleep(1);
        if ((++sp & 255u) == 0u) { if (xb_ld(&bar[XB_TMO])) break; if (sp > XB_SPIN_CAP) { atomicAdd(&bar[XB_TMO], 1u); break; } }
    }
    nloc = mine > 0u ? mine : 1u; nx = cnt > 0u ? cnt : 1u;
}
__device__ __forceinline__ void xcd_barrier(const XcdBarrier& b) {
    asm volatile("s_waitcnt vmcnt(0)" ::: "memory");
    __syncthreads();
    if (threadIdx.x == 0) {
        unsigned* bar = b.bar;
        __builtin_amdgcn_s_waitcnt(0);
        unsigned nloc = b.st[0], nx = b.st[1];
        if (nloc == 0u) { xcd_barrier_complete(bar, b.x, nloc, nx); b.st[0] = nloc; b.st[1] = nx; }
        const unsigned old = xb_add(&bar[XB_XSUB(b.x)], 1u);
        const unsigned gen = old / nloc;
        if (old + 1u == (gen + 1u) * nloc) {
            __builtin_amdgcn_fence(__ATOMIC_RELEASE, "agent");
            asm volatile("s_waitcnt vmcnt(0)" ::: "memory");
            const unsigned og = xb_add(&bar[XB_TOP], 1u);
            const unsigned tg = og / nx;
            if (og + 1u == (tg + 1u) * nx) xb_add(&bar[XB_TOPGEN], 1u);
            else XB_SPIN(xb_ld(&bar[XB_TOPGEN]) == tg, bar);
            __builtin_amdgcn_fence(__ATOMIC_ACQUIRE, "agent");
            xb_add(&bar[XB_XGEN(b.x)], 1u);
            asm volatile("s_waitcnt vmcnt(0)" ::: "memory");
        } else {
            XB_SPIN(xb_ld(&bar[XB_XGEN(b.x)]) == gen, bar);
            __builtin_amdgcn_fence(__ATOMIC_ACQUIRE, "agent");
            asm volatile("s_waitcnt vmcnt(0)" ::: "memory");
        }
    }
    __syncthreads();
}

__device__ __forceinline__ float wave_sum(float v) {
#pragma unroll
    for (int o = 1; o < 64; o <<= 1) v += __shfl_xor(v, o);
    return v;
}
__device__ __forceinline__ float log_sigmoidf(float x) { return fminf(x, 0.f) - log1pf(expf(-fabsf(x))); }
__device__ __forceinline__ float rstd_of(const ssq_t* ssq_row) { return 1.0f / sqrtf(ssq_val(*ssq_row) * (1.0f / D) + EPS); }

__device__ __forceinline__ void tr_item64(const float* W, int ldW, int k0, int c0, bf16_t* WT, int ldT, int r0, const float* kg, const float* cg, float mul, LAS unsigned* scr, int lane) {
    const int n4 = lane & 15, kq = lane >> 4;
    f32x4 cm = (f32x4){mul, mul, mul, mul}; if (cg) cm = *(const f32x4*)(cg + c0 + 4 * n4) * mul;
    f32x4 va[8], vb[8];
#pragma unroll
    for (int i = 0; i < 8; ++i) { const int kp = kq + 4 * i; const float* p = W + (size_t)(k0 + 2 * kp) * ldW + c0 + 4 * n4; va[i] = *(const f32x4*)p; vb[i] = *(const f32x4*)(p + ldW); }
#pragma unroll
    for (int i = 0; i < 8; ++i) { const int kp = kq + 4 * i; const float g0 = kg ? kg[k0 + 2 * kp] : 1.0f, g1 = kg ? kg[k0 + 2 * kp + 1] : 1.0f;
#pragma unroll
        for (int e = 0; e < 4; ++e) scr[kp * 65 + 4 * n4 + e] = pack2(va[i][e] * cm[e] * g0, vb[i][e] * cm[e] * g1); }
    LDS_WAIT(); asm volatile("" ::: "memory");
    const int j = lane & 7, nl = lane >> 3;
#pragma unroll
    for (int it = 0; it < 8; ++it) { const int n = nl + 8 * it; u32x4 o; o.x = scr[(4 * j + 0) * 65 + n]; o.y = scr[(4 * j + 1) * 65 + n]; o.z = scr[(4 * j + 2) * 65 + n]; o.w = scr[(4 * j + 3) * 65 + n];
        *(u32x4*)(WT + (size_t)(r0 + n) * ldT + k0 + 8 * j) = o; }
    LDS_WAIT(); asm volatile("" ::: "memory");
}

struct Args;
constexpr int I_IN = 16 * 48, I_OUT = 16 * 16, I_POOL = 4 * 4 * 4, I_GU = 16 * 88, I_DN = 44 * 16;
constexpr int CV_P0 = I_GU + I_IN + I_OUT, CV_T0 = CV_P0 + I_DN + I_POOL + I_GU + I_OUT, CV_T1 = CV_T0 + I_DN + I_IN + I_GU, CV_T2 = CV_T1 + I_DN + I_POOL + I_GU, CV_END = CV_T2 + I_DN;
struct Args { const float* in[12]; float* out; unsigned char* ws; int ph_lo, ph_hi; };

enum { JT_GU = 0, JT_DN = 1, JT_IN = 2, JT_OUT = 3, JT_POOL = 4 };
__device__ __forceinline__ void convert_one(const Args& args, unsigned char* ws, LAS unsigned* scr, int lane, int type, int l, int r) {
    const float* const* in = args.in;
    if (type == JT_GU) { const int kb = r / 88, nb = r % 88, r0 = nb * 64, pn = r0 >> 8, j = r0 & 255; const int c0 = (j < 128) ? pn * 128 + j : FF + pn * 128 + (j - 128);
        tr_item64(in[9] + (size_t)l * D * GU, GU, kb * 64, c0, (bf16_t*)(ws + WS_WGU) + (size_t)l * GU * D, D, r0, in[2] + l * D, nullptr, 1.0f, scr, lane); }
    else if (type == JT_DN) { const int kb = r / 16, nb = r % 16;
        tr_item64(in[10] + (size_t)l * FF * D, D, kb * 64, nb * 64, (bf16_t*)(ws + WS_WDN) + (size_t)l * D * FF, FF, nb * 64, nullptr, nullptr, 1.0f, scr, lane); }
    else if (type == JT_IN) { const int kb = r / 48, nb = r % 48, r0 = nb * 64;
        tr_item64(in[3] + (size_t)l * D * NIN, NIN, kb * 64, r0, (bf16_t*)(ws + WS_WIN) + (size_t)l * NQKVO * D, D, r0, in[1] + (2 * l) * D, nullptr, (r0 >= 512 && r0 < 1024) ? 0.125f : 1.0f, scr, lane); }
    else if (type == JT_OUT) { const int kb = r / 16, nb = r % 16;
        tr_item64(in[6] + (size_t)l * D * D, D, kb * 64, nb * 64, (bf16_t*)(ws + WS_WOUT) + (size_t)l * D * D, D, nb * 64, in[5] + l * D, nullptr, 1.0f, scr, lane); }
    else { const int gi = r / 16, r2 = r % 16, kb = r2 / 4, nb = r2 % 4;
        tr_item64(in[7] + (size_t)(l * 4 + gi) * 256 * 256, 256, kb * 64, nb * 64, (bf16_t*)(ws + WS_WPOOL) + (size_t)l * D * 256 + (size_t)gi * 256 * 256, 256, nb * 64,
                  in[1] + (2 * l + 1) * D + gi * 256, in[8] + l * D + gi * 256, 1.0f, scr, lane); }
}
__device__ __forceinline__ void convert_items(const Args& args, unsigned char* ws, LAS unsigned* scr, int lane, int lo, int hi, int w, int nw) {
    for (int it = lo + w; it < hi; it += nw) {
        int r = it;
#define CV_JOB(T, L, N) if (r < (N)) { convert_one(args, ws, scr, lane, T, L, r); continue; } r -= (N);
        CV_JOB(JT_GU, 0, I_GU) CV_JOB(JT_IN, 0, I_IN) CV_JOB(JT_OUT, 0, I_OUT)
        CV_JOB(JT_DN, 0, I_DN) CV_JOB(JT_POOL, 0, I_POOL) CV_JOB(JT_GU, 1, I_GU) CV_JOB(JT_OUT, 1, I_OUT)
        CV_JOB(JT_DN, 1, I_DN) CV_JOB(JT_IN, 1, I_IN) CV_JOB(JT_GU, 2, I_GU)
        CV_JOB(JT_DN, 2, I_DN) CV_JOB(JT_POOL, 1, I_POOL) CV_JOB(JT_GU, 3, I_GU)
        CV_JOB(JT_DN, 3, I_DN)
#undef CV_JOB
    }
}
constexpr int N_PHASES = 20;

__global__ void __launch_bounds__(NT, 2) fwd_kernel(Args args) {
    extern __shared__ __attribute__((aligned(16))) unsigned char lds_raw[];
    LAS unsigned char* lds = (LAS unsigned char*)lds_raw;
    volatile LAS unsigned* MISC = (volatile LAS unsigned*)(lds + MISC_OFF);
    LAS float* rtab = (LAS float*)(lds + RSTD_OFF);
    int tid = threadIdx.x, lane = tid & 63, wave = __builtin_amdgcn_readfirstlane(tid >> 6);
#define FRESH_TID() do { tid = threadIdx.x; asm volatile("" : "+v"(tid)); lane = tid & 63; wave = __builtin_amdgcn_readfirstlane(tid >> 6); } while (0)
    const int G = gridDim.x, bid = blockIdx.x;
    unsigned char* const ws = args.ws;
#define x_in       (args.in[0])
#define norm_mix   (args.in[1])
#define norm_ffn   (args.in[2])
#define w_in       (args.in[3])
#define gate_bias  (args.in[4])
#define head_gain  (args.in[5])
#define w_out      (args.in[6])
#define pool_w     (args.in[7])
#define pool_scale (args.in[8])
#define w_gu       (args.in[9])
#define w_dn       (args.in[10])
#define final_norm (args.in[11])
#define Win_t   ((bf16_t*)(ws + WS_WIN))
#define Wout_t  ((bf16_t*)(ws + WS_WOUT))
#define Wpool_t ((bf16_t*)(ws + WS_WPOOL))
#define Wgu_t   ((bf16_t*)(ws + WS_WGU))
#define Wdn_t   ((bf16_t*)(ws + WS_WDN))
#define Wg      ((bf16_t*)(ws + WS_WG))
#define ssq     ((ssq_t*)(ws + WS_SSQ))
#define gates   ((float*)(ws + WS_GATES))
#define decay   ((float*)(ws + WS_DECAY))
#define GT      ((float*)(ws + WS_GT))
#define xb      ((bf16_t*)(ws + WS_XB))
#define BIG     ((bf16_t*)(ws + WS_BIG))
#define ST      ((bf16_t*)(ws + WS_ST))

    for (int u = tid; u < (LDS_BYTES - LDSCTL_OFF) / 4; u += NT) ((LAS unsigned*)(lds + LDSCTL_OFF))[u] = 0u;
    __syncthreads();
    XcdBarrier bar; bar.bar = (unsigned*)(ws + WS_CTL) + CW_BAR; bar.x = 0; bar.st = nullptr;
    if (MK_N_LAUNCHES == 1) bar = xcd_barrier_post((unsigned*)(ws + WS_CTL) + CW_BAR, MISC + 8);

    const int lo = args.ph_lo, hi = args.ph_hi;
    int ph = 0;
#define IN_PH() (lo <= ph && ph < hi)
#define BEGIN_PH() FRESH_TID()
#if PROBE_PH >= 0
#define LAS_REP_PTR(op, row, h, ch) (LAST_REP() ? (op) : (u32x4*)args.out + ((size_t)(row) * 128 + (h) * 16 + (ch)))
#define REPS() ((ph == PROBE_PH) ? PROBE_REP : 1)
#define LAST_REP() (rep_ + 1 == REPS())
#else
#define LAS_REP_PTR(op, row, h, ch) (op)
#define REPS() 1
#define LAST_REP() true
#endif
#define END_PH() do { if (lo <= ph && ph + 1 < hi) xcd_barrier(bar); ++ph; } while (0)

    if (IN_PH()) for (int rep_ = 0; rep_ < REPS(); ++rep_) { BEGIN_PH();
        LAS unsigned* scr = (LAS unsigned*)(lds + RING_OFF + wave * 8448);
        const int gw = bid * NWAVES + wave, NGW = G * NWAVES;
        convert_items(args, ws, scr, lane, 0, (G == 256) ? CV_P0 : CV_END, gw, NGW);
        for (int e = bid * NT + tid; e < 2 * 16 * D; e += G * NT) { const int l = e / (16 * D), rem = e % (16 * D), k = rem >> 4, j = rem & 15;
            Wg[(size_t)l * 16 * D + j * D + k] = f2bf(w_in[(size_t)l * D * NIN + (size_t)k * NIN + NQKVO + j] * norm_mix[(2 * l) * D + k]); }
        for (int e = bid * NT + tid; e < 8 * M; e += G * NT) ssq[M + e] = 0ull;
        for (int m = 2 * gw; m < M; m += 2 * NGW) {
            const f32x4* xr = (const f32x4*)(x_in + (size_t)m * D) + lane; f32x4 v[8]; float s0 = 0.f, s1 = 0.f;
#pragma unroll
            for (int j = 0; j < 8; ++j) v[j] = xr[64 * j];
#pragma unroll
            for (int j = 0; j < 4; ++j) { s0 += (v[j][0] * v[j][0] + v[j][1] * v[j][1]) + (v[j][2] * v[j][2] + v[j][3] * v[j][3]);
                                          s1 += (v[j + 4][0] * v[j + 4][0] + v[j + 4][1] * v[j + 4][1]) + (v[j + 4][2] * v[j + 4][2] + v[j + 4][3] * v[j + 4][3]); }
            s0 = wave_sum(s0); s1 = wave_sum(s1);
#pragma unroll
            for (int j = 0; j < 8; ++j) { u32x2 w; w.x = cvt_pk_bf16(v[j][0], v[j][1]); w.y = cvt_pk_bf16(v[j][2], v[j][3]); ((u32x2*)(xb + (size_t)m * D))[64 * j + lane] = w; }
            if (lane < 2) ssq[m + lane] = ssq_fix((lane == 0) ? s0 : s1);
        }
    }
    END_PH();
#if PROBE_BARS > 0
    if (MK_N_LAUNCHES == 1) for (int i_ = 0; i_ < PROBE_BARS; ++i_) xcd_barrier(bar);
#endif

    for (int layer = 0; layer < DEPTH; ++layer) {
        const int slot = layer >> 1;
        ssq_t* ssq_a = ssq + (size_t)(2 * layer) * M;
        ssq_t* ssq_b = ssq_a + M;
        ssq_t* ssq_c = ssq_b + M;
        if ((layer & 1) == 0) {
            if (IN_PH()) for (int rep_ = 0; rep_ < REPS(); ++rep_) { BEGIN_PH();
                {
                    const bf16_t* wgb = Wg + (size_t)slot * 16 * D;
                    LAS float* red = (LAS float*)lds;
                    const int rbk = wave & 3, kh = wave >> 2, fr = lane & 15, fq = lane >> 4;
                    for (int rb = bid; rb < M / 64; rb += G) {
                        const bf16_t* ap = xb + (size_t)(rb * 64 + rbk * 16 + fr) * D + kh * 512 + 8 * fq;
                        const bf16_t* bp = wgb + (size_t)fr * D + kh * 512 + 8 * fq;
                        f32x4 ga = (f32x4){0.f, 0.f, 0.f, 0.f};
#pragma unroll
                        for (int ks = 0; ks < 16; ++ks) ga = __builtin_amdgcn_mfma_f32_16x16x32_bf16(*(const bf16x8*)(ap + 32 * ks), *(const bf16x8*)(bp + 32 * ks), ga, 0, 0, 0);
                        if (kh == 1) *(LAS f32x4*)(red + (rbk * 64 + lane) * 4) = ga;
                        __syncthreads();
                        if (kh == 0) {
                            ga += *(const LAS f32x4*)(red + (rbk * 64 + lane) * 4);
                            const float gb = gate_bias[slot * 16 + fr];
#pragma unroll
                            for (int r = 0; r < 4; ++r) { const int row = rb * 64 + rbk * 16 + 4 * fq + r; const float gv = ga[r] * rstd_of(ssq_a + row) + gb;
                                gates[(size_t)row * 16 + fr] = SOFTCAP * tanhf(gv * (1.0f / SOFTCAP)); }
                        }
                        __syncthreads();
                    }
                }
                pg8::Gemm g{xb, Win_t + (size_t)slot * NQKVO * D}; pg8::Order S; S.init(M, NQKVO, G, bid, ssq_a, rtab);
                pg8::EpiProj E{BIG, rtab};
                pg8::gemm_phase<pg8::EpiProj, true, D, D, D, 0>(lds + RING_OFF, g, S, E);
            }
            END_PH();
            if (IN_PH()) for (int rep_ = 0; rep_ < REPS(); ++rep_) { BEGIN_PH();
                LAS unsigned char* kimg = lds;
                LAS unsigned char* vimg = lds + 49152;
                LAS float* wtab = (LAS float*)(lds + TAB_OFF);
                const int hh = lane >> 5, l31 = lane & 31, g16 = (lane >> 4) & 1, q4 = (lane & 15) >> 2, p4 = lane & 3;
                const int troffK = (8 * hh + q4) * 192 + (16 * g16 + 4 * p4) * 2, troffV = (8 * hh + q4) * 320 + (16 * g16 + 4 * p4) * 2;
                bf16x8 a_one; { const short o = (l31 == 0) ? (short)0x3F80 : (short)0; for (int j = 0; j < 8; ++j) a_one[j] = o; }
                const int vt = wave >> 1, dt = wave & 1;
                for (int item = bid; item < NBLK; item += G) {
                    const int b = item >> 6, h = (item >> 3) & 7, blk = item & 7, row0 = b * SEQ + blk * BLK;
                    __syncthreads();
                    { float lf[4], ig[4];
#pragma unroll
                      for (int e = 0; e < 4; ++e) { const float* gp = gates + (size_t)(row0 + 4 * lane + e) * 16; lf[e] = log_sigmoidf(gp[8 + h]); ig[e] = gp[h]; }
                      const float p0 = lf[0], p1 = p0 + lf[1], p2 = p1 + lf[2], p3 = p2 + lf[3];
                      float sc = p3;
#pragma unroll
                      for (int o = 1; o < 64; o <<= 1) { const float t = __shfl_up(sc, o); if (lane >= o) sc += t; }
                      const float ex = sc - p3, bl = __shfl(sc, 63);
                      if (wave == 0) { *(LAS f32x4*)(wtab + 4 * lane) = (f32x4){__expf(bl - (ex + p0) + ig[0]), __expf(bl - (ex + p1) + ig[1]), __expf(bl - (ex + p2) + ig[2]), __expf(bl - (ex + p3) + ig[3])};
                                       *(f32x4*)(GT + (size_t)item * 512 + 4 * lane) = (f32x4){ex + p0, ex + p1, ex + p2, ex + p3};
                                       *(f32x4*)(GT + (size_t)item * 512 + 256 + 4 * lane) = (f32x4){ig[0] - (ex + p0), ig[1] - (ex + p1), ig[2] - (ex + p2), ig[3] - (ex + p3)};
                                       if (lane == 0) decay[item] = __expf(bl); } }
#pragma unroll
                    for (int i = 0; i < 4; ++i) { const int id = i * NT + tid, r = id >> 3, ch = id & 7; *(LAS u32x4*)(kimg + r * 192 + ch * 16) = *(const u32x4*)(BIG + (size_t)(row0 + r) * NQKVO + 512 + h * DK + ch * 8); }
#pragma unroll
                    for (int i = 0; i < 8; ++i) { const int id = i * NT + tid, r = id >> 4, ch = id & 15; *(LAS u32x4*)(vimg + r * 320 + ch * 16) = *(const u32x4*)(BIG + (size_t)(row0 + r) * NQKVO + 1024 + h * DV + ch * 8); }
                    __syncthreads();
                    f32x16 acc = zero16(), accn = zero16();
#pragma unroll 4
                    for (int ks = 0; ks < 16; ++ks) {
                        const bf16x8 kf = tr_pair(kimg + troffK + ks * 16 * 192 + dt * 64, 4 * 192);
                        const f32x4 w0 = *(const LAS f32x4*)(wtab + 16 * ks + 8 * hh), w1 = *(const LAS f32x4*)(wtab + 16 * ks + 8 * hh + 4);
                        const u32x4 kb = __builtin_bit_cast(u32x4, kf);
                        u32x4 ksc; ksc.x = pack2(bflo(kb.x) * w0[0], bfhi(kb.x) * w0[1]); ksc.y = pack2(bflo(kb.y) * w0[2], bfhi(kb.y) * w0[3]);
                        ksc.z = pack2(bflo(kb.z) * w1[0], bfhi(kb.z) * w1[1]); ksc.w = pack2(bflo(kb.w) * w1[2], bfhi(kb.w) * w1[3]);
                        const bf16x8 kfs = __builtin_bit_cast(bf16x8, ksc);
                        const bf16x8 vf = tr_pair(vimg + troffV + ks * 16 * 320 + vt * 64, 4 * 320);
                        acc = MFMA32(kfs, vf, acc);
                        if (vt == 0) accn = MFMA32(kfs, a_one, accn);
                    }
                    bf16_t* st = ST + (size_t)item * STE;
#pragma unroll
                    for (int g4 = 0; g4 < 4; ++g4) { u32x2 pk; pk.x = pack2(acc[4 * g4], acc[4 * g4 + 1]); pk.y = pack2(acc[4 * g4 + 2], acc[4 * g4 + 3]);
                        *(u32x2*)(st + (size_t)(32 * vt + l31) * 64 + 32 * dt + 8 * g4 + 4 * hh) = pk; }
                    if (vt == 0 && l31 == 0) {
#pragma unroll
                        for (int g4 = 0; g4 < 4; ++g4) { u32x2 pk; pk.x = pack2(accn[4 * g4], accn[4 * g4 + 1]); pk.y = pack2(accn[4 * g4 + 2], accn[4 * g4 + 3]);
                            *(u32x2*)(st + 128 * 64 + 32 * dt + 8 * g4 + 4 * hh) = pk; }
                    }
                }
            }
            END_PH();
            if (IN_PH()) for (int rep_ = 0; rep_ < REPS(); ++rep_) { BEGIN_PH();
                LAS unsigned char* vimg = lds;
                LAS unsigned char* cimg = lds + 81920;
                LAS float* btab = (LAS float*)(lds + 100608);
                LAS float* ctab = btab + 256;
                const int st = (wave < 4) ? 7 - wave : wave - 4;
                for (int item = bid; item < NBLK; item += G) {
                    FRESH_TID();
                    const int hh = lane >> 5, l31 = lane & 31, g16 = (lane >> 4) & 1, q4 = (lane & 15) >> 2, p4 = lane & 3;
                    const int troff = (4 * hh + q4) * 320 + (16 * g16 + 4 * p4) * 2;
                    bf16x8 a_one; { const short o = (l31 == 0) ? (short)0x3F80 : (short)0; for (int j = 0; j < 8; ++j) a_one[j] = o; }
                    const int b = item >> 6, h = (item >> 3) & 7, blk = item & 7, row0 = b * SEQ + blk * BLK;
                    u32x4 vv[8];
#pragma unroll
                    for (int i = 0; i < 8; ++i) { const int id = i * NT + tid, r = id >> 4, ch = id & 15; vv[i] = *(const u32x4*)(BIG + (size_t)(row0 + r) * NQKVO + 1024 + h * DV + ch * 8); }
                    f32x4 tb = (f32x4){0.f, 0.f, 0.f, 0.f};
                    if (tid < 128) tb = *(const f32x4*)(GT + (size_t)item * 512 + 4 * tid);
                    u32x4 uu[2][7]; float dj[7];
#pragma unroll
                    for (int j = 0; j < 7; ++j) { dj[j] = 0.f; uu[0][j] = (u32x4){0u, 0u, 0u, 0u}; uu[1][j] = (u32x4){0u, 0u, 0u, 0u};
                        if (j < blk) { dj[j] = decay[item - blk + j]; const bf16_t* up = ST + (size_t)(item - blk + j) * STE + tid * 8; uu[0][j] = *(const u32x4*)up; uu[1][j] = *(const u32x4*)(up + NT * 8); } }
                    unsigned un[7];
#pragma unroll
                    for (int j = 0; j < 7; ++j) { un[j] = 0u; if (j < blk && tid < 32) un[j] = ((const unsigned*)(ST + (size_t)(item - blk + j) * STE + 8192))[tid]; }
                    __syncthreads();
#pragma unroll
                    for (int i = 0; i < 8; ++i) { const int id = i * NT + tid, r = id >> 4, ch = id & 15; *(LAS u32x4*)(vimg + r * 320 + ch * 16) = vv[i]; }
                    if (tid < 128) *(LAS f32x4*)(btab + 4 * tid) = tb;
#pragma unroll
                    for (int cc = 0; cc < 2; ++cc) { const int chunk = cc * NT + tid; float a8[8];
#pragma unroll
                        for (int e = 0; e < 8; ++e) a8[e] = 0.f;
#pragma unroll
                        for (int j = 0; j < 7; ++j) { const u32x4 u = uu[cc][j]; const float d = dj[j];
                            if (j < blk) {
                            a8[0] = d * a8[0] + bflo(u.x); a8[1] = d * a8[1] + bfhi(u.x); a8[2] = d * a8[2] + bflo(u.y); a8[3] = d * a8[3] + bfhi(u.y);
                            a8[4] = d * a8[4] + bflo(u.z); a8[5] = d * a8[5] + bfhi(u.z); a8[6] = d * a8[6] + bflo(u.w); a8[7] = d * a8[7] + bfhi(u.w); } }
                        u32x4 o; o.x = pack2(a8[0], a8[1]); o.y = pack2(a8[2], a8[3]); o.z = pack2(a8[4], a8[5]); o.w = pack2(a8[6], a8[7]);
                        *(LAS u32x4*)(cimg + (chunk >> 3) * 144 + (chunk & 7) * 16) = o; }
                    if (tid < 32) { float n0 = 0.f, n1 = 0.f;
#pragma unroll
                        for (int j = 0; j < 7; ++j) if (j < blk) { n0 = dj[j] * n0 + bflo(un[j]); n1 = dj[j] * n1 + bfhi(un[j]); }
                        *(LAS unsigned*)(cimg + 128 * 144 + tid * 4) = pack2(n0, n1); }
                    __syncthreads();
                    const float bs = btab[32 * st + l31], eb = __expf(bs);
                    bf16x8 qf[4];
                    { const bf16_t* qp = BIG + (size_t)(row0 + 32 * st + l31) * NQKVO + h * DK + 8 * hh;
#pragma unroll
                      for (int ks = 0; ks < 4; ++ks) qf[ks] = *(const bf16x8*)(qp + 16 * ks); }
                    u32x4 ov[8];
#pragma unroll
                    for (int i = 0; i < 8; ++i) { const int id = i * 64 + lane, rho = id >> 4, ch = id & 15; ov[i] = *(const u32x4*)(BIG + (size_t)(row0 + 32 * st + rho) * NQKVO + 2048 + h * DV + ch * 8); }
                    f32x16 acc[5];
#pragma unroll
                    for (int v5 = 0; v5 < 5; ++v5) acc[v5] = zero16();
                    bf16x8 kn[4];
                    { const bf16_t* kp = BIG + (size_t)(row0 + l31) * NQKVO + 512 + h * DK + 8 * hh;
#pragma unroll
                      for (int ks = 0; ks < 4; ++ks) kn[ks] = *(const bf16x8*)(kp + 16 * ks); }
                    for (int rt = 0; rt <= st; ++rt) {
                        f32x16 X = zero16();
#pragma unroll
                        for (int ks = 0; ks < 4; ++ks) X = MFMA32(kn[ks], qf[ks], X);
                        if (rt < st) { const bf16_t* kp = BIG + (size_t)(row0 + 32 * (rt + 1) + l31) * NQKVO + 512 + h * DK + 8 * hh;
#pragma unroll
                            for (int ks = 0; ks < 4; ++ks) kn[ks] = *(const bf16x8*)(kp + 16 * ks); }
#pragma unroll
                        for (int g4 = 0; g4 < 4; ++g4) {
                            const f32x4 cr = *(const LAS f32x4*)(ctab + 32 * rt + 8 * g4 + 4 * hh);
#pragma unroll
                            for (int e = 0; e < 4; ++e) { float pv = X[4 * g4 + e] * __expf(bs + cr[e]); if (rt == st && (8 * g4 + 4 * hh + e) > l31) pv = 0.f; X[4 * g4 + e] = pv; }
                        }
#pragma unroll
                        for (int sp = 0; sp < 2; ++sp) {
                            u32x4 pk; pk.x = pack2(X[8 * sp + 0], X[8 * sp + 1]); pk.y = pack2(X[8 * sp + 2], X[8 * sp + 3]); pk.z = pack2(X[8 * sp + 4], X[8 * sp + 5]); pk.w = pack2(X[8 * sp + 6], X[8 * sp + 7]);
                            const bf16x8 pf = __builtin_bit_cast(bf16x8, pk);
#pragma unroll
                            for (int v4 = 0; v4 < 4; ++v4) acc[v4] = MFMA32(tr_pair(vimg + troff + (32 * rt + 16 * sp) * 320 + v4 * 64, 8 * 320), pf, acc[v4]);
                            acc[4] = MFMA32(a_one, pf, acc[4]);
                        }
                    }
                    {   bf16x8 qs[4];
#pragma unroll
                        for (int ks = 0; ks < 4; ++ks) { const u32x4 qb = __builtin_bit_cast(u32x4, qf[ks]); u32x4 o; o.x = pack2(bflo(qb.x) * eb, bfhi(qb.x) * eb); o.y = pack2(bflo(qb.y) * eb, bfhi(qb.y) * eb);
                            o.z = pack2(bflo(qb.z) * eb, bfhi(qb.z) * eb); o.w = pack2(bflo(qb.w) * eb, bfhi(qb.w) * eb); qs[ks] = __builtin_bit_cast(bf16x8, o); }
#pragma unroll
                        for (int v5 = 0; v5 < 5; ++v5) {
                            const int vrow = (v5 < 4) ? 32 * v5 + l31 : 128;
#pragma unroll
                            for (int ks = 0; ks < 4; ++ks) {
                                u32x4 cf = *(const LAS u32x4*)(cimg + vrow * 144 + (16 * ks + 8 * hh) * 2);
                                if (v5 == 4 && l31 != 0) cf = (u32x4){0u, 0u, 0u, 0u};
                                acc[v5] = MFMA32(__builtin_bit_cast(bf16x8, cf), qs[ks], acc[v5]);
                            }
                        }
                    }
                    const float den = __shfl(acc[4][0], l31), dd = fmaxf(fabsf(den), 1.0f);
                    float ss = 0.f;
#pragma unroll
                    for (int v4 = 0; v4 < 4; ++v4)
#pragma unroll
                        for (int r = 0; r < 16; ++r) ss += acc[v4][r] * acc[v4][r];
                    ss += __shfl_xor(ss, 32);
                    const float idd = 1.0f / dd; const float scale = idd / sqrtf(ss * idd * idd * (1.0f / DV) + EPS);
                    __syncthreads();
                    LAS unsigned char* wl = vimg + wave * 8704;
#pragma unroll
                    for (int v4 = 0; v4 < 4; ++v4)
#pragma unroll
                        for (int g4 = 0; g4 < 4; ++g4) { u32x2 pk; pk.x = pack2(acc[v4][4 * g4] * scale, acc[v4][4 * g4 + 1] * scale); pk.y = pack2(acc[v4][4 * g4 + 2] * scale, acc[v4][4 * g4 + 3] * scale);
                            *(LAS u32x2*)(wl + l31 * 272 + (32 * v4 + 8 * g4 + 4 * hh) * 2) = pk; }
#pragma unroll
                    for (int i = 0; i < 8; ++i) { const int id = i * 64 + lane, rho = id >> 4, ch = id & 15;
                        const u32x4 hv = *(const LAS u32x4*)(wl + rho * 272 + ch * 16);
                        u32x4* op = (u32x4*)(BIG + (size_t)(row0 + 32 * st + rho) * NQKVO + 2048 + h * DV + ch * 8); const u32x4 o4 = ov[i];
                        u32x4 w4; w4.x = pack2(bflo(hv.x) * bflo(o4.x), bfhi(hv.x) * bfhi(o4.x)); w4.y = pack2(bflo(hv.y) * bflo(o4.y), bfhi(hv.y) * bfhi(o4.y));
                        w4.z = pack2(bflo(hv.z) * bflo(o4.z), bfhi(hv.z) * bfhi(o4.z)); w4.w = pack2(bflo(hv.w) * bflo(o4.w), bfhi(hv.w) * bfhi(o4.w));
                        *(LAS_REP_PTR(op, row0 + 32 * st + rho, h, ch)) = w4; }
                }
            }
            END_PH();
        }
        if (IN_PH()) for (int rep_ = 0; rep_ < REPS(); ++rep_) { BEGIN_PH();
            pg8::Order S; S.init(M, D, G, bid, nullptr, rtab);
            pg8::EpiRes E{xb, LAST_REP() ? xb : (bf16_t*)args.out, LAST_REP() ? ssq_b : (ssq_t*)(args.out + 8 * 1024 * 1024) + rep_ * M};
            if ((layer & 1) == 0) { pg8::Gemm g{BIG + 2048, Wout_t + (size_t)slot * D * D}; pg8::gemm_phase<pg8::EpiRes, false, NQKVO, D, D, 0>(lds + RING_OFF, g, S, E); }
            else {
                pg8::Unit u;
                for (int ui = 0; S.next(ui, u); ++ui) {
                    LAS float* hn = (LAS float*)lds;
                    LAS float* rsv = hn + 79 * 256;
                    const int gi = u.pn, w = 2 << gi, R0 = u.pm * 256, bb = R0 / SEQ, t0 = R0 % SEQ;
                    const int c16 = tid & 31, rp = tid >> 5;
                    const int c4 = tid & 63, tg = tid >> 6;
                    for (int tb = 0; tb < 4; ++tb) {
                        const int ts = t0 + 64 * tb;
                        __syncthreads();
                        if (tid < 79) { const int t = ts - 15 + tid; rsv[tid] = (t >= 0) ? rstd_of(ssq_a + (bb * SEQ + t)) : 0.f; }
                        u32x4 xv[5];
#pragma unroll
                        for (int ps = 0; ps < 5; ++ps) { const int rho = rp + 16 * ps, t = ts - 15 + rho; xv[ps] = (u32x4){0u, 0u, 0u, 0u};
                            if (rho < 79 && t >= 0) xv[ps] = *(const u32x4*)(xb + (size_t)(bb * SEQ + t) * D + 256 * gi + 8 * c16); }
                        __syncthreads();
#pragma unroll
                        for (int ps = 0; ps < 5; ++ps) { const int rho = rp + 16 * ps;
                            if (rho < 79) { const float r = rsv[rho]; LAS f32x4* dst = (LAS f32x4*)(hn + rho * 256 + 8 * c16);
                                dst[0] = (f32x4){bflo(xv[ps].x) * r, bfhi(xv[ps].x) * r, bflo(xv[ps].y) * r, bfhi(xv[ps].y) * r};
                                dst[1] = (f32x4){bflo(xv[ps].z) * r, bfhi(xv[ps].z) * r, bflo(xv[ps].w) * r, bfhi(xv[ps].w) * r}; } }
                        __syncthreads();
                        { const int tt0 = 8 * tg; f32x4 sw = (f32x4){0.f, 0.f, 0.f, 0.f};
                          for (int j = 1; j < w; ++j) sw += *(const LAS f32x4*)(hn + (15 + tt0 - j) * 256 + 4 * c4);
#pragma unroll
                          for (int tt = tt0; tt < tt0 + 8; ++tt) {
                              const f32x4 v = *(const LAS f32x4*)(hn + (15 + tt) * 256 + 4 * c4); sw += v;
                              const int tpos = ts + tt; const float inv = 1.0f / (float)((tpos + 1 < w) ? tpos + 1 : w);
                              u32x2 o; o.x = pack2(sw[0] * inv - v[0], sw[1] * inv - v[1]); o.y = pack2(sw[2] * inv - v[2], sw[3] * inv - v[3]);
                              *(u32x2*)(BIG + (size_t)(R0 + 64 * tb + tt) * D + 256 * gi + 4 * c4) = o;
                              sw -= *(const LAS f32x4*)(hn + (15 + tt - w + 1) * 256 + 4 * c4);
                          } }
                    }
                }
                VM_WAIT(); __syncthreads();
                pg8::Gemm g{BIG, Wpool_t + (size_t)slot * D * 256}; pg8::gemm_phase<pg8::EpiRes, false, D, 256, 256, 256>(lds + RING_OFF, g, S, E);
            }
        }
        END_PH();
        if (IN_PH()) for (int rep_ = 0; rep_ < REPS(); ++rep_) { BEGIN_PH();
            pg8::Gemm g{xb, Wgu_t + (size_t)layer * GU * D}; pg8::Order S; S.init(M, GU, G, bid, ssq_b, rtab);
            pg8::EpiGU E{BIG, rtab};
            pg8::gemm_phase<pg8::EpiGU, true, D, D, D, 0>(lds + RING_OFF, g, S, E);
            if (G == 256 && bid >= 128 && LAST_REP()) {
                const int lo_ = (layer == 0) ? CV_P0 : (layer == 1) ? CV_T0 : (layer == 2) ? CV_T1 : CV_T2, hi_ = (layer == 0) ? CV_T0 : (layer == 1) ? CV_T1 : (layer == 2) ? CV_T2 : CV_END;
                convert_items(args, ws, (LAS unsigned*)(lds + RING_OFF + wave * 8448), lane, lo_, hi_, (bid - 128) * NWAVES + wave, 128 * NWAVES);
            }
        }
        END_PH();
        if (IN_PH()) for (int rep_ = 0; rep_ < REPS(); ++rep_) { BEGIN_PH();
            pg8::Gemm g{BIG, Wdn_t + (size_t)layer * D * FF}; pg8::Order S; S.init(M, D, G, bid, nullptr, rtab);
            pg8::EpiRes E{xb, LAST_REP() ? xb : (bf16_t*)args.out, LAST_REP() ? ssq_c : (ssq_t*)(args.out + 8 * 1024 * 1024) + rep_ * M};
            pg8::gemm_phase<pg8::EpiRes, false, FF, FF, FF, 0>(lds + RING_OFF, g, S, E);
        }
        END_PH();
    }
    if (IN_PH()) for (int rep_ = 0; rep_ < REPS(); ++rep_) { BEGIN_PH();
        const int gw = bid * NWAVES + wave, NGW = G * NWAVES;
        for (int m = gw; m < M; m += NGW) {
            const u32x4 a = ((const u32x4*)(xb + (size_t)m * D))[lane], b2 = ((const u32x4*)(xb + (size_t)m * D))[64 + lane];
            float v[16] = {bflo(a.x), bfhi(a.x), bflo(a.y), bfhi(a.y), bflo(a.z), bfhi(a.z), bflo(a.w), bfhi(a.w), bflo(b2.x), bfhi(b2.x), bflo(b2.y), bfhi(b2.y), bflo(b2.z), bfhi(b2.z), bflo(b2.w), bfhi(b2.w)};
            float sq = 0.f;
#pragma unroll
            for (int j = 0; j < 16; ++j) sq += v[j] * v[j];
            const float rs = 1.0f / sqrtf(wave_sum(sq) * (1.0f / D) + EPS);
#pragma unroll
            for (int hpart = 0; hpart < 2; ++hpart)
#pragma unroll
                for (int q = 0; q < 2; ++q) { const int col = hpart * 512 + lane * 8 + q * 4; const f32x4 gn = *(const f32x4*)(final_norm + col);
                    f32x4 o; o[0] = v[hpart * 8 + q * 4 + 0] * rs * gn[0]; o[1] = v[hpart * 8 + q * 4 + 1] * rs * gn[1]; o[2] = v[hpart * 8 + q * 4 + 2] * rs * gn[2]; o[3] = v[hpart * 8 + q * 4 + 3] * rs * gn[3];
                    *(f32x4*)(args.out + (size_t)m * D + col) = o; }
        }
    }
#undef IN_PH
#undef END_PH
}

extern "C" void kernel_launch(void* const* d_in, const int* in_sizes, int n_in, void* d_out, int out_size, void* d_ws, size_t ws_size, hipStream_t stream) {
    static int grid = 0;
    if (grid == 0) {
        if (n_in != 12 || in_sizes[0] != M * D || out_size != M * D || ws_size < WS_END) { fprintf(stderr, "kernel_launch: unexpected shapes / workspace (n_in %d, ws %zu, need %zu)\n", n_in, ws_size, (size_t)WS_END); grid = -1; return; }
        int dev = 0, cus = 0, per_cu = 0;
        if (hipGetDevice(&dev) != hipSuccess || hipDeviceGetAttribute(&cus, hipDeviceAttributeMultiprocessorCount, dev) != hipSuccess) { grid = -1; return; }
        if (hipFuncSetAttribute((const void*)fwd_kernel, hipFuncAttributeMaxDynamicSharedMemorySize, LDS_BYTES) != hipSuccess) { fprintf(stderr, "kernel_launch: hipFuncSetAttribute failed\n"); grid = -1; return; }
        if (hipOccupancyMaxActiveBlocksPerMultiprocessor(&per_cu, (const void*)fwd_kernel, NT, LDS_BYTES) != hipSuccess || per_cu < 1) { fprintf(stderr, "kernel_launch: occupancy query says %d blocks per CU\n", per_cu); grid = -1; (void)hipGetLastError(); return; }
        grid = cus;
    }
    if (grid < 0) return;
    Args a{};
    for (int i = 0; i < 12; ++i) a.in[i] = (const float*)d_in[i];
    a.out = (float*)d_out; a.ws = (unsigned char*)d_ws;
#if MK_N_LAUNCHES == 1
    (void)hipMemsetAsync((char*)d_ws + WS_CTL, 0, CTL_ZERO_BYTES, stream);
    a.ph_lo = 0; a.ph_hi = N_PHASES;
    void* kargs[] = {&a};
    hipError_t e = hipLaunchCooperativeKernel((const void*)fwd_kernel, dim3(grid), dim3(NT), kargs, LDS_BYTES, stream);
    if (e != hipSuccess) fprintf(stderr, "cooperative launch failed: %s (grid %d)\n", hipGetErrorString(e), grid);
#else
    for (int p = 0; p < N_PHASES; ++p) {
        a.ph_lo = p; a.ph_hi = p + 1;
        hipLaunchKernelGGL(fwd_kernel, dim3(grid), dim3(NT), LDS_BYTES, stream, a);
    }
#endif
}
```

```cpp
#include <hip/hip_runtime.h>
#include <cstdio>
#include <cstdint>

#ifndef MK_N_LAUNCHES
#define MK_N_LAUNCHES 1
#endif

#ifndef PROBE_PH
#define PROBE_PH (-1)
#endif
#define PROBE_REP 3
#define PROBE_BARS 0

#define LAS __attribute__((address_space(3)))
typedef unsigned short bf16_t;
typedef short bf16x8 __attribute__((ext_vector_type(8)));
typedef float f32x4 __attribute__((ext_vector_type(4)));
typedef float f32x2 __attribute__((ext_vector_type(2)));
typedef unsigned u32x4 __attribute__((ext_vector_type(4)));
typedef unsigned u32x2 __attribute__((ext_vector_type(2)));
typedef unsigned long long ssq_t;
__device__ __forceinline__ ssq_t ssq_fix(float s) { return (ssq_t)(fminf(s, 1.0e12f) * 1048576.0f); }
__device__ __forceinline__ float ssq_val(ssq_t v) { return (float)v * (1.0f / 1048576.0f); }

constexpr int BATCH = 8, SEQ = 2048, D = 1024, DEPTH = 4, M = BATCH * SEQ;
constexpr int NH = 8, DK = 64, DV = 128, NQKVO = 3072, NIN = 3088, FF = 2816, GU = 2 * FF, CH = 64, NCH = SEQ / CH;
constexpr int BLK = 256, NBLK = BATCH * NH * (SEQ / BLK);
constexpr int NITEM = NBLK;
constexpr int STE = (DV + 1) * DK;
constexpr float EPS = 1e-6f, SOFTCAP = 15.0f;

__device__ __forceinline__ unsigned cvt_pk_bf16(float lo, float hi) { unsigned r; asm volatile("v_cvt_pk_bf16_f32 %0, %1, %2" : "=v"(r) : "v"(lo), "v"(hi)); return r; }
__device__ __forceinline__ float bf2f(unsigned short u) { return __uint_as_float((unsigned)u << 16); }
__device__ __forceinline__ float bflo(unsigned u) { return __uint_as_float(u << 16); }
__device__ __forceinline__ float bfhi(unsigned u) { return __uint_as_float(u & 0xffff0000u); }
__device__ __forceinline__ unsigned short f2bf(float f) { unsigned u = __float_as_uint(f); return (unsigned short)((u + 0x7fffu + ((u >> 16) & 1u)) >> 16); }


typedef short s16x4 __attribute__((ext_vector_type(4)));
typedef float f32x16 __attribute__((ext_vector_type(16)));
__device__ __forceinline__ unsigned pack2(float a, float b) { typedef __bf16 bf2 __attribute__((ext_vector_type(2))); f32x2 v = {a, b}; bf2 r = __builtin_convertvector(v, bf2); return __builtin_bit_cast(unsigned, r); }
__device__ __forceinline__ bf16x8 tr_pair(LAS unsigned char* p, int delta) {
    const s16x4 lo = __builtin_amdgcn_ds_read_tr16_b64_v4i16((LAS s16x4*)p), hi = __builtin_amdgcn_ds_read_tr16_b64_v4i16((LAS s16x4*)(p + delta));
    return __builtin_shufflevector(lo, hi, 0, 1, 2, 3, 4, 5, 6, 7);
}
#define MFMA32(a, b, c) __builtin_amdgcn_mfma_f32_32x32x16_bf16((a), (b), (c), 0, 0, 0)
__device__ __forceinline__ f32x16 zero16() { f32x16 z; for (int i = 0; i < 16; ++i) z[i] = 0.f; return z; }

namespace pg8 {
constexpr int BM = 256, BK = 64, HALF = 128, HTB = HALF * BK * 2, STAGE_BYTES = 8 * HTB, NXCD = 8, WGM = 8;
__host__ __device__ __forceinline__ int lds_byte(int r, int c) { const int st = (r >> 4) * 2 + (c >> 5), rr = r & 15, cc = c & 31, ob = rr * 64 + cc * 2; return st * 1024 + (ob ^ (((ob >> 9) & 1) << 5)); }
__host__ __device__ __forceinline__ void stage_rc(int b, int& R, int& C) { const int st = b / 1024, sb = b % 1024, swz = sb ^ (((sb >> 9) & 1) << 5); R = (st >> 1) * 16 + swz / 64; C = (st & 1) * 32 + (swz % 64) / 2; }
__host__ __device__ __forceinline__ int perm32(int rho) { const int n = rho >> 4, i = rho & 15; return 8 * (i >> 2) + 4 * n + (i & 3); }

struct Unit { int pm, pn, idx, hm; };
struct Gemm { const bf16_t* A; const bf16_t* Bt; };

struct Order {
    int nM, nN, nwg, G, c, nsplit;
    const ssq_t* ssq;
    LAS float* tab;
    __device__ __forceinline__ void init(int M_, int N, int G_, int c_, const ssq_t* ssq_, LAS float* tab_) { nM = M_ / BM; nN = N / BM; nwg = nM * nN; G = G_; c = c_; ssq = ssq_; tab = tab_; nsplit = 0; }
    __device__ __forceinline__ void split_tail(int ns) { if (G == 256 && nM == 64 && ns == 2) { nsplit = ns; nN -= ns; nwg = nM * nN; } }
    __device__ __forceinline__ bool next(int i, Unit& u) const {
        const long L = (long)i * G + c;
        const bool tail = L >= nwg;
        if (tail && (nsplit == 0 || L >= nwg + G)) return false;
        int wgid = tail ? 0 : (int)L; { const int q = nwg / NXCD, r = nwg % NXCD, xcd = wgid % NXCD, off = wgid / NXCD; wgid = (xcd < r ? xcd * (q + 1) : r * (q + 1) + (xcd - r) * q) + off; }
        const int nig = WGM * nN, gid = wgid / nig, fm = gid * WGM, gsz = (nM - fm) < WGM ? (nM - fm) : WGM;
        const int x = c & 7, j = c >> 3;
        const int pm = tail ? 8 * x + (j & 7) : fm + ((wgid % nig) % gsz);
        const int pn = tail ? nN + ((j >> 3) & 1) : (wgid % nig) / gsz;
        const int hm = tail ? (j >> 4) : -1;
        u.pm = pm; u.pn = pn; u.idx = i; u.hm = hm; return true;
    }
    __device__ __forceinline__ void a_ready(const Unit& u) const {
        int t_ = threadIdx.x; asm volatile("" : "+v"(t_));
        if (ssq != nullptr && t_ < 256) {
            const float s = ssq_val(ssq[(size_t)(u.pm * BM + (u.hm > 0 ? HALF : 0) + t_)]);
            tab[(u.idx & 1) * 256 + t_] = __builtin_amdgcn_rsqf(s * (1.0f / D) + EPS);
        }
    }
    __device__ __forceinline__ void done(const Unit&) const {}
};

__device__ __forceinline__ float sigmoidf_fast(float x) { return __builtin_amdgcn_rcpf(1.0f + __expf(-x)); }

struct EpiProj {
    static constexpr bool PERM = true, HAS_INIT = false;
    bf16_t* O; const LAS float* tab;
    __device__ __forceinline__ void operator()(const f32x4 (&acc)[2][2][4][2], const Unit& u, int wr, int wc, int fr, int fq) const {
        const LAS float* t = tab + (u.idx & 1) * 256;
        const bool sig = u.pn >= 8;
        const int row0 = u.pm * BM + wr * 64 + fr, col0 = u.pn * BM + wc * 32 + 8 * fq;
#pragma unroll
        for (int ai = 0; ai < 2; ++ai)
#pragma unroll
            for (int m = 0; m < 4; ++m) {
                const float rs = t[ai * HALF + wr * 64 + m * 16 + fr];
                bf16_t* rowp = O + (size_t)(row0 + ai * HALF + m * 16) * NQKVO + col0;
#pragma unroll
                for (int bj = 0; bj < 2; ++bj) {
                    f32x4 v0 = acc[ai][bj][m][0] * rs, v1 = acc[ai][bj][m][1] * rs;
                    if (sig) {
#pragma unroll
                        for (int i = 0; i < 4; ++i) { v0[i] = sigmoidf_fast(v0[i]); v1[i] = sigmoidf_fast(v1[i]); }
                    }
                    u32x4 w; w.x = cvt_pk_bf16(v0[0], v0[1]); w.y = cvt_pk_bf16(v0[2], v0[3]); w.z = cvt_pk_bf16(v1[0], v1[1]); w.w = cvt_pk_bf16(v1[2], v1[3]);
                    *(u32x4*)(rowp + bj * HALF) = w;
                }
            }
    }
};
struct EpiGU {
    static constexpr bool PERM = true, HAS_INIT = false;
    bf16_t* H; const LAS float* tab;
    __device__ __forceinline__ void operator()(const f32x4 (&acc)[2][2][4][2], const Unit& u, int wr, int wc, int fr, int fq) const {
        const LAS float* t = tab + (u.idx & 1) * 256;
        const int row0 = u.pm * BM + (u.hm > 0 ? HALF : 0) + wr * 64 + fr, col0 = u.pn * HALF + wc * 32 + 8 * fq;
#pragma unroll
        for (int ai = 0; ai < 2; ++ai) { if (ai == 1 && u.hm >= 0) break;
#pragma unroll
            for (int m = 0; m < 4; ++m) {
                const float rs = t[ai * HALF + wr * 64 + m * 16 + fr];
                const float c1 = rs * -1.4426950408889634f, rs2 = rs * rs;
                float hv[8];
#pragma unroll
                for (int n = 0; n < 2; ++n)
#pragma unroll
                    for (int i = 0; i < 4; ++i) { const float g = acc[ai][0][m][n][i], uu = acc[ai][1][m][n][i]; hv[n * 4 + i] = (g * uu) * (rs2 * __builtin_amdgcn_rcpf(1.0f + __builtin_amdgcn_exp2f(g * c1))); }
                u32x4 w; w.x = cvt_pk_bf16(hv[0], hv[1]); w.y = cvt_pk_bf16(hv[2], hv[3]); w.z = cvt_pk_bf16(hv[4], hv[5]); w.w = cvt_pk_bf16(hv[6], hv[7]);
                *(u32x4*)(H + (size_t)(row0 + ai * HALF + m * 16) * FF + col0) = w;
            }
        }
    }
};
struct EpiRes {
    static constexpr bool PERM = true, HAS_INIT = true;
    bf16_t* xb; bf16_t* xo; ssq_t* ssq_out;
    __device__ __forceinline__ void init(f32x4 (&acc)[2][2][4][2], const Unit& u, int wr, int wc, int fr, int fq) const {
        const int row0 = u.pm * BM + wr * 64 + fr, col0 = u.pn * BM + wc * 32 + 8 * fq;
        u32x4 t[2][4][2];
#pragma unroll
        for (int ai = 0; ai < 2; ++ai)
#pragma unroll
            for (int m = 0; m < 4; ++m)
#pragma unroll
                for (int bj = 0; bj < 2; ++bj) t[ai][m][bj] = *(const u32x4*)(xb + (size_t)(row0 + ai * HALF + m * 16) * D + col0 + bj * HALF);
#pragma unroll
        for (int ai = 0; ai < 2; ++ai)
#pragma unroll
            for (int m = 0; m < 4; ++m)
#pragma unroll
                for (int bj = 0; bj < 2; ++bj) { const u32x4 v = t[ai][m][bj];
                    acc[ai][bj][m][0] = (f32x4){bflo(v.x), bfhi(v.x), bflo(v.y), bfhi(v.y)}; acc[ai][bj][m][1] = (f32x4){bflo(v.z), bfhi(v.z), bflo(v.w), bfhi(v.w)}; }
    }
    __device__ __forceinline__ void operator()(const f32x4 (&acc)[2][2][4][2], const Unit& u, int wr, int wc, int fr, int fq) const {
        const int row0 = u.pm * BM + wr * 64 + fr, col0 = u.pn * BM + wc * 32 + 8 * fq;
#pragma unroll
        for (int ai = 0; ai < 2; ++ai)
#pragma unroll
            for (int m = 0; m < 4; ++m) {
                const int row = row0 + ai * HALF + m * 16; float ss = 0.f;
#pragma unroll
                for (int bj = 0; bj < 2; ++bj) {
                    const f32x4 v0 = acc[ai][bj][m][0], v1 = acc[ai][bj][m][1];
                    u32x4 w; w.x = cvt_pk_bf16(v0[0], v0[1]); w.y = cvt_pk_bf16(v0[2], v0[3]); w.z = cvt_pk_bf16(v1[0], v1[1]); w.w = cvt_pk_bf16(v1[2], v1[3]);
                    *(u32x4*)(xo + (size_t)row * D + col0 + bj * HALF) = w;
                    ss += ((v0[0] * v0[0] + v0[1] * v0[1]) + (v0[2] * v0[2] + v0[3] * v0[3])) + ((v1[0] * v1[0] + v1[1] * v1[1]) + (v1[2] * v1[2] + v1[3] * v1[3]));
                }
                ss += __shfl_xor(ss, 16); ss += __shfl_xor(ss, 32);
                if (fq == 0) atomicAdd(ssq_out + row, ssq_fix(ss));
            }
    }
};

template <class Epi, bool ALIGN_EPI, int LDA, int LDB, int KLEN, int ACOL, bool HALFU = false>
__device__ __forceinline__ void gemm_phase(LAS unsigned char* lds, const Gemm g, const Order& S, const Epi& E) {
    int tid_ = threadIdx.x; asm volatile("" : "+v"(tid_));
    const int tid = tid_, wid = __builtin_amdgcn_readfirstlane(tid >> 6), lane = tid & 63, wr = wid >> 2, wc = wid & 3, fr = lane & 15, fq = lane >> 4;
    constexpr int nt = KLEN / BK;
    unsigned voffA[2], voffB[2];
#pragma unroll
    for (int i = 0; i < 2; ++i) { int R, C; stage_rc(tid * 16 + i * 8192, R, C); const int Rb = Epi::PERM ? ((R & ~31) + perm32(R & 31)) : R;
        voffA[i] = (unsigned)(R * LDA + C) * 2u; voffB[i] = (unsigned)(Rb * LDB + C) * 2u; }
    constexpr size_t kstep = (size_t)(BK * 2);
    constexpr size_t hstepA = (size_t)HALF * LDA * 2, tstepA = 2 * hstepA, hstepB = (size_t)HALF * LDB * 2, tstepB = 2 * hstepB;
    constexpr size_t pnstepA = (size_t)ACOL * 2;
    const unsigned ldsw = (unsigned)wid * 1024u;
    const int aoff = lds_byte(wr * 64 + fr, fq * 8), boff = lds_byte(wc * 32 + fr, fq * 8);
#define PG8_SA(b, h) (((b) * 2 + (h)) * HTB)
#define PG8_SB(b, h) ((4 + (b) * 2 + (h)) * HTB)
#define PG8_STAGE(bufoff, gbase, voff) do { _Pragma("unroll") for (int _i = 0; _i < 2; ++_i) \
        __builtin_amdgcn_global_load_lds((const unsigned*)((const char*)(gbase) + (voff)[_i]), (LAS unsigned*)(lds + (bufoff) + ldsw + _i * 8192), 16, 0, 0); } while (0)
#define PG8_LDA(dst, b, h) do { _Pragma("unroll") for (int m = 0; m < 4; ++m) _Pragma("unroll") for (int k = 0; k < 2; ++k) dst[m][k] = *(const LAS bf16x8*)(lds + PG8_SA(b, h) + aoff + m * 2048 + k * 1024); } while (0)
#define PG8_LDB(dst, b, h) do { _Pragma("unroll") for (int n = 0; n < 2; ++n) _Pragma("unroll") for (int k = 0; k < 2; ++k) dst[n][k] = *(const LAS bf16x8*)(lds + PG8_SB(b, h) + boff + n * 2048 + k * 1024); } while (0)
#define PG8_MMA(ai, bj, At, Bt) do { __builtin_amdgcn_s_setprio(1); _Pragma("unroll") for (int m = 0; m < 4; ++m) _Pragma("unroll") for (int n = 0; n < 2; ++n) _Pragma("unroll") for (int k = 0; k < 2; ++k) \
        acc[ai][bj][m][n] = __builtin_amdgcn_mfma_f32_16x16x32_bf16(Bt[n][k], At[m][k], acc[ai][bj][m][n], 0, 0, 0); __builtin_amdgcn_s_setprio(0); } while (0)
#define PG8_WAIT_V(n) asm volatile("s_waitcnt vmcnt(" #n ")" ::: "memory")
#define PG8_WAIT_L(n) asm volatile("s_waitcnt lgkmcnt(" #n ")" ::: "memory")
#define PG8_BAR __builtin_amdgcn_s_barrier()
#define PG8_SCHED __builtin_amdgcn_sched_barrier(0)
    Unit cur, nxt; int ui = 0;
    if (!S.next(0, cur)) return;
    f32x4 acc[2][2][4][2];
    if constexpr (Epi::HAS_INIT) E.init(acc, cur, wr, wc, fr, fq);
    else {
#pragma unroll
    for (int a = 0; a < 2; ++a)
#pragma unroll
        for (int b = 0; b < 2; ++b)
#pragma unroll
            for (int m = 0; m < 4; ++m)
#pragma unroll
                for (int n = 0; n < 2; ++n) acc[a][b][m][n] = (f32x4){0.f, 0.f, 0.f, 0.f};
    }
    bf16x8 At[4][2], B0[2][2], B1[2][2];
    const char* cA = (const char*)g.A + (size_t)cur.pm * tstepA + (size_t)cur.pn * pnstepA + ((HALFU && cur.hm > 0) ? hstepA : 0); const char* cB = (const char*)g.Bt + (size_t)cur.pn * tstepB;
    S.a_ready(cur);
    PG8_STAGE(PG8_SB(0, 0), cB, voffB); PG8_STAGE(PG8_SB(0, 1), cB + hstepB, voffB); PG8_STAGE(PG8_SA(0, 0), cA, voffA); PG8_STAGE(PG8_SA(0, 1), cA + hstepA, voffA);
    if (wr == 1) PG8_BAR;
    PG8_WAIT_V(2); PG8_BAR;
    PG8_STAGE(PG8_SB(1, 0), cB + kstep, voffB); PG8_STAGE(PG8_SA(1, 0), cA + kstep, voffA); PG8_STAGE(PG8_SB(1, 1), cB + hstepB + kstep, voffB);
    PG8_WAIT_V(6); PG8_BAR;
    for (;;) {
        const bool has_next = S.next(ui + 1, nxt);
        const char* nA = has_next ? (const char*)g.A + (size_t)nxt.pm * tstepA + (size_t)nxt.pn * pnstepA + ((HALFU && nxt.hm > 0) ? hstepA : 0) : cA;
        const bool full = !HALFU || cur.hm < 0;
        const char* nB = has_next ? (const char*)g.Bt + (size_t)nxt.pn * tstepB : cB;
#pragma unroll 1
        for (int t = 0; t < nt; t += 2) {
            const bool last = (t == nt - 2);
            const char* a1 = cA + (size_t)(t + 1) * kstep;
            const char* a2 = last ? nA : cA + (size_t)(t + 2) * kstep; const char* b2 = last ? nB : cB + (size_t)(t + 2) * kstep;
            const char* a3 = a2 + kstep; const char* b3 = b2 + kstep;
            if (last && has_next) S.a_ready(nxt);
            PG8_LDB(B0, 0, 0); PG8_LDB(B1, 0, 1); PG8_SCHED; PG8_LDA(At, 0, 0); PG8_STAGE(PG8_SA(1, 1), a1 + hstepA, voffA);
            PG8_WAIT_V(8); PG8_WAIT_L(0); PG8_BAR; PG8_MMA(0, 0, At, B0); PG8_MMA(0, 1, At, B1); PG8_BAR; PG8_SCHED;
            PG8_LDA(At, 0, 1); PG8_STAGE(PG8_SB(0, 0), b2, voffB); PG8_STAGE(PG8_SB(0, 1), b2 + hstepB, voffB); PG8_STAGE(PG8_SA(0, 0), a2, voffA);
            PG8_WAIT_V(8); PG8_WAIT_L(0); PG8_BAR; if (full) { PG8_MMA(1, 0, At, B0); PG8_MMA(1, 1, At, B1); } PG8_BAR; PG8_SCHED;
            PG8_LDB(B0, 1, 0); PG8_LDB(B1, 1, 1); PG8_SCHED; PG8_LDA(At, 1, 0); PG8_STAGE(PG8_SA(0, 1), a2 + hstepA, voffA);
            PG8_WAIT_V(8); PG8_WAIT_L(0); PG8_BAR; PG8_MMA(0, 0, At, B0); PG8_MMA(0, 1, At, B1); PG8_BAR; PG8_SCHED;
            PG8_LDA(At, 1, 1); PG8_STAGE(PG8_SB(1, 0), b3, voffB); PG8_STAGE(PG8_SB(1, 1), b3 + hstepB, voffB); PG8_STAGE(PG8_SA(1, 0), a3, voffA);
            PG8_WAIT_V(8); PG8_WAIT_L(0); PG8_BAR; if (full) { PG8_MMA(1, 0, At, B0); PG8_MMA(1, 1, At, B1); } PG8_BAR; PG8_SCHED;
        }
        if constexpr (ALIGN_EPI) { if (wr == 0) PG8_BAR; }
        E(acc, cur, wr, wc, fr, fq);
#if defined(PROBE_EPI2)
        E(acc, cur, wr, wc, fr, fq); E(acc, cur, wr, wc, fr, fq);
#endif
        S.done(cur);
        if (!has_next) break;
        if constexpr (Epi::HAS_INIT) E.init(acc, nxt, wr, wc, fr, fq);
        else {
#pragma unroll
        for (int a = 0; a < 2; ++a)
#pragma unroll
            for (int b = 0; b < 2; ++b)
#pragma unroll
                for (int m = 0; m < 4; ++m)
#pragma unroll
                    for (int n = 0; n < 2; ++n) acc[a][b][m][n] = (f32x4){0.f, 0.f, 0.f, 0.f};
        }
        cur = nxt; cA = nA; cB = nB; ++ui;
        if constexpr (ALIGN_EPI) { if (wr == 1) PG8_BAR; }
    }
    PG8_WAIT_V(0);
    if constexpr (!ALIGN_EPI) { if (wr == 0) PG8_BAR; }
    PG8_BAR;
#undef PG8_SA
#undef PG8_SB
#undef PG8_STAGE
#undef PG8_LDA
#undef PG8_LDB
#undef PG8_MMA
#undef PG8_WAIT_V
#undef PG8_WAIT_L
#undef PG8_BAR
#undef PG8_SCHED
}
}

constexpr size_t MiB = 1u << 20;
constexpr size_t WS_CTL = 0, CTL_ZERO_BYTES = 1 * MiB;
constexpr size_t SZ_WIN = (size_t)NQKVO * D * 2, SZ_WOUT = (size_t)D * D * 2, SZ_WPOOL = (size_t)D * 256 * 2, SZ_WGU = (size_t)GU * D * 2, SZ_WDN = (size_t)D * FF * 2, SZ_WG = (size_t)16 * D * 2;
constexpr size_t WS_WIN = 1 * MiB;
constexpr size_t WS_WOUT = WS_WIN + 2 * SZ_WIN;
constexpr size_t WS_WPOOL = WS_WOUT + 2 * SZ_WOUT;
constexpr size_t WS_WGU = WS_WPOOL + 2 * SZ_WPOOL;
constexpr size_t WS_WDN = WS_WGU + 4 * SZ_WGU;
constexpr size_t WS_WG = WS_WDN + 4 * SZ_WDN;
constexpr size_t WS_SSQ = WS_WG + 2 * SZ_WG;
constexpr size_t SZ_SSQ = (size_t)M * 8;
constexpr size_t WS_GATES = WS_SSQ + 9 * SZ_SSQ;
constexpr size_t WS_DECAY = WS_GATES + (size_t)M * 16 * 4;
constexpr size_t WS_GT = WS_DECAY + 4096;
constexpr size_t WS_XB = ((WS_GT + (size_t)512 * 512 * 4 + MiB - 1) / MiB) * MiB;
constexpr size_t WS_BIG = WS_XB + (size_t)M * D * 2;
constexpr size_t WS_ST = WS_BIG + (size_t)M * NQKVO * 2;
constexpr size_t WS_END = WS_ST + (size_t)NITEM * STE * 2;
static_assert(WS_END <= 352 * MiB, "d_ws map must fit the guaranteed workspace");
static_assert((size_t)M * FF * 2 <= (size_t)M * NQKVO * 2, "H overlays q|k|v|o");

constexpr int CW_BAR = 4096;
constexpr int RING_OFF = 0, RING_BYTES = 131072;
constexpr int LDSCTL_OFF = RING_BYTES, MISC_OFF = LDSCTL_OFF + 320;
constexpr int RSTD_OFF = RING_BYTES + 1024;
constexpr int TAB_OFF = RING_BYTES + 3072;
constexpr int LDS_BYTES = 147456;
constexpr int NWAVES = 8, NT = NWAVES * 64;

#define VM_WAIT() asm volatile("s_waitcnt vmcnt(0)" ::: "memory")
#define LDS_WAIT() asm volatile("s_waitcnt lgkmcnt(0)" ::: "memory")

#define XB_TMO      128
#define XB_XCNT(j)  (256  + 64 * (j))
#define XB_XSUB(j)  (1280 + 64 * (j))
#define XB_XGEN(j)  (2304 + 64 * (j))
#define XB_TOP      3328
#define XB_TOPGEN   3392
#define XCD_BAR_WORDS 3456
#define XB_SPIN_CAP (1u << 18)
__device__ __forceinline__ unsigned xb_ld(unsigned* p)              { return __hip_atomic_load(p, __ATOMIC_RELAXED, __HIP_MEMORY_SCOPE_AGENT); }
__device__ __forceinline__ unsigned xb_add(unsigned* p, unsigned v) { return __hip_atomic_fetch_add(p, v, __ATOMIC_RELAXED, __HIP_MEMORY_SCOPE_AGENT); }
__device__ __forceinline__ unsigned xb_xcc_id() { return (unsigned)__builtin_amdgcn_s_getreg((3 << 11) | 20) & 0xFu; }
#define XB_SPIN(cond, bar) do { unsigned _sp = 0; while (cond) { __builtin_amdgcn_s_sleep(1); \
    if ((++_sp & 255u) == 0u) { if (xb_ld(&(bar)[XB_TMO])) break; if (_sp > XB_SPIN_CAP) { atomicAdd(&(bar)[XB_TMO], 1u); break; } } } } while (0)
struct XcdBarrier { unsigned* bar; unsigned x; volatile LAS unsigned* st; };
__device__ __forceinline__ XcdBarrier xcd_barrier_post(unsigned* bar, volatile LAS unsigned* st) {
    XcdBarrier b; b.bar = bar; b.x = xb_xcc_id(); b.st = st;
    if (threadIdx.x == 0) (void)xb_add(&bar[XB_XCNT(b.x)], 1u);
    return b;
}
__device__ __forceinline__ void xcd_barrier_complete(unsigned* bar, unsigned x, unsigned& nloc, unsigned& nx) {
    const unsigned G = gridDim.x * gridDim.y * gridDim.z;
    unsigned sum, cnt, mine, sp = 0u;
    for (;;) {
        sum = 0u; cnt = 0u; mine = 0u;
#pragma unroll
        for (unsigned j = 0; j < 16; ++j) { const unsigned c = xb_ld(&bar[XB_XCNT(j)]); sum += c; cnt += (c > 0u) ? 1u : 0u; mine = (j == x) ? c : mine; }
        if (sum == G) break;
        __builtin_amdgcn_s_sleep(1);
        if ((++sp & 255u) == 0u) { if (xb_ld(&bar[XB_TMO])) break; if (sp > XB_SPIN_CAP) { atomicAdd(&bar[XB_TMO], 1u); break; } }
    }
    nloc = mine > 0u ? mine : 1u; nx = cnt > 0u ? cnt : 1u;
}
__device__ __forceinline__ void xcd_barrier(const XcdBarrier& b) {
    asm volatile("s_waitcnt vmcnt(0)" ::: "memory");
    __syncthreads();
    if (threadIdx.x == 0) {
        unsigned* bar = b.bar;
        __builtin_amdgcn_s_waitcnt(0);
        unsigned nloc = b.st[0], nx = b.st[1];
        if (nloc == 0u) { xcd_barrier_complete(bar, b.x, nloc, nx); b.st[0] = nloc; b.st[1] = nx; }
        const unsigned old = xb_add(&bar[XB_XSUB(b.x)], 1u);
        const unsigned gen = old / nloc;
        if (old + 1u == (gen + 1u) * nloc) {
            __builtin_amdgcn_fence(__ATOMIC_RELEASE, "agent");
            asm volatile("s_waitcnt vmcnt(0)" ::: "memory");
            const unsigned og = xb_add(&bar[XB_TOP], 1u);
            const unsigned tg = og / nx;
            if (og + 1u == (tg + 1u) * nx) xb_add(&bar[XB_TOPGEN], 1u);
            else XB_SPIN(xb_ld(&bar[XB_TOPGEN]) == tg, bar);
            __builtin_amdgcn_fence(__ATOMIC_ACQUIRE, "agent");
            xb_add(&bar[XB_XGEN(b.x)], 1u);
            asm volatile("s_waitcnt vmcnt(0)" ::: "memory");
        } else {
            XB_SPIN(xb_ld(&bar[XB_XGEN(b.x)]) == gen, bar);
            __builtin_amdgcn_fence(__ATOMIC_ACQUIRE, "agent");
            asm volatile("s_waitcnt vmcnt(0)" ::: "memory");
        }
    }
    __syncthreads();
}

__device__ __forceinline__ float wave_sum(float v) {
#pragma unroll
    for (int o = 1; o < 64; o <<= 1) v += __shfl_xor(v, o);
    return v;
}
__device__ __forceinline__ float log_sigmoidf(float x) { return fminf(x, 0.f) - log1pf(expf(-fabsf(x))); }
__device__ __forceinline__ float rstd_of(const ssq_t* ssq_row) { return 1.0f / sqrtf(ssq_val(*ssq_row) * (1.0f / D) + EPS); }

__device__ __forceinline__ void tr_item64(const float* W, int ldW, int k0, int c0, bf16_t* WT, int ldT, int r0, const float* kg, const float* cg, float mul, LAS unsigned* scr, int lane) {
    const int n4 = lane & 15, kq = lane >> 4;
    f32x4 cm = (f32x4){mul, mul, mul, mul}; if (cg) cm = *(const f32x4*)(cg + c0 + 4 * n4) * mul;
    f32x4 va[8], vb[8];
#pragma unroll
    for (int i = 0; i < 8; ++i) { const int kp = kq + 4 * i; const float* p = W + (size_t)(k0 + 2 * kp) * ldW + c0 + 4 * n4; va[i] = *(const f32x4*)p; vb[i] = *(const f32x4*)(p + ldW); }
#pragma unroll
    for (int i = 0; i < 8; ++i) { const int kp = kq + 4 * i; const float g0 = kg ? kg[k0 + 2 * kp] : 1.0f, g1 = kg ? kg[k0 + 2 * kp + 1] : 1.0f;
#pragma unroll
        for (int e = 0; e < 4; ++e) scr[kp * 65 + 4 * n4 + e] = pack2(va[i][e] * cm[e] * g0, vb[i][e] * cm[e] * g1); }
    LDS_WAIT(); asm volatile("" ::: "memory");
    const int j = lane & 7, nl = lane >> 3;
#pragma unroll
    for (int it = 0; it < 8; ++it) { const int n = nl + 8 * it; u32x4 o; o.x = scr[(4 * j + 0) * 65 + n]; o.y = scr[(4 * j + 1) * 65 + n]; o.z = scr[(4 * j + 2) * 65 + n]; o.w = scr[(4 * j + 3) * 65 + n];
        *(u32x4*)(WT + (size_t)(r0 + n) * ldT + k0 + 8 * j) = o; }
    LDS_WAIT(); asm volatile("" ::: "memory");
}

struct Args;
constexpr int I_IN = 16 * 48, I_OUT = 16 * 16, I_POOL = 4 * 4 * 4, I_GU = 16 * 88, I_DN = 44 * 16;
constexpr int CV_P0 = I_GU + I_IN + I_OUT, CV_T0 = CV_P0 + I_DN + I_POOL + I_GU + I_OUT, CV_T1 = CV_T0 + I_DN + I_IN + I_GU, CV_T2 = CV_T1 + I_DN + I_POOL + I_GU, CV_END = CV_T2 + I_DN;
struct Args { const float* in[12]; float* out; unsigned char* ws; int ph_lo, ph_hi; };

enum { JT_GU = 0, JT_DN = 1, JT_IN = 2, JT_OUT = 3, JT_POOL = 4 };
__device__ __forceinline__ void convert_one(const Args& args, unsigned char* ws, LAS unsigned* scr, int lane, int type, int l, int r) {
    const float* const* in = args.in;
    if (type == JT_GU) { const int kb = r / 88, nb = r % 88, r0 = nb * 64, pn = r0 >> 8, j = r0 & 255; const int c0 = (j < 128) ? pn * 128 + j : FF + pn * 128 + (j - 128);
        tr_item64(in[9] + (size_t)l * D * GU, GU, kb * 64, c0, (bf16_t*)(ws + WS_WGU) + (size_t)l * GU * D, D, r0, in[2] + l * D, nullptr, 1.0f, scr, lane); }
    else if (type == JT_DN) { const int kb = r / 16, nb = r % 16;
        tr_item64(in[10] + (size_t)l * FF * D, D, kb * 64, nb * 64, (bf16_t*)(ws + WS_WDN) + (size_t)l * D * FF, FF, nb * 64, nullptr, nullptr, 1.0f, scr, lane); }
    else if (type == JT_IN) { const int kb = r / 48, nb = r % 48, r0 = nb * 64;
        tr_item64(in[3] + (size_t)l * D * NIN, NIN, kb * 64, r0, (bf16_t*)(ws + WS_WIN) + (size_t)l * NQKVO * D, D, r0, in[1] + (2 * l) * D, nullptr, (r0 >= 512 && r0 < 1024) ? 0.125f : 1.0f, scr, lane); }
    else if (type == JT_OUT) { const int kb = r / 16, nb = r % 16;
        tr_item64(in[6] + (size_t)l * D * D, D, kb * 64, nb * 64, (bf16_t*)(ws + WS_WOUT) + (size_t)l * D * D, D, nb * 64, in[5] + l * D, nullptr, 1.0f, scr, lane); }
    else { const int gi = r / 16, r2 = r % 16, kb = r2 / 4, nb = r2 % 4;
        tr_item64(in[7] + (size_t)(l * 4 + gi) * 256 * 256, 256, kb * 64, nb * 64, (bf16_t*)(ws + WS_WPOOL) + (size_t)l * D * 256 + (size_t)gi * 256 * 256, 256, nb * 64,
                  in[1] + (2 * l + 1) * D + gi * 256, in[8] + l * D + gi * 256, 1.0f, scr, lane); }
}
__device__ __forceinline__ void convert_items(const Args& args, unsigned char* ws, LAS unsigned* scr, int lane, int lo, int hi, int w, int nw) {
    for (int it = lo + w; it < hi; it += nw) {
        int r = it;
#define CV_JOB(T, L, N) if (r < (N)) { convert_one(args, ws, scr, lane, T, L, r); continue; } r -= (N);
        CV_JOB(JT_GU, 0, I_GU) CV_JOB(JT_IN, 0, I_IN) CV_JOB(JT_OUT, 0, I_OUT)
        CV_JOB(JT_DN, 0, I_DN) CV_JOB(JT_POOL, 0, I_POOL) CV_JOB(JT_GU, 1, I_GU) CV_JOB(JT_OUT, 1, I_OUT)
        CV_JOB(JT_DN, 1, I_DN) CV_JOB(JT_IN, 1, I_IN) CV_JOB(JT_GU, 2, I_GU)
        CV_JOB(JT_DN, 2, I_DN) CV_JOB(JT_POOL, 1, I_POOL) CV_JOB(JT_GU, 3, I_GU)
        CV_JOB(JT_DN, 3, I_DN)
#undef CV_JOB
    }
}
constexpr int N_PHASES = 20;

__global__ void __launch_bounds__(NT, 2) fwd_kernel(Args args) {
    extern __shared__ __attribute__((aligned(16))) unsigned char lds_raw[];
    LAS unsigned char* lds = (LAS unsigned char*)lds_raw;
    volatile LAS unsigned* MISC = (volatile LAS unsigned*)(lds + MISC_OFF);
    LAS float* rtab = (LAS float*)(lds + RSTD_OFF);
    int tid = threadIdx.x, lane = tid & 63, wave = __builtin_amdgcn_readfirstlane(tid >> 6);
#define FRESH_TID() do { tid = threadIdx.x; asm volatile("" : "+v"(tid)); lane = tid & 63; wave = __builtin_amdgcn_readfirstlane(tid >> 6); } while (0)
    const int G = gridDim.x, bid = blockIdx.x;
    unsigned char* const ws = args.ws;
#define x_in       (args.in[0])
#define norm_mix   (args.in[1])
#define norm_ffn   (args.in[2])
#define w_in       (args.in[3])
#define gate_bias  (args.in[4])
#define head_gain  (args.in[5])
#define w_out      (args.in[6])
#define pool_w     (args.in[7])
#define pool_scale (args.in[8])
#define w_gu       (args.in[9])
#define w_dn       (args.in[10])
#define final_norm (args.in[11])
#define Win_t   ((bf16_t*)(ws + WS_WIN))
#define Wout_t  ((bf16_t*)(ws + WS_WOUT))
#define Wpool_t ((bf16_t*)(ws + WS_WPOOL))
#define Wgu_t   ((bf16_t*)(ws + WS_WGU))
#define Wdn_t   ((bf16_t*)(ws + WS_WDN))
#define Wg      ((bf16_t*)(ws + WS_WG))
#define ssq     ((ssq_t*)(ws + WS_SSQ))
#define gates   ((float*)(ws + WS_GATES))
#define decay   ((float*)(ws + WS_DECAY))
#define GT      ((float*)(ws + WS_GT))
#define xb      ((bf16_t*)(ws + WS_XB))
#define BIG     ((bf16_t*)(ws + WS_BIG))
#define ST      ((bf16_t*)(ws + WS_ST))

    for (int u = tid; u < (LDS_BYTES - LDSCTL_OFF) / 4; u += NT) ((LAS unsigned*)(lds + LDSCTL_OFF))[u] = 0u;
    __syncthreads();
    XcdBarrier bar; bar.bar = (unsigned*)(ws + WS_CTL) + CW_BAR; bar.x = 0; bar.st = nullptr;
    if (MK_N_LAUNCHES == 1) bar = xcd_barrier_post((unsigned*)(ws + WS_CTL) + CW_BAR, MISC + 8);

    const int lo = args.ph_lo, hi = args.ph_hi;
    int ph = 0;
#define IN_PH() (lo <= ph && ph < hi)
#define BEGIN_PH() FRESH_TID()
#if PROBE_PH >= 0
#define LAS_REP_PTR(op, row, h, ch) (LAST_REP() ? (op) : (u32x4*)args.out + ((size_t)(row) * 128 + (h) * 16 + (ch)))
#define REPS() ((ph == PROBE_PH) ? PROBE_REP : 1)
#define LAST_REP() (rep_ + 1 == REPS())
#else
#define LAS_REP_PTR(op, row, h, ch) (op)
#define REPS() 1
#define LAST_REP() true
#endif
#define END_PH() do { if (lo <= ph && ph + 1 < hi) xcd_barrier(bar); ++ph; } while (0)

    if (IN_PH()) for (int rep_ = 0; rep_ < REPS(); ++rep_) { BEGIN_PH();
        LAS unsigned* scr = (LAS unsigned*)(lds + RING_OFF + wave * 8448);
        const int gw = bid * NWAVES + wave, NGW = G * NWAVES;
        convert_items(args, ws, scr, lane, 0, (G == 256) ? CV_P0 : CV_END, gw, NGW);
        for (int e = bid * NT + tid; e < 2 * 16 * D; e += G * NT) { const int l = e / (16 * D), rem = e % (16 * D), k = rem >> 4, j = rem & 15;
            Wg[(size_t)l * 16 * D + j * D + k] = f2bf(w_in[(size_t)l * D * NIN + (size_t)k * NIN + NQKVO + j] * norm_mix[(2 * l) * D + k]); }
        for (int e = bid * NT + tid; e < 8 * M; e += G * NT) ssq[M + e] = 0ull;
        for (int m = 2 * gw; m < M; m += 2 * NGW) {
            const f32x4* xr = (const f32x4*)(x_in + (size_t)m * D) + lane; f32x4 v[8]; float s0 = 0.f, s1 = 0.f;
#pragma unroll
            for (int j = 0; j < 8; ++j) v[j] = xr[64 * j];
#pragma unroll
            for (int j = 0; j < 4; ++j) { s0 += (v[j][0] * v[j][0] + v[j][1] * v[j][1]) + (v[j][2] * v[j][2] + v[j][3] * v[j][3]);
                                          s1 += (v[j + 4][0] * v[j + 4][0] + v[j + 4][1] * v[j + 4][1]) + (v[j + 4][2] * v[j + 4][2] + v[j + 4][3] * v[j + 4][3]); }
            s0 = wave_sum(s0); s1 = wave_sum(s1);
#pragma unroll
            for (int j = 0; j < 8; ++j) { u32x2 w; w.x = cvt_pk_bf16(v[j][0], v[j][1]); w.y = cvt_pk_bf16(v[j][2], v[j][3]); ((u32x2*)(xb + (size_t)m * D))[64 * j + lane] = w; }
            if (lane < 2) ssq[m + lane] = ssq_fix((lane == 0) ? s0 : s1);
        }
    }
    END_PH();
#if PROBE_BARS > 0
    if (MK_N_LAUNCHES == 1) for (int i_ = 0; i_ < PROBE_BARS; ++i_) xcd_barrier(bar);
#endif

    for (int layer = 0; layer < DEPTH; ++layer) {
        const int slot = layer >> 1;
        ssq_t* ssq_a = ssq + (size_t)(2 * layer) * M;
        ssq_t* ssq_b = ssq_a + M;
        ssq_t* ssq_c = ssq_b + M;
        if ((layer & 1) == 0) {
            if (IN_PH()) for (int rep_ = 0; rep_ < REPS(); ++rep_) { BEGIN_PH();
                {
                    const bf16_t* wgb = Wg + (size_t)slot * 16 * D;
                    LAS float* red = (LAS float*)lds;
                    const int rbk = wave & 3, kh = wave >> 2, fr = lane & 15, fq = lane >> 4;
#if defined(PROBE_GATES)
                    for (int grep_ = 0; grep_ < 3; ++grep_)
#endif
                    for (int rb = bid; rb < M / 64; rb += G) {
                        const bf16_t* ap = xb + (size_t)(rb * 64 + rbk * 16 + fr) * D + kh * 512 + 8 * fq;
                        const bf16_t* bp = wgb + (size_t)fr * D + kh * 512 + 8 * fq;
                        f32x4 ga = (f32x4){0.f, 0.f, 0.f, 0.f};
#pragma unroll
                        for (int ks = 0; ks < 16; ++ks) ga = __builtin_amdgcn_mfma_f32_16x16x32_bf16(*(const bf16x8*)(ap + 32 * ks), *(const bf16x8*)(bp + 32 * ks), ga, 0, 0, 0);
                        if (kh == 1) *(LAS f32x4*)(red + (rbk * 64 + lane) * 4) = ga;
                        __syncthreads();
                        if (kh == 0) {
                            ga += *(const LAS f32x4*)(red + (rbk * 64 + lane) * 4);
                            const float gb = gate_bias[slot * 16 + fr];
#pragma unroll
                            for (int r = 0; r < 4; ++r) { const int row = rb * 64 + rbk * 16 + 4 * fq + r; const float gv = ga[r] * rstd_of(ssq_a + row) + gb;
                                gates[(size_t)row * 16 + fr] = SOFTCAP * tanhf(gv * (1.0f / SOFTCAP)); }
                        }
                        __syncthreads();
                    }
                }
                pg8::Gemm g{xb, Win_t + (size_t)slot * NQKVO * D}; pg8::Order S; S.init(M, NQKVO, G, bid, ssq_a, rtab);
                pg8::EpiProj E{BIG, rtab};
                pg8::gemm_phase<pg8::EpiProj, true, D, D, D, 0>(lds + RING_OFF, g, S, E);
            }
            END_PH();
            if (IN_PH()) for (int rep_ = 0; rep_ < REPS(); ++rep_) { BEGIN_PH();
                LAS unsigned char* kimg = lds;
                LAS unsigned char* vimg = lds + 49152;
                LAS float* wtab = (LAS float*)(lds + TAB_OFF);
                const int hh = lane >> 5, l31 = lane & 31, g16 = (lane >> 4) & 1, q4 = (lane & 15) >> 2, p4 = lane & 3;
                const int troffK = (8 * hh + q4) * 192 + (16 * g16 + 4 * p4) * 2, troffV = (8 * hh + q4) * 320 + (16 * g16 + 4 * p4) * 2;
                bf16x8 a_one; { const short o = (l31 == 0) ? (short)0x3F80 : (short)0; for (int j = 0; j < 8; ++j) a_one[j] = o; }
                const int vt = wave >> 1, dt = wave & 1;
                for (int item = bid; item < NBLK; item += G) {
                    const int b = item >> 6, h = (item >> 3) & 7, blk = item & 7, row0 = b * SEQ + blk * BLK;
                    __syncthreads();
                    { float lf[4], ig[4];
#pragma unroll
                      for (int e = 0; e < 4; ++e) { const float* gp = gates + (size_t)(row0 + 4 * lane + e) * 16; lf[e] = log_sigmoidf(gp[8 + h]); ig[e] = gp[h]; }
                      const float p0 = lf[0], p1 = p0 + lf[1], p2 = p1 + lf[2], p3 = p2 + lf[3];
                      float sc = p3;
#pragma unroll
                      for (int o = 1; o < 64; o <<= 1) { const float t = __shfl_up(sc, o); if (lane >= o) sc += t; }
                      const float ex = sc - p3, bl = __shfl(sc, 63);
                      if (wave == 0) { *(LAS f32x4*)(wtab + 4 * lane) = (f32x4){__expf(bl - (ex + p0) + ig[0]), __expf(bl - (ex + p1) + ig[1]), __expf(bl - (ex + p2) + ig[2]), __expf(bl - (ex + p3) + ig[3])};
                                       *(f32x4*)(GT + (size_t)item * 512 + 4 * lane) = (f32x4){ex + p0, ex + p1, ex + p2, ex + p3};
                                       *(f32x4*)(GT + (size_t)item * 512 + 256 + 4 * lane) = (f32x4){ig[0] - (ex + p0), ig[1] - (ex + p1), ig[2] - (ex + p2), ig[3] - (ex + p3)};
                                       if (lane == 0) decay[item] = __expf(bl); } }
#pragma unroll
                    for (int i = 0; i < 4; ++i) { const int id = i * NT + tid, r = id >> 3, ch = id & 7; *(LAS u32x4*)(kimg + r * 192 + ch * 16) = *(const u32x4*)(BIG + (size_t)(row0 + r) * NQKVO + 512 + h * DK + ch * 8); }
#pragma unroll
                    for (int i = 0; i < 8; ++i) { const int id = i * NT + tid, r = id >> 4, ch = id & 15; *(LAS u32x4*)(vimg + r * 320 + ch * 16) = *(const u32x4*)(BIG + (size_t)(row0 + r) * NQKVO + 1024 + h * DV + ch * 8); }
                    __syncthreads();
                    f32x16 acc = zero16(), accn = zero16();
#pragma unroll 4
                    for (int ks = 0; ks < 16; ++ks) {
                        const bf16x8 kf = tr_pair(kimg + troffK + ks * 16 * 192 + dt * 64, 4 * 192);
                        const f32x4 w0 = *(const LAS f32x4*)(wtab + 16 * ks + 8 * hh), w1 = *(const LAS f32x4*)(wtab + 16 * ks + 8 * hh + 4);
                        const u32x4 kb = __builtin_bit_cast(u32x4, kf);
                        u32x4 ksc; ksc.x = pack2(bflo(kb.x) * w0[0], bfhi(kb.x) * w0[1]); ksc.y = pack2(bflo(kb.y) * w0[2], bfhi(kb.y) * w0[3]);
                        ksc.z = pack2(bflo(kb.z) * w1[0], bfhi(kb.z) * w1[1]); ksc.w = pack2(bflo(kb.w) * w1[2], bfhi(kb.w) * w1[3]);
                        const bf16x8 kfs = __builtin_bit_cast(bf16x8, ksc);
                        const bf16x8 vf = tr_pair(vimg + troffV + ks * 16 * 320 + vt * 64, 4 * 320);
                        acc = MFMA32(kfs, vf, acc);
                        if (vt == 0) accn = MFMA32(kfs, a_one, accn);
                    }
                    bf16_t* st = ST + (size_t)item * STE;
#pragma unroll
                    for (int g4 = 0; g4 < 4; ++g4) { u32x2 pk; pk.x = pack2(acc[4 * g4], acc[4 * g4 + 1]); pk.y = pack2(acc[4 * g4 + 2], acc[4 * g4 + 3]);
                        *(u32x2*)(st + (size_t)(32 * vt + l31) * 64 + 32 * dt + 8 * g4 + 4 * hh) = pk; }
                    if (vt == 0 && l31 == 0) {
#pragma unroll
                        for (int g4 = 0; g4 < 4; ++g4) { u32x2 pk; pk.x = pack2(accn[4 * g4], accn[4 * g4 + 1]); pk.y = pack2(accn[4 * g4 + 2], accn[4 * g4 + 3]);
                            *(u32x2*)(st + 128 * 64 + 32 * dt + 8 * g4 + 4 * hh) = pk; }
                    }
                }
            }
            END_PH();
            if (IN_PH()) for (int rep_ = 0; rep_ < REPS(); ++rep_) { BEGIN_PH();
                LAS unsigned char* vimg = lds;
                LAS unsigned char* cimg = lds + 81920;
                LAS float* btab = (LAS float*)(lds + 100608);
                LAS float* ctab = btab + 256;
                const int st = (wave < 4) ? 7 - wave : wave - 4;
                for (int item = bid; item < NBLK; item += G) {
                    FRESH_TID();
                    const int hh = lane >> 5, l31 = lane & 31, g16 = (lane >> 4) & 1, q4 = (lane & 15) >> 2, p4 = lane & 3;
                    const int troff = (4 * hh + q4) * 320 + (16 * g16 + 4 * p4) * 2;
                    bf16x8 a_one; { const short o = (l31 == 0) ? (short)0x3F80 : (short)0; for (int j = 0; j < 8; ++j) a_one[j] = o; }
                    const int b = item >> 6, h = (item >> 3) & 7, blk = item & 7, row0 = b * SEQ + blk * BLK;
                    u32x4 vv[8];
#pragma unroll
                    for (int i = 0; i < 8; ++i) { const int id = i * NT + tid, r = id >> 4, ch = id & 15; vv[i] = *(const u32x4*)(BIG + (size_t)(row0 + r) * NQKVO + 1024 + h * DV + ch * 8); }
                    f32x4 tb = (f32x4){0.f, 0.f, 0.f, 0.f};
                    if (tid < 128) tb = *(const f32x4*)(GT + (size_t)item * 512 + 4 * tid);
                    u32x4 uu[2][7]; float dj[7];
#pragma unroll
                    for (int j = 0; j < 7; ++j) { dj[j] = 0.f; uu[0][j] = (u32x4){0u, 0u, 0u, 0u}; uu[1][j] = (u32x4){0u, 0u, 0u, 0u};
                        if (j < blk) { dj[j] = decay[item - blk + j]; const bf16_t* up = ST + (size_t)(item - blk + j) * STE + tid * 8; uu[0][j] = *(const u32x4*)up; uu[1][j] = *(const u32x4*)(up + NT * 8); } }
                    unsigned un[7];
#pragma unroll
                    for (int j = 0; j < 7; ++j) { un[j] = 0u; if (j < blk && tid < 32) un[j] = ((const unsigned*)(ST + (size_t)(item - blk + j) * STE + 8192))[tid]; }
                    __syncthreads();
#pragma unroll
                    for (int i = 0; i < 8; ++i) { const int id = i * NT + tid, r = id >> 4, ch = id & 15; *(LAS u32x4*)(vimg + r * 320 + ch * 16) = vv[i]; }
                    if (tid < 128) *(LAS f32x4*)(btab + 4 * tid) = tb;
#pragma unroll
                    for (int cc = 0; cc < 2; ++cc) { const int chunk = cc * NT + tid; float a8[8];
#pragma unroll
                        for (int e = 0; e < 8; ++e) a8[e] = 0.f;
#pragma unroll
                        for (int j = 0; j < 7; ++j) { const u32x4 u = uu[cc][j]; const float d = dj[j];
                            if (j < blk) {
                            a8[0] = d * a8[0] + bflo(u.x); a8[1] = d * a8[1] + bfhi(u.x); a8[2] = d * a8[2] + bflo(u.y); a8[3] = d * a8[3] + bfhi(u.y);
                            a8[4] = d * a8[4] + bflo(u.z); a8[5] = d * a8[5] + bfhi(u.z); a8[6] = d * a8[6] + bflo(u.w); a8[7] = d * a8[7] + bfhi(u.w); } }
                        u32x4 o; o.x = pack2(a8[0], a8[1]); o.y = pack2(a8[2], a8[3]); o.z = pack2(a8[4], a8[5]); o.w = pack2(a8[6], a8[7]);
                        *(LAS u32x4*)(cimg + (chunk >> 3) * 144 + (chunk & 7) * 16) = o; }
                    if (tid < 32) { float n0 = 0.f, n1 = 0.f;
#pragma unroll
                        for (int j = 0; j < 7; ++j) if (j < blk) { n0 = dj[j] * n0 + bflo(un[j]); n1 = dj[j] * n1 + bfhi(un[j]); }
                        *(LAS unsigned*)(cimg + 128 * 144 + tid * 4) = pack2(n0, n1); }
                    __syncthreads();
                    const float bs = btab[32 * st + l31], eb = __expf(bs);
                    bf16x8 qf[4];
                    { const bf16_t* qp = BIG + (size_t)(row0 + 32 * st + l31) * NQKVO + h * DK + 8 * hh;
#pragma unroll
                      for (int ks = 0; ks < 4; ++ks) qf[ks] = *(const bf16x8*)(qp + 16 * ks); }
                    u32x4 ov[8];
#pragma unroll
                    for (int i = 0; i < 8; ++i) { const int id = i * 64 + lane, rho = id >> 4, ch = id & 15; ov[i] = *(const u32x4*)(BIG + (size_t)(row0 + 32 * st + rho) * NQKVO + 2048 + h * DV + ch * 8); }
                    f32x16 acc[5];
#pragma unroll
                    for (int v5 = 0; v5 < 5; ++v5) acc[v5] = zero16();
                    bf16x8 kn[4];
                    { const bf16_t* kp = BIG + (size_t)(row0 + l31) * NQKVO + 512 + h * DK + 8 * hh;
#pragma unroll
                      for (int ks = 0; ks < 4; ++ks) kn[ks] = *(const bf16x8*)(kp + 16 * ks); }
                    for (int rt = 0; rt <= st; ++rt) {
                        f32x16 X = zero16();
#pragma unroll
                        for (int ks = 0; ks < 4; ++ks) X = MFMA32(kn[ks], qf[ks], X);
                        if (rt < st) { const bf16_t* kp = BIG + (size_t)(row0 + 32 * (rt + 1) + l31) * NQKVO + 512 + h * DK + 8 * hh;
#pragma unroll
                            for (int ks = 0; ks < 4; ++ks) kn[ks] = *(const bf16x8*)(kp + 16 * ks); }
#pragma unroll
                        for (int g4 = 0; g4 < 4; ++g4) {
                            const f32x4 cr = *(const LAS f32x4*)(ctab + 32 * rt + 8 * g4 + 4 * hh);
#pragma unroll
                            for (int e = 0; e < 4; ++e) { float pv = X[4 * g4 + e] * __expf(bs + cr[e]); if (rt == st && (8 * g4 + 4 * hh + e) > l31) pv = 0.f; X[4 * g4 + e] = pv; }
                        }
#pragma unroll
                        for (int sp = 0; sp < 2; ++sp) {
                            u32x4 pk; pk.x = pack2(X[8 * sp + 0], X[8 * sp + 1]); pk.y = pack2(X[8 * sp + 2], X[8 * sp + 3]); pk.z = pack2(X[8 * sp + 4], X[8 * sp + 5]); pk.w = pack2(X[8 * sp + 6], X[8 * sp + 7]);
                            const bf16x8 pf = __builtin_bit_cast(bf16x8, pk);
#pragma unroll
                            for (int v4 = 0; v4 < 4; ++v4) acc[v4] = MFMA32(tr_pair(vimg + troff + (32 * rt + 16 * sp) * 320 + v4 * 64, 8 * 320), pf, acc[v4]);
                            acc[4] = MFMA32(a_one, pf, acc[4]);
                        }
                    }
                    {   bf16x8 qs[4];
#pragma unroll
                        for (int ks = 0; ks < 4; ++ks) { const u32x4 qb = __builtin_bit_cast(u32x4, qf[ks]); u32x4 o; o.x = pack2(bflo(qb.x) * eb, bfhi(qb.x) * eb); o.y = pack2(bflo(qb.y) * eb, bfhi(qb.y) * eb);
                            o.z = pack2(bflo(qb.z) * eb, bfhi(qb.z) * eb); o.w = pack2(bflo(qb.w) * eb, bfhi(qb.w) * eb); qs[ks] = __builtin_bit_cast(bf16x8, o); }
#pragma unroll
                        for (int v5 = 0; v5 < 5; ++v5) {
                            const int vrow = (v5 < 4) ? 32 * v5 + l31 : 128;
#pragma unroll
                            for (int ks = 0; ks < 4; ++ks) {
                                u32x4 cf = *(const LAS u32x4*)(cimg + vrow * 144 + (16 * ks + 8 * hh) * 2);
                                if (v5 == 4 && l31 != 0) cf = (u32x4){0u, 0u, 0u, 0u};
                                acc[v5] = MFMA32(__builtin_bit_cast(bf16x8, cf), qs[ks], acc[v5]);
                            }
                        }
                    }
                    const float den = __shfl(acc[4][0], l31), dd = fmaxf(fabsf(den), 1.0f);
                    float ss = 0.f;
#pragma unroll
                    for (int v4 = 0; v4 < 4; ++v4)
#pragma unroll
                        for (int r = 0; r < 16; ++r) ss += acc[v4][r] * acc[v4][r];
                    ss += __shfl_xor(ss, 32);
                    const float idd = 1.0f / dd; const float scale = idd / sqrtf(ss * idd * idd * (1.0f / DV) + EPS);
                    __syncthreads();
                    LAS unsigned char* wl = vimg + wave * 8704;
#pragma unroll
                    for (int v4 = 0; v4 < 4; ++v4)
#pragma unroll
                        for (int g4 = 0; g4 < 4; ++g4) { u32x2 pk; pk.x = pack2(acc[v4][4 * g4] * scale, acc[v4][4 * g4 + 1] * scale); pk.y = pack2(acc[v4][4 * g4 + 2] * scale, acc[v4][4 * g4 + 3] * scale);
                            *(LAS u32x2*)(wl + l31 * 272 + (32 * v4 + 8 * g4 + 4 * hh) * 2) = pk; }
#pragma unroll
                    for (int i = 0; i < 8; ++i) { const int id = i * 64 + lane, rho = id >> 4, ch = id & 15;
                        const u32x4 hv = *(const LAS u32x4*)(wl + rho * 272 + ch * 16);
                        u32x4* op = (u32x4*)(BIG + (size_t)(row0 + 32 * st + rho) * NQKVO + 2048 + h * DV + ch * 8); const u32x4 o4 = ov[i];
                        u32x4 w4; w4.x = pack2(bflo(hv.x) * bflo(o4.x), bfhi(hv.x) * bfhi(o4.x)); w4.y = pack2(bflo(hv.y) * bflo(o4.y), bfhi(hv.y) * bfhi(o4.y));
                        w4.z = pack2(bflo(hv.z) * bflo(o4.z), bfhi(hv.z) * bfhi(o4.z)); w4.w = pack2(bflo(hv.w) * bflo(o4.w), bfhi(hv.w) * bfhi(o4.w));
                        *(LAS_REP_PTR(op, row0 + 32 * st + rho, h, ch)) = w4; }
                }
            }
            END_PH();
        }
        if (IN_PH()) for (int rep_ = 0; rep_ < REPS(); ++rep_) { BEGIN_PH();
            pg8::Order S; S.init(M, D, G, bid, nullptr, rtab);
            pg8::EpiRes E{xb, LAST_REP() ? xb : (bf16_t*)args.out, LAST_REP() ? ssq_b : (ssq_t*)(args.out + 8 * 1024 * 1024) + rep_ * M};
            if ((layer & 1) == 0) { pg8::Gemm g{BIG + 2048, Wout_t + (size_t)slot * D * D}; pg8::gemm_phase<pg8::EpiRes, false, NQKVO, D, D, 0>(lds + RING_OFF, g, S, E); }
            else {
                pg8::Unit u;
                for (int ui = 0; S.next(ui, u); ++ui) {
                    LAS float* hn = (LAS float*)lds;
                    LAS float* rsv = hn + 79 * 256;
                    const int gi = u.pn, w = 2 << gi, R0 = u.pm * 256, bb = R0 / SEQ, t0 = R0 % SEQ;
                    const int c16 = tid & 31, rp = tid >> 5;
                    const int c4 = tid & 63, tg = tid >> 6;
                    for (int tb = 0; tb < 4; ++tb) {
                        const int ts = t0 + 64 * tb;
                        __syncthreads();
                        if (tid < 79) { const int t = ts - 15 + tid; rsv[tid] = (t >= 0) ? rstd_of(ssq_a + (bb * SEQ + t)) : 0.f; }
                        u32x4 xv[5];
#pragma unroll
                        for (int ps = 0; ps < 5; ++ps) { const int rho = rp + 16 * ps, t = ts - 15 + rho; xv[ps] = (u32x4){0u, 0u, 0u, 0u};
                            if (rho < 79 && t >= 0) xv[ps] = *(const u32x4*)(xb + (size_t)(bb * SEQ + t) * D + 256 * gi + 8 * c16); }
                        __syncthreads();
#pragma unroll
                        for (int ps = 0; ps < 5; ++ps) { const int rho = rp + 16 * ps;
                            if (rho < 79) { const float r = rsv[rho]; LAS f32x4* dst = (LAS f32x4*)(hn + rho * 256 + 8 * c16);
                                dst[0] = (f32x4){bflo(xv[ps].x) * r, bfhi(xv[ps].x) * r, bflo(xv[ps].y) * r, bfhi(xv[ps].y) * r};
                                dst[1] = (f32x4){bflo(xv[ps].z) * r, bfhi(xv[ps].z) * r, bflo(xv[ps].w) * r, bfhi(xv[ps].w) * r}; } }
                        __syncthreads();
                        { const int tt0 = 8 * tg; f32x4 sw = (f32x4){0.f, 0.f, 0.f, 0.f};
                          for (int j = 1; j < w; ++j) sw += *(const LAS f32x4*)(hn + (15 + tt0 - j) * 256 + 4 * c4);
#pragma unroll
                          for (int tt = tt0; tt < tt0 + 8; ++tt) {
                              const f32x4 v = *(const LAS f32x4*)(hn + (15 + tt) * 256 + 4 * c4); sw += v;
                              const int tpos = ts + tt; const float inv = 1.0f / (float)((tpos + 1 < w) ? tpos + 1 : w);
                              u32x2 o; o.x = pack2(sw[0] * inv - v[0], sw[1] * inv - v[1]); o.y = pack2(sw[2] * inv - v[2], sw[3] * inv - v[3]);
                              *(u32x2*)(BIG + (size_t)(R0 + 64 * tb + tt) * D + 256 * gi + 4 * c4) = o;
                              sw -= *(const LAS f32x4*)(hn + (15 + tt - w + 1) * 256 + 4 * c4);
                          } }
                    }
                }
                VM_WAIT(); __syncthreads();
                pg8::Gemm g{BIG, Wpool_t + (size_t)slot * D * 256}; pg8::gemm_phase<pg8::EpiRes, false, D, 256, 256, 256>(lds + RING_OFF, g, S, E);
            }
        }
        END_PH();
        if (IN_PH()) for (int rep_ = 0; rep_ < REPS(); ++rep_) { BEGIN_PH();
            if (G == 256 && bid >= 128 && LAST_REP()) {
                const int lo_ = (layer == 0) ? CV_P0 : (layer == 1) ? CV_T0 : (layer == 2) ? CV_T1 : CV_T2, hi_ = (layer == 0) ? CV_T0 : (layer == 1) ? CV_T1 : (layer == 2) ? CV_T2 : CV_END;
                convert_items(args, ws, (LAS unsigned*)(lds + RING_OFF + wave * 8448), lane, lo_, hi_, (bid - 128) * NWAVES + wave, 128 * NWAVES);
                __syncthreads();
            }
            pg8::Gemm g{xb, Wgu_t + (size_t)layer * GU * D}; pg8::Order S; S.init(M, GU, G, bid, ssq_b, rtab);
            pg8::EpiGU E{BIG, rtab};
            pg8::gemm_phase<pg8::EpiGU, true, D, D, D, 0>(lds + RING_OFF, g, S, E);
        }
        END_PH();
        if (IN_PH()) for (int rep_ = 0; rep_ < REPS(); ++rep_) { BEGIN_PH();
            pg8::Gemm g{BIG, Wdn_t + (size_t)layer * D * FF}; pg8::Order S; S.init(M, D, G, bid, nullptr, rtab);
            pg8::EpiRes E{xb, LAST_REP() ? xb : (bf16_t*)args.out, LAST_REP() ? ssq_c : (ssq_t*)(args.out + 8 * 1024 * 1024) + rep_ * M};
            pg8::gemm_phase<pg8::EpiRes, false, FF, FF, FF, 0>(lds + RING_OFF, g, S, E);
        }
        END_PH();
    }
    if (IN_PH()) for (int rep_ = 0; rep_ < REPS(); ++rep_) { BEGIN_PH();
        const int gw = bid * NWAVES + wave, NGW = G * NWAVES;
        for (int m = gw; m < M; m += NGW) {
            const u32x4 a = ((const u32x4*)(xb + (size_t)m * D))[lane], b2 = ((const u32x4*)(xb + (size_t)m * D))[64 + lane];
            float v[16] = {bflo(a.x), bfhi(a.x), bflo(a.y), bfhi(a.y), bflo(a.z), bfhi(a.z), bflo(a.w), bfhi(a.w), bflo(b2.x), bfhi(b2.x), bflo(b2.y), bfhi(b2.y), bflo(b2.z), bfhi(b2.z), bflo(b2.w), bfhi(b2.w)};
            float sq = 0.f;
#pragma unroll
            for (int j = 0; j < 16; ++j) sq += v[j] * v[j];
            const float rs = 1.0f / sqrtf(wave_sum(sq) * (1.0f / D) + EPS);
#pragma unroll
            for (int hpart = 0; hpart < 2; ++hpart)
#pragma unroll
                for (int q = 0; q < 2; ++q) { const int col = hpart * 512 + lane * 8 + q * 4; const f32x4 gn = *(const f32x4*)(final_norm + col);
                    f32x4 o; o[0] = v[hpart * 8 + q * 4 + 0] * rs * gn[0]; o[1] = v[hpart * 8 + q * 4 + 1] * rs * gn[1]; o[2] = v[hpart * 8 + q * 4 + 2] * rs * gn[2]; o[3] = v[hpart * 8 + q * 4 + 3] * rs * gn[3];
                    *(f32x4*)(args.out + (size_t)m * D + col) = o; }
        }
    }
#undef IN_PH
#undef END_PH
}

extern "C" void kernel_launch(void* const* d_in, const int* in_sizes, int n_in, void* d_out, int out_size, void* d_ws, size_t ws_size, hipStream_t stream) {
    static int grid = 0;
    if (grid == 0) {
        if (n_in != 12 || in_sizes[0] != M * D || out_size != M * D || ws_size < WS_END) { fprintf(stderr, "kernel_launch: unexpected shapes / workspace (n_in %d, ws %zu, need %zu)\n", n_in, ws_size, (size_t)WS_END); grid = -1; return; }
        int dev = 0, cus = 0, per_cu = 0;
        if (hipGetDevice(&dev) != hipSuccess || hipDeviceGetAttribute(&cus, hipDeviceAttributeMultiprocessorCount, dev) != hipSuccess) { grid = -1; return; }
        if (hipFuncSetAttribute((const void*)fwd_kernel, hipFuncAttributeMaxDynamicSharedMemorySize, LDS_BYTES) != hipSuccess) { fprintf(stderr, "kernel_launch: hipFuncSetAttribute failed\n"); grid = -1; return; }
        if (hipOccupancyMaxActiveBlocksPerMultiprocessor(&per_cu, (const void*)fwd_kernel, NT, LDS_BYTES) != hipSuccess || per_cu < 1) { fprintf(stderr, "kernel_launch: occupancy query says %d blocks per CU\n", per_cu); grid = -1; (void)hipGetLastError(); return; }
        grid = cus;
    }
    if (grid < 0) return;
    Args a{};
    for (int i = 0; i < 12; ++i) a.in[i] = (const float*)d_in[i];
    a.out = (float*)d_out; a.ws = (unsigned char*)d_ws;
#if MK_N_LAUNCHES == 1
    (void)hipMemsetAsync((char*)d_ws + WS_CTL, 0, CTL_ZERO_BYTES, stream);
    a.ph_lo = 0; a.ph_hi = N_PHASES;
    void* kargs[] = {&a};
    hipError_t e = hipLaunchCooperativeKernel((const void*)fwd_kernel, dim3(grid), dim3(NT), kargs, LDS_BYTES, stream);
    if (e != hipSuccess) fprintf(stderr, "cooperative launch failed: %s (grid %d)\n", hipGetErrorString(e), grid);
#else
    for (int p = 0; p < N_PHASES; ++p) {
        a.ph_lo = p; a.ph_hi = p + 1;
        hipLaunchKernelGGL(fwd_kernel, dim3(grid), dim3(NT), LDS_BYTES, stream, a);
    }
#endif
}
```

```cpp
#include <hip/hip_runtime.h>
#include <cstdio>
#include <cstdint>

#ifndef MK_N_LAUNCHES
#define MK_N_LAUNCHES 1
#endif

#ifndef PROBE_PH
#define PROBE_PH (-1)
#endif
#define PROBE_REP 3
#define GU_WGM 8
#define PROBE_BARS 0

#define LAS __attribute__((address_space(3)))
typedef unsigned short bf16_t;
typedef short bf16x8 __attribute__((ext_vector_type(8)));
typedef float f32x4 __attribute__((ext_vector_type(4)));
typedef float f32x2 __attribute__((ext_vector_type(2)));
typedef unsigned u32x4 __attribute__((ext_vector_type(4)));
typedef unsigned u32x2 __attribute__((ext_vector_type(2)));
typedef float ssq_t;
__device__ __forceinline__ float ssq_val(const ssq_t* p) { const f32x4* q = (const f32x4*)p; const f32x4 a = q[0], b = q[1], c = q[2], d = q[3];
    return ((a[0] + a[1]) + (a[2] + a[3])) + ((b[0] + b[1]) + (b[2] + b[3])) + ((c[0] + c[1]) + (c[2] + c[3])) + ((d[0] + d[1]) + (d[2] + d[3])); }

constexpr int BATCH = 8, SEQ = 2048, D = 1024, DEPTH = 4, M = BATCH * SEQ;
constexpr int NH = 8, DK = 64, DV = 128, NQKVO = 3072, NIN = 3088, FF = 2816, GU = 2 * FF, CH = 64, NCH = SEQ / CH;
constexpr int BLK = 256, NBLK = BATCH * NH * (SEQ / BLK);
constexpr int NITEM = NBLK;
constexpr int STE = (DV + 1) * DK;
constexpr float EPS = 1e-6f, SOFTCAP = 15.0f;

__device__ __forceinline__ unsigned cvt_pk_bf16(float lo, float hi) { unsigned r; asm volatile("v_cvt_pk_bf16_f32 %0, %1, %2" : "=v"(r) : "v"(lo), "v"(hi)); return r; }
__device__ __forceinline__ float bf2f(unsigned short u) { return __uint_as_float((unsigned)u << 16); }
__device__ __forceinline__ float bflo(unsigned u) { return __uint_as_float(u << 16); }
__device__ __forceinline__ float bfhi(unsigned u) { return __uint_as_float(u & 0xffff0000u); }
__device__ __forceinline__ unsigned short f2bf(float f) { unsigned u = __float_as_uint(f); return (unsigned short)((u + 0x7fffu + ((u >> 16) & 1u)) >> 16); }


typedef short s16x4 __attribute__((ext_vector_type(4)));
typedef float f32x16 __attribute__((ext_vector_type(16)));
__device__ __forceinline__ unsigned pack2(float a, float b) { typedef __bf16 bf2 __attribute__((ext_vector_type(2))); f32x2 v = {a, b}; bf2 r = __builtin_convertvector(v, bf2); return __builtin_bit_cast(unsigned, r); }
__device__ __forceinline__ bf16x8 tr_pair(LAS unsigned char* p, int delta) {
    const s16x4 lo = __builtin_amdgcn_ds_read_tr16_b64_v4i16((LAS s16x4*)p), hi = __builtin_amdgcn_ds_read_tr16_b64_v4i16((LAS s16x4*)(p + delta));
    return __builtin_shufflevector(lo, hi, 0, 1, 2, 3, 4, 5, 6, 7);
}
#define MFMA32(a, b, c) __builtin_amdgcn_mfma_f32_32x32x16_bf16((a), (b), (c), 0, 0, 0)
__device__ __forceinline__ f32x16 zero16() { f32x16 z; for (int i = 0; i < 16; ++i) z[i] = 0.f; return z; }

namespace pg8 {
constexpr int BM = 256, BK = 64, HALF = 128, HTB = HALF * BK * 2, STAGE_BYTES = 8 * HTB, NXCD = 8, WGM = 8;
__host__ __device__ __forceinline__ int lds_byte(int r, int c) { const int st = (r >> 4) * 2 + (c >> 5), rr = r & 15, cc = c & 31, ob = rr * 64 + cc * 2; return st * 1024 + (ob ^ (((ob >> 9) & 1) << 5)); }
__host__ __device__ __forceinline__ void stage_rc(int b, int& R, int& C) { const int st = b / 1024, sb = b % 1024, swz = sb ^ (((sb >> 9) & 1) << 5); R = (st >> 1) * 16 + swz / 64; C = (st & 1) * 32 + (swz % 64) / 2; }
__host__ __device__ __forceinline__ int perm32(int rho) { const int n = rho >> 4, i = rho & 15; return 8 * (i >> 2) + 4 * n + (i & 3); }

struct Unit { int pm, pn, idx, hm; };
struct Gemm { const bf16_t* A; const bf16_t* Bt; };

struct Order {
    int nM, nN, nwg, G, c, nsplit, wgm;
    const ssq_t* ssq;
    LAS float* tab;
    __device__ __forceinline__ void init(int M_, int N, int G_, int c_, const ssq_t* ssq_, LAS float* tab_) { nM = M_ / BM; nN = N / BM; nwg = nM * nN; G = G_; c = c_; ssq = ssq_; tab = tab_; nsplit = 0; wgm = WGM; }
    __device__ __forceinline__ void split_tail(int ns) { if (G == 256 && nM == 64 && ns == 2) { nsplit = ns; nN -= ns; nwg = nM * nN; } }
    __device__ __forceinline__ bool next(int i, Unit& u) const {
        const long L = (long)i * G + c;
        const bool tail = L >= nwg;
        if (tail && (nsplit == 0 || L >= nwg + G)) return false;
        int wgid = tail ? 0 : (int)L; { const int q = nwg / NXCD, r = nwg % NXCD, xcd = wgid % NXCD, off = wgid / NXCD; wgid = (xcd < r ? xcd * (q + 1) : r * (q + 1) + (xcd - r) * q) + off; }
        const int nig = wgm * nN, gid = wgid / nig, fm = gid * wgm, gsz = (nM - fm) < wgm ? (nM - fm) : wgm;
        const int x = c & 7, j = c >> 3;
        const int pm = tail ? 8 * x + (j & 7) : fm + ((wgid % nig) % gsz);
        const int pn = tail ? nN + ((j >> 3) & 1) : (wgid % nig) / gsz;
        const int hm = tail ? (j >> 4) : -1;
        u.pm = pm; u.pn = pn; u.idx = i; u.hm = hm; return true;
    }
    __device__ __forceinline__ void a_ready(const Unit& u) const {
        int t_ = threadIdx.x; asm volatile("" : "+v"(t_));
        if (ssq != nullptr && t_ < 256) {
            const float s = ssq_val(ssq + (size_t)(u.pm * BM + (u.hm > 0 ? HALF : 0) + t_) * 16);
            tab[(u.idx & 1) * 256 + t_] = __builtin_amdgcn_rsqf(s * (1.0f / D) + EPS);
        }
    }
    __device__ __forceinline__ void done(const Unit&) const {}
};

__device__ __forceinline__ float sigmoidf_fast(float x) { return __builtin_amdgcn_rcpf(1.0f + __expf(-x)); }

struct EpiProj {
    static constexpr bool PERM = true, HAS_INIT = false;
    bf16_t* O; const LAS float* tab;
    __device__ __forceinline__ void operator()(const f32x4 (&acc)[2][2][4][2], const Unit& u, int wr, int wc, int fr, int fq) const {
        const LAS float* t = tab + (u.idx & 1) * 256;
        const bool sig = u.pn >= 8;
        const int row0 = u.pm * BM + wr * 64 + fr, col0 = u.pn * BM + wc * 32 + 8 * fq;
#pragma unroll
        for (int ai = 0; ai < 2; ++ai)
#pragma unroll
            for (int m = 0; m < 4; ++m) {
                const float rs = t[ai * HALF + wr * 64 + m * 16 + fr];
                bf16_t* rowp = O + (size_t)(row0 + ai * HALF + m * 16) * NQKVO + col0;
#pragma unroll
                for (int bj = 0; bj < 2; ++bj) {
                    f32x4 v0 = acc[ai][bj][m][0] * rs, v1 = acc[ai][bj][m][1] * rs;
                    if (sig) {
#pragma unroll
                        for (int i = 0; i < 4; ++i) { v0[i] = sigmoidf_fast(v0[i]); v1[i] = sigmoidf_fast(v1[i]); }
                    }
                    u32x4 w; w.x = cvt_pk_bf16(v0[0], v0[1]); w.y = cvt_pk_bf16(v0[2], v0[3]); w.z = cvt_pk_bf16(v1[0], v1[1]); w.w = cvt_pk_bf16(v1[2], v1[3]);
                    *(u32x4*)(rowp + bj * HALF) = w;
                }
            }
    }
};
struct EpiGU {
    static constexpr bool PERM = true, HAS_INIT = false;
    bf16_t* H; const LAS float* tab;
    __device__ __forceinline__ void operator()(const f32x4 (&acc)[2][2][4][2], const Unit& u, int wr, int wc, int fr, int fq) const {
        const LAS float* t = tab + (u.idx & 1) * 256;
        const int row0 = u.pm * BM + (u.hm > 0 ? HALF : 0) + wr * 64 + fr, col0 = u.pn * HALF + wc * 32 + 8 * fq;
#pragma unroll
        for (int ai = 0; ai < 2; ++ai) { if (ai == 1 && u.hm >= 0) break;
#pragma unroll
            for (int m = 0; m < 4; ++m) {
                const float rs = t[ai * HALF + wr * 64 + m * 16 + fr];
                const float c1 = rs * -1.4426950408889634f, rs2 = rs * rs;
                float hv[8];
#pragma unroll
                for (int n = 0; n < 2; ++n)
#pragma unroll
                    for (int i = 0; i < 4; ++i) { const float g = acc[ai][0][m][n][i], uu = acc[ai][1][m][n][i]; hv[n * 4 + i] = (g * uu) * (rs2 * __builtin_amdgcn_rcpf(1.0f + __builtin_amdgcn_exp2f(g * c1))); }
                u32x4 w; w.x = cvt_pk_bf16(hv[0], hv[1]); w.y = cvt_pk_bf16(hv[2], hv[3]); w.z = cvt_pk_bf16(hv[4], hv[5]); w.w = cvt_pk_bf16(hv[6], hv[7]);
                *(u32x4*)(H + (size_t)(row0 + ai * HALF + m * 16) * FF + col0) = w;
            }
        }
    }
};
struct EpiRes {
    static constexpr bool PERM = true, HAS_INIT = true;
    bf16_t* xb; bf16_t* xo; ssq_t* ssq_out;
    __device__ __forceinline__ void init_load(u32x4 (&t)[2][4][2], const Unit& u, int wr, int wc, int fr, int fq) const {
        const int row0 = u.pm * BM + wr * 64 + fr, col0 = u.pn * BM + wc * 32 + 8 * fq;
#pragma unroll
        for (int ai = 0; ai < 2; ++ai)
#pragma unroll
            for (int m = 0; m < 4; ++m)
#pragma unroll
                for (int bj = 0; bj < 2; ++bj) t[ai][m][bj] = *(const u32x4*)(xb + (size_t)(row0 + ai * HALF + m * 16) * D + col0 + bj * HALF);
    }
    __device__ __forceinline__ void init_cvt(f32x4 (&acc)[2][2][4][2], const u32x4 (&t)[2][4][2]) const {
#pragma unroll
        for (int ai = 0; ai < 2; ++ai)
#pragma unroll
            for (int m = 0; m < 4; ++m)
#pragma unroll
                for (int bj = 0; bj < 2; ++bj) { const u32x4 v = t[ai][m][bj];
                    acc[ai][bj][m][0] = (f32x4){bflo(v.x), bfhi(v.x), bflo(v.y), bfhi(v.y)}; acc[ai][bj][m][1] = (f32x4){bflo(v.z), bfhi(v.z), bflo(v.w), bfhi(v.w)}; }
    }
    __device__ __forceinline__ void init(f32x4 (&acc)[2][2][4][2], const Unit& u, int wr, int wc, int fr, int fq) const { u32x4 t[2][4][2]; init_load(t, u, wr, wc, fr, fq); init_cvt(acc, t); }
    __device__ __forceinline__ void operator()(const f32x4 (&acc)[2][2][4][2], const Unit& u, int wr, int wc, int fr, int fq) const {
        const int row0 = u.pm * BM + wr * 64 + fr, col0 = u.pn * BM + wc * 32 + 8 * fq;
#pragma unroll
        for (int ai = 0; ai < 2; ++ai)
#pragma unroll
            for (int m = 0; m < 4; ++m) {
                const int row = row0 + ai * HALF + m * 16; float ss = 0.f;
#pragma unroll
                for (int bj = 0; bj < 2; ++bj) {
                    const f32x4 v0 = acc[ai][bj][m][0], v1 = acc[ai][bj][m][1];
                    u32x4 w; w.x = cvt_pk_bf16(v0[0], v0[1]); w.y = cvt_pk_bf16(v0[2], v0[3]); w.z = cvt_pk_bf16(v1[0], v1[1]); w.w = cvt_pk_bf16(v1[2], v1[3]);
                    *(u32x4*)(xo + (size_t)row * D + col0 + bj * HALF) = w;
                    ss += ((v0[0] * v0[0] + v0[1] * v0[1]) + (v0[2] * v0[2] + v0[3] * v0[3])) + ((v1[0] * v1[0] + v1[1] * v1[1]) + (v1[2] * v1[2] + v1[3] * v1[3]));
                }
                ss += __shfl_xor(ss, 16); ss += __shfl_xor(ss, 32);
                if (fq == 0) ssq_out[(size_t)row * 16 + u.pn * 4 + wc] = ss;
            }
    }
};

template <class Epi, bool ALIGN_EPI, int LDA, int LDB, int KLEN, int ACOL, bool HALFU = false>
__device__ __forceinline__ void gemm_phase(LAS unsigned char* lds, const Gemm g, const Order& S, const Epi& E) {
    int tid_ = threadIdx.x; asm volatile("" : "+v"(tid_));
    const int tid = tid_, wid = __builtin_amdgcn_readfirstlane(tid >> 6), lane = tid & 63, wr = wid >> 2, wc = wid & 3, fr = lane & 15, fq = lane >> 4;
    constexpr int nt = KLEN / BK;
    unsigned voffA[2], voffB[2];
#pragma unroll
    for (int i = 0; i < 2; ++i) {
        const int R = i * 64 + (tid >> 3), C = 8 * ((tid & 7) ^ ((R >> 1) & 7)); const int Rb = Epi::PERM ? ((R & ~31) + perm32(R & 31)) : R;
        voffA[i] = (unsigned)(R * LDA + C) * 2u; voffB[i] = (unsigned)(Rb * LDB + C) * 2u; }
    constexpr size_t kstep = (size_t)(BK * 2);
    constexpr size_t hstepA = (size_t)HALF * LDA * 2, tstepA = 2 * hstepA, hstepB = (size_t)HALF * LDB * 2, tstepB = 2 * hstepB;
    constexpr size_t pnstepA = (size_t)ACOL * 2;
    const unsigned ldsw = (unsigned)wid * 1024u;
    const int sw0 = 16 * (fq ^ ((fr >> 1) & 7)), aoff0 = (wr * 64 + fr) * 128 + sw0, aoff1 = aoff0 ^ 64, boff0 = (wc * 32 + fr) * 128 + sw0, boff1 = boff0 ^ 64;
#define PG8_SA(b, h) (((b) * 2 + (h)) * HTB)
#define PG8_SB(b, h) ((4 + (b) * 2 + (h)) * HTB)
#define PG8_STAGE(bufoff, gbase, voff) do { _Pragma("unroll") for (int _i = 0; _i < 2; ++_i) \
        __builtin_amdgcn_global_load_lds((const unsigned*)((const char*)(gbase) + (voff)[_i]), (LAS unsigned*)(lds + (bufoff) + ldsw + _i * 8192), 16, 0, 0); } while (0)
#define PG8_LDA(dst, b, h) do { _Pragma("unroll") for (int m = 0; m < 4; ++m) _Pragma("unroll") for (int k = 0; k < 2; ++k) dst[m][k] = *(const LAS bf16x8*)(lds + PG8_SA(b, h) + (k ? aoff1 : aoff0) + m * 2048); } while (0)
#define PG8_LDB(dst, b, h) do { _Pragma("unroll") for (int n = 0; n < 2; ++n) _Pragma("unroll") for (int k = 0; k < 2; ++k) dst[n][k] = *(const LAS bf16x8*)(lds + PG8_SB(b, h) + (k ? boff1 : boff0) + n * 2048); } while (0)
#define PG8_MMA(ai, bj, At, Bt) do { __builtin_amdgcn_s_setprio(1); _Pragma("unroll") for (int m = 0; m < 4; ++m) _Pragma("unroll") for (int n = 0; n < 2; ++n) _Pragma("unroll") for (int k = 0; k < 2; ++k) \
        acc[ai][bj][m][n] = __builtin_amdgcn_mfma_f32_16x16x32_bf16(Bt[n][k], At[m][k], acc[ai][bj][m][n], 0, 0, 0); __builtin_amdgcn_s_setprio(0); } while (0)
#define PG8_WAIT_V(n) asm volatile("s_waitcnt vmcnt(" #n ")" ::: "memory")
#define PG8_WAIT_L(n) asm volatile("s_waitcnt lgkmcnt(" #n ")" ::: "memory")
#define PG8_BAR __builtin_amdgcn_s_barrier()
#define PG8_SCHED __builtin_amdgcn_sched_barrier(0)
    Unit cur, nxt; int ui = 0;
    if (!S.next(0, cur)) return;
    f32x4 acc[2][2][4][2];
    u32x4 xt[Epi::HAS_INIT ? 2 : 1][4][2];
    if constexpr (Epi::HAS_INIT) E.init_load(xt, cur, wr, wc, fr, fq);
    else {
#pragma unroll
    for (int a = 0; a < 2; ++a)
#pragma unroll
        for (int b = 0; b < 2; ++b)
#pragma unroll
            for (int m = 0; m < 4; ++m)
#pragma unroll
                for (int n = 0; n < 2; ++n) acc[a][b][m][n] = (f32x4){0.f, 0.f, 0.f, 0.f};
    }
    bf16x8 At[4][2], B0[2][2], B1[2][2];
    const char* cA = (const char*)g.A + (size_t)cur.pm * tstepA + (size_t)cur.pn * pnstepA + ((HALFU && cur.hm > 0) ? hstepA : 0); const char* cB = (const char*)g.Bt + (size_t)cur.pn * tstepB;
    S.a_ready(cur);
    PG8_STAGE(PG8_SB(0, 0), cB, voffB); PG8_STAGE(PG8_SB(0, 1), cB + hstepB, voffB); PG8_STAGE(PG8_SA(0, 0), cA, voffA); PG8_STAGE(PG8_SA(0, 1), cA + hstepA, voffA);
    if constexpr (Epi::HAS_INIT) E.init_cvt(acc, xt);
    if (wr == 1) PG8_BAR;
    PG8_WAIT_V(2); PG8_BAR;
    PG8_STAGE(PG8_SB(1, 0), cB + kstep, voffB); PG8_STAGE(PG8_SA(1, 0), cA + kstep, voffA); PG8_STAGE(PG8_SB(1, 1), cB + hstepB + kstep, voffB);
    PG8_WAIT_V(6); PG8_BAR;
    for (;;) {
        const bool has_next = S.next(ui + 1, nxt);
        const char* nA = has_next ? (const char*)g.A + (size_t)nxt.pm * tstepA + (size_t)nxt.pn * pnstepA + ((HALFU && nxt.hm > 0) ? hstepA : 0) : cA;
        const bool full = !HALFU || cur.hm < 0;
        const char* nB = has_next ? (const char*)g.Bt + (size_t)nxt.pn * tstepB : cB;
#pragma unroll 1
        for (int t = 0; t < nt; t += 2) {
            const bool last = (t == nt - 2);
            const char* a1 = cA + (size_t)(t + 1) * kstep;
            const char* a2 = last ? nA : cA + (size_t)(t + 2) * kstep; const char* b2 = last ? nB : cB + (size_t)(t + 2) * kstep;
            const char* a3 = a2 + kstep; const char* b3 = b2 + kstep;
            if (last && has_next) S.a_ready(nxt);
            PG8_LDB(B0, 0, 0); PG8_LDB(B1, 0, 1); PG8_SCHED; PG8_LDA(At, 0, 0); PG8_STAGE(PG8_SA(1, 1), a1 + hstepA, voffA);
            PG8_WAIT_V(8); PG8_WAIT_L(0); PG8_BAR; PG8_MMA(0, 0, At, B0); PG8_MMA(0, 1, At, B1); PG8_BAR; PG8_SCHED;
            PG8_LDA(At, 0, 1); PG8_STAGE(PG8_SB(0, 0), b2, voffB); PG8_STAGE(PG8_SB(0, 1), b2 + hstepB, voffB); PG8_STAGE(PG8_SA(0, 0), a2, voffA);
            PG8_WAIT_V(8); PG8_WAIT_L(0); PG8_BAR; if (full) { PG8_MMA(1, 0, At, B0); PG8_MMA(1, 1, At, B1); } PG8_BAR; PG8_SCHED;
            PG8_LDB(B0, 1, 0); PG8_LDB(B1, 1, 1); PG8_SCHED; PG8_LDA(At, 1, 0); PG8_STAGE(PG8_SA(0, 1), a2 + hstepA, voffA);
            PG8_WAIT_V(8); PG8_WAIT_L(0); PG8_BAR; PG8_MMA(0, 0, At, B0); PG8_MMA(0, 1, At, B1); PG8_BAR; PG8_SCHED;
            PG8_LDA(At, 1, 1); PG8_STAGE(PG8_SB(1, 0), b3, voffB); PG8_STAGE(PG8_SB(1, 1), b3 + hstepB, voffB); PG8_STAGE(PG8_SA(1, 0), a3, voffA);
            PG8_WAIT_V(8); PG8_WAIT_L(0); PG8_BAR; if (full) { PG8_MMA(1, 0, At, B0); PG8_MMA(1, 1, At, B1); } PG8_BAR; PG8_SCHED;
        }
        if constexpr (ALIGN_EPI) { if (wr == 0) PG8_BAR; }
        E(acc, cur, wr, wc, fr, fq);
#if defined(PROBE_EPI2)
        E(acc, cur, wr, wc, fr, fq); E(acc, cur, wr, wc, fr, fq);
#endif
        S.done(cur);
        if (!has_next) break;
        if constexpr (Epi::HAS_INIT) E.init(acc, nxt, wr, wc, fr, fq);
        else {
#pragma unroll
        for (int a = 0; a < 2; ++a)
#pragma unroll
            for (int b = 0; b < 2; ++b)
#pragma unroll
                for (int m = 0; m < 4; ++m)
#pragma unroll
                    for (int n = 0; n < 2; ++n) acc[a][b][m][n] = (f32x4){0.f, 0.f, 0.f, 0.f};
        }
        cur = nxt; cA = nA; cB = nB; ++ui;
        if constexpr (ALIGN_EPI) { if (wr == 1) PG8_BAR; }
    }
    PG8_WAIT_V(0);
    if constexpr (!ALIGN_EPI) { if (wr == 0) PG8_BAR; }
    PG8_BAR;
#undef PG8_SA
#undef PG8_SB
#undef PG8_STAGE
#undef PG8_LDA
#undef PG8_LDB
#undef PG8_MMA
#undef PG8_WAIT_V
#undef PG8_WAIT_L
#undef PG8_BAR
#undef PG8_SCHED
}
}

constexpr size_t MiB = 1u << 20;
constexpr size_t WS_CTL = 0, CTL_ZERO_BYTES = 1 * MiB;
constexpr size_t SZ_WIN = (size_t)NQKVO * D * 2, SZ_WOUT = (size_t)D * D * 2, SZ_WPOOL = (size_t)D * 256 * 2, SZ_WGU = (size_t)GU * D * 2, SZ_WDN = (size_t)D * FF * 2, SZ_WG = (size_t)16 * D * 2;
constexpr size_t WS_WIN = 1 * MiB;
constexpr size_t WS_WOUT = WS_WIN + 2 * SZ_WIN;
constexpr size_t WS_WPOOL = WS_WOUT + 2 * SZ_WOUT;
constexpr size_t WS_WGU = WS_WPOOL + 2 * SZ_WPOOL;
constexpr size_t WS_WDN = WS_WGU + 4 * SZ_WGU;
constexpr size_t WS_WG = WS_WDN + 4 * SZ_WDN;
constexpr size_t WS_SSQ = WS_WG + 2 * SZ_WG;
constexpr size_t SZ_SSQ = (size_t)M * 16 * 4;
constexpr size_t WS_GATES = WS_SSQ + 9 * SZ_SSQ;
constexpr size_t WS_DECAY = WS_GATES + (size_t)M * 16 * 4;
constexpr size_t WS_GT = WS_DECAY + 4096;
constexpr size_t WS_XB = ((WS_GT + (size_t)512 * 512 * 4 + MiB - 1) / MiB) * MiB;
constexpr size_t WS_BIG = WS_XB + (size_t)M * D * 2;
constexpr size_t WS_ST = WS_BIG + (size_t)M * NQKVO * 2;
constexpr size_t WS_END = WS_ST + (size_t)NITEM * STE * 2;
static_assert(WS_END <= 352 * MiB, "d_ws map must fit the guaranteed workspace");
static_assert((size_t)M * FF * 2 <= (size_t)M * NQKVO * 2, "H overlays q|k|v|o");

constexpr int CW_BAR = 4096;
constexpr int CW_CENSUS = 8192;
constexpr int CW_XL_SUB = 9216, CW_XL_GEN = 10240;
constexpr int RING_OFF = 0, RING_BYTES = 131072;
constexpr int LDSCTL_OFF = RING_BYTES, MISC_OFF = LDSCTL_OFF + 320;
constexpr int RSTD_OFF = RING_BYTES + 1024;
constexpr int TAB_OFF = RING_BYTES + 3072;
constexpr int LDS_BYTES = 147456;
constexpr int NWAVES = 8, NT = NWAVES * 64;

#define VM_WAIT() asm volatile("s_waitcnt vmcnt(0)" ::: "memory")
#define LDS_WAIT() asm volatile("s_waitcnt lgkmcnt(0)" ::: "memory")

#define XB_TMO      128
#define XB_XCNT(j)  (256  + 64 * (j))
#define XB_XSUB(j)  (1280 + 64 * (j))
#define XB_XGEN(j)  (2304 + 64 * (j))
#define XB_TOP      3328
#define XB_TOPGEN   3392
#define XCD_BAR_WORDS 3456
#define XB_SPIN_CAP (1u << 18)
__device__ __forceinline__ unsigned xb_ld(unsigned* p)              { return __hip_atomic_load(p, __ATOMIC_RELAXED, __HIP_MEMORY_SCOPE_AGENT); }
__device__ __forceinline__ unsigned xb_add(unsigned* p, unsigned v) { return __hip_atomic_fetch_add(p, v, __ATOMIC_RELAXED, __HIP_MEMORY_SCOPE_AGENT); }
__device__ __forceinline__ unsigned xb_xcc_id() { return (unsigned)__builtin_amdgcn_s_getreg((3 << 11) | 20) & 0xFu; }
#define XB_SPIN(cond, bar) do { unsigned _sp = 0; while (cond) { __builtin_amdgcn_s_sleep(1); \
    if ((++_sp & 255u) == 0u) { if (xb_ld(&(bar)[XB_TMO])) break; if (_sp > XB_SPIN_CAP) { atomicAdd(&(bar)[XB_TMO], 1u); break; } } } } while (0)
struct XcdBarrier { unsigned* bar; unsigned x; volatile LAS unsigned* st; };
__device__ __forceinline__ XcdBarrier xcd_barrier_post(unsigned* bar, volatile LAS unsigned* st) {
    XcdBarrier b; b.bar = bar; b.x = xb_xcc_id(); b.st = st;
    if (threadIdx.x == 0) (void)xb_add(&bar[XB_XCNT(b.x)], 1u);
    return b;
}
__device__ __forceinline__ void xcd_barrier_complete(unsigned* bar, unsigned x, unsigned& nloc, unsigned& nx) {
    const unsigned G = gridDim.x * gridDim.y * gridDim.z;
    unsigned sum, cnt, mine, sp = 0u;
    for (;;) {
        sum = 0u; cnt = 0u; mine = 0u;
#pragma unroll
        for (unsigned j = 0; j < 16; ++j) { const unsigned c = xb_ld(&bar[XB_XCNT(j)]); sum += c; cnt += (c > 0u) ? 1u : 0u; mine = (j == x) ? c : mine; }
        if (sum == G) break;
        __builtin_amdgcn_s_sleep(1);
        if ((++sp & 255u) == 0u) { if (xb_ld(&bar[XB_TMO])) break; if (sp > XB_SPIN_CAP) { atomicAdd(&bar[XB_TMO], 1u); break; } }
    }
    nloc = mine > 0u ? mine : 1u; nx = cnt > 0u ? cnt : 1u;
}
__device__ __forceinline__ void xcd_barrier(const XcdBarrier& b) {
    asm volatile("s_waitcnt vmcnt(0)" ::: "memory");
    __syncthreads();
    if (threadIdx.x == 0) {
        unsigned* bar = b.bar;
        __builtin_amdgcn_s_waitcnt(0);
        unsigned nloc = b.st[0], nx = b.st[1];
        if (nloc == 0u) { xcd_barrier_complete(bar, b.x, nloc, nx); b.st[0] = nloc; b.st[1] = nx; }
        const unsigned old = xb_add(&bar[XB_XSUB(b.x)], 1u);
        const unsigned gen = old / nloc;
        if (old + 1u == (gen + 1u) * nloc) {
            __builtin_amdgcn_fence(__ATOMIC_RELEASE, "agent");
            asm volatile("s_waitcnt vmcnt(0)" ::: "memory");
            const unsigned og = xb_add(&bar[XB_TOP], 1u);
            const unsigned tg = og / nx;
            if (og + 1u == (tg + 1u) * nx) xb_add(&bar[XB_TOPGEN], 1u);
            else XB_SPIN(xb_ld(&bar[XB_TOPGEN]) == tg, bar);
            __builtin_amdgcn_fence(__ATOMIC_ACQUIRE, "agent");
            xb_add(&bar[XB_XGEN(b.x)], 1u);
            asm volatile("s_waitcnt vmcnt(0)" ::: "memory");
        } else {
            XB_SPIN(xb_ld(&bar[XB_XGEN(b.x)]) == gen, bar);
            __builtin_amdgcn_fence(__ATOMIC_ACQUIRE, "agent");
            asm volatile("s_waitcnt vmcnt(0)" ::: "memory");
        }
    }
    __syncthreads();
}

__device__ __forceinline__ void xcc_local_barrier(unsigned* ctl, unsigned x, unsigned nloc) {
    asm volatile("s_waitcnt vmcnt(0)" ::: "memory");
    __syncthreads();
    if (threadIdx.x == 0) {
        const unsigned old = xb_add(&ctl[CW_XL_SUB + 64 * x], 1u);
        const unsigned gen = old / nloc;
        if (old + 1u == (gen + 1u) * nloc) xb_add(&ctl[CW_XL_GEN + 64 * x], 1u);
        else XB_SPIN(xb_ld(&ctl[CW_XL_GEN + 64 * x]) == gen, ctl + CW_BAR);
        __builtin_amdgcn_fence(__ATOMIC_ACQUIRE, "agent");
        asm volatile("s_waitcnt vmcnt(0)" ::: "memory");
    }
    __syncthreads();
}

__device__ __forceinline__ float wave_sum(float v) {
#pragma unroll
    for (int o = 1; o < 64; o <<= 1) v += __shfl_xor(v, o);
    return v;
}
__device__ __forceinline__ float log_sigmoidf(float x) { return fminf(x, 0.f) - log1pf(expf(-fabsf(x))); }
__device__ __forceinline__ float rstd_of(const ssq_t* ssq_row) { return 1.0f / sqrtf(ssq_val(ssq_row) * (1.0f / D) + EPS); }

__device__ __forceinline__ void tr_item64(const float* W, int ldW, int k0, int c0, bf16_t* WT, int ldT, int r0, const float* kg, const float* cg, float mul, LAS unsigned* scr, int lane) {
    const int n4 = lane & 15, kq = lane >> 4;
    f32x4 cm = (f32x4){mul, mul, mul, mul}; if (cg) cm = *(const f32x4*)(cg + c0 + 4 * n4) * mul;
    f32x4 va[8], vb[8];
#pragma unroll
    for (int i = 0; i < 8; ++i) { const int kp = kq + 4 * i; const float* p = W + (size_t)(k0 + 2 * kp) * ldW + c0 + 4 * n4; va[i] = *(const f32x4*)p; vb[i] = *(const f32x4*)(p + ldW); }
#pragma unroll
    for (int i = 0; i < 8; ++i) { const int kp = kq + 4 * i; const float g0 = kg ? kg[k0 + 2 * kp] : 1.0f, g1 = kg ? kg[k0 + 2 * kp + 1] : 1.0f;
#pragma unroll
        for (int e = 0; e < 4; ++e) scr[kp * 65 + 4 * n4 + e] = pack2(va[i][e] * cm[e] * g0, vb[i][e] * cm[e] * g1); }
    LDS_WAIT(); asm volatile("" ::: "memory");
    const int j = lane & 7, nl = lane >> 3;
#pragma unroll
    for (int it = 0; it < 8; ++it) { const int n = nl + 8 * it; u32x4 o; o.x = scr[(4 * j + 0) * 65 + n]; o.y = scr[(4 * j + 1) * 65 + n]; o.z = scr[(4 * j + 2) * 65 + n]; o.w = scr[(4 * j + 3) * 65 + n];
        *(u32x4*)(WT + (size_t)(r0 + n) * ldT + k0 + 8 * j) = o; }
    LDS_WAIT(); asm volatile("" ::: "memory");
}

struct Args;
constexpr int I_IN = 16 * 48, I_OUT = 16 * 16, I_POOL = 4 * 4 * 4, I_GU = 16 * 88, I_DN = 44 * 16;
constexpr int CV_P0 = I_GU + I_IN + I_OUT, CV_T0 = CV_P0 + I_DN + I_POOL + I_GU + I_OUT, CV_T1 = CV_T0 + I_DN + I_IN + I_GU, CV_T2 = CV_T1 + I_DN + I_POOL + I_GU, CV_END = CV_T2 + I_DN;
struct Args { const float* in[12]; float* out; unsigned char* ws; int ph_lo, ph_hi; };

enum { JT_GU = 0, JT_DN = 1, JT_IN = 2, JT_OUT = 3, JT_POOL = 4 };
__device__ __forceinline__ void convert_one(const Args& args, unsigned char* ws, LAS unsigned* scr, int lane, int type, int l, int r) {
    const float* const* in = args.in;
    if (type == JT_GU) { const int kb = r / 88, nb = r % 88, r0 = nb * 64, pn = r0 >> 8, j = r0 & 255; const int c0 = (j < 128) ? pn * 128 + j : FF + pn * 128 + (j - 128);
        tr_item64(in[9] + (size_t)l * D * GU, GU, kb * 64, c0, (bf16_t*)(ws + WS_WGU) + (size_t)l * GU * D, D, r0, in[2] + l * D, nullptr, 1.0f, scr, lane); }
    else if (type == JT_DN) { const int kb = r / 16, nb = r % 16;
        tr_item64(in[10] + (size_t)l * FF * D, D, kb * 64, nb * 64, (bf16_t*)(ws + WS_WDN) + (size_t)l * D * FF, FF, nb * 64, nullptr, nullptr, 1.0f, scr, lane); }
    else if (type == JT_IN) { const int kb = r / 48, nb = r % 48, r0 = nb * 64;
        tr_item64(in[3] + (size_t)l * D * NIN, NIN, kb * 64, r0, (bf16_t*)(ws + WS_WIN) + (size_t)l * NQKVO * D, D, r0, in[1] + (2 * l) * D, nullptr, (r0 >= 512 && r0 < 1024) ? 0.125f : 1.0f, scr, lane); }
    else if (type == JT_OUT) { const int kb = r / 16, nb = r % 16;
        tr_item64(in[6] + (size_t)l * D * D, D, kb * 64, nb * 64, (bf16_t*)(ws + WS_WOUT) + (size_t)l * D * D, D, nb * 64, in[5] + l * D, nullptr, 1.0f, scr, lane); }
    else { const int gi = r / 16, r2 = r % 16, kb = r2 / 4, nb = r2 % 4;
        tr_item64(in[7] + (size_t)(l * 4 + gi) * 256 * 256, 256, kb * 64, nb * 64, (bf16_t*)(ws + WS_WPOOL) + (size_t)l * D * 256 + (size_t)gi * 256 * 256, 256, nb * 64,
                  in[1] + (2 * l + 1) * D + gi * 256, in[8] + l * D + gi * 256, 1.0f, scr, lane); }
}
__device__ __forceinline__ void convert_items(const Args& args, unsigned char* ws, LAS unsigned* scr, int lane, int lo, int hi, int w, int nw) {
    for (int it = lo + w; it < hi; it += nw) {
        int r = it;
#define CV_JOB(T, L, N) if (r < (N)) { convert_one(args, ws, scr, lane, T, L, r); continue; } r -= (N);
        CV_JOB(JT_GU, 0, I_GU) CV_JOB(JT_IN, 0, I_IN) CV_JOB(JT_OUT, 0, I_OUT)
        CV_JOB(JT_DN, 0, I_DN) CV_JOB(JT_POOL, 0, I_POOL) CV_JOB(JT_GU, 1, I_GU) CV_JOB(JT_OUT, 1, I_OUT)
        CV_JOB(JT_DN, 1, I_DN) CV_JOB(JT_IN, 1, I_IN) CV_JOB(JT_GU, 2, I_GU)
        CV_JOB(JT_DN, 2, I_DN) CV_JOB(JT_POOL, 1, I_POOL) CV_JOB(JT_GU, 3, I_GU)
        CV_JOB(JT_DN, 3, I_DN)
#undef CV_JOB
    }
}
constexpr int N_PHASES = 20;

__global__ void __launch_bounds__(NT, 2) fwd_kernel(Args args) {
    extern __shared__ __attribute__((aligned(16))) unsigned char lds_raw[];
    LAS unsigned char* lds = (LAS unsigned char*)lds_raw;
    volatile LAS unsigned* MISC = (volatile LAS unsigned*)(lds + MISC_OFF);
    LAS float* rtab = (LAS float*)(lds + RSTD_OFF);
    int tid = threadIdx.x, lane = tid & 63, wave = __builtin_amdgcn_readfirstlane(tid >> 6);
#define FRESH_TID() do { tid = threadIdx.x; asm volatile("" : "+v"(tid)); lane = tid & 63; wave = __builtin_amdgcn_readfirstlane(tid >> 6); } while (0)
    const int G = gridDim.x, bid0 = blockIdx.x;
    int bid = bid0;
    unsigned char* const ws = args.ws;
#define x_in       (args.in[0])
#define norm_mix   (args.in[1])
#define norm_ffn   (args.in[2])
#define w_in       (args.in[3])
#define gate_bias  (args.in[4])
#define head_gain  (args.in[5])
#define w_out      (args.in[6])
#define pool_w     (args.in[7])
#define pool_scale (args.in[8])
#define w_gu       (args.in[9])
#define w_dn       (args.in[10])
#define final_norm (args.in[11])
#define Win_t   ((bf16_t*)(ws + WS_WIN))
#define Wout_t  ((bf16_t*)(ws + WS_WOUT))
#define Wpool_t ((bf16_t*)(ws + WS_WPOOL))
#define Wgu_t   ((bf16_t*)(ws + WS_WGU))
#define Wdn_t   ((bf16_t*)(ws + WS_WDN))
#define Wg      ((bf16_t*)(ws + WS_WG))
#define ssq     ((ssq_t*)(ws + WS_SSQ))
#define gates   ((float*)(ws + WS_GATES))
#define decay   ((float*)(ws + WS_DECAY))
#define GT      ((float*)(ws + WS_GT))
#define xb      ((bf16_t*)(ws + WS_XB))
#define BIG     ((bf16_t*)(ws + WS_BIG))
#define ST      ((bf16_t*)(ws + WS_ST))

    for (int u = tid; u < (LDS_BYTES - LDSCTL_OFF) / 4; u += NT) ((LAS unsigned*)(lds + LDSCTL_OFF))[u] = 0u;
    __syncthreads();
    XcdBarrier bar; bar.bar = (unsigned*)(ws + WS_CTL) + CW_BAR; bar.x = 0; bar.st = nullptr;
    if (MK_N_LAUNCHES == 1) bar = xcd_barrier_post((unsigned*)(ws + WS_CTL) + CW_BAR, MISC + 8);
    unsigned* const ctl = (unsigned*)(ws + WS_CTL);
    if (MK_N_LAUNCHES == 1) {
        if (tid == 0) { const unsigned x = xb_xcc_id(); MISC[4] = x; MISC[5] = xb_add(&ctl[CW_CENSUS + 64 * x], 1u); }
        __syncthreads();
    }
    const int xcc = (int)MISC[4], xrank = (int)MISC[5];
    int xmode = 0;

    const int lo = args.ph_lo, hi = args.ph_hi;
    int ph = 0;
#define IN_PH() (lo <= ph && ph < hi)
#define BEGIN_PH() FRESH_TID()
#if PROBE_PH >= 0
#define LAS_REP_PTR(op, row, h, ch) (LAST_REP() ? (op) : (u32x4*)args.out + ((size_t)(row) * 128 + (h) * 16 + (ch)))
#define REPS() ((ph == PROBE_PH) ? PROBE_REP : 1)
#define LAST_REP() (rep_ + 1 == REPS())
#else
#define LAS_REP_PTR(op, row, h, ch) (op)
#define REPS() 1
#define LAST_REP() true
#endif
#define END_PH() do { if (lo <= ph && ph + 1 < hi) xcd_barrier(bar); ++ph; } while (0)
#define END_PH_X() do { if (lo <= ph && ph + 1 < hi) { if (xmode) xcc_local_barrier(ctl, (unsigned)xcc, (unsigned)(G / 8)); else xcd_barrier(bar); } ++ph; } while (0)

    if (IN_PH()) for (int rep_ = 0; rep_ < REPS(); ++rep_) { BEGIN_PH();
        LAS unsigned* scr = (LAS unsigned*)(lds + RING_OFF + wave * 8448);
        const int gw = bid * NWAVES + wave, NGW = G * NWAVES;
        convert_items(args, ws, scr, lane, 0, (G == 256) ? CV_P0 : CV_END, gw, NGW);
        for (int e = bid * NT + tid; e < 2 * 16 * D; e += G * NT) { const int l = e / (16 * D), rem = e % (16 * D), k = rem >> 4, j = rem & 15;
            Wg[(size_t)l * 16 * D + j * D + k] = f2bf(w_in[(size_t)l * D * NIN + (size_t)k * NIN + NQKVO + j] * norm_mix[(2 * l) * D + k]); }
        for (int m = 2 * gw; m < M; m += 2 * NGW) {
            const f32x4* xr = (const f32x4*)(x_in + (size_t)m * D) + lane; f32x4 v[8]; float s0 = 0.f, s1 = 0.f;
#pragma unroll
            for (int j = 0; j < 8; ++j) v[j] = xr[64 * j];
#pragma unroll
            for (int j = 0; j < 4; ++j) { s0 += (v[j][0] * v[j][0] + v[j][1] * v[j][1]) + (v[j][2] * v[j][2] + v[j][3] * v[j][3]);
                                          s1 += (v[j + 4][0] * v[j + 4][0] + v[j + 4][1] * v[j + 4][1]) + (v[j + 4][2] * v[j + 4][2] + v[j + 4][3] * v[j + 4][3]); }
            s0 = wave_sum(s0); s1 = wave_sum(s1);
#pragma unroll
            for (int j = 0; j < 8; ++j) { u32x2 w; w.x = cvt_pk_bf16(v[j][0], v[j][1]); w.y = cvt_pk_bf16(v[j][2], v[j][3]); ((u32x2*)(xb + (size_t)m * D))[64 * j + lane] = w; }
            if (lane < 32) ssq[(size_t)m * 16 + lane] = (lane == 0) ? s0 : (lane == 16) ? s1 : 0.f;
        }
    }
    END_PH();
    if (MK_N_LAUNCHES == 1 && lo == 0 && (G & 7) == 0 && BATCH == 8) {
        if (tid == 0) { unsigned ok = 1u;
#pragma unroll
            for (int j = 0; j < 8; ++j) ok &= (xb_ld(&ctl[CW_CENSUS + 64 * j]) == (unsigned)(G / 8)) ? 1u : 0u;
            MISC[6] = ok; }
        __syncthreads();
        xmode = (int)MISC[6];
        if (xmode) bid = xcc + 8 * xrank;
    }
    const int gq = G / 8;
    const int it0 = xmode ? 64 * xcc + xrank : bid, its = xmode ? gq : G, itn = xmode ? 64 * xcc + 64 : NBLK;
    const int rb0 = xmode ? 32 * xcc + xrank : bid, rbn = xmode ? 32 * xcc + 32 : M / 64;
#if PROBE_BARS > 0
    if (MK_N_LAUNCHES == 1) for (int i_ = 0; i_ < PROBE_BARS; ++i_) xcd_barrier(bar);
#endif

    for (int layer = 0; layer < DEPTH; ++layer) {
        const int slot = layer >> 1;
        ssq_t* ssq_a = ssq + (size_t)(2 * layer) * M * 16;
        ssq_t* ssq_b = ssq_a + (size_t)M * 16;
        ssq_t* ssq_c = ssq_b + (size_t)M * 16;
        if ((layer & 1) == 0) {
            if (IN_PH()) for (int rep_ = 0; rep_ < REPS(); ++rep_) { BEGIN_PH();
                {
                    const bf16_t* wgb = Wg + (size_t)slot * 16 * D;
                    LAS float* red = (LAS float*)lds;
                    const int rbk = wave & 3, kh = wave >> 2, fr = lane & 15, fq = lane >> 4;
#if defined(PROBE_GATES)
                    for (int grep_ = 0; grep_ < 3; ++grep_)
#endif
                    for (int rb = rb0; rb < rbn; rb += its) {
                        const bf16_t* ap = xb + (size_t)(rb * 64 + rbk * 16 + fr) * D + kh * 512 + 8 * fq;
                        const bf16_t* bp = wgb + (size_t)fr * D + kh * 512 + 8 * fq;
                        f32x4 ga = (f32x4){0.f, 0.f, 0.f, 0.f};
#pragma unroll
                        for (int ks = 0; ks < 16; ++ks) ga = __builtin_amdgcn_mfma_f32_16x16x32_bf16(*(const bf16x8*)(ap + 32 * ks), *(const bf16x8*)(bp + 32 * ks), ga, 0, 0, 0);
                        if (kh == 1) *(LAS f32x4*)(red + (rbk * 64 + lane) * 4) = ga;
                        __syncthreads();
                        if (kh == 0) {
                            ga += *(const LAS f32x4*)(red + (rbk * 64 + lane) * 4);
                            const float gb = gate_bias[slot * 16 + fr];
#pragma unroll
                            for (int r = 0; r < 4; ++r) { const int row = rb * 64 + rbk * 16 + 4 * fq + r; const float gv = ga[r] * rstd_of(ssq_a + (size_t)row * 16) + gb;
                                gates[(size_t)row * 16 + fr] = SOFTCAP * tanhf(gv * (1.0f / SOFTCAP)); }
                        }
                        __syncthreads();
                    }
                }
                pg8::Gemm g{xb, Win_t + (size_t)slot * NQKVO * D}; pg8::Order S; S.init(M, NQKVO, G, bid, ssq_a, rtab);
                pg8::EpiProj E{BIG, rtab};
                pg8::gemm_phase<pg8::EpiProj, true, D, D, D, 0>(lds + RING_OFF, g, S, E);
            }
            END_PH_X();
            if (IN_PH()) for (int rep_ = 0; rep_ < REPS(); ++rep_) { BEGIN_PH();
                LAS unsigned char* kimg = lds;
                LAS unsigned char* vimg = lds + 49152;
                LAS float* wtab = (LAS float*)(lds + TAB_OFF);
                const int hh = lane >> 5, l31 = lane & 31, g16 = (lane >> 4) & 1, q4 = (lane & 15) >> 2, p4 = lane & 3;
                const int troffK = (8 * hh + q4) * 192 + (16 * g16 + 4 * p4) * 2, troffV = (8 * hh + q4) * 320 + (16 * g16 + 4 * p4) * 2;
                bf16x8 a_one; { const short o = (l31 == 0) ? (short)0x3F80 : (short)0; for (int j = 0; j < 8; ++j) a_one[j] = o; }
                const int vt = wave >> 1, dt = wave & 1;
                for (int item = it0; item < itn; item += its) {
                    const int b = item >> 6, h = (item >> 3) & 7, blk = item & 7, row0 = b * SEQ + blk * BLK;
                    __syncthreads();
                    { float lf[4], ig[4];
#pragma unroll
                      for (int e = 0; e < 4; ++e) { const float* gp = gates + (size_t)(row0 + 4 * lane + e) * 16; lf[e] = log_sigmoidf(gp[8 + h]); ig[e] = gp[h]; }
                      const float p0 = lf[0], p1 = p0 + lf[1], p2 = p1 + lf[2], p3 = p2 + lf[3];
                      float sc = p3;
#pragma unroll
                      for (int o = 1; o < 64; o <<= 1) { const float t = __shfl_up(sc, o); if (lane >= o) sc += t; }
                      const float ex = sc - p3, bl = __shfl(sc, 63);
                      if (wave == 0) { *(LAS f32x4*)(wtab + 4 * lane) = (f32x4){__expf(bl - (ex + p0) + ig[0]), __expf(bl - (ex + p1) + ig[1]), __expf(bl - (ex + p2) + ig[2]), __expf(bl - (ex + p3) + ig[3])};
                                       *(f32x4*)(GT + (size_t)item * 512 + 4 * lane) = (f32x4){ex + p0, ex + p1, ex + p2, ex + p3};
                                       *(f32x4*)(GT + (size_t)item * 512 + 256 + 4 * lane) = (f32x4){ig[0] - (ex + p0), ig[1] - (ex + p1), ig[2] - (ex + p2), ig[3] - (ex + p3)};
                                       if (lane == 0) decay[item] = __expf(bl); } }
#pragma unroll
                    for (int i = 0; i < 4; ++i) { const int id = i * NT + tid, r = id >> 3, ch = id & 7; *(LAS u32x4*)(kimg + r * 192 + ch * 16) = *(const u32x4*)(BIG + (size_t)(row0 + r) * NQKVO + 512 + h * DK + ch * 8); }
#pragma unroll
                    for (int i = 0; i < 8; ++i) { const int id = i * NT + tid, r = id >> 4, ch = id & 15; *(LAS u32x4*)(vimg + r * 320 + ch * 16) = *(const u32x4*)(BIG + (size_t)(row0 + r) * NQKVO + 1024 + h * DV + ch * 8); }
                    __syncthreads();
                    f32x16 acc = zero16(), accn = zero16();
#pragma unroll 4
                    for (int ks = 0; ks < 16; ++ks) {
                        const bf16x8 kf = tr_pair(kimg + troffK + ks * 16 * 192 + dt * 64, 4 * 192);
                        const f32x4 w0 = *(const LAS f32x4*)(wtab + 16 * ks + 8 * hh), w1 = *(const LAS f32x4*)(wtab + 16 * ks + 8 * hh + 4);
                        const u32x4 kb = __builtin_bit_cast(u32x4, kf);
                        u32x4 ksc; ksc.x = pack2(bflo(kb.x) * w0[0], bfhi(kb.x) * w0[1]); ksc.y = pack2(bflo(kb.y) * w0[2], bfhi(kb.y) * w0[3]);
                        ksc.z = pack2(bflo(kb.z) * w1[0], bfhi(kb.z) * w1[1]); ksc.w = pack2(bflo(kb.w) * w1[2], bfhi(kb.w) * w1[3]);
                        const bf16x8 kfs = __builtin_bit_cast(bf16x8, ksc);
                        const bf16x8 vf = tr_pair(vimg + troffV + ks * 16 * 320 + vt * 64, 4 * 320);
                        acc = MFMA32(kfs, vf, acc);
                        if (vt == 0) accn = MFMA32(kfs, a_one, accn);
                    }
                    bf16_t* st = ST + (size_t)item * STE;
#pragma unroll
                    for (int g4 = 0; g4 < 4; ++g4) { u32x2 pk; pk.x = pack2(acc[4 * g4], acc[4 * g4 + 1]); pk.y = pack2(acc[4 * g4 + 2], acc[4 * g4 + 3]);
                        *(u32x2*)(st + (size_t)(32 * vt + l31) * 64 + 32 * dt + 8 * g4 + 4 * hh) = pk; }
                    if (vt == 0 && l31 == 0) {
#pragma unroll
                        for (int g4 = 0; g4 < 4; ++g4) { u32x2 pk; pk.x = pack2(accn[4 * g4], accn[4 * g4 + 1]); pk.y = pack2(accn[4 * g4 + 2], accn[4 * g4 + 3]);
                            *(u32x2*)(st + 128 * 64 + 32 * dt + 8 * g4 + 4 * hh) = pk; }
                    }
                }
            }
            END_PH_X();
            if (IN_PH()) for (int rep_ = 0; rep_ < REPS(); ++rep_) { BEGIN_PH();
                LAS unsigned char* vimg = lds;
                LAS unsigned char* cimg = lds + 81920;
                LAS float* btab = (LAS float*)(lds + 100608);
                LAS float* ctab = btab + 256;
                const int st = (wave < 4) ? 7 - wave : wave - 4;
                for (int item = it0; item < itn; item += its) {
                    FRESH_TID();
                    const int hh = lane >> 5, l31 = lane & 31, g16 = (lane >> 4) & 1, q4 = (lane & 15) >> 2, p4 = lane & 3;
                    const int troff = (4 * hh + q4) * 320 + (16 * g16 + 4 * p4) * 2;
                    bf16x8 a_one; { const short o = (l31 == 0) ? (short)0x3F80 : (short)0; for (int j = 0; j < 8; ++j) a_one[j] = o; }
                    const int b = item >> 6, h = (item >> 3) & 7, blk = item & 7, row0 = b * SEQ + blk * BLK;
                    u32x4 vv[8];
#pragma unroll
                    for (int i = 0; i < 8; ++i) { const int id = i * NT + tid, r = id >> 4, ch = id & 15; vv[i] = *(const u32x4*)(BIG + (size_t)(row0 + r) * NQKVO + 1024 + h * DV + ch * 8); }
                    f32x4 tb = (f32x4){0.f, 0.f, 0.f, 0.f};
                    if (tid < 128) tb = *(const f32x4*)(GT + (size_t)item * 512 + 4 * tid);
                    u32x4 uu[2][7]; float dj[7];
#pragma unroll
                    for (int j = 0; j < 7; ++j) { dj[j] = 0.f; uu[0][j] = (u32x4){0u, 0u, 0u, 0u}; uu[1][j] = (u32x4){0u, 0u, 0u, 0u};
                        if (j < blk) { dj[j] = decay[item - blk + j]; const bf16_t* up = ST + (size_t)(item - blk + j) * STE + tid * 8; uu[0][j] = *(const u32x4*)up; uu[1][j] = *(const u32x4*)(up + NT * 8); } }
                    unsigned un[7];
#pragma unroll
                    for (int j = 0; j < 7; ++j) { un[j] = 0u; if (j < blk && tid < 32) un[j] = ((const unsigned*)(ST + (size_t)(item - blk + j) * STE + 8192))[tid]; }
                    __syncthreads();
#pragma unroll
                    for (int i = 0; i < 8; ++i) { const int id = i * NT + tid, r = id >> 4, ch = id & 15; *(LAS u32x4*)(vimg + r * 320 + ch * 16) = vv[i]; }
                    if (tid < 128) *(LAS f32x4*)(btab + 4 * tid) = tb;
#pragma unroll
                    for (int cc = 0; cc < 2; ++cc) { const int chunk = cc * NT + tid; float a8[8];
#pragma unroll
                        for (int e = 0; e < 8; ++e) a8[e] = 0.f;
#pragma unroll
                        for (int j = 0; j < 7; ++j) { const u32x4 u = uu[cc][j]; const float d = dj[j];
                            if (j < blk) {
                            a8[0] = d * a8[0] + bflo(u.x); a8[1] = d * a8[1] + bfhi(u.x); a8[2] = d * a8[2] + bflo(u.y); a8[3] = d * a8[3] + bfhi(u.y);
                            a8[4] = d * a8[4] + bflo(u.z); a8[5] = d * a8[5] + bfhi(u.z); a8[6] = d * a8[6] + bflo(u.w); a8[7] = d * a8[7] + bfhi(u.w); } }
                        u32x4 o; o.x = pack2(a8[0], a8[1]); o.y = pack2(a8[2], a8[3]); o.z = pack2(a8[4], a8[5]); o.w = pack2(a8[6], a8[7]);
                        *(LAS u32x4*)(cimg + (chunk >> 3) * 144 + (chunk & 7) * 16) = o; }
                    if (tid < 32) { float n0 = 0.f, n1 = 0.f;
#pragma unroll
                        for (int j = 0; j < 7; ++j) if (j < blk) { n0 = dj[j] * n0 + bflo(un[j]); n1 = dj[j] * n1 + bfhi(un[j]); }
                        *(LAS unsigned*)(cimg + 128 * 144 + tid * 4) = pack2(n0, n1); }
                    __syncthreads();
                    const float bs = btab[32 * st + l31], eb = __expf(bs);
                    bf16x8 qf[4];
                    { const bf16_t* qp = BIG + (size_t)(row0 + 32 * st + l31) * NQKVO + h * DK + 8 * hh;
#pragma unroll
                      for (int ks = 0; ks < 4; ++ks) qf[ks] = *(const bf16x8*)(qp + 16 * ks); }
                    u32x4 ov[8];
#pragma unroll
                    for (int i = 0; i < 8; ++i) { const int id = i * 64 + lane, rho = id >> 4, ch = id & 15; ov[i] = *(const u32x4*)(BIG + (size_t)(row0 + 32 * st + rho) * NQKVO + 2048 + h * DV + ch * 8); }
                    f32x16 acc[5];
#pragma unroll
                    for (int v5 = 0; v5 < 5; ++v5) acc[v5] = zero16();
                    bf16x8 kn[4];
                    { const bf16_t* kp = BIG + (size_t)(row0 + l31) * NQKVO + 512 + h * DK + 8 * hh;
#pragma unroll
                      for (int ks = 0; ks < 4; ++ks) kn[ks] = *(const bf16x8*)(kp + 16 * ks); }
                    for (int rt = 0; rt <= st; ++rt) {
                        f32x16 X = zero16();
#pragma unroll
                        for (int ks = 0; ks < 4; ++ks) X = MFMA32(kn[ks], qf[ks], X);
                        if (rt < st) { const bf16_t* kp = BIG + (size_t)(row0 + 32 * (rt + 1) + l31) * NQKVO + 512 + h * DK + 8 * hh;
#pragma unroll
                            for (int ks = 0; ks < 4; ++ks) kn[ks] = *(const bf16x8*)(kp + 16 * ks); }
#pragma unroll
                        for (int g4 = 0; g4 < 4; ++g4) {
                            const f32x4 cr = *(const LAS f32x4*)(ctab + 32 * rt + 8 * g4 + 4 * hh);
#pragma unroll
                            for (int e = 0; e < 4; ++e) { float pv = X[4 * g4 + e] * __expf(bs + cr[e]); if (rt == st && (8 * g4 + 4 * hh + e) > l31) pv = 0.f; X[4 * g4 + e] = pv; }
                        }
#pragma unroll
                        for (int sp = 0; sp < 2; ++sp) {
                            u32x4 pk; pk.x = pack2(X[8 * sp + 0], X[8 * sp + 1]); pk.y = pack2(X[8 * sp + 2], X[8 * sp + 3]); pk.z = pack2(X[8 * sp + 4], X[8 * sp + 5]); pk.w = pack2(X[8 * sp + 6], X[8 * sp + 7]);
                            const bf16x8 pf = __builtin_bit_cast(bf16x8, pk);
#pragma unroll
                            for (int v4 = 0; v4 < 4; ++v4) acc[v4] = MFMA32(tr_pair(vimg + troff + (32 * rt + 16 * sp) * 320 + v4 * 64, 8 * 320), pf, acc[v4]);
                            acc[4] = MFMA32(a_one, pf, acc[4]);
                        }
                    }
                    {   bf16x8 qs[4];
#pragma unroll
                        for (int ks = 0; ks < 4; ++ks) { const u32x4 qb = __builtin_bit_cast(u32x4, qf[ks]); u32x4 o; o.x = pack2(bflo(qb.x) * eb, bfhi(qb.x) * eb); o.y = pack2(bflo(qb.y) * eb, bfhi(qb.y) * eb);
                            o.z = pack2(bflo(qb.z) * eb, bfhi(qb.z) * eb); o.w = pack2(bflo(qb.w) * eb, bfhi(qb.w) * eb); qs[ks] = __builtin_bit_cast(bf16x8, o); }
#pragma unroll
                        for (int v5 = 0; v5 < 5; ++v5) {
                            const int vrow = (v5 < 4) ? 32 * v5 + l31 : 128;
#pragma unroll
                            for (int ks = 0; ks < 4; ++ks) {
                                u32x4 cf = *(const LAS u32x4*)(cimg + vrow * 144 + (16 * ks + 8 * hh) * 2);
                                if (v5 == 4 && l31 != 0) cf = (u32x4){0u, 0u, 0u, 0u};
                                acc[v5] = MFMA32(__builtin_bit_cast(bf16x8, cf), qs[ks], acc[v5]);
                            }
                        }
                    }
                    const float den = __shfl(acc[4][0], l31), dd = fmaxf(fabsf(den), 1.0f);
                    float ss = 0.f;
#pragma unroll
                    for (int v4 = 0; v4 < 4; ++v4)
#pragma unroll
                        for (int r = 0; r < 16; ++r) ss += acc[v4][r] * acc[v4][r];
                    ss += __shfl_xor(ss, 32);
                    const float idd = 1.0f / dd; const float scale = idd / sqrtf(ss * idd * idd * (1.0f / DV) + EPS);
                    __syncthreads();
                    LAS unsigned char* wl = vimg + wave * 8704;
#pragma unroll
                    for (int v4 = 0; v4 < 4; ++v4)
#pragma unroll
                        for (int g4 = 0; g4 < 4; ++g4) { u32x2 pk; pk.x = pack2(acc[v4][4 * g4] * scale, acc[v4][4 * g4 + 1] * scale); pk.y = pack2(acc[v4][4 * g4 + 2] * scale, acc[v4][4 * g4 + 3] * scale);
                            *(LAS u32x2*)(wl + l31 * 272 + (32 * v4 + 8 * g4 + 4 * hh) * 2) = pk; }
#pragma unroll
                    for (int i = 0; i < 8; ++i) { const int id = i * 64 + lane, rho = id >> 4, ch = id & 15;
                        const u32x4 hv = *(const LAS u32x4*)(wl + rho * 272 + ch * 16);
                        u32x4* op = (u32x4*)(BIG + (size_t)(row0 + 32 * st + rho) * NQKVO + 2048 + h * DV + ch * 8); const u32x4 o4 = ov[i];
                        u32x4 w4; w4.x = pack2(bflo(hv.x) * bflo(o4.x), bfhi(hv.x) * bfhi(o4.x)); w4.y = pack2(bflo(hv.y) * bflo(o4.y), bfhi(hv.y) * bfhi(o4.y));
                        w4.z = pack2(bflo(hv.z) * bflo(o4.z), bfhi(hv.z) * bfhi(o4.z)); w4.w = pack2(bflo(hv.w) * bflo(o4.w), bfhi(hv.w) * bfhi(o4.w));
                        *(LAS_REP_PTR(op, row0 + 32 * st + rho, h, ch)) = w4; }
                }
            }
            END_PH_X();
        }
        if (IN_PH()) for (int rep_ = 0; rep_ < REPS(); ++rep_) { BEGIN_PH();
            pg8::Order S; S.init(M, D, G, bid, nullptr, rtab);
            pg8::EpiRes E{xb, LAST_REP() ? xb : (bf16_t*)args.out, LAST_REP() ? ssq_b : (ssq_t*)(args.out + 8 * 1024 * 1024) + (size_t)rep_ * M * 16};
            if ((layer & 1) == 0) { pg8::Gemm g{BIG + 2048, Wout_t + (size_t)slot * D * D}; pg8::gemm_phase<pg8::EpiRes, true, NQKVO, D, D, 0>(lds + RING_OFF, g, S, E); }
            else {
                pg8::Unit u;
                for (int ui = 0; S.next(ui, u); ++ui) {
                    LAS float* hn = (LAS float*)lds;
                    LAS float* rsv = hn + 79 * 256;
                    const int gi = u.pn, w = 2 << gi, R0 = u.pm * 256, bb = R0 / SEQ, t0 = R0 % SEQ;
                    const int c16 = tid & 31, rp = tid >> 5;
                    const int c4 = tid & 63, tg = tid >> 6;
                    for (int tb = 0; tb < 4; ++tb) {
                        const int ts = t0 + 64 * tb;
                        __syncthreads();
                        if (tid < 79) { const int t = ts - 15 + tid; rsv[tid] = (t >= 0) ? rstd_of(ssq_a + (size_t)(bb * SEQ + t) * 16) : 0.f; }
                        u32x4 xv[5];
#pragma unroll
                        for (int ps = 0; ps < 5; ++ps) { const int rho = rp + 16 * ps, t = ts - 15 + rho; xv[ps] = (u32x4){0u, 0u, 0u, 0u};
                            if (rho < 79 && t >= 0) xv[ps] = *(const u32x4*)(xb + (size_t)(bb * SEQ + t) * D + 256 * gi + 8 * c16); }
                        __syncthreads();
#pragma unroll
                        for (int ps = 0; ps < 5; ++ps) { const int rho = rp + 16 * ps;
                            if (rho < 79) { const float r = rsv[rho]; LAS f32x4* dst = (LAS f32x4*)(hn + rho * 256 + 8 * c16);
                                dst[0] = (f32x4){bflo(xv[ps].x) * r, bfhi(xv[ps].x) * r, bflo(xv[ps].y) * r, bfhi(xv[ps].y) * r};
                                dst[1] = (f32x4){bflo(xv[ps].z) * r, bfhi(xv[ps].z) * r, bflo(xv[ps].w) * r, bfhi(xv[ps].w) * r}; } }
                        __syncthreads();
                        { const int tt0 = 8 * tg; f32x4 sw = (f32x4){0.f, 0.f, 0.f, 0.f};
                          for (int j = 1; j < w; ++j) sw += *(const LAS f32x4*)(hn + (15 + tt0 - j) * 256 + 4 * c4);
#pragma unroll
                          for (int tt = tt0; tt < tt0 + 8; ++tt) {
                              const f32x4 v = *(const LAS f32x4*)(hn + (15 + tt) * 256 + 4 * c4); sw += v;
                              const int tpos = ts + tt; const float inv = 1.0f / (float)((tpos + 1 < w) ? tpos + 1 : w);
                              u32x2 o; o.x = pack2(sw[0] * inv - v[0], sw[1] * inv - v[1]); o.y = pack2(sw[2] * inv - v[2], sw[3] * inv - v[3]);
                              *(u32x2*)(BIG + (size_t)(R0 + 64 * tb + tt) * D + 256 * gi + 4 * c4) = o;
                              sw -= *(const LAS f32x4*)(hn + (15 + tt - w + 1) * 256 + 4 * c4);
                          } }
                    }
                }
                VM_WAIT(); __syncthreads();
                pg8::Gemm g{BIG, Wpool_t + (size_t)slot * D * 256}; pg8::gemm_phase<pg8::EpiRes, true, D, 256, 256, 256>(lds + RING_OFF, g, S, E);
            }
        }
        END_PH_X();
        if (IN_PH()) for (int rep_ = 0; rep_ < REPS(); ++rep_) { BEGIN_PH();
            if (G == 256 && bid >= 128 && LAST_REP()) {
                const int lo_ = (layer == 0) ? CV_P0 : (layer == 1) ? CV_T0 : (layer == 2) ? CV_T1 : CV_T2, hi_ = (layer == 0) ? CV_T0 : (layer == 1) ? CV_T1 : (layer == 2) ? CV_T2 : CV_END;
                convert_items(args, ws, (LAS unsigned*)(lds + RING_OFF + wave * 8448), lane, lo_, hi_, (bid - 128) * NWAVES + wave, 128 * NWAVES);
                __syncthreads();
            }
            pg8::Gemm g{xb, Wgu_t + (size_t)layer * GU * D}; pg8::Order S; S.init(M, GU, G, bid, ssq_b, rtab); S.wgm = GU_WGM;
            pg8::EpiGU E{BIG, rtab};
            pg8::gemm_phase<pg8::EpiGU, true, D, D, D, 0>(lds + RING_OFF, g, S, E);
        }
        END_PH();
        if (IN_PH()) for (int rep_ = 0; rep_ < REPS(); ++rep_) { BEGIN_PH();
            pg8::Gemm g{BIG, Wdn_t + (size_t)layer * D * FF}; pg8::Order S; S.init(M, D, G, bid, nullptr, rtab);
            pg8::EpiRes E{xb, LAST_REP() ? xb : (bf16_t*)args.out, LAST_REP() ? ssq_c : (ssq_t*)(args.out + 8 * 1024 * 1024) + (size_t)rep_ * M * 16};
            pg8::gemm_phase<pg8::EpiRes, true, FF, FF, FF, 0>(lds + RING_OFF, g, S, E);
        }
        END_PH_X();
    }
    if (IN_PH()) for (int rep_ = 0; rep_ < REPS(); ++rep_) { BEGIN_PH();
        const int m0 = xmode ? xcc * SEQ + xrank * NWAVES + wave : bid * NWAVES + wave, ms = its * NWAVES, mn = xmode ? xcc * SEQ + SEQ : M;
        for (int m = m0; m < mn; m += ms) {
            const u32x4 a = ((const u32x4*)(xb + (size_t)m * D))[lane], b2 = ((const u32x4*)(xb + (size_t)m * D))[64 + lane];
            float v[16] = {bflo(a.x), bfhi(a.x), bflo(a.y), bfhi(a.y), bflo(a.z), bfhi(a.z), bflo(a.w), bfhi(a.w), bflo(b2.x), bfhi(b2.x), bflo(b2.y), bfhi(b2.y), bflo(b2.z), bfhi(b2.z), bflo(b2.w), bfhi(b2.w)};
            float sq = 0.f;
#pragma unroll
            for (int j = 0; j < 16; ++j) sq += v[j] * v[j];
            const float rs = 1.0f / sqrtf(wave_sum(sq) * (1.0f / D) + EPS);
#pragma unroll
            for (int hpart = 0; hpart < 2; ++hpart)
#pragma unroll
                for (int q = 0; q < 2; ++q) { const int col = hpart * 512 + lane * 8 + q * 4; const f32x4 gn = *(const f32x4*)(final_norm + col);
                    f32x4 o; o[0] = v[hpart * 8 + q * 4 + 0] * rs * gn[0]; o[1] = v[hpart * 8 + q * 4 + 1] * rs * gn[1]; o[2] = v[hpart * 8 + q * 4 + 2] * rs * gn[2]; o[3] = v[hpart * 8 + q * 4 + 3] * rs * gn[3];
                    *(f32x4*)(args.out + (size_t)m * D + col) = o; }
        }
    }
#undef IN_PH
#undef END_PH
}

extern "C" void kernel_launch(void* const* d_in, const int* in_sizes, int n_in, void* d_out, int out_size, void* d_ws, size_t ws_size, hipStream_t stream) {
    static int grid = 0;
    if (grid == 0) {
        if (n_in != 12 || in_sizes[0] != M * D || out_size != M * D || ws_size < WS_END) { fprintf(stderr, "kernel_launch: unexpected shapes / workspace (n_in %d, ws %zu, need %zu)\n", n_in, ws_size, (size_t)WS_END); grid = -1; return; }
        int dev = 0, cus = 0, per_cu = 0;
        if (hipGetDevice(&dev) != hipSuccess || hipDeviceGetAttribute(&cus, hipDeviceAttributeMultiprocessorCount, dev) != hipSuccess) { grid = -1; return; }
        if (hipFuncSetAttribute((const void*)fwd_kernel, hipFuncAttributeMaxDynamicSharedMemorySize, LDS_BYTES) != hipSuccess) { fprintf(stderr, "kernel_launch: hipFuncSetAttribute failed\n"); grid = -1; return; }
        if (hipOccupancyMaxActiveBlocksPerMultiprocessor(&per_cu, (const void*)fwd_kernel, NT, LDS_BYTES) != hipSuccess || per_cu < 1) { fprintf(stderr, "kernel_launch: occupancy query says %d blocks per CU\n", per_cu); grid = -1; (void)hipGetLastError(); return; }
        grid = cus;
    }
    if (grid < 0) return;
    Args a{};
    for (int i = 0; i < 12; ++i) a.in[i] = (const float*)d_in[i];
    a.out = (float*)d_out; a.ws = (unsigned char*)d_ws;
#if MK_N_LAUNCHES == 1
    (void)hipMemsetAsync((char*)d_ws + WS_CTL, 0, CTL_ZERO_BYTES, stream);
    a.ph_lo = 0; a.ph_hi = N_PHASES;
    void* kargs[] = {&a};
    hipError_t e = hipLaunchCooperativeKernel((const void*)fwd_kernel, dim3(grid), dim3(NT), kargs, LDS_BYTES, stream);
    if (e != hipSuccess) fprintf(stderr, "cooperative launch failed: %s (grid %d)\n", hipGetErrorString(e), grid);
#else
    for (int p = 0; p < N_PHASES; ++p) {
        a.ph_lo = p; a.ph_hi = p + 1;
        hipLaunchKernelGGL(fwd_kernel, dim3(grid), dim3(NT), LDS_BYTES, stream, a);
    }
#endif
}
```

```cpp
#include <hip/hip_runtime.h>
#include <cstdio>
#include <cstdint>

#ifndef MK_N_LAUNCHES
#define MK_N_LAUNCHES 1
#endif

#ifndef PROBE_PH
#define PROBE_PH (-1)
#endif
#define PROBE_REP 3
#define GU_WGM 8
#define PROBE_BARS 0

#define LAS __attribute__((address_space(3)))
typedef unsigned short bf16_t;
typedef short bf16x8 __attribute__((ext_vector_type(8)));
typedef float f32x4 __attribute__((ext_vector_type(4)));
typedef float f32x2 __attribute__((ext_vector_type(2)));
typedef unsigned u32x4 __attribute__((ext_vector_type(4)));
typedef unsigned u32x2 __attribute__((ext_vector_type(2)));
typedef int i32x4 __attribute__((ext_vector_type(4)));
typedef float ssq_t;
__device__ __forceinline__ float ssq_val(const ssq_t* p) { const f32x4* q = (const f32x4*)p; const f32x4 a = q[0], b = q[1], c = q[2], d = q[3];
    return ((a[0] + a[1]) + (a[2] + a[3])) + ((b[0] + b[1]) + (b[2] + b[3])) + ((c[0] + c[1]) + (c[2] + c[3])) + ((d[0] + d[1]) + (d[2] + d[3])); }

constexpr int BATCH = 8, SEQ = 2048, D = 1024, DEPTH = 4, M = BATCH * SEQ;
constexpr int NH = 8, DK = 64, DV = 128, NQKVO = 3072, NIN = 3088, FF = 2816, GU = 2 * FF, CH = 64, NCH = SEQ / CH;
constexpr int BLK = 256, NBLK = BATCH * NH * (SEQ / BLK);
constexpr int NITEM = NBLK;
constexpr int STE = (DV + 1) * DK;
constexpr float EPS = 1e-6f, SOFTCAP = 15.0f;

__device__ __forceinline__ unsigned cvt_pk_bf16(float lo, float hi) { unsigned r; asm volatile("v_cvt_pk_bf16_f32 %0, %1, %2" : "=v"(r) : "v"(lo), "v"(hi)); return r; }
__device__ __forceinline__ float bf2f(unsigned short u) { return __uint_as_float((unsigned)u << 16); }
__device__ __forceinline__ float bflo(unsigned u) { return __uint_as_float(u << 16); }
__device__ __forceinline__ float bfhi(unsigned u) { return __uint_as_float(u & 0xffff0000u); }
__device__ __forceinline__ unsigned short f2bf(float f) { unsigned u = __float_as_uint(f); return (unsigned short)((u + 0x7fffu + ((u >> 16) & 1u)) >> 16); }


typedef short s16x4 __attribute__((ext_vector_type(4)));
typedef float f32x16 __attribute__((ext_vector_type(16)));
__device__ __forceinline__ unsigned pack2(float a, float b) { typedef __bf16 bf2 __attribute__((ext_vector_type(2))); f32x2 v = {a, b}; bf2 r = __builtin_convertvector(v, bf2); return __builtin_bit_cast(unsigned, r); }
__device__ __forceinline__ bf16x8 tr_pair(LAS unsigned char* p, int delta) {
    const s16x4 lo = __builtin_amdgcn_ds_read_tr16_b64_v4i16((LAS s16x4*)p), hi = __builtin_amdgcn_ds_read_tr16_b64_v4i16((LAS s16x4*)(p + delta));
    return __builtin_shufflevector(lo, hi, 0, 1, 2, 3, 4, 5, 6, 7);
}
#define MFMA32(a, b, c) __builtin_amdgcn_mfma_f32_32x32x16_bf16((a), (b), (c), 0, 0, 0)
__device__ __forceinline__ f32x16 zero16() { f32x16 z; for (int i = 0; i < 16; ++i) z[i] = 0.f; return z; }

namespace pg8 {
constexpr int BM = 256, BK = 64, HALF = 128, HTB = HALF * BK * 2, STAGE_BYTES = 8 * HTB, NXCD = 8, WGM = 8;
__host__ __device__ __forceinline__ int lds_byte(int r, int c) { const int st = (r >> 4) * 2 + (c >> 5), rr = r & 15, cc = c & 31, ob = rr * 64 + cc * 2; return st * 1024 + (ob ^ (((ob >> 9) & 1) << 5)); }
__host__ __device__ __forceinline__ void stage_rc(int b, int& R, int& C) { const int st = b / 1024, sb = b % 1024, swz = sb ^ (((sb >> 9) & 1) << 5); R = (st >> 1) * 16 + swz / 64; C = (st & 1) * 32 + (swz % 64) / 2; }
__host__ __device__ __forceinline__ int perm32(int rho) { const int n = rho >> 4, i = rho & 15; return 8 * (i >> 2) + 4 * n + (i & 3); }

struct Unit { int pm, pn, idx, hm; };
struct Gemm { const bf16_t* A; const bf16_t* Bt; };

struct Order {
    int nM, nN, nwg, G, c, nsplit, wgm;
    const ssq_t* ssq;
    LAS float* tab;
    const float* rowscale;
    __device__ __forceinline__ void init(int M_, int N, int G_, int c_, const ssq_t* ssq_, LAS float* tab_) { nM = M_ / BM; nN = N / BM; nwg = nM * nN; G = G_; c = c_; ssq = ssq_; tab = tab_; nsplit = 0; wgm = WGM; rowscale = nullptr; }
    __device__ __forceinline__ void split_tail(int ns) { if (G == 256 && nM == 64 && ns == 2) { nsplit = ns; nN -= ns; nwg = nM * nN; } }
    __device__ __forceinline__ bool next(int i, Unit& u) const {
        const long L = (long)i * G + c;
        const bool tail = L >= nwg;
        if (tail && (nsplit == 0 || L >= nwg + G)) return false;
        int wgid = tail ? 0 : (int)L; { const int q = nwg / NXCD, r = nwg % NXCD, xcd = wgid % NXCD, off = wgid / NXCD; wgid = (xcd < r ? xcd * (q + 1) : r * (q + 1) + (xcd - r) * q) + off; }
        const int nig = wgm * nN, gid = wgid / nig, fm = gid * wgm, gsz = (nM - fm) < wgm ? (nM - fm) : wgm;
        const int x = c & 7, j = c >> 3;
        const int pm = tail ? 8 * x + (j & 7) : fm + ((wgid % nig) % gsz);
        const int pn = tail ? nN + ((j >> 3) & 1) : (wgid % nig) / gsz;
        const int hm = tail ? (j >> 4) : -1;
        u.pm = pm; u.pn = pn; u.idx = i; u.hm = hm; return true;
    }
    __device__ __forceinline__ void a_ready(const Unit& u) const {
        int t_ = threadIdx.x; asm volatile("" : "+v"(t_));
        if (rowscale != nullptr) { if (t_ < 256) tab[(u.idx & 1) * 256 + t_] = rowscale[u.pm * BM + (u.hm > 0 ? HALF : 0) + t_]; }
        else if (ssq != nullptr && t_ < 256) {
            const float s = ssq_val(ssq + (size_t)(u.pm * BM + (u.hm > 0 ? HALF : 0) + t_) * 16);
            tab[(u.idx & 1) * 256 + t_] = __builtin_amdgcn_rsqf(s * (1.0f / D) + EPS);
        }
    }
    __device__ __forceinline__ void done(const Unit&) const {}
};

__device__ __forceinline__ float sigmoidf_fast(float x) { return __builtin_amdgcn_rcpf(1.0f + __expf(-x)); }

struct EpiProj {
    static constexpr bool PERM = true, HAS_INIT = false;
    bf16_t* O; const LAS float* tab;
    __device__ __forceinline__ void operator()(const f32x4 (&acc)[2][2][4][2], const Unit& u, int wr, int wc, int fr, int fq) const {
        const LAS float* t = tab + (u.idx & 1) * 256;
        const bool sig = u.pn >= 8;
        const int row0 = u.pm * BM + wr * 64 + fr, col0 = u.pn * BM + wc * 32 + 8 * fq;
#pragma unroll
        for (int ai = 0; ai < 2; ++ai)
#pragma unroll
            for (int m = 0; m < 4; ++m) {
                const float rs = t[ai * HALF + wr * 64 + m * 16 + fr];
                bf16_t* rowp = O + (size_t)(row0 + ai * HALF + m * 16) * NQKVO + col0;
#pragma unroll
                for (int bj = 0; bj < 2; ++bj) {
                    f32x4 v0 = acc[ai][bj][m][0] * rs, v1 = acc[ai][bj][m][1] * rs;
                    if (sig) {
#pragma unroll
                        for (int i = 0; i < 4; ++i) { v0[i] = sigmoidf_fast(v0[i]); v1[i] = sigmoidf_fast(v1[i]); }
                    }
                    u32x4 w; w.x = cvt_pk_bf16(v0[0], v0[1]); w.y = cvt_pk_bf16(v0[2], v0[3]); w.z = cvt_pk_bf16(v1[0], v1[1]); w.w = cvt_pk_bf16(v1[2], v1[3]);
                    *(u32x4*)(rowp + bj * HALF) = w;
                }
            }
    }
};
struct EpiGU {
    static constexpr bool PERM = true, HAS_INIT = false;
    bf16_t* H; const LAS float* tab;
    __device__ __forceinline__ void operator()(const f32x4 (&acc)[2][2][4][2], const Unit& u, int wr, int wc, int fr, int fq) const {
        const LAS float* t = tab + (u.idx & 1) * 256;
        const int row0 = u.pm * BM + (u.hm > 0 ? HALF : 0) + wr * 64 + fr, col0 = u.pn * HALF + wc * 32 + 8 * fq;
#pragma unroll
        for (int ai = 0; ai < 2; ++ai) { if (ai == 1 && u.hm >= 0) break;
#pragma unroll
            for (int m = 0; m < 4; ++m) {
                const float rs = t[ai * HALF + wr * 64 + m * 16 + fr];
                const float c1 = rs * -1.4426950408889634f, rs2 = rs * rs;
                float hv[8];
#pragma unroll
                for (int n = 0; n < 2; ++n)
#pragma unroll
                    for (int i = 0; i < 4; ++i) { const float g = acc[ai][0][m][n][i], uu = acc[ai][1][m][n][i]; hv[n * 4 + i] = (g * uu) * (rs2 * __builtin_amdgcn_rcpf(1.0f + __builtin_amdgcn_exp2f(g * c1))); }
                u32x4 w; w.x = cvt_pk_bf16(hv[0], hv[1]); w.y = cvt_pk_bf16(hv[2], hv[3]); w.z = cvt_pk_bf16(hv[4], hv[5]); w.w = cvt_pk_bf16(hv[6], hv[7]);
                *(u32x4*)(H + (size_t)(row0 + ai * HALF + m * 16) * FF + col0) = w;
            }
        }
    }
};
struct EpiGU8 {
    static constexpr bool PERM = true, HAS_INIT = false;
    bf16_t* H; const LAS float* tab; const float* colscale;
    __device__ __forceinline__ void operator()(const i32x4 (&acc)[2][2][4][2], const Unit& u, int wr, int wc, int fr, int fq) const {
        const LAS float* t = tab + (u.idx & 1) * 256;
        const int row0 = u.pm * BM + wr * 64 + fr, col0 = u.pn * HALF + wc * 32 + 8 * fq;
        const float* cs = colscale + u.pn * BM + wc * 32 + 8 * fq;
        const f32x4 sg0 = *(const f32x4*)cs, sg1 = *(const f32x4*)(cs + 4), su0 = *(const f32x4*)(cs + HALF), su1 = *(const f32x4*)(cs + HALF + 4);
#pragma unroll
        for (int ai = 0; ai < 2; ++ai)
#pragma unroll
            for (int m = 0; m < 4; ++m) {
                const float rs = t[ai * HALF + wr * 64 + m * 16 + fr];
                float hv[8];
#pragma unroll
                for (int n = 0; n < 2; ++n)
#pragma unroll
                    for (int i = 0; i < 4; ++i) { const float g = (float)acc[ai][0][m][n][i] * (rs * (n ? sg1[i] : sg0[i])), uu = (float)acc[ai][1][m][n][i] * (rs * (n ? su1[i] : su0[i]));
                        hv[n * 4 + i] = (g * uu) * __builtin_amdgcn_rcpf(1.0f + __builtin_amdgcn_exp2f(g * -1.4426950408889634f)); }
                u32x4 w; w.x = cvt_pk_bf16(hv[0], hv[1]); w.y = cvt_pk_bf16(hv[2], hv[3]); w.z = cvt_pk_bf16(hv[4], hv[5]); w.w = cvt_pk_bf16(hv[6], hv[7]);
                *(u32x4*)(H + (size_t)(row0 + ai * HALF + m * 16) * FF + col0) = w;
            }
    }
};
struct EpiRes {
    static constexpr bool PERM = true, HAS_INIT = true;
    bf16_t* xb; bf16_t* xo; ssq_t* ssq_out;
    __device__ __forceinline__ void init_load(u32x4 (&t)[2][4][2], const Unit& u, int wr, int wc, int fr, int fq) const {
        const int row0 = u.pm * BM + wr * 64 + fr, col0 = u.pn * BM + wc * 32 + 8 * fq;
#pragma unroll
        for (int ai = 0; ai < 2; ++ai)
#pragma unroll
            for (int m = 0; m < 4; ++m)
#pragma unroll
                for (int bj = 0; bj < 2; ++bj) t[ai][m][bj] = *(const u32x4*)(xb + (size_t)(row0 + ai * HALF + m * 16) * D + col0 + bj * HALF);
    }
    __device__ __forceinline__ void init_cvt(f32x4 (&acc)[2][2][4][2], const u32x4 (&t)[2][4][2]) const {
#pragma unroll
        for (int ai = 0; ai < 2; ++ai)
#pragma unroll
            for (int m = 0; m < 4; ++m)
#pragma unroll
                for (int bj = 0; bj < 2; ++bj) { const u32x4 v = t[ai][m][bj];
                    acc[ai][bj][m][0] = (f32x4){bflo(v.x), bfhi(v.x), bflo(v.y), bfhi(v.y)}; acc[ai][bj][m][1] = (f32x4){bflo(v.z), bfhi(v.z), bflo(v.w), bfhi(v.w)}; }
    }
    __device__ __forceinline__ void init(f32x4 (&acc)[2][2][4][2], const Unit& u, int wr, int wc, int fr, int fq) const { u32x4 t[2][4][2]; init_load(t, u, wr, wc, fr, fq); init_cvt(acc, t); }
    __device__ __forceinline__ void operator()(const f32x4 (&acc)[2][2][4][2], const Unit& u, int wr, int wc, int fr, int fq) const {
        const int row0 = u.pm * BM + wr * 64 + fr, col0 = u.pn * BM + wc * 32 + 8 * fq;
#pragma unroll
        for (int ai = 0; ai < 2; ++ai)
#pragma unroll
            for (int m = 0; m < 4; ++m) {
                const int row = row0 + ai * HALF + m * 16; float ss = 0.f;
#pragma unroll
                for (int bj = 0; bj < 2; ++bj) {
                    const f32x4 v0 = acc[ai][bj][m][0], v1 = acc[ai][bj][m][1];
                    u32x4 w; w.x = cvt_pk_bf16(v0[0], v0[1]); w.y = cvt_pk_bf16(v0[2], v0[3]); w.z = cvt_pk_bf16(v1[0], v1[1]); w.w = cvt_pk_bf16(v1[2], v1[3]);
                    *(u32x4*)(xo + (size_t)row * D + col0 + bj * HALF) = w;
                    ss += ((v0[0] * v0[0] + v0[1] * v0[1]) + (v0[2] * v0[2] + v0[3] * v0[3])) + ((v1[0] * v1[0] + v1[1] * v1[1]) + (v1[2] * v1[2] + v1[3] * v1[3]));
                }
                ss += __shfl_xor(ss, 16); ss += __shfl_xor(ss, 32);
                if (fq == 0) ssq_out[(size_t)row * 16 + u.pn * 4 + wc] = ss;
            }
    }
};

template <bool I8> struct AccOf { typedef f32x4 type; };
template <> struct AccOf<true> { typedef i32x4 type; };
template <bool I8> __device__ __forceinline__ typename AccOf<I8>::type mma16(const bf16x8& b, const bf16x8& a, typename AccOf<I8>::type c) {
    if constexpr (I8) return __builtin_amdgcn_mfma_i32_16x16x64_i8(__builtin_bit_cast(i32x4, b), __builtin_bit_cast(i32x4, a), c, 0, 0, 0);
    else return __builtin_amdgcn_mfma_f32_16x16x32_bf16(b, a, c, 0, 0, 0);
}
template <class Epi, bool ALIGN_EPI, int LDA, int LDB, int KLEN, int ACOL, bool HALFU = false, bool I8 = false>
__device__ __forceinline__ void gemm_phase(LAS unsigned char* lds, const Gemm g, const Order& S, const Epi& E) {
    int tid_ = threadIdx.x; asm volatile("" : "+v"(tid_));
    const int tid = tid_, wid = __builtin_amdgcn_readfirstlane(tid >> 6), lane = tid & 63, wr = wid >> 2, wc = wid & 3, fr = lane & 15, fq = lane >> 4;
    constexpr int nt = KLEN / BK;
    unsigned voffA[2], voffB[2];
#pragma unroll
    for (int i = 0; i < 2; ++i) {
        const int R = i * 64 + (tid >> 3), C = 8 * ((tid & 7) ^ ((R >> 1) & 7)); const int Rb = Epi::PERM ? ((R & ~31) + perm32(R & 31)) : R;
        voffA[i] = (unsigned)(R * LDA + C) * 2u; voffB[i] = (unsigned)(Rb * LDB + C) * 2u; }
    constexpr size_t kstep = (size_t)(BK * 2);
    constexpr size_t hstepA = (size_t)HALF * LDA * 2, tstepA = 2 * hstepA, hstepB = (size_t)HALF * LDB * 2, tstepB = 2 * hstepB;
    constexpr size_t pnstepA = (size_t)ACOL * 2;
    const unsigned ldsw = (unsigned)wid * 1024u;
    const int sw0 = 16 * (fq ^ ((fr >> 1) & 7)), aoff0 = (wr * 64 + fr) * 128 + sw0, aoff1 = aoff0 ^ 64, boff0 = (wc * 32 + fr) * 128 + sw0, boff1 = boff0 ^ 64;
#define PG8_SA(b, h) (((b) * 2 + (h)) * HTB)
#define PG8_SB(b, h) ((4 + (b) * 2 + (h)) * HTB)
#define PG8_STAGE(bufoff, gbase, voff) do { _Pragma("unroll") for (int _i = 0; _i < 2; ++_i) \
        __builtin_amdgcn_global_load_lds((const unsigned*)((const char*)(gbase) + (voff)[_i]), (LAS unsigned*)(lds + (bufoff) + ldsw + _i * 8192), 16, 0, 0); } while (0)
#define PG8_LDA(dst, b, h) do { _Pragma("unroll") for (int m = 0; m < 4; ++m) _Pragma("unroll") for (int k = 0; k < 2; ++k) dst[m][k] = *(const LAS bf16x8*)(lds + PG8_SA(b, h) + (k ? aoff1 : aoff0) + m * 2048); } while (0)
#define PG8_LDB(dst, b, h) do { _Pragma("unroll") for (int n = 0; n < 2; ++n) _Pragma("unroll") for (int k = 0; k < 2; ++k) dst[n][k] = *(const LAS bf16x8*)(lds + PG8_SB(b, h) + (k ? boff1 : boff0) + n * 2048); } while (0)
#define PG8_MMA(ai, bj, At, Bt) do { __builtin_amdgcn_s_setprio(1); _Pragma("unroll") for (int m = 0; m < 4; ++m) _Pragma("unroll") for (int n = 0; n < 2; ++n) _Pragma("unroll") for (int k = 0; k < 2; ++k) \
        acc[ai][bj][m][n] = mma16<I8>(Bt[n][k], At[m][k], acc[ai][bj][m][n]); __builtin_amdgcn_s_setprio(0); } while (0)
#define PG8_WAIT_V(n) asm volatile("s_waitcnt vmcnt(" #n ")" ::: "memory")
#define PG8_WAIT_L(n) asm volatile("s_waitcnt lgkmcnt(" #n ")" ::: "memory")
#define PG8_BAR __builtin_amdgcn_s_barrier()
#define PG8_SCHED __builtin_amdgcn_sched_barrier(0)
    Unit cur, nxt; int ui = 0;
    if (!S.next(0, cur)) return;
    typedef typename AccOf<I8>::type acc_t;
    acc_t acc[2][2][4][2];
    u32x4 xt[Epi::HAS_INIT ? 2 : 1][4][2];
    if constexpr (Epi::HAS_INIT) E.init_load(xt, cur, wr, wc, fr, fq);
    else {
#pragma unroll
    for (int a = 0; a < 2; ++a)
#pragma unroll
        for (int b = 0; b < 2; ++b)
#pragma unroll
            for (int m = 0; m < 4; ++m)
#pragma unroll
                for (int n = 0; n < 2; ++n) acc[a][b][m][n] = acc_t{};
    }
    bf16x8 At[4][2], B0[2][2], B1[2][2];
    const char* cA = (const char*)g.A + (size_t)cur.pm * tstepA + (size_t)cur.pn * pnstepA + ((HALFU && cur.hm > 0) ? hstepA : 0); const char* cB = (const char*)g.Bt + (size_t)cur.pn * tstepB;
    S.a_ready(cur);
    PG8_STAGE(PG8_SB(0, 0), cB, voffB); PG8_STAGE(PG8_SB(0, 1), cB + hstepB, voffB); PG8_STAGE(PG8_SA(0, 0), cA, voffA); PG8_STAGE(PG8_SA(0, 1), cA + hstepA, voffA);
    if constexpr (Epi::HAS_INIT) E.init_cvt(acc, xt);
    if (wr == 1) PG8_BAR;
    PG8_WAIT_V(2); PG8_BAR;
    PG8_STAGE(PG8_SB(1, 0), cB + kstep, voffB); PG8_STAGE(PG8_SA(1, 0), cA + kstep, voffA); PG8_STAGE(PG8_SB(1, 1), cB + hstepB + kstep, voffB);
    PG8_WAIT_V(6); PG8_BAR;
    for (;;) {
        const bool has_next = S.next(ui + 1, nxt);
        const char* nA = has_next ? (const char*)g.A + (size_t)nxt.pm * tstepA + (size_t)nxt.pn * pnstepA + ((HALFU && nxt.hm > 0) ? hstepA : 0) : cA;
        const bool full = !HALFU || cur.hm < 0;
        const char* nB = has_next ? (const char*)g.Bt + (size_t)nxt.pn * tstepB : cB;
#pragma unroll 1
        for (int t = 0; t < nt; t += 2) {
            const bool last = (t == nt - 2);
            const char* a1 = cA + (size_t)(t + 1) * kstep;
            const char* a2 = last ? nA : cA + (size_t)(t + 2) * kstep; const char* b2 = last ? nB : cB + (size_t)(t + 2) * kstep;
            const char* a3 = a2 + kstep; const char* b3 = b2 + kstep;
            if (last && has_next) S.a_ready(nxt);
            PG8_LDB(B0, 0, 0); PG8_LDB(B1, 0, 1); PG8_SCHED; PG8_LDA(At, 0, 0); PG8_STAGE(PG8_SA(1, 1), a1 + hstepA, voffA);
            PG8_WAIT_V(8); PG8_WAIT_L(0); PG8_BAR; PG8_MMA(0, 0, At, B0); PG8_MMA(0, 1, At, B1); PG8_BAR; PG8_SCHED;
            PG8_LDA(At, 0, 1); PG8_STAGE(PG8_SB(0, 0), b2, voffB); PG8_STAGE(PG8_SB(0, 1), b2 + hstepB, voffB); PG8_STAGE(PG8_SA(0, 0), a2, voffA);
            PG8_WAIT_V(8); PG8_WAIT_L(0); PG8_BAR; if (full) { PG8_MMA(1, 0, At, B0); PG8_MMA(1, 1, At, B1); } PG8_BAR; PG8_SCHED;
            PG8_LDB(B0, 1, 0); PG8_LDB(B1, 1, 1); PG8_SCHED; PG8_LDA(At, 1, 0); PG8_STAGE(PG8_SA(0, 1), a2 + hstepA, voffA);
            PG8_WAIT_V(8); PG8_WAIT_L(0); PG8_BAR; PG8_MMA(0, 0, At, B0); PG8_MMA(0, 1, At, B1); PG8_BAR; PG8_SCHED;
            PG8_LDA(At, 1, 1); PG8_STAGE(PG8_SB(1, 0), b3, voffB); PG8_STAGE(PG8_SB(1, 1), b3 + hstepB, voffB); PG8_STAGE(PG8_SA(1, 0), a3, voffA);
            PG8_WAIT_V(8); PG8_WAIT_L(0); PG8_BAR; if (full) { PG8_MMA(1, 0, At, B0); PG8_MMA(1, 1, At, B1); } PG8_BAR; PG8_SCHED;
        }
        if constexpr (ALIGN_EPI) { if (wr == 0) PG8_BAR; }
        E(acc, cur, wr, wc, fr, fq);
#if defined(PROBE_EPI2)
        E(acc, cur, wr, wc, fr, fq); E(acc, cur, wr, wc, fr, fq);
#endif
        S.done(cur);
        if (!has_next) break;
        if constexpr (Epi::HAS_INIT) E.init(acc, nxt, wr, wc, fr, fq);
        else {
#pragma unroll
        for (int a = 0; a < 2; ++a)
#pragma unroll
            for (int b = 0; b < 2; ++b)
#pragma unroll
                for (int m = 0; m < 4; ++m)
#pragma unroll
                    for (int n = 0; n < 2; ++n) acc[a][b][m][n] = acc_t{};
        }
        cur = nxt; cA = nA; cB = nB; ++ui;
        if constexpr (ALIGN_EPI) { if (wr == 1) PG8_BAR; }
    }
    PG8_WAIT_V(0);
    if constexpr (!ALIGN_EPI) { if (wr == 0) PG8_BAR; }
    PG8_BAR;
#undef PG8_SA
#undef PG8_SB
#undef PG8_STAGE
#undef PG8_LDA
#undef PG8_LDB
#undef PG8_MMA
#undef PG8_WAIT_V
#undef PG8_WAIT_L
#undef PG8_BAR
#undef PG8_SCHED
}
}

constexpr size_t MiB = 1u << 20;
constexpr size_t WS_CTL = 0, CTL_ZERO_BYTES = 1 * MiB;
constexpr size_t SZ_WIN = (size_t)NQKVO * D * 2, SZ_WOUT = (size_t)D * D * 2, SZ_WPOOL = (size_t)D * 256 * 2, SZ_WGU = (size_t)GU * D * 2, SZ_WDN = (size_t)D * FF * 2, SZ_WG = (size_t)16 * D * 2;
constexpr size_t WS_WIN = 1 * MiB;
constexpr size_t WS_WOUT = WS_WIN + 2 * SZ_WIN;
constexpr size_t WS_WPOOL = WS_WOUT + 2 * SZ_WOUT;
constexpr size_t WS_WGU = WS_WPOOL + 2 * SZ_WPOOL;
constexpr size_t WS_WDN = WS_WGU + 4 * SZ_WGU;
constexpr size_t WS_WG = WS_WDN + 4 * SZ_WDN;
constexpr size_t WS_SSQ = WS_WG + 2 * SZ_WG;
constexpr size_t SZ_SSQ = (size_t)M * 16 * 4;
constexpr size_t WS_GATES = WS_SSQ + 9 * SZ_SSQ;
constexpr size_t WS_DECAY = WS_GATES + (size_t)M * 16 * 4;
constexpr size_t WS_GT = WS_DECAY + 4096;
constexpr size_t WS_XB = ((WS_GT + (size_t)512 * 512 * 4 + MiB - 1) / MiB) * MiB;
constexpr size_t WS_BIG = WS_XB + (size_t)M * D * 2;
constexpr size_t WS_ST = WS_BIG + (size_t)M * NQKVO * 2;
constexpr size_t WS_A8 = ((WS_ST + (size_t)NITEM * STE * 2 + 4095) / 4096) * 4096;
constexpr size_t WS_RS8 = WS_A8 + (size_t)M * D;
constexpr size_t WS_SB = WS_RS8 + (size_t)M * 4;
constexpr size_t WS_END = WS_SB + (size_t)4 * GU * 4;
static_assert(WS_END <= 352 * MiB, "d_ws map must fit the guaranteed workspace");
static_assert((size_t)M * FF * 2 <= (size_t)M * NQKVO * 2, "H overlays q|k|v|o");

constexpr int CW_BAR = 4096;
constexpr int CW_CENSUS = 8192;
constexpr int CW_XL_SUB = 9216, CW_XL_GEN = 10240;
constexpr int RING_OFF = 0, RING_BYTES = 131072;
constexpr int LDSCTL_OFF = RING_BYTES, MISC_OFF = LDSCTL_OFF + 320;
constexpr int RSTD_OFF = RING_BYTES + 1024;
constexpr int TAB_OFF = RING_BYTES + 3072;
constexpr int LDS_BYTES = 147456;
constexpr int NWAVES = 8, NT = NWAVES * 64;

#define VM_WAIT() asm volatile("s_waitcnt vmcnt(0)" ::: "memory")
#define LDS_WAIT() asm volatile("s_waitcnt lgkmcnt(0)" ::: "memory")

#define XB_TMO      128
#define XB_XCNT(j)  (256  + 64 * (j))
#define XB_XSUB(j)  (1280 + 64 * (j))
#define XB_XGEN(j)  (2304 + 64 * (j))
#define XB_TOP      3328
#define XB_TOPGEN   3392
#define XCD_BAR_WORDS 3456
#define XB_SPIN_CAP (1u << 18)
__device__ __forceinline__ unsigned xb_ld(unsigned* p)              { return __hip_atomic_load(p, __ATOMIC_RELAXED, __HIP_MEMORY_SCOPE_AGENT); }
__device__ __forceinline__ unsigned xb_add(unsigned* p, unsigned v) { return __hip_atomic_fetch_add(p, v, __ATOMIC_RELAXED, __HIP_MEMORY_SCOPE_AGENT); }
__device__ __forceinline__ unsigned xb_xcc_id() { return (unsigned)__builtin_amdgcn_s_getreg((3 << 11) | 20) & 0xFu; }
#define XB_SPIN(cond, bar) do { unsigned _sp = 0; while (cond) { __builtin_amdgcn_s_sleep(1); \
    if ((++_sp & 255u) == 0u) { if (xb_ld(&(bar)[XB_TMO])) break; if (_sp > XB_SPIN_CAP) { atomicAdd(&(bar)[XB_TMO], 1u); break; } } } } while (0)
struct XcdBarrier { unsigned* bar; unsigned x; volatile LAS unsigned* st; };
__device__ __forceinline__ XcdBarrier xcd_barrier_post(unsigned* bar, volatile LAS unsigned* st) {
    XcdBarrier b; b.bar = bar; b.x = xb_xcc_id(); b.st = st;
    if (threadIdx.x == 0) (void)xb_add(&bar[XB_XCNT(b.x)], 1u);
    return b;
}
__device__ __forceinline__ void xcd_barrier_complete(unsigned* bar, unsigned x, unsigned& nloc, unsigned& nx) {
    const unsigned G = gridDim.x * gridDim.y * gridDim.z;
    unsigned sum, cnt, mine, sp = 0u;
    for (;;) {
        sum = 0u; cnt = 0u; mine = 0u;
#pragma unroll
        for (unsigned j = 0; j < 16; ++j) { const unsigned c = xb_ld(&bar[XB_XCNT(j)]); sum += c; cnt += (c > 0u) ? 1u : 0u; mine = (j == x) ? c : mine; }
        if (sum == G) break;
        __builtin_amdgcn_s_sleep(1);
        if ((++sp & 255u) == 0u) { if (xb_ld(&bar[XB_TMO])) break; if (sp > XB_SPIN_CAP) { atomicAdd(&bar[XB_TMO], 1u); break; } }
    }
    nloc = mine > 0u ? mine : 1u; nx = cnt > 0u ? cnt : 1u;
}
__device__ __forceinline__ void xcd_barrier(const XcdBarrier& b) {
    asm volatile("s_waitcnt vmcnt(0)" ::: "memory");
    __syncthreads();
    if (threadIdx.x == 0) {
        unsigned* bar = b.bar;
        __builtin_amdgcn_s_waitcnt(0);
        unsigned nloc = b.st[0], nx = b.st[1];
        if (nloc == 0u) { xcd_barrier_complete(bar, b.x, nloc, nx); b.st[0] = nloc; b.st[1] = nx; }
        const unsigned old = xb_add(&bar[XB_XSUB(b.x)], 1u);
        const unsigned gen = old / nloc;
        if (old + 1u == (gen + 1u) * nloc) {
            __builtin_amdgcn_fence(__ATOMIC_RELEASE, "agent");
            asm volatile("s_waitcnt vmcnt(0)" ::: "memory");
            const unsigned og = xb_add(&bar[XB_TOP], 1u);
            const unsigned tg = og / nx;
            if (og + 1u == (tg + 1u) * nx) xb_add(&bar[XB_TOPGEN], 1u);
            else XB_SPIN(xb_ld(&bar[XB_TOPGEN]) == tg, bar);
            __builtin_amdgcn_fence(__ATOMIC_ACQUIRE, "agent");
            xb_add(&bar[XB_XGEN(b.x)], 1u);
            asm volatile("s_waitcnt vmcnt(0)" ::: "memory");
        } else {
            XB_SPIN(xb_ld(&bar[XB_XGEN(b.x)]) == gen, bar);
            __builtin_amdgcn_fence(__ATOMIC_ACQUIRE, "agent");
            asm volatile("s_waitcnt vmcnt(0)" ::: "memory");
        }
    }
    __syncthreads();
}

__device__ __forceinline__ void xcc_local_barrier(unsigned* ctl, unsigned x, unsigned nloc) {
    asm volatile("s_waitcnt vmcnt(0)" ::: "memory");
    __syncthreads();
    if (threadIdx.x == 0) {
        const unsigned old = xb_add(&ctl[CW_XL_SUB + 64 * x], 1u);
        const unsigned gen = old / nloc;
        if (old + 1u == (gen + 1u) * nloc) xb_add(&ctl[CW_XL_GEN + 64 * x], 1u);
        else XB_SPIN(xb_ld(&ctl[CW_XL_GEN + 64 * x]) == gen, ctl + CW_BAR);
        __builtin_amdgcn_fence(__ATOMIC_ACQUIRE, "agent");
        asm volatile("s_waitcnt vmcnt(0)" ::: "memory");
    }
    __syncthreads();
}

__device__ __forceinline__ float wave_sum(float v) {
#pragma unroll
    for (int o = 1; o < 64; o <<= 1) v += __shfl_xor(v, o);
    return v;
}
__device__ __forceinline__ float log_sigmoidf(float x) { return fminf(x, 0.f) - log1pf(expf(-fabsf(x))); }
__device__ __forceinline__ float rstd_of(const ssq_t* ssq_row) { return 1.0f / sqrtf(ssq_val(ssq_row) * (1.0f / D) + EPS); }

__device__ __forceinline__ void tr_item64(const float* W, int ldW, int k0, int c0, bf16_t* WT, int ldT, int r0, const float* kg, const float* cg, float mul, LAS unsigned* scr, int lane) {
    const int n4 = lane & 15, kq = lane >> 4;
    f32x4 cm = (f32x4){mul, mul, mul, mul}; if (cg) cm = *(const f32x4*)(cg + c0 + 4 * n4) * mul;
    f32x4 va[8], vb[8];
#pragma unroll
    for (int i = 0; i < 8; ++i) { const int kp = kq + 4 * i; const float* p = W + (size_t)(k0 + 2 * kp) * ldW + c0 + 4 * n4; va[i] = *(const f32x4*)p; vb[i] = *(const f32x4*)(p + ldW); }
#pragma unroll
    for (int i = 0; i < 8; ++i) { const int kp = kq + 4 * i; const float g0 = kg ? kg[k0 + 2 * kp] : 1.0f, g1 = kg ? kg[k0 + 2 * kp + 1] : 1.0f;
#pragma unroll
        for (int e = 0; e < 4; ++e) scr[kp * 65 + 4 * n4 + e] = pack2(va[i][e] * cm[e] * g0, vb[i][e] * cm[e] * g1); }
    LDS_WAIT(); asm volatile("" ::: "memory");
    const int j = lane & 7, nl = lane >> 3;
#pragma unroll
    for (int it = 0; it < 8; ++it) { const int n = nl + 8 * it; u32x4 o; o.x = scr[(4 * j + 0) * 65 + n]; o.y = scr[(4 * j + 1) * 65 + n]; o.z = scr[(4 * j + 2) * 65 + n]; o.w = scr[(4 * j + 3) * 65 + n];
        *(u32x4*)(WT + (size_t)(r0 + n) * ldT + k0 + 8 * j) = o; }
    LDS_WAIT(); asm volatile("" ::: "memory");
}

struct Args;
constexpr int I_IN = 16 * 48, I_OUT = 16 * 16, I_POOL = 4 * 4 * 4, I_GU = 16 * 88, I_DN = 44 * 16;
constexpr int CV_P0 = I_IN + I_OUT, CV_T0 = CV_P0 + I_DN + I_POOL + I_OUT, CV_T1 = CV_T0 + I_DN + I_IN, CV_T2 = CV_T1 + I_DN + I_POOL, CV_END = CV_T2 + I_DN;
constexpr int GU_ITEMS = GU / 64;
struct Args { const float* in[12]; float* out; unsigned char* ws; int ph_lo, ph_hi; };

enum { JT_GU = 0, JT_DN = 1, JT_IN = 2, JT_OUT = 3, JT_POOL = 4 };
__device__ __forceinline__ void convert_one(const Args& args, unsigned char* ws, LAS unsigned* scr, int lane, int type, int l, int r) {
    const float* const* in = args.in;
    if (type == JT_GU) { const int kb = r / 88, nb = r % 88, r0 = nb * 64, pn = r0 >> 8, j = r0 & 255; const int c0 = (j < 128) ? pn * 128 + j : FF + pn * 128 + (j - 128);
        tr_item64(in[9] + (size_t)l * D * GU, GU, kb * 64, c0, (bf16_t*)(ws + WS_WGU) + (size_t)l * GU * D, D, r0, in[2] + l * D, nullptr, 1.0f, scr, lane); }
    else if (type == JT_DN) { const int kb = r / 16, nb = r % 16;
        tr_item64(in[10] + (size_t)l * FF * D, D, kb * 64, nb * 64, (bf16_t*)(ws + WS_WDN) + (size_t)l * D * FF, FF, nb * 64, nullptr, nullptr, 1.0f, scr, lane); }
    else if (type == JT_IN) { const int kb = r / 48, nb = r % 48, r0 = nb * 64;
        tr_item64(in[3] + (size_t)l * D * NIN, NIN, kb * 64, r0, (bf16_t*)(ws + WS_WIN) + (size_t)l * NQKVO * D, D, r0, in[1] + (2 * l) * D, nullptr, (r0 >= 512 && r0 < 1024) ? 0.125f : 1.0f, scr, lane); }
    else if (type == JT_OUT) { const int kb = r / 16, nb = r % 16;
        tr_item64(in[6] + (size_t)l * D * D, D, kb * 64, nb * 64, (bf16_t*)(ws + WS_WOUT) + (size_t)l * D * D, D, nb * 64, in[5] + l * D, nullptr, 1.0f, scr, lane); }
    else { const int gi = r / 16, r2 = r % 16, kb = r2 / 4, nb = r2 % 4;
        tr_item64(in[7] + (size_t)(l * 4 + gi) * 256 * 256, 256, kb * 64, nb * 64, (bf16_t*)(ws + WS_WPOOL) + (size_t)l * D * 256 + (size_t)gi * 256 * 256, 256, nb * 64,
                  in[1] + (2 * l + 1) * D + gi * 256, in[8] + l * D + gi * 256, 1.0f, scr, lane); }
}
__device__ __forceinline__ void convert_items(const Args& args, unsigned char* ws, LAS unsigned* scr, int lane, int lo, int hi, int w, int nw) {
    for (int it = lo + w; it < hi; it += nw) {
        int r = it;
#define CV_JOB(T, L, N) if (r < (N)) { convert_one(args, ws, scr, lane, T, L, r); continue; } r -= (N);
        CV_JOB(JT_IN, 0, I_IN) CV_JOB(JT_OUT, 0, I_OUT)
        CV_JOB(JT_DN, 0, I_DN) CV_JOB(JT_POOL, 0, I_POOL) CV_JOB(JT_OUT, 1, I_OUT)
        CV_JOB(JT_DN, 1, I_DN) CV_JOB(JT_IN, 1, I_IN)
        CV_JOB(JT_DN, 2, I_DN) CV_JOB(JT_POOL, 1, I_POOL)
        CV_JOB(JT_DN, 3, I_DN)
#undef CV_JOB
    }
}
constexpr int N_PHASES = 24;

__device__ __forceinline__ void quant_gu_item(const Args& args, unsigned char* ws, LAS unsigned char* lds, int layer, int nb, int tid) {
    const int lane = tid & 63, wave = __builtin_amdgcn_readfirstlane(tid >> 6);
    const float* W = args.in[9] + (size_t)layer * D * GU; const float* kg = args.in[2] + layer * D;
    const int r0 = nb * 64, pn = r0 >> 8, jt = r0 & 255, c0 = (jt < 128) ? pn * 128 + jt : FF + pn * 128 + (jt - 128);
    LAS float* part = (LAS float*)(lds + 40960); LAS float* sc = part + 512;
    {   const int n4 = tid & 15, kq = tid >> 4; f32x4 mx = (f32x4){0.f, 0.f, 0.f, 0.f};
#pragma unroll 1
        for (int b = 0; b < 4; ++b) { f32x4 v[8];
#pragma unroll
            for (int i = 0; i < 8; ++i) v[i] = *(const f32x4*)(W + (size_t)(kq + 32 * (b * 8 + i)) * GU + c0 + 4 * n4);
#pragma unroll
            for (int i = 0; i < 8; ++i) { const float g = kg[kq + 32 * (b * 8 + i)];
#pragma unroll
                for (int e = 0; e < 4; ++e) mx[e] = fmaxf(mx[e], fabsf(v[i][e] * g)); } }
#pragma unroll
        for (int e = 0; e < 4; ++e) { mx[e] = fmaxf(mx[e], __shfl_xor(mx[e], 16)); mx[e] = fmaxf(mx[e], __shfl_xor(mx[e], 32)); }
        if (lane < 16) *(LAS f32x4*)(part + wave * 64 + 4 * n4) = mx; }
    __syncthreads();
    if (tid < 64) { float m = 0.f;
#pragma unroll
        for (int w = 0; w < 8; ++w) m = fmaxf(m, part[w * 64 + tid]);
        sc[tid] = m > 0.f ? 127.0f / m : 0.f; ((float*)(ws + WS_SB))[(size_t)layer * GU + r0 + tid] = m * (1.0f / 127.0f); }
    __syncthreads();
    LAS unsigned* scr = (LAS unsigned*)(lds + wave * 4224);
    const int n4 = lane & 15, kq4 = lane >> 4; const f32x4 isc = *(const LAS f32x4*)(sc + 4 * n4);
    unsigned char* B8 = ws + WS_WGU + ((size_t)layer * GU + r0) * D;
#pragma unroll 1
    for (int kk = 0; kk < 2; ++kk) { const int kb = wave * 2 + kk; f32x4 v[16];
#pragma unroll
        for (int i = 0; i < 16; ++i) v[i] = *(const f32x4*)(W + (size_t)(kb * 64 + kq4 * 16 + i) * GU + c0 + 4 * n4);
#pragma unroll
        for (int a = 0; a < 4; ++a) { const f32x4 g4 = *(const f32x4*)(kg + kb * 64 + kq4 * 16 + 4 * a);
#pragma unroll
            for (int e = 0; e < 4; ++e) { const float is = isc[e];
                const unsigned q0 = (unsigned)__float2int_rn(v[4 * a][e] * g4[0] * is) & 255u, q1 = (unsigned)__float2int_rn(v[4 * a + 1][e] * g4[1] * is) & 255u,
                               q2 = (unsigned)__float2int_rn(v[4 * a + 2][e] * g4[2] * is) & 255u, q3 = (unsigned)__float2int_rn(v[4 * a + 3][e] * g4[3] * is) & 255u;
                scr[(kq4 * 4 + a) * 65 + 4 * n4 + e] = q0 | (q1 << 8) | (q2 << 16) | (q3 << 24); } }
        LDS_WAIT(); asm volatile("" ::: "memory");
        const int jj = lane & 3, nl = lane >> 2;
#pragma unroll
        for (int it = 0; it < 4; ++it) { const int n = nl + 16 * it; u32x4 o; o.x = scr[(4 * jj + 0) * 65 + n]; o.y = scr[(4 * jj + 1) * 65 + n]; o.z = scr[(4 * jj + 2) * 65 + n]; o.w = scr[(4 * jj + 3) * 65 + n];
            *(u32x4*)(B8 + (size_t)n * D + kb * 64 + 16 * jj) = o; }
        LDS_WAIT(); asm volatile("" ::: "memory");
    }
}

__global__ void __launch_bounds__(NT, 2) fwd_kernel(Args args) {
    extern __shared__ __attribute__((aligned(16))) unsigned char lds_raw[];
    LAS unsigned char* lds = (LAS unsigned char*)lds_raw;
    volatile LAS unsigned* MISC = (volatile LAS unsigned*)(lds + MISC_OFF);
    LAS float* rtab = (LAS float*)(lds + RSTD_OFF);
    int tid = threadIdx.x, lane = tid & 63, wave = __builtin_amdgcn_readfirstlane(tid >> 6);
#define FRESH_TID() do { tid = threadIdx.x; asm volatile("" : "+v"(tid)); lane = tid & 63; wave = __builtin_amdgcn_readfirstlane(tid >> 6); } while (0)
    const int G = gridDim.x, bid0 = blockIdx.x;
    int bid = bid0;
    unsigned char* const ws = args.ws;
#define x_in       (args.in[0])
#define norm_mix   (args.in[1])
#define norm_ffn   (args.in[2])
#define w_in       (args.in[3])
#define gate_bias  (args.in[4])
#define head_gain  (args.in[5])
#define w_out      (args.in[6])
#define pool_w     (args.in[7])
#define pool_scale (args.in[8])
#define w_gu       (args.in[9])
#define w_dn       (args.in[10])
#define final_norm (args.in[11])
#define Win_t   ((bf16_t*)(ws + WS_WIN))
#define Wout_t  ((bf16_t*)(ws + WS_WOUT))
#define Wpool_t ((bf16_t*)(ws + WS_WPOOL))
#define Wgu_t   ((bf16_t*)(ws + WS_WGU))
#define Wdn_t   ((bf16_t*)(ws + WS_WDN))
#define Wg      ((bf16_t*)(ws + WS_WG))
#define ssq     ((ssq_t*)(ws + WS_SSQ))
#define gates   ((float*)(ws + WS_GATES))
#define decay   ((float*)(ws + WS_DECAY))
#define GT      ((float*)(ws + WS_GT))
#define A8      ((unsigned char*)(ws + WS_A8))
#define RS8     ((float*)(ws + WS_RS8))
#define SBW     ((float*)(ws + WS_SB))
#define xb      ((bf16_t*)(ws + WS_XB))
#define BIG     ((bf16_t*)(ws + WS_BIG))
#define ST      ((bf16_t*)(ws + WS_ST))

    for (int u = tid; u < (LDS_BYTES - LDSCTL_OFF) / 4; u += NT) ((LAS unsigned*)(lds + LDSCTL_OFF))[u] = 0u;
    __syncthreads();
    XcdBarrier bar; bar.bar = (unsigned*)(ws + WS_CTL) + CW_BAR; bar.x = 0; bar.st = nullptr;
    if (MK_N_LAUNCHES == 1) bar = xcd_barrier_post((unsigned*)(ws + WS_CTL) + CW_BAR, MISC + 8);
    unsigned* const ctl = (unsigned*)(ws + WS_CTL);
    if (MK_N_LAUNCHES == 1) {
        if (tid == 0) { const unsigned x = xb_xcc_id(); MISC[4] = x; MISC[5] = xb_add(&ctl[CW_CENSUS + 64 * x], 1u); }
        __syncthreads();
    }
    const int xcc = (int)MISC[4], xrank = (int)MISC[5];
    int xmode = 0;

    const int lo = args.ph_lo, hi = args.ph_hi;
    int ph = 0;
#define IN_PH() (lo <= ph && ph < hi)
#define BEGIN_PH() FRESH_TID()
#if PROBE_PH >= 0
#define LAS_REP_PTR(op, row, h, ch) (LAST_REP() ? (op) : (u32x4*)args.out + ((size_t)(row) * 128 + (h) * 16 + (ch)))
#define REPS() ((ph == PROBE_PH) ? PROBE_REP : 1)
#define LAST_REP() (rep_ + 1 == REPS())
#else
#define LAS_REP_PTR(op, row, h, ch) (op)
#define REPS() 1
#define LAST_REP() true
#endif
#define END_PH() do { if (lo <= ph && ph + 1 < hi) xcd_barrier(bar); ++ph; } while (0)
#define END_PH_X() do { if (lo <= ph && ph + 1 < hi) { if (xmode) xcc_local_barrier(ctl, (unsigned)xcc, (unsigned)(G / 8)); else xcd_barrier(bar); } ++ph; } while (0)

    if (IN_PH()) for (int rep_ = 0; rep_ < REPS(); ++rep_) { BEGIN_PH();
        LAS unsigned* scr = (LAS unsigned*)(lds + RING_OFF + wave * 8448);
        const int gw = bid * NWAVES + wave, NGW = G * NWAVES;
        if (G == 256) { if (bid < GU_ITEMS) quant_gu_item(args, ws, lds, 0, bid, tid); }
        else for (int it = bid; it < 4 * GU_ITEMS; it += G) { quant_gu_item(args, ws, lds, it / GU_ITEMS, it % GU_ITEMS, tid); __syncthreads(); }
        __syncthreads();
        convert_items(args, ws, scr, lane, 0, (G == 256) ? CV_P0 : CV_END, gw, NGW);
        for (int e = bid * NT + tid; e < 2 * 16 * D; e += G * NT) { const int l = e / (16 * D), rem = e % (16 * D), k = rem >> 4, j = rem & 15;
            Wg[(size_t)l * 16 * D + j * D + k] = f2bf(w_in[(size_t)l * D * NIN + (size_t)k * NIN + NQKVO + j] * norm_mix[(2 * l) * D + k]); }
        for (int m = 2 * gw; m < M; m += 2 * NGW) {
            const f32x4* xr = (const f32x4*)(x_in + (size_t)m * D) + lane; f32x4 v[8]; float s0 = 0.f, s1 = 0.f;
#pragma unroll
            for (int j = 0; j < 8; ++j) v[j] = xr[64 * j];
#pragma unroll
            for (int j = 0; j < 4; ++j) { s0 += (v[j][0] * v[j][0] + v[j][1] * v[j][1]) + (v[j][2] * v[j][2] + v[j][3] * v[j][3]);
                                          s1 += (v[j + 4][0] * v[j + 4][0] + v[j + 4][1] * v[j + 4][1]) + (v[j + 4][2] * v[j + 4][2] + v[j + 4][3] * v[j + 4][3]); }
            s0 = wave_sum(s0); s1 = wave_sum(s1);
#pragma unroll
            for (int j = 0; j < 8; ++j) { u32x2 w; w.x = cvt_pk_bf16(v[j][0], v[j][1]); w.y = cvt_pk_bf16(v[j][2], v[j][3]); ((u32x2*)(xb + (size_t)m * D))[64 * j + lane] = w; }
            if (lane < 32) ssq[(size_t)m * 16 + lane] = (lane == 0) ? s0 : (lane == 16) ? s1 : 0.f;
        }
    }
    END_PH();
    if (MK_N_LAUNCHES == 1 && lo == 0 && (G & 7) == 0 && BATCH == 8) {
        if (tid == 0) { unsigned ok = 1u;
#pragma unroll
            for (int j = 0; j < 8; ++j) ok &= (xb_ld(&ctl[CW_CENSUS + 64 * j]) == (unsigned)(G / 8)) ? 1u : 0u;
            MISC[6] = ok; }
        __syncthreads();
        xmode = (int)MISC[6];
        if (xmode) bid = xcc + 8 * xrank;
    }
    const int gq = G / 8;
    const int it0 = xmode ? 64 * xcc + xrank : bid, its = xmode ? gq : G, itn = xmode ? 64 * xcc + 64 : NBLK;
    const int rb0 = xmode ? 32 * xcc + xrank : bid, rbn = xmode ? 32 * xcc + 32 : M / 64;
#if PROBE_BARS > 0
    if (MK_N_LAUNCHES == 1) for (int i_ = 0; i_ < PROBE_BARS; ++i_) xcd_barrier(bar);
#endif

    for (int layer = 0; layer < DEPTH; ++layer) {
        const int slot = layer >> 1;
        ssq_t* ssq_a = ssq + (size_t)(2 * layer) * M * 16;
        ssq_t* ssq_b = ssq_a + (size_t)M * 16;
        ssq_t* ssq_c = ssq_b + (size_t)M * 16;
        if ((layer & 1) == 0) {
            if (IN_PH()) for (int rep_ = 0; rep_ < REPS(); ++rep_) { BEGIN_PH();
                {
                    const bf16_t* wgb = Wg + (size_t)slot * 16 * D;
                    LAS float* red = (LAS float*)lds;
                    const int rbk = wave & 3, kh = wave >> 2, fr = lane & 15, fq = lane >> 4;
#if defined(PROBE_GATES)
                    for (int grep_ = 0; grep_ < 3; ++grep_)
#endif
                    for (int rb = rb0; rb < rbn; rb += its) {
                        const bf16_t* ap = xb + (size_t)(rb * 64 + rbk * 16 + fr) * D + kh * 512 + 8 * fq;
                        const bf16_t* bp = wgb + (size_t)fr * D + kh * 512 + 8 * fq;
                        f32x4 ga = (f32x4){0.f, 0.f, 0.f, 0.f};
#pragma unroll
                        for (int ks = 0; ks < 16; ++ks) ga = __builtin_amdgcn_mfma_f32_16x16x32_bf16(*(const bf16x8*)(ap + 32 * ks), *(const bf16x8*)(bp + 32 * ks), ga, 0, 0, 0);
                        if (kh == 1) *(LAS f32x4*)(red + (rbk * 64 + lane) * 4) = ga;
                        __syncthreads();
                        if (kh == 0) {
                            ga += *(const LAS f32x4*)(red + (rbk * 64 + lane) * 4);
                            const float gb = gate_bias[slot * 16 + fr];
#pragma unroll
                            for (int r = 0; r < 4; ++r) { const int row = rb * 64 + rbk * 16 + 4 * fq + r; const float gv = ga[r] * rstd_of(ssq_a + (size_t)row * 16) + gb;
                                gates[(size_t)row * 16 + fr] = SOFTCAP * tanhf(gv * (1.0f / SOFTCAP)); }
                        }
                        __syncthreads();
                    }
                }
                pg8::Gemm g{xb, Win_t + (size_t)slot * NQKVO * D}; pg8::Order S; S.init(M, NQKVO, G, bid, ssq_a, rtab);
                pg8::EpiProj E{BIG, rtab};
                pg8::gemm_phase<pg8::EpiProj, true, D, D, D, 0>(lds + RING_OFF, g, S, E);
            }
            END_PH_X();
            if (IN_PH()) for (int rep_ = 0; rep_ < REPS(); ++rep_) { BEGIN_PH();
                LAS unsigned char* kimg = lds;
                LAS unsigned char* vimg = lds + 49152;
                LAS float* wtab = (LAS float*)(lds + TAB_OFF);
                const int hh = lane >> 5, l31 = lane & 31, g16 = (lane >> 4) & 1, q4 = (lane & 15) >> 2, p4 = lane & 3;
                const int troffK = (8 * hh + q4) * 192 + (16 * g16 + 4 * p4) * 2, troffV = (8 * hh + q4) * 320 + (16 * g16 + 4 * p4) * 2;
                bf16x8 a_one; { const short o = (l31 == 0) ? (short)0x3F80 : (short)0; for (int j = 0; j < 8; ++j) a_one[j] = o; }
                const int vt = wave >> 1, dt = wave & 1;
                for (int item = it0; item < itn; item += its) {
                    const int b = item >> 6, h = (item >> 3) & 7, blk = item & 7, row0 = b * SEQ + blk * BLK;
                    __syncthreads();
                    { float lf[4], ig[4];
#pragma unroll
                      for (int e = 0; e < 4; ++e) { const float* gp = gates + (size_t)(row0 + 4 * lane + e) * 16; lf[e] = log_sigmoidf(gp[8 + h]); ig[e] = gp[h]; }
                      const float p0 = lf[0], p1 = p0 + lf[1], p2 = p1 + lf[2], p3 = p2 + lf[3];
                      float sc = p3;
#pragma unroll
                      for (int o = 1; o < 64; o <<= 1) { const float t = __shfl_up(sc, o); if (lane >= o) sc += t; }
                      const float ex = sc - p3, bl = __shfl(sc, 63);
                      if (wave == 0) { *(LAS f32x4*)(wtab + 4 * lane) = (f32x4){__expf(bl - (ex + p0) + ig[0]), __expf(bl - (ex + p1) + ig[1]), __expf(bl - (ex + p2) + ig[2]), __expf(bl - (ex + p3) + ig[3])};
                                       *(f32x4*)(GT + (size_t)item * 512 + 4 * lane) = (f32x4){ex + p0, ex + p1, ex + p2, ex + p3};
                                       *(f32x4*)(GT + (size_t)item * 512 + 256 + 4 * lane) = (f32x4){ig[0] - (ex + p0), ig[1] - (ex + p1), ig[2] - (ex + p2), ig[3] - (ex + p3)};
                                       if (lane == 0) decay[item] = __expf(bl); } }
#pragma unroll
                    for (int i = 0; i < 4; ++i) { const int id = i * NT + tid, r = id >> 3, ch = id & 7; *(LAS u32x4*)(kimg + r * 192 + ch * 16) = *(const u32x4*)(BIG + (size_t)(row0 + r) * NQKVO + 512 + h * DK + ch * 8); }
#pragma unroll
                    for (int i = 0; i < 8; ++i) { const int id = i * NT + tid, r = id >> 4, ch = id & 15; *(LAS u32x4*)(vimg + r * 320 + ch * 16) = *(const u32x4*)(BIG + (size_t)(row0 + r) * NQKVO + 1024 + h * DV + ch * 8); }
                    __syncthreads();
                    f32x16 acc = zero16(), accn = zero16();
#pragma unroll 4
                    for (int ks = 0; ks < 16; ++ks) {
                        const bf16x8 kf = tr_pair(kimg + troffK + ks * 16 * 192 + dt * 64, 4 * 192);
                        const f32x4 w0 = *(const LAS f32x4*)(wtab + 16 * ks + 8 * hh), w1 = *(const LAS f32x4*)(wtab + 16 * ks + 8 * hh + 4);
                        const u32x4 kb = __builtin_bit_cast(u32x4, kf);
                        u32x4 ksc; ksc.x = pack2(bflo(kb.x) * w0[0], bfhi(kb.x) * w0[1]); ksc.y = pack2(bflo(kb.y) * w0[2], bfhi(kb.y) * w0[3]);
                        ksc.z = pack2(bflo(kb.z) * w1[0], bfhi(kb.z) * w1[1]); ksc.w = pack2(bflo(kb.w) * w1[2], bfhi(kb.w) * w1[3]);
                        const bf16x8 kfs = __builtin_bit_cast(bf16x8, ksc);
                        const bf16x8 vf = tr_pair(vimg + troffV + ks * 16 * 320 + vt * 64, 4 * 320);
                        acc = MFMA32(kfs, vf, acc);
                        if (vt == 0) accn = MFMA32(kfs, a_one, accn);
                    }
                    bf16_t* st = ST + (size_t)item * STE;
#pragma unroll
                    for (int g4 = 0; g4 < 4; ++g4) { u32x2 pk; pk.x = pack2(acc[4 * g4], acc[4 * g4 + 1]); pk.y = pack2(acc[4 * g4 + 2], acc[4 * g4 + 3]);
                        *(u32x2*)(st + (size_t)(32 * vt + l31) * 64 + 32 * dt + 8 * g4 + 4 * hh) = pk; }
                    if (vt == 0 && l31 == 0) {
#pragma unroll
                        for (int g4 = 0; g4 < 4; ++g4) { u32x2 pk; pk.x = pack2(accn[4 * g4], accn[4 * g4 + 1]); pk.y = pack2(accn[4 * g4 + 2], accn[4 * g4 + 3]);
                            *(u32x2*)(st + 128 * 64 + 32 * dt + 8 * g4 + 4 * hh) = pk; }
                    }
                }
            }
            END_PH_X();
            if (IN_PH()) for (int rep_ = 0; rep_ < REPS(); ++rep_) { BEGIN_PH();
                LAS unsigned char* vimg = lds;
                LAS unsigned char* cimg = lds + 81920;
                LAS float* btab = (LAS float*)(lds + 100608);
                LAS float* ctab = btab + 256;
                const int st = (wave < 4) ? 7 - wave : wave - 4;
                for (int item = it0; item < itn; item += its) {
                    FRESH_TID();
                    const int hh = lane >> 5, l31 = lane & 31, g16 = (lane >> 4) & 1, q4 = (lane & 15) >> 2, p4 = lane & 3;
                    const int troff = (4 * hh + q4) * 320 + (16 * g16 + 4 * p4) * 2;
                    bf16x8 a_one; { const short o = (l31 == 0) ? (short)0x3F80 : (short)0; for (int j = 0; j < 8; ++j) a_one[j] = o; }
                    const int b = item >> 6, h = (item >> 3) & 7, blk = item & 7, row0 = b * SEQ + blk * BLK;
                    u32x4 vv[8];
#pragma unroll
                    for (int i = 0; i < 8; ++i) { const int id = i * NT + tid, r = id >> 4, ch = id & 15; vv[i] = *(const u32x4*)(BIG + (size_t)(row0 + r) * NQKVO + 1024 + h * DV + ch * 8); }
                    f32x4 tb = (f32x4){0.f, 0.f, 0.f, 0.f};
                    if (tid < 128) tb = *(const f32x4*)(GT + (size_t)item * 512 + 4 * tid);
                    u32x4 uu[2][7]; float dj[7];
#pragma unroll
                    for (int j = 0; j < 7; ++j) { dj[j] = 0.f; uu[0][j] = (u32x4){0u, 0u, 0u, 0u}; uu[1][j] = (u32x4){0u, 0u, 0u, 0u};
                        if (j < blk) { dj[j] = decay[item - blk + j]; const bf16_t* up = ST + (size_t)(item - blk + j) * STE + tid * 8; uu[0][j] = *(const u32x4*)up; uu[1][j] = *(const u32x4*)(up + NT * 8); } }
                    unsigned un[7];
#pragma unroll
                    for (int j = 0; j < 7; ++j) { un[j] = 0u; if (j < blk && tid < 32) un[j] = ((const unsigned*)(ST + (size_t)(item - blk + j) * STE + 8192))[tid]; }
                    __syncthreads();
#pragma unroll
                    for (int i = 0; i < 8; ++i) { const int id = i * NT + tid, r = id >> 4, ch = id & 15; *(LAS u32x4*)(vimg + r * 320 + ch * 16) = vv[i]; }
                    if (tid < 128) *(LAS f32x4*)(btab + 4 * tid) = tb;
#pragma unroll
                    for (int cc = 0; cc < 2; ++cc) { const int chunk = cc * NT + tid; float a8[8];
#pragma unroll
                        for (int e = 0; e < 8; ++e) a8[e] = 0.f;
#pragma unroll
                        for (int j = 0; j < 7; ++j) { const u32x4 u = uu[cc][j]; const float d = dj[j];
                            if (j < blk) {
                            a8[0] = d * a8[0] + bflo(u.x); a8[1] = d * a8[1] + bfhi(u.x); a8[2] = d * a8[2] + bflo(u.y); a8[3] = d * a8[3] + bfhi(u.y);
                            a8[4] = d * a8[4] + bflo(u.z); a8[5] = d * a8[5] + bfhi(u.z); a8[6] = d * a8[6] + bflo(u.w); a8[7] = d * a8[7] + bfhi(u.w); } }
                        u32x4 o; o.x = pack2(a8[0], a8[1]); o.y = pack2(a8[2], a8[3]); o.z = pack2(a8[4], a8[5]); o.w = pack2(a8[6], a8[7]);
                        *(LAS u32x4*)(cimg + (chunk >> 3) * 144 + (chunk & 7) * 16) = o; }
                    if (tid < 32) { float n0 = 0.f, n1 = 0.f;
#pragma unroll
                        for (int j = 0; j < 7; ++j) if (j < blk) { n0 = dj[j] * n0 + bflo(un[j]); n1 = dj[j] * n1 + bfhi(un[j]); }
                        *(LAS unsigned*)(cimg + 128 * 144 + tid * 4) = pack2(n0, n1); }
                    __syncthreads();
                    const float bs = btab[32 * st + l31], eb = __expf(bs);
                    bf16x8 qf[4];
                    { const bf16_t* qp = BIG + (size_t)(row0 + 32 * st + l31) * NQKVO + h * DK + 8 * hh;
#pragma unroll
                      for (int ks = 0; ks < 4; ++ks) qf[ks] = *(const bf16x8*)(qp + 16 * ks); }
                    u32x4 ov[8];
#pragma unroll
                    for (int i = 0; i < 8; ++i) { const int id = i * 64 + lane, rho = id >> 4, ch = id & 15; ov[i] = *(const u32x4*)(BIG + (size_t)(row0 + 32 * st + rho) * NQKVO + 2048 + h * DV + ch * 8); }
                    f32x16 acc[5];
#pragma unroll
                    for (int v5 = 0; v5 < 5; ++v5) acc[v5] = zero16();
                    bf16x8 kn[4];
                    { const bf16_t* kp = BIG + (size_t)(row0 + l31) * NQKVO + 512 + h * DK + 8 * hh;
#pragma unroll
                      for (int ks = 0; ks < 4; ++ks) kn[ks] = *(const bf16x8*)(kp + 16 * ks); }
                    for (int rt = 0; rt <= st; ++rt) {
                        f32x16 X = zero16();
#pragma unroll
                        for (int ks = 0; ks < 4; ++ks) X = MFMA32(kn[ks], qf[ks], X);
                        if (rt < st) { const bf16_t* kp = BIG + (size_t)(row0 + 32 * (rt + 1) + l31) * NQKVO + 512 + h * DK + 8 * hh;
#pragma unroll
                            for (int ks = 0; ks < 4; ++ks) kn[ks] = *(const bf16x8*)(kp + 16 * ks); }
#pragma unroll
                        for (int g4 = 0; g4 < 4; ++g4) {
                            const f32x4 cr = *(const LAS f32x4*)(ctab + 32 * rt + 8 * g4 + 4 * hh);
#pragma unroll
                            for (int e = 0; e < 4; ++e) { float pv = X[4 * g4 + e] * __expf(bs + cr[e]); if (rt == st && (8 * g4 + 4 * hh + e) > l31) pv = 0.f; X[4 * g4 + e] = pv; }
                        }
#pragma unroll
                        for (int sp = 0; sp < 2; ++sp) {
                            u32x4 pk; pk.x = pack2(X[8 * sp + 0], X[8 * sp + 1]); pk.y = pack2(X[8 * sp + 2], X[8 * sp + 3]); pk.z = pack2(X[8 * sp + 4], X[8 * sp + 5]); pk.w = pack2(X[8 * sp + 6], X[8 * sp + 7]);
                            const bf16x8 pf = __builtin_bit_cast(bf16x8, pk);
#pragma unroll
                            for (int v4 = 0; v4 < 4; ++v4) acc[v4] = MFMA32(tr_pair(vimg + troff + (32 * rt + 16 * sp) * 320 + v4 * 64, 8 * 320), pf, acc[v4]);
                            acc[4] = MFMA32(a_one, pf, acc[4]);
                        }
                    }
                    {   bf16x8 qs[4];
#pragma unroll
                        for (int ks = 0; ks < 4; ++ks) { const u32x4 qb = __builtin_bit_cast(u32x4, qf[ks]); u32x4 o; o.x = pack2(bflo(qb.x) * eb, bfhi(qb.x) * eb); o.y = pack2(bflo(qb.y) * eb, bfhi(qb.y) * eb);
                            o.z = pack2(bflo(qb.z) * eb, bfhi(qb.z) * eb); o.w = pack2(bflo(qb.w) * eb, bfhi(qb.w) * eb); qs[ks] = __builtin_bit_cast(bf16x8, o); }
#pragma unroll
                        for (int v5 = 0; v5 < 5; ++v5) {
                            const int vrow = (v5 < 4) ? 32 * v5 + l31 : 128;
#pragma unroll
                            for (int ks = 0; ks < 4; ++ks) {
                                u32x4 cf = *(const LAS u32x4*)(cimg + vrow * 144 + (16 * ks + 8 * hh) * 2);
                                if (v5 == 4 && l31 != 0) cf = (u32x4){0u, 0u, 0u, 0u};
                                acc[v5] = MFMA32(__builtin_bit_cast(bf16x8, cf), qs[ks], acc[v5]);
                            }
                        }
                    }
                    const float den = __shfl(acc[4][0], l31), dd = fmaxf(fabsf(den), 1.0f);
                    float ss = 0.f;
#pragma unroll
                    for (int v4 = 0; v4 < 4; ++v4)
#pragma unroll
                        for (int r = 0; r < 16; ++r) ss += acc[v4][r] * acc[v4][r];
                    ss += __shfl_xor(ss, 32);
                    const float idd = 1.0f / dd; const float scale = idd / sqrtf(ss * idd * idd * (1.0f / DV) + EPS);
                    __syncthreads();
                    LAS unsigned char* wl = vimg + wave * 8704;
#pragma unroll
                    for (int v4 = 0; v4 < 4; ++v4)
#pragma unroll
                        for (int g4 = 0; g4 < 4; ++g4) { u32x2 pk; pk.x = pack2(acc[v4][4 * g4] * scale, acc[v4][4 * g4 + 1] * scale); pk.y = pack2(acc[v4][4 * g4 + 2] * scale, acc[v4][4 * g4 + 3] * scale);
                            *(LAS u32x2*)(wl + l31 * 272 + (32 * v4 + 8 * g4 + 4 * hh) * 2) = pk; }
#pragma unroll
                    for (int i = 0; i < 8; ++i) { const int id = i * 64 + lane, rho = id >> 4, ch = id & 15;
                        const u32x4 hv = *(const LAS u32x4*)(wl + rho * 272 + ch * 16);
                        u32x4* op = (u32x4*)(BIG + (size_t)(row0 + 32 * st + rho) * NQKVO + 2048 + h * DV + ch * 8); const u32x4 o4 = ov[i];
                        u32x4 w4; w4.x = pack2(bflo(hv.x) * bflo(o4.x), bfhi(hv.x) * bfhi(o4.x)); w4.y = pack2(bflo(hv.y) * bflo(o4.y), bfhi(hv.y) * bfhi(o4.y));
                        w4.z = pack2(bflo(hv.z) * bflo(o4.z), bfhi(hv.z) * bfhi(o4.z)); w4.w = pack2(bflo(hv.w) * bflo(o4.w), bfhi(hv.w) * bfhi(o4.w));
                        *(LAS_REP_PTR(op, row0 + 32 * st + rho, h, ch)) = w4; }
                }
            }
            END_PH_X();
        }
        if (IN_PH()) for (int rep_ = 0; rep_ < REPS(); ++rep_) { BEGIN_PH();
            pg8::Order S; S.init(M, D, G, bid, nullptr, rtab);
            pg8::EpiRes E{xb, LAST_REP() ? xb : (bf16_t*)args.out, LAST_REP() ? ssq_b : (ssq_t*)(args.out + 8 * 1024 * 1024) + (size_t)rep_ * M * 16};
            if ((layer & 1) == 0) { pg8::Gemm g{BIG + 2048, Wout_t + (size_t)slot * D * D}; pg8::gemm_phase<pg8::EpiRes, false, NQKVO, D, D, 0>(lds + RING_OFF, g, S, E); }
            else {
                pg8::Unit u;
                for (int ui = 0; S.next(ui, u); ++ui) {
                    LAS float* hn = (LAS float*)lds;
                    LAS float* rsv = hn + 79 * 256;
                    const int gi = u.pn, w = 2 << gi, R0 = u.pm * 256, bb = R0 / SEQ, t0 = R0 % SEQ;
                    const int c16 = tid & 31, rp = tid >> 5;
                    const int c4 = tid & 63, tg = tid >> 6;
                    for (int tb = 0; tb < 4; ++tb) {
                        const int ts = t0 + 64 * tb;
                        __syncthreads();
                        if (tid < 79) { const int t = ts - 15 + tid; rsv[tid] = (t >= 0) ? rstd_of(ssq_a + (size_t)(bb * SEQ + t) * 16) : 0.f; }
                        u32x4 xv[5];
#pragma unroll
                        for (int ps = 0; ps < 5; ++ps) { const int rho = rp + 16 * ps, t = ts - 15 + rho; xv[ps] = (u32x4){0u, 0u, 0u, 0u};
                            if (rho < 79 && t >= 0) xv[ps] = *(const u32x4*)(xb + (size_t)(bb * SEQ + t) * D + 256 * gi + 8 * c16); }
                        __syncthreads();
#pragma unroll
                        for (int ps = 0; ps < 5; ++ps) { const int rho = rp + 16 * ps;
                            if (rho < 79) { const float r = rsv[rho]; LAS f32x4* dst = (LAS f32x4*)(hn + rho * 256 + 8 * c16);
                                dst[0] = (f32x4){bflo(xv[ps].x) * r, bfhi(xv[ps].x) * r, bflo(xv[ps].y) * r, bfhi(xv[ps].y) * r};
                                dst[1] = (f32x4){bflo(xv[ps].z) * r, bfhi(xv[ps].z) * r, bflo(xv[ps].w) * r, bfhi(xv[ps].w) * r}; } }
                        __syncthreads();
                        { const int tt0 = 8 * tg; f32x4 sw = (f32x4){0.f, 0.f, 0.f, 0.f};
                          for (int j = 1; j < w; ++j) sw += *(const LAS f32x4*)(hn + (15 + tt0 - j) * 256 + 4 * c4);
#pragma unroll
                          for (int tt = tt0; tt < tt0 + 8; ++tt) {
                              const f32x4 v = *(const LAS f32x4*)(hn + (15 + tt) * 256 + 4 * c4); sw += v;
                              const int tpos = ts + tt; const float inv = 1.0f / (float)((tpos + 1 < w) ? tpos + 1 : w);
                              u32x2 o; o.x = pack2(sw[0] * inv - v[0], sw[1] * inv - v[1]); o.y = pack2(sw[2] * inv - v[2], sw[3] * inv - v[3]);
                              *(u32x2*)(BIG + (size_t)(R0 + 64 * tb + tt) * D + 256 * gi + 4 * c4) = o;
                              sw -= *(const LAS f32x4*)(hn + (15 + tt - w + 1) * 256 + 4 * c4);
                          } }
                    }
                }
                VM_WAIT(); __syncthreads();
                pg8::Gemm g{BIG, Wpool_t + (size_t)slot * D * 256}; pg8::gemm_phase<pg8::EpiRes, false, D, 256, 256, 256>(lds + RING_OFF, g, S, E);
            }
        }
        END_PH_X();
        if (IN_PH()) for (int rep_ = 0; rep_ < REPS(); ++rep_) { BEGIN_PH();
            const int m0 = xmode ? xcc * SEQ + xrank * NWAVES + wave : bid * NWAVES + wave, ms = its * NWAVES, mn = xmode ? xcc * SEQ + SEQ : M;
            for (int m = m0; m < mn; m += ms) {
                const u32x4 a = ((const u32x4*)(xb + (size_t)m * D))[lane], b2 = ((const u32x4*)(xb + (size_t)m * D))[64 + lane];
                float v[16] = {bflo(a.x), bfhi(a.x), bflo(a.y), bfhi(a.y), bflo(a.z), bfhi(a.z), bflo(a.w), bfhi(a.w), bflo(b2.x), bfhi(b2.x), bflo(b2.y), bfhi(b2.y), bflo(b2.z), bfhi(b2.z), bflo(b2.w), bfhi(b2.w)};
                float sq = 0.f, am = 0.f;
#pragma unroll
                for (int j = 0; j < 16; ++j) { sq += v[j] * v[j]; am = fmaxf(am, fabsf(v[j])); }
                sq = wave_sum(sq);
#pragma unroll
                for (int o = 1; o < 64; o <<= 1) am = fmaxf(am, __shfl_xor(am, o));
                const float inv = am > 0.f ? 127.0f / am : 0.f;
                unsigned q[16];
#pragma unroll
                for (int j = 0; j < 16; ++j) q[j] = (unsigned)__float2int_rn(v[j] * inv) & 255u;
                u32x2 w0, w1; w0.x = q[0] | (q[1] << 8) | (q[2] << 16) | (q[3] << 24); w0.y = q[4] | (q[5] << 8) | (q[6] << 16) | (q[7] << 24);
                w1.x = q[8] | (q[9] << 8) | (q[10] << 16) | (q[11] << 24); w1.y = q[12] | (q[13] << 8) | (q[14] << 16) | (q[15] << 24);
                ((u32x2*)(A8 + (size_t)m * D))[lane] = w0; ((u32x2*)(A8 + (size_t)m * D))[64 + lane] = w1;
                if (lane == 0) RS8[m] = am * (1.0f / 127.0f) / sqrtf(sq * (1.0f / D) + EPS);
            }
        }
        END_PH_X();
        if (IN_PH()) for (int rep_ = 0; rep_ < REPS(); ++rep_) { BEGIN_PH();
            if (G == 256 && bid >= 128 && LAST_REP()) {
                if (layer < 3 && bid - 128 < GU_ITEMS) quant_gu_item(args, ws, lds, layer + 1, bid - 128, tid);
                __syncthreads();
                const int lo_ = (layer == 0) ? CV_P0 : (layer == 1) ? CV_T0 : (layer == 2) ? CV_T1 : CV_T2, hi_ = (layer == 0) ? CV_T0 : (layer == 1) ? CV_T1 : (layer == 2) ? CV_T2 : CV_END;
                convert_items(args, ws, (LAS unsigned*)(lds + RING_OFF + wave * 8448), lane, lo_, hi_, (bid - 128) * NWAVES + wave, 128 * NWAVES);
                __syncthreads();
            }
            pg8::Gemm g{(const bf16_t*)A8, (const bf16_t*)(ws + WS_WGU + (size_t)layer * GU * D)}; pg8::Order S; S.init(M, GU, G, bid, nullptr, rtab); S.wgm = GU_WGM; S.rowscale = RS8;
            pg8::EpiGU8 E{BIG, rtab, SBW + (size_t)layer * GU};
            pg8::gemm_phase<pg8::EpiGU8, true, D / 2, D / 2, D / 2, 0, false, true>(lds + RING_OFF, g, S, E);
        }
        END_PH();
        if (IN_PH()) for (int rep_ = 0; rep_ < REPS(); ++rep_) { BEGIN_PH();
            pg8::Gemm g{BIG, Wdn_t + (size_t)layer * D * FF}; pg8::Order S; S.init(M, D, G, bid, nullptr, rtab);
            pg8::EpiRes E{xb, LAST_REP() ? xb : (bf16_t*)args.out, LAST_REP() ? ssq_c : (ssq_t*)(args.out + 8 * 1024 * 1024) + (size_t)rep_ * M * 16};
            pg8::gemm_phase<pg8::EpiRes, false, FF, FF, FF, 0>(lds + RING_OFF, g, S, E);
        }
        END_PH_X();
    }
    if (IN_PH()) for (int rep_ = 0; rep_ < REPS(); ++rep_) { BEGIN_PH();
        const int m0 = xmode ? xcc * SEQ + xrank * NWAVES + wave : bid * NWAVES + wave, ms = its * NWAVES, mn = xmode ? xcc * SEQ + SEQ : M;
        for (int m = m0; m < mn; m += ms) {
            const u32x4 a = ((const u32x4*)(xb + (size_t)m * D))[lane], b2 = ((const u32x4*)(xb + (size_t)m * D))[64 + lane];
            float v[16] = {bflo(a.x), bfhi(a.x), bflo(a.y), bfhi(a.y), bflo(a.z), bfhi(a.z), bflo(a.w), bfhi(a.w), bflo(b2.x), bfhi(b2.x), bflo(b2.y), bfhi(b2.y), bflo(b2.z), bfhi(b2.z), bflo(b2.w), bfhi(b2.w)};
            float sq = 0.f;
#pragma unroll
            for (int j = 0; j < 16; ++j) sq += v[j] * v[j];
            const float rs = 1.0f / sqrtf(wave_sum(sq) * (1.0f / D) + EPS);
#pragma unroll
            for (int hpart = 0; hpart < 2; ++hpart)
#pragma unroll
                for (int q = 0; q < 2; ++q) { const int col = hpart * 512 + lane * 8 + q * 4; const f32x4 gn = *(const f32x4*)(final_norm + col);
                    f32x4 o; o[0] = v[hpart * 8 + q * 4 + 0] * rs * gn[0]; o[1] = v[hpart * 8 + q * 4 + 1] * rs * gn[1]; o[2] = v[hpart * 8 + q * 4 + 2] * rs * gn[2]; o[3] = v[hpart * 8 + q * 4 + 3] * rs * gn[3];
                    *(f32x4*)(args.out + (size_t)m * D + col) = o; }
        }
    }
#undef IN_PH
#undef END_PH
}

extern "C" void kernel_launch(void* const* d_in, const int* in_sizes, int n_in, void* d_out, int out_size, void* d_ws, size_t ws_size, hipStream_t stream) {
    static int grid = 0;
    if (grid == 0) {
        if (n_in != 12 || in_sizes[0] != M * D || out_size != M * D || ws_size < WS_END) { fprintf(stderr, "kernel_launch: unexpected shapes / workspace (n_in %d, ws %zu, need %zu)\n", n_in, ws_size, (size_t)WS_END); grid = -1; return; }
        int dev = 0, cus = 0, per_cu = 0;
        if (hipGetDevice(&dev) != hipSuccess || hipDeviceGetAttribute(&cus, hipDeviceAttributeMultiprocessorCount, dev) != hipSuccess) { grid = -1; return; }
        if (hipFuncSetAttribute((const void*)fwd_kernel, hipFuncAttributeMaxDynamicSharedMemorySize, LDS_BYTES) != hipSuccess) { fprintf(stderr, "kernel_launch: hipFuncSetAttribute failed\n"); grid = -1; return; }
        if (hipOccupancyMaxActiveBlocksPerMultiprocessor(&per_cu, (const void*)fwd_kernel, NT, LDS_BYTES) != hipSuccess || per_cu < 1) { fprintf(stderr, "kernel_launch: occupancy query says %d blocks per CU\n", per_cu); grid = -1; (void)hipGetLastError(); return; }
        grid = cus;
    }
    if (grid < 0) return;
    Args a{};
    for (int i = 0; i < 12; ++i) a.in[i] = (const float*)d_in[i];
    a.out = (float*)d_out; a.ws = (unsigned char*)d_ws;
#if MK_N_LAUNCHES == 1
    (void)hipMemsetAsync((char*)d_ws + WS_CTL, 0, CTL_ZERO_BYTES, stream);
    a.ph_lo = 0; a.ph_hi = N_PHASES;
    void* kargs[] = {&a};
    hipError_t e = hipLaunchCooperativeKernel((const void*)fwd_kernel, dim3(grid), dim3(NT), kargs, LDS_BYTES, stream);
    if (e != hipSuccess) fprintf(stderr, "cooperative launch failed: %s (grid %d)\n", hipGetErrorString(e), grid);
#else
    for (int p = 0; p < N_PHASES; ++p) {
        a.ph_lo = p; a.ph_hi = p + 1;
        hipLaunchKernelGGL(fwd_kernel, dim3(grid), dim3(NT), LDS_BYTES, stream, a);
    }
#endif
}
```

```cpp
#include <hip/hip_runtime.h>
#include <cstdio>
#include <cstdint>

#ifndef MK_N_LAUNCHES
#define MK_N_LAUNCHES 1
#endif

#ifndef PROBE_PH
#define PROBE_PH (-1)
#endif
#define PROBE_REP 3
#define GU_WGM 8
#define PROBE_BARS 0

#define LAS __attribute__((address_space(3)))
typedef unsigned short bf16_t;
typedef short bf16x8 __attribute__((ext_vector_type(8)));
typedef float f32x4 __attribute__((ext_vector_type(4)));
typedef float f32x2 __attribute__((ext_vector_type(2)));
typedef unsigned u32x4 __attribute__((ext_vector_type(4)));
typedef unsigned u32x2 __attribute__((ext_vector_type(2)));
typedef int i32x4 __attribute__((ext_vector_type(4)));
typedef float ssq_t;
__device__ __forceinline__ float ssq_val(const ssq_t* p) { const f32x4* q = (const f32x4*)p; const f32x4 a = q[0], b = q[1], c = q[2], d = q[3];
    return ((a[0] + a[1]) + (a[2] + a[3])) + ((b[0] + b[1]) + (b[2] + b[3])) + ((c[0] + c[1]) + (c[2] + c[3])) + ((d[0] + d[1]) + (d[2] + d[3])); }

constexpr int BATCH = 8, SEQ = 2048, D = 1024, DEPTH = 4, M = BATCH * SEQ;
constexpr int NH = 8, DK = 64, DV = 128, NQKVO = 3072, NIN = 3088, FF = 2816, GU = 2 * FF, CH = 64, NCH = SEQ / CH;
constexpr int BLK = 256, NBLK = BATCH * NH * (SEQ / BLK);
constexpr int NITEM = NBLK;
constexpr int STE = (DV + 1) * DK;
constexpr float EPS = 1e-6f, SOFTCAP = 15.0f;

__device__ __forceinline__ unsigned cvt_pk_bf16(float lo, float hi) { unsigned r; asm volatile("v_cvt_pk_bf16_f32 %0, %1, %2" : "=v"(r) : "v"(lo), "v"(hi)); return r; }
__device__ __forceinline__ float bf2f(unsigned short u) { return __uint_as_float((unsigned)u << 16); }
__device__ __forceinline__ float bflo(unsigned u) { return __uint_as_float(u << 16); }
__device__ __forceinline__ float bfhi(unsigned u) { return __uint_as_float(u & 0xffff0000u); }
__device__ __forceinline__ unsigned short f2bf(float f) { unsigned u = __float_as_uint(f); return (unsigned short)((u + 0x7fffu + ((u >> 16) & 1u)) >> 16); }


typedef short s16x4 __attribute__((ext_vector_type(4)));
typedef float f32x16 __attribute__((ext_vector_type(16)));
__device__ __forceinline__ unsigned pack2(float a, float b) { typedef __bf16 bf2 __attribute__((ext_vector_type(2))); f32x2 v = {a, b}; bf2 r = __builtin_convertvector(v, bf2); return __builtin_bit_cast(unsigned, r); }
__device__ __forceinline__ bf16x8 tr_pair(LAS unsigned char* p, int delta) {
    const s16x4 lo = __builtin_amdgcn_ds_read_tr16_b64_v4i16((LAS s16x4*)p), hi = __builtin_amdgcn_ds_read_tr16_b64_v4i16((LAS s16x4*)(p + delta));
    return __builtin_shufflevector(lo, hi, 0, 1, 2, 3, 4, 5, 6, 7);
}
#define MFMA32(a, b, c) __builtin_amdgcn_mfma_f32_32x32x16_bf16((a), (b), (c), 0, 0, 0)
__device__ __forceinline__ f32x16 zero16() { f32x16 z; for (int i = 0; i < 16; ++i) z[i] = 0.f; return z; }

namespace pg8 {
constexpr int BM = 256, BK = 64, HALF = 128, HTB = HALF * BK * 2, STAGE_BYTES = 8 * HTB, NXCD = 8, WGM = 8;
__host__ __device__ __forceinline__ int lds_byte(int r, int c) { const int st = (r >> 4) * 2 + (c >> 5), rr = r & 15, cc = c & 31, ob = rr * 64 + cc * 2; return st * 1024 + (ob ^ (((ob >> 9) & 1) << 5)); }
__host__ __device__ __forceinline__ void stage_rc(int b, int& R, int& C) { const int st = b / 1024, sb = b % 1024, swz = sb ^ (((sb >> 9) & 1) << 5); R = (st >> 1) * 16 + swz / 64; C = (st & 1) * 32 + (swz % 64) / 2; }
__host__ __device__ __forceinline__ int perm32(int rho) { const int n = rho >> 4, i = rho & 15; return 8 * (i >> 2) + 4 * n + (i & 3); }

struct Unit { int pm, pn, idx, hm; };
struct Gemm { const bf16_t* A; const bf16_t* Bt; };

struct Order {
    int nM, nN, nwg, G, c, nsplit, wgm;
    const ssq_t* ssq;
    LAS float* tab;
    const float* rowscale;
    __device__ __forceinline__ void init(int M_, int N, int G_, int c_, const ssq_t* ssq_, LAS float* tab_) { nM = M_ / BM; nN = N / BM; nwg = nM * nN; G = G_; c = c_; ssq = ssq_; tab = tab_; nsplit = 0; wgm = WGM; rowscale = nullptr; }
    __device__ __forceinline__ void split_tail(int ns) { if (G == 256 && nM == 64 && ns == 2) { nsplit = ns; nN -= ns; nwg = nM * nN; } }
    __device__ __forceinline__ bool next(int i, Unit& u) const {
        const long L = (long)i * G + c;
        const bool tail = L >= nwg;
        if (tail && (nsplit == 0 || L >= nwg + G)) return false;
        int wgid = tail ? 0 : (int)L; { const int q = nwg / NXCD, r = nwg % NXCD, xcd = wgid % NXCD, off = wgid / NXCD; wgid = (xcd < r ? xcd * (q + 1) : r * (q + 1) + (xcd - r) * q) + off; }
        const int nig = wgm * nN, gid = wgid / nig, fm = gid * wgm, gsz = (nM - fm) < wgm ? (nM - fm) : wgm;
        const int x = c & 7, j = c >> 3;
        const int pm = tail ? 8 * x + (j & 7) : fm + ((wgid % nig) % gsz);
        const int pn = tail ? nN + ((j >> 3) & 1) : (wgid % nig) / gsz;
        const int hm = tail ? (j >> 4) : -1;
        u.pm = pm; u.pn = pn; u.idx = i; u.hm = hm; return true;
    }
    __device__ __forceinline__ void a_ready(const Unit& u) const {
        int t_ = threadIdx.x; asm volatile("" : "+v"(t_));
        if (rowscale != nullptr) { if (t_ < 256) tab[(u.idx & 1) * 256 + t_] = rowscale[u.pm * BM + (u.hm > 0 ? HALF : 0) + t_]; }
        else if (ssq != nullptr && t_ < 256) {
            const float s = ssq_val(ssq + (size_t)(u.pm * BM + (u.hm > 0 ? HALF : 0) + t_) * 16);
            tab[(u.idx & 1) * 256 + t_] = __builtin_amdgcn_rsqf(s * (1.0f / D) + EPS);
        }
    }
    __device__ __forceinline__ void done(const Unit&) const {}
};

__device__ __forceinline__ float sigmoidf_fast(float x) { return __builtin_amdgcn_rcpf(1.0f + __expf(-x)); }

struct EpiProj {
    static constexpr bool PERM = true, HAS_INIT = false;
    bf16_t* O; const LAS float* tab;
    __device__ __forceinline__ void operator()(const f32x4 (&acc)[2][2][4][2], const Unit& u, int wr, int wc, int fr, int fq) const {
        const LAS float* t = tab + (u.idx & 1) * 256;
        const bool sig = u.pn >= 8;
        const int row0 = u.pm * BM + wr * 64 + fr, col0 = u.pn * BM + wc * 32 + 8 * fq;
#pragma unroll
        for (int ai = 0; ai < 2; ++ai)
#pragma unroll
            for (int m = 0; m < 4; ++m) {
                const float rs = t[ai * HALF + wr * 64 + m * 16 + fr];
                bf16_t* rowp = O + (size_t)(row0 + ai * HALF + m * 16) * NQKVO + col0;
#pragma unroll
                for (int bj = 0; bj < 2; ++bj) {
                    f32x4 v0 = acc[ai][bj][m][0] * rs, v1 = acc[ai][bj][m][1] * rs;
                    if (sig) {
#pragma unroll
                        for (int i = 0; i < 4; ++i) { v0[i] = sigmoidf_fast(v0[i]); v1[i] = sigmoidf_fast(v1[i]); }
                    }
                    u32x4 w; w.x = cvt_pk_bf16(v0[0], v0[1]); w.y = cvt_pk_bf16(v0[2], v0[3]); w.z = cvt_pk_bf16(v1[0], v1[1]); w.w = cvt_pk_bf16(v1[2], v1[3]);
                    *(u32x4*)(rowp + bj * HALF) = w;
                }
            }
    }
};
struct EpiGU {
    static constexpr bool PERM = true, HAS_INIT = false;
    bf16_t* H; const LAS float* tab;
    __device__ __forceinline__ void operator()(const f32x4 (&acc)[2][2][4][2], const Unit& u, int wr, int wc, int fr, int fq) const {
        const LAS float* t = tab + (u.idx & 1) * 256;
        const int row0 = u.pm * BM + (u.hm > 0 ? HALF : 0) + wr * 64 + fr, col0 = u.pn * HALF + wc * 32 + 8 * fq;
#pragma unroll
        for (int ai = 0; ai < 2; ++ai) { if (ai == 1 && u.hm >= 0) break;
#pragma unroll
            for (int m = 0; m < 4; ++m) {
                const float rs = t[ai * HALF + wr * 64 + m * 16 + fr];
                const float c1 = rs * -1.4426950408889634f, rs2 = rs * rs;
                float hv[8];
#pragma unroll
                for (int n = 0; n < 2; ++n)
#pragma unroll
                    for (int i = 0; i < 4; ++i) { const float g = acc[ai][0][m][n][i], uu = acc[ai][1][m][n][i]; hv[n * 4 + i] = (g * uu) * (rs2 * __builtin_amdgcn_rcpf(1.0f + __builtin_amdgcn_exp2f(g * c1))); }
                u32x4 w; w.x = cvt_pk_bf16(hv[0], hv[1]); w.y = cvt_pk_bf16(hv[2], hv[3]); w.z = cvt_pk_bf16(hv[4], hv[5]); w.w = cvt_pk_bf16(hv[6], hv[7]);
                *(u32x4*)(H + (size_t)(row0 + ai * HALF + m * 16) * FF + col0) = w;
            }
        }
    }
};
struct EpiGU8 {
    static constexpr bool PERM = true, HAS_INIT = false;
    bf16_t* H; const LAS float* tab; const float* colscale;
    __device__ __forceinline__ void operator()(const i32x4 (&acc)[2][2][4][2], const Unit& u, int wr, int wc, int fr, int fq) const {
        const LAS float* t = tab + (u.idx & 1) * 256;
        const int row0 = u.pm * BM + wr * 64 + fr, col0 = u.pn * HALF + wc * 32 + 8 * fq;
        const float* cs = colscale + u.pn * BM + wc * 32 + 8 * fq;
        const f32x4 sg0 = *(const f32x4*)cs, sg1 = *(const f32x4*)(cs + 4), su0 = *(const f32x4*)(cs + HALF), su1 = *(const f32x4*)(cs + HALF + 4);
#pragma unroll
        for (int ai = 0; ai < 2; ++ai)
#pragma unroll
            for (int m = 0; m < 4; ++m) {
                const float rs = t[ai * HALF + wr * 64 + m * 16 + fr];
                float hv[8];
#pragma unroll
                for (int n = 0; n < 2; ++n)
#pragma unroll
                    for (int i = 0; i < 4; ++i) { const float g = (float)acc[ai][0][m][n][i] * (rs * (n ? sg1[i] : sg0[i])), uu = (float)acc[ai][1][m][n][i] * (rs * (n ? su1[i] : su0[i]));
                        hv[n * 4 + i] = (g * uu) * __builtin_amdgcn_rcpf(1.0f + __builtin_amdgcn_exp2f(g * -1.4426950408889634f)); }
                u32x4 w; w.x = cvt_pk_bf16(hv[0], hv[1]); w.y = cvt_pk_bf16(hv[2], hv[3]); w.z = cvt_pk_bf16(hv[4], hv[5]); w.w = cvt_pk_bf16(hv[6], hv[7]);
                *(u32x4*)(H + (size_t)(row0 + ai * HALF + m * 16) * FF + col0) = w;
            }
    }
};
struct EpiRes {
    static constexpr bool PERM = true, HAS_INIT = true;
    bf16_t* xb; bf16_t* xo; ssq_t* ssq_out;
    __device__ __forceinline__ void init_load(u32x4 (&t)[2][4][2], const Unit& u, int wr, int wc, int fr, int fq) const {
        const int row0 = u.pm * BM + wr * 64 + fr, col0 = u.pn * BM + wc * 32 + 8 * fq;
#pragma unroll
        for (int ai = 0; ai < 2; ++ai)
#pragma unroll
            for (int m = 0; m < 4; ++m)
#pragma unroll
                for (int bj = 0; bj < 2; ++bj) t[ai][m][bj] = *(const u32x4*)(xb + (size_t)(row0 + ai * HALF + m * 16) * D + col0 + bj * HALF);
    }
    __device__ __forceinline__ void init_cvt(f32x4 (&acc)[2][2][4][2], const u32x4 (&t)[2][4][2]) const {
#pragma unroll
        for (int ai = 0; ai < 2; ++ai)
#pragma unroll
            for (int m = 0; m < 4; ++m)
#pragma unroll
                for (int bj = 0; bj < 2; ++bj) { const u32x4 v = t[ai][m][bj];
                    acc[ai][bj][m][0] = (f32x4){bflo(v.x), bfhi(v.x), bflo(v.y), bfhi(v.y)}; acc[ai][bj][m][1] = (f32x4){bflo(v.z), bfhi(v.z), bflo(v.w), bfhi(v.w)}; }
    }
    __device__ __forceinline__ void init(f32x4 (&acc)[2][2][4][2], const Unit& u, int wr, int wc, int fr, int fq) const { u32x4 t[2][4][2]; init_load(t, u, wr, wc, fr, fq); init_cvt(acc, t); }
    __device__ __forceinline__ void operator()(const f32x4 (&acc)[2][2][4][2], const Unit& u, int wr, int wc, int fr, int fq) const {
        const int row0 = u.pm * BM + wr * 64 + fr, col0 = u.pn * BM + wc * 32 + 8 * fq;
#pragma unroll
        for (int ai = 0; ai < 2; ++ai)
#pragma unroll
            for (int m = 0; m < 4; ++m) {
                const int row = row0 + ai * HALF + m * 16; float ss = 0.f;
#pragma unroll
                for (int bj = 0; bj < 2; ++bj) {
                    const f32x4 v0 = acc[ai][bj][m][0], v1 = acc[ai][bj][m][1];
                    u32x4 w; w.x = cvt_pk_bf16(v0[0], v0[1]); w.y = cvt_pk_bf16(v0[2], v0[3]); w.z = cvt_pk_bf16(v1[0], v1[1]); w.w = cvt_pk_bf16(v1[2], v1[3]);
                    *(u32x4*)(xo + (size_t)row * D + col0 + bj * HALF) = w;
                    ss += ((v0[0] * v0[0] + v0[1] * v0[1]) + (v0[2] * v0[2] + v0[3] * v0[3])) + ((v1[0] * v1[0] + v1[1] * v1[1]) + (v1[2] * v1[2] + v1[3] * v1[3]));
                }
                ss += __shfl_xor(ss, 16); ss += __shfl_xor(ss, 32);
                if (fq == 0) ssq_out[(size_t)row * 16 + u.pn * 4 + wc] = ss;
            }
    }
};

template <bool I8> struct AccOf { typedef f32x4 type; };
template <> struct AccOf<true> { typedef i32x4 type; };
template <bool I8> __device__ __forceinline__ typename AccOf<I8>::type mma16(const bf16x8& b, const bf16x8& a, typename AccOf<I8>::type c) {
    if constexpr (I8) return __builtin_amdgcn_mfma_i32_16x16x64_i8(__builtin_bit_cast(i32x4, b), __builtin_bit_cast(i32x4, a), c, 0, 0, 0);
    else return __builtin_amdgcn_mfma_f32_16x16x32_bf16(b, a, c, 0, 0, 0);
}
template <class Epi, bool ALIGN_EPI, int LDA, int LDB, int KLEN, int ACOL, bool HALFU = false, bool I8 = false>
__device__ __forceinline__ void gemm_phase(LAS unsigned char* lds, const Gemm g, const Order& S, const Epi& E) {
    int tid_ = threadIdx.x; asm volatile("" : "+v"(tid_));
    const int tid = tid_, wid = __builtin_amdgcn_readfirstlane(tid >> 6), lane = tid & 63, wr = wid >> 2, wc = wid & 3, fr = lane & 15, fq = lane >> 4;
    constexpr int nt = KLEN / BK;
    unsigned voffA[2], voffB[2];
#pragma unroll
    for (int i = 0; i < 2; ++i) {
        const int R = i * 64 + (tid >> 3), C = 8 * ((tid & 7) ^ ((R >> 1) & 7)); const int Rb = Epi::PERM ? ((R & ~31) + perm32(R & 31)) : R;
        voffA[i] = (unsigned)(R * LDA + C) * 2u; voffB[i] = (unsigned)(Rb * LDB + C) * 2u; }
    constexpr size_t kstep = (size_t)(BK * 2);
    constexpr size_t hstepA = (size_t)HALF * LDA * 2, tstepA = 2 * hstepA, hstepB = (size_t)HALF * LDB * 2, tstepB = 2 * hstepB;
    constexpr size_t pnstepA = (size_t)ACOL * 2;
    const unsigned ldsw = (unsigned)wid * 1024u;
    const int sw0 = 16 * (fq ^ ((fr >> 1) & 7)), aoff0 = (wr * 64 + fr) * 128 + sw0, aoff1 = aoff0 ^ 64, boff0 = (wc * 32 + fr) * 128 + sw0, boff1 = boff0 ^ 64;
#define PG8_SA(b, h) (((b) * 2 + (h)) * HTB)
#define PG8_SB(b, h) ((4 + (b) * 2 + (h)) * HTB)
#define PG8_STAGE(bufoff, gbase, voff) do { _Pragma("unroll") for (int _i = 0; _i < 2; ++_i) \
        __builtin_amdgcn_global_load_lds((const unsigned*)((const char*)(gbase) + (voff)[_i]), (LAS unsigned*)(lds + (bufoff) + ldsw + _i * 8192), 16, 0, 0); } while (0)
#define PG8_LDA(dst, b, h) do { _Pragma("unroll") for (int m = 0; m < 4; ++m) _Pragma("unroll") for (int k = 0; k < 2; ++k) dst[m][k] = *(const LAS bf16x8*)(lds + PG8_SA(b, h) + (k ? aoff1 : aoff0) + m * 2048); } while (0)
#define PG8_LDB(dst, b, h) do { _Pragma("unroll") for (int n = 0; n < 2; ++n) _Pragma("unroll") for (int k = 0; k < 2; ++k) dst[n][k] = *(const LAS bf16x8*)(lds + PG8_SB(b, h) + (k ? boff1 : boff0) + n * 2048); } while (0)
#define PG8_MMA(ai, bj, At, Bt) do { __builtin_amdgcn_s_setprio(1); _Pragma("unroll") for (int m = 0; m < 4; ++m) _Pragma("unroll") for (int n = 0; n < 2; ++n) _Pragma("unroll") for (int k = 0; k < 2; ++k) \
        acc[ai][bj][m][n] = mma16<I8>(Bt[n][k], At[m][k], acc[ai][bj][m][n]); __builtin_amdgcn_s_setprio(0); } while (0)
#define PG8_WAIT_V(n) asm volatile("s_waitcnt vmcnt(" #n ")" ::: "memory")
#define PG8_WAIT_L(n) asm volatile("s_waitcnt lgkmcnt(" #n ")" ::: "memory")
#define PG8_BAR __builtin_amdgcn_s_barrier()
#define PG8_SCHED __builtin_amdgcn_sched_barrier(0)
    Unit cur, nxt; int ui = 0;
    if (!S.next(0, cur)) return;
    typedef typename AccOf<I8>::type acc_t;
    acc_t acc[2][2][4][2];
    u32x4 xt[Epi::HAS_INIT ? 2 : 1][4][2];
    if constexpr (Epi::HAS_INIT) E.init_load(xt, cur, wr, wc, fr, fq);
    else {
#pragma unroll
    for (int a = 0; a < 2; ++a)
#pragma unroll
        for (int b = 0; b < 2; ++b)
#pragma unroll
            for (int m = 0; m < 4; ++m)
#pragma unroll
                for (int n = 0; n < 2; ++n) acc[a][b][m][n] = acc_t{};
    }
    bf16x8 At[4][2], B0[2][2], B1[2][2];
    const char* cA = (const char*)g.A + (size_t)cur.pm * tstepA + (size_t)cur.pn * pnstepA + ((HALFU && cur.hm > 0) ? hstepA : 0); const char* cB = (const char*)g.Bt + (size_t)cur.pn * tstepB;
    S.a_ready(cur);
    PG8_STAGE(PG8_SB(0, 0), cB, voffB); PG8_STAGE(PG8_SB(0, 1), cB + hstepB, voffB); PG8_STAGE(PG8_SA(0, 0), cA, voffA); PG8_STAGE(PG8_SA(0, 1), cA + hstepA, voffA);
    if constexpr (Epi::HAS_INIT) E.init_cvt(acc, xt);
    if (wr == 1) PG8_BAR;
    PG8_WAIT_V(2); PG8_BAR;
    PG8_STAGE(PG8_SB(1, 0), cB + kstep, voffB); PG8_STAGE(PG8_SA(1, 0), cA + kstep, voffA); PG8_STAGE(PG8_SB(1, 1), cB + hstepB + kstep, voffB);
    PG8_WAIT_V(6); PG8_BAR;
    for (;;) {
        const bool has_next = S.next(ui + 1, nxt);
        const char* nA = has_next ? (const char*)g.A + (size_t)nxt.pm * tstepA + (size_t)nxt.pn * pnstepA + ((HALFU && nxt.hm > 0) ? hstepA : 0) : cA;
        const bool full = !HALFU || cur.hm < 0;
        const char* nB = has_next ? (const char*)g.Bt + (size_t)nxt.pn * tstepB : cB;
#pragma unroll 1
        for (int t = 0; t < nt; t += 2) {
            const bool last = (t == nt - 2);
            const char* a1 = cA + (size_t)(t + 1) * kstep;
            const char* a2 = last ? nA : cA + (size_t)(t + 2) * kstep; const char* b2 = last ? nB : cB + (size_t)(t + 2) * kstep;
            const char* a3 = a2 + kstep; const char* b3 = b2 + kstep;
            if (last && has_next) S.a_ready(nxt);
            PG8_LDB(B0, 0, 0); PG8_LDB(B1, 0, 1); PG8_SCHED; PG8_LDA(At, 0, 0); PG8_STAGE(PG8_SA(1, 1), a1 + hstepA, voffA);
            PG8_WAIT_V(8); PG8_WAIT_L(0); PG8_BAR; PG8_MMA(0, 0, At, B0); PG8_MMA(0, 1, At, B1); PG8_BAR; PG8_SCHED;
            PG8_LDA(At, 0, 1); PG8_STAGE(PG8_SB(0, 0), b2, voffB); PG8_STAGE(PG8_SB(0, 1), b2 + hstepB, voffB); PG8_STAGE(PG8_SA(0, 0), a2, voffA);
            PG8_WAIT_V(8); PG8_WAIT_L(0); PG8_BAR; if (full) { PG8_MMA(1, 0, At, B0); PG8_MMA(1, 1, At, B1); } PG8_BAR; PG8_SCHED;
            PG8_LDB(B0, 1, 0); PG8_LDB(B1, 1, 1); PG8_SCHED; PG8_LDA(At, 1, 0); PG8_STAGE(PG8_SA(0, 1), a2 + hstepA, voffA);
            PG8_WAIT_V(8); PG8_WAIT_L(0); PG8_BAR; PG8_MMA(0, 0, At, B0); PG8_MMA(0, 1, At, B1); PG8_BAR; PG8_SCHED;
            PG8_LDA(At, 1, 1); PG8_STAGE(PG8_SB(1, 0), b3, voffB); PG8_STAGE(PG8_SB(1, 1), b3 + hstepB, voffB); PG8_STAGE(PG8_SA(1, 0), a3, voffA);
            PG8_WAIT_V(8); PG8_WAIT_L(0); PG8_BAR; if (full) { PG8_MMA(1, 0, At, B0); PG8_MMA(1, 1, At, B1); } PG8_BAR; PG8_SCHED;
        }
        if constexpr (ALIGN_EPI) { if (wr == 0) PG8_BAR; }
        E(acc, cur, wr, wc, fr, fq);
#if defined(PROBE_EPI2)
        E(acc, cur, wr, wc, fr, fq); E(acc, cur, wr, wc, fr, fq);
#endif
        S.done(cur);
        if (!has_next) break;
        if constexpr (Epi::HAS_INIT) E.init(acc, nxt, wr, wc, fr, fq);
        else {
#pragma unroll
        for (int a = 0; a < 2; ++a)
#pragma unroll
            for (int b = 0; b < 2; ++b)
#pragma unroll
                for (int m = 0; m < 4; ++m)
#pragma unroll
                    for (int n = 0; n < 2; ++n) acc[a][b][m][n] = acc_t{};
        }
        cur = nxt; cA = nA; cB = nB; ++ui;
        if constexpr (ALIGN_EPI) { if (wr == 1) PG8_BAR; }
    }
    PG8_WAIT_V(0);
    if constexpr (!ALIGN_EPI) { if (wr == 0) PG8_BAR; }
    PG8_BAR;
#undef PG8_SA
#undef PG8_SB
#undef PG8_STAGE
#undef PG8_LDA
#undef PG8_LDB
#undef PG8_MMA
#undef PG8_WAIT_V
#undef PG8_WAIT_L
#undef PG8_BAR
#undef PG8_SCHED
}
}

constexpr size_t MiB = 1u << 20;
constexpr size_t WS_CTL = 0, CTL_ZERO_BYTES = 1 * MiB;
constexpr size_t SZ_WIN = (size_t)NQKVO * D * 2, SZ_WOUT = (size_t)D * D * 2, SZ_WPOOL = (size_t)D * 256 * 2, SZ_WGU = (size_t)GU * D * 2, SZ_WDN = (size_t)D * FF * 2, SZ_WG = (size_t)16 * D * 2;
constexpr size_t WS_WIN = 1 * MiB;
constexpr size_t WS_WOUT = WS_WIN + 2 * SZ_WIN;
constexpr size_t WS_WPOOL = WS_WOUT + 2 * SZ_WOUT;
constexpr size_t WS_WGU = WS_WPOOL + 2 * SZ_WPOOL;
constexpr size_t WS_WDN = WS_WGU + 4 * SZ_WGU;
constexpr size_t WS_WG = WS_WDN + 4 * SZ_WDN;
constexpr size_t WS_SSQ = WS_WG + 2 * SZ_WG;
constexpr size_t SZ_SSQ = (size_t)M * 16 * 4;
constexpr size_t WS_GATES = WS_SSQ + 9 * SZ_SSQ;
constexpr size_t WS_DECAY = WS_GATES + (size_t)M * 16 * 4;
constexpr size_t WS_GT = WS_DECAY + 4096;
constexpr size_t WS_XB = ((WS_GT + (size_t)512 * 512 * 4 + MiB - 1) / MiB) * MiB;
constexpr size_t WS_BIG = WS_XB + (size_t)M * D * 2;
constexpr size_t WS_ST = WS_BIG + (size_t)M * NQKVO * 2;
constexpr size_t WS_A8 = ((WS_ST + (size_t)NITEM * STE * 2 + 4095) / 4096) * 4096;
constexpr size_t WS_RS8 = WS_A8 + (size_t)M * D;
constexpr size_t WS_SB = WS_RS8 + (size_t)M * 4;
constexpr size_t WS_END = WS_SB + (size_t)4 * GU * 4;
static_assert(WS_END <= 352 * MiB, "d_ws map must fit the guaranteed workspace");
static_assert((size_t)M * FF * 2 <= (size_t)M * NQKVO * 2, "H overlays q|k|v|o");

constexpr int CW_BAR = 4096;
constexpr int CW_CENSUS = 8192;
constexpr int CW_XL_SUB = 9216, CW_XL_GEN = 10240;
constexpr int RING_OFF = 0, RING_BYTES = 131072;
constexpr int LDSCTL_OFF = RING_BYTES, MISC_OFF = LDSCTL_OFF + 320;
constexpr int RSTD_OFF = RING_BYTES + 1024;
constexpr int TAB_OFF = RING_BYTES + 3072;
constexpr int LDS_BYTES = 147456;
constexpr int NWAVES = 8, NT = NWAVES * 64;

#define VM_WAIT() asm volatile("s_waitcnt vmcnt(0)" ::: "memory")
#define LDS_WAIT() asm volatile("s_waitcnt lgkmcnt(0)" ::: "memory")

#define XB_TMO      128
#define XB_XCNT(j)  (256  + 64 * (j))
#define XB_XSUB(j)  (1280 + 64 * (j))
#define XB_XGEN(j)  (2304 + 64 * (j))
#define XB_TOP      3328
#define XB_TOPGEN   3392
#define XCD_BAR_WORDS 3456
#define XB_SPIN_CAP (1u << 18)
__device__ __forceinline__ unsigned xb_ld(unsigned* p)              { return __hip_atomic_load(p, __ATOMIC_RELAXED, __HIP_MEMORY_SCOPE_AGENT); }
__device__ __forceinline__ unsigned xb_add(unsigned* p, unsigned v) { return __hip_atomic_fetch_add(p, v, __ATOMIC_RELAXED, __HIP_MEMORY_SCOPE_AGENT); }
__device__ __forceinline__ unsigned xb_xcc_id() { return (unsigned)__builtin_amdgcn_s_getreg((3 << 11) | 20) & 0xFu; }
#define XB_SPIN(cond, bar) do { unsigned _sp = 0; while (cond) { __builtin_amdgcn_s_sleep(1); \
    if ((++_sp & 255u) == 0u) { if (xb_ld(&(bar)[XB_TMO])) break; if (_sp > XB_SPIN_CAP) { atomicAdd(&(bar)[XB_TMO], 1u); break; } } } } while (0)
struct XcdBarrier { unsigned* bar; unsigned x; volatile LAS unsigned* st; };
__device__ __forceinline__ XcdBarrier xcd_barrier_post(unsigned* bar, volatile LAS unsigned* st) {
    XcdBarrier b; b.bar = bar; b.x = xb_xcc_id(); b.st = st;
    if (threadIdx.x == 0) (void)xb_add(&bar[XB_XCNT(b.x)], 1u);
    return b;
}
__device__ __forceinline__ void xcd_barrier_complete(unsigned* bar, unsigned x, unsigned& nloc, unsigned& nx) {
    const unsigned G = gridDim.x * gridDim.y * gridDim.z;
    unsigned sum, cnt, mine, sp = 0u;
    for (;;) {
        sum = 0u; cnt = 0u; mine = 0u;
#pragma unroll
        for (unsigned j = 0; j < 16; ++j) { const unsigned c = xb_ld(&bar[XB_XCNT(j)]); sum += c; cnt += (c > 0u) ? 1u : 0u; mine = (j == x) ? c : mine; }
        if (sum == G) break;
        __builtin_amdgcn_s_sleep(1);
        if ((++sp & 255u) == 0u) { if (xb_ld(&bar[XB_TMO])) break; if (sp > XB_SPIN_CAP) { atomicAdd(&bar[XB_TMO], 1u); break; } }
    }
    nloc = mine > 0u ? mine : 1u; nx = cnt > 0u ? cnt : 1u;
}
__device__ __forceinline__ void xcd_barrier(const XcdBarrier& b) {
    asm volatile("s_waitcnt vmcnt(0)" ::: "memory");
    __syncthreads();
    if (threadIdx.x == 0) {
        unsigned* bar = b.bar;
        __builtin_amdgcn_s_waitcnt(0);
        unsigned nloc = b.st[0], nx = b.st[1];
        if (nloc == 0u) { xcd_barrier_complete(bar, b.x, nloc, nx); b.st[0] = nloc; b.st[1] = nx; }
        const unsigned old = xb_add(&bar[XB_XSUB(b.x)], 1u);
        const unsigned gen = old / nloc;
        if (old + 1u == (gen + 1u) * nloc) {
            __builtin_amdgcn_fence(__ATOMIC_RELEASE, "agent");
            asm volatile("s_waitcnt vmcnt(0)" ::: "memory");
            const unsigned og = xb_add(&bar[XB_TOP], 1u);
            const unsigned tg = og / nx;
            if (og + 1u == (tg + 1u) * nx) xb_add(&bar[XB_TOPGEN], 1u);
            else XB_SPIN(xb_ld(&bar[XB_TOPGEN]) == tg, bar);
            __builtin_amdgcn_fence(__ATOMIC_ACQUIRE, "agent");
            xb_add(&bar[XB_XGEN(b.x)], 1u);
            asm volatile("s_waitcnt vmcnt(0)" ::: "memory");
        } else {
            XB_SPIN(xb_ld(&bar[XB_XGEN(b.x)]) == gen, bar);
            __builtin_amdgcn_fence(__ATOMIC_ACQUIRE, "agent");
            asm volatile("s_waitcnt vmcnt(0)" ::: "memory");
        }
    }
    __syncthreads();
}

__device__ __forceinline__ void xcc_local_barrier(unsigned* ctl, unsigned x, unsigned nloc) {
    asm volatile("s_waitcnt vmcnt(0)" ::: "memory");
    __syncthreads();
    if (threadIdx.x == 0) {
        const unsigned old = xb_add(&ctl[CW_XL_SUB + 64 * x], 1u);
        const unsigned gen = old / nloc;
        if (old + 1u == (gen + 1u) * nloc) xb_add(&ctl[CW_XL_GEN + 64 * x], 1u);
        else XB_SPIN(xb_ld(&ctl[CW_XL_GEN + 64 * x]) == gen, ctl + CW_BAR);
        __builtin_amdgcn_fence(__ATOMIC_ACQUIRE, "agent");
        asm volatile("s_waitcnt vmcnt(0)" ::: "memory");
    }
    __syncthreads();
}

__device__ __forceinline__ float wave_sum(float v) {
#pragma unroll
    for (int o = 1; o < 64; o <<= 1) v += __shfl_xor(v, o);
    return v;
}
__device__ __forceinline__ float log_sigmoidf(float x) { return fminf(x, 0.f) - log1pf(expf(-fabsf(x))); }
__device__ __forceinline__ float rstd_of(const ssq_t* ssq_row) { return 1.0f / sqrtf(ssq_val(ssq_row) * (1.0f / D) + EPS); }

__device__ __forceinline__ void tr_item64(const float* W, int ldW, int k0, int c0, bf16_t* WT, int ldT, int r0, const float* kg, const float* cg, float mul, LAS unsigned* scr, int lane) {
    const int n4 = lane & 15, kq = lane >> 4;
    f32x4 cm = (f32x4){mul, mul, mul, mul}; if (cg) cm = *(const f32x4*)(cg + c0 + 4 * n4) * mul;
    f32x4 va[8], vb[8];
#pragma unroll
    for (int i = 0; i < 8; ++i) { const int kp = kq + 4 * i; const float* p = W + (size_t)(k0 + 2 * kp) * ldW + c0 + 4 * n4; va[i] = *(const f32x4*)p; vb[i] = *(const f32x4*)(p + ldW); }
#pragma unroll
    for (int i = 0; i < 8; ++i) { const int kp = kq + 4 * i; const float g0 = kg ? kg[k0 + 2 * kp] : 1.0f, g1 = kg ? kg[k0 + 2 * kp + 1] : 1.0f;
#pragma unroll
        for (int e = 0; e < 4; ++e) scr[kp * 65 + 4 * n4 + e] = pack2(va[i][e] * cm[e] * g0, vb[i][e] * cm[e] * g1); }
    LDS_WAIT(); asm volatile("" ::: "memory");
    const int j = lane & 7, nl = lane >> 3;
#pragma unroll
    for (int it = 0; it < 8; ++it) { const int n = nl + 8 * it; u32x4 o; o.x = scr[(4 * j + 0) * 65 + n]; o.y = scr[(4 * j + 1) * 65 + n]; o.z = scr[(4 * j + 2) * 65 + n]; o.w = scr[(4 * j + 3) * 65 + n];
        *(u32x4*)(WT + (size_t)(r0 + n) * ldT + k0 + 8 * j) = o; }
    LDS_WAIT(); asm volatile("" ::: "memory");
}

struct Args;
constexpr int I_IN = 16 * 48, I_OUT = 16 * 16, I_POOL = 4 * 4 * 4, I_GU = 16 * 88, I_DN = 44 * 16;
constexpr int CV_P0 = I_IN + I_OUT, CV_T0 = CV_P0 + I_DN + I_POOL + I_OUT, CV_T1 = CV_T0 + I_DN + I_IN, CV_T2 = CV_T1 + I_DN + I_POOL, CV_END = CV_T2 + I_DN;
constexpr int GU_ITEMS = GU / 64;
struct Args { const float* in[12]; float* out; unsigned char* ws; int ph_lo, ph_hi; };

enum { JT_GU = 0, JT_DN = 1, JT_IN = 2, JT_OUT = 3, JT_POOL = 4 };
__device__ __forceinline__ void convert_one(const Args& args, unsigned char* ws, LAS unsigned* scr, int lane, int type, int l, int r) {
    const float* const* in = args.in;
    if (type == JT_GU) { const int kb = r / 88, nb = r % 88, r0 = nb * 64, pn = r0 >> 8, j = r0 & 255; const int c0 = (j < 128) ? pn * 128 + j : FF + pn * 128 + (j - 128);
        tr_item64(in[9] + (size_t)l * D * GU, GU, kb * 64, c0, (bf16_t*)(ws + WS_WGU) + (size_t)l * GU * D, D, r0, in[2] + l * D, nullptr, 1.0f, scr, lane); }
    else if (type == JT_DN) { const int kb = r / 16, nb = r % 16;
        tr_item64(in[10] + (size_t)l * FF * D, D, kb * 64, nb * 64, (bf16_t*)(ws + WS_WDN) + (size_t)l * D * FF, FF, nb * 64, nullptr, nullptr, 1.0f, scr, lane); }
    else if (type == JT_IN) { const int kb = r / 48, nb = r % 48, r0 = nb * 64;
        tr_item64(in[3] + (size_t)l * D * NIN, NIN, kb * 64, r0, (bf16_t*)(ws + WS_WIN) + (size_t)l * NQKVO * D, D, r0, in[1] + (2 * l) * D, nullptr, (r0 >= 512 && r0 < 1024) ? 0.125f : 1.0f, scr, lane); }
    else if (type == JT_OUT) { const int kb = r / 16, nb = r % 16;
        tr_item64(in[6] + (size_t)l * D * D, D, kb * 64, nb * 64, (bf16_t*)(ws + WS_WOUT) + (size_t)l * D * D, D, nb * 64, in[5] + l * D, nullptr, 1.0f, scr, lane); }
    else { const int gi = r / 16, r2 = r % 16, kb = r2 / 4, nb = r2 % 4;
        tr_item64(in[7] + (size_t)(l * 4 + gi) * 256 * 256, 256, kb * 64, nb * 64, (bf16_t*)(ws + WS_WPOOL) + (size_t)l * D * 256 + (size_t)gi * 256 * 256, 256, nb * 64,
                  in[1] + (2 * l + 1) * D + gi * 256, in[8] + l * D + gi * 256, 1.0f, scr, lane); }
}
__device__ __forceinline__ void convert_items(const Args& args, unsigned char* ws, LAS unsigned* scr, int lane, int lo, int hi, int w, int nw) {
    for (int it = lo + w; it < hi; it += nw) {
        int r = it;
#define CV_JOB(T, L, N) if (r < (N)) { convert_one(args, ws, scr, lane, T, L, r); continue; } r -= (N);
        CV_JOB(JT_IN, 0, I_IN) CV_JOB(JT_OUT, 0, I_OUT)
        CV_JOB(JT_DN, 0, I_DN) CV_JOB(JT_POOL, 0, I_POOL) CV_JOB(JT_OUT, 1, I_OUT)
        CV_JOB(JT_DN, 1, I_DN) CV_JOB(JT_IN, 1, I_IN)
        CV_JOB(JT_DN, 2, I_DN) CV_JOB(JT_POOL, 1, I_POOL)
        CV_JOB(JT_DN, 3, I_DN)
#undef CV_JOB
    }
}
constexpr int N_PHASES = 24;

__device__ __forceinline__ void quant_gu_item(const Args& args, unsigned char* ws, LAS unsigned char* lds, int layer, int nb, int tid) {
    const int lane = tid & 63, wave = __builtin_amdgcn_readfirstlane(tid >> 6);
    const float* W = args.in[9] + (size_t)layer * D * GU; const float* kg = args.in[2] + layer * D;
    const int r0 = nb * 64, pn = r0 >> 8, jt = r0 & 255, c0 = (jt < 128) ? pn * 128 + jt : FF + pn * 128 + (jt - 128);
    LAS float* part = (LAS float*)(lds + 69632); LAS float* sc = part + 512;
    const int n4 = tid & 15, kq = tid >> 4;
    f32x4 v[32];
#pragma unroll
    for (int j = 0; j < 32; ++j) v[j] = *(const f32x4*)(W + (size_t)(kq * 32 + j) * GU + c0 + 4 * n4);
    f32x4 mx = (f32x4){0.f, 0.f, 0.f, 0.f};
#pragma unroll
    for (int a = 0; a < 8; ++a) { const f32x4 g4 = *(const f32x4*)(kg + kq * 32 + 4 * a);
#pragma unroll
        for (int i = 0; i < 4; ++i) { v[4 * a + i] = v[4 * a + i] * g4[i];
#pragma unroll
            for (int e = 0; e < 4; ++e) mx[e] = fmaxf(mx[e], fabsf(v[4 * a + i][e])); } }
#pragma unroll
    for (int e = 0; e < 4; ++e) { mx[e] = fmaxf(mx[e], __shfl_xor(mx[e], 16)); mx[e] = fmaxf(mx[e], __shfl_xor(mx[e], 32)); }
    if (lane < 16) *(LAS f32x4*)(part + wave * 64 + 4 * n4) = mx;
    __syncthreads();
    if (tid < 64) { float m = 0.f;
#pragma unroll
        for (int w = 0; w < 8; ++w) m = fmaxf(m, part[w * 64 + tid]);
        sc[tid] = m > 0.f ? 127.0f / m : 0.f; ((float*)(ws + WS_SB))[(size_t)layer * GU + r0 + tid] = m * (1.0f / 127.0f); }
    __syncthreads();
    LAS unsigned* scr = (LAS unsigned*)(lds + wave * 8448);
    const f32x4 isc = *(const LAS f32x4*)(sc + 4 * n4);
#pragma unroll
    for (int a = 0; a < 8; ++a)
#pragma unroll
        for (int e = 0; e < 4; ++e) { const float is = isc[e];
            const unsigned q0 = (unsigned)__float2int_rn(v[4 * a][e] * is) & 255u, q1 = (unsigned)__float2int_rn(v[4 * a + 1][e] * is) & 255u,
                           q2 = (unsigned)__float2int_rn(v[4 * a + 2][e] * is) & 255u, q3 = (unsigned)__float2int_rn(v[4 * a + 3][e] * is) & 255u;
            scr[((kq & 3) * 8 + a) * 65 + 4 * n4 + e] = q0 | (q1 << 8) | (q2 << 16) | (q3 << 24); }
    LDS_WAIT(); asm volatile("" ::: "memory");
    unsigned char* B8 = ws + WS_WGU + ((size_t)layer * GU + r0) * D + wave * 128;
    const int j8 = lane & 7, nl = lane >> 3;
#pragma unroll
    for (int it = 0; it < 8; ++it) { const int n = nl + 8 * it; u32x4 o; o.x = scr[(4 * j8 + 0) * 65 + n]; o.y = scr[(4 * j8 + 1) * 65 + n]; o.z = scr[(4 * j8 + 2) * 65 + n]; o.w = scr[(4 * j8 + 3) * 65 + n];
        *(u32x4*)(B8 + (size_t)n * D + 16 * j8) = o; }
    LDS_WAIT(); asm volatile("" ::: "memory");
}

__global__ void __launch_bounds__(NT, 2) fwd_kernel(Args args) {
    extern __shared__ __attribute__((aligned(16))) unsigned char lds_raw[];
    LAS unsigned char* lds = (LAS unsigned char*)lds_raw;
    volatile LAS unsigned* MISC = (volatile LAS unsigned*)(lds + MISC_OFF);
    LAS float* rtab = (LAS float*)(lds + RSTD_OFF);
    int tid = threadIdx.x, lane = tid & 63, wave = __builtin_amdgcn_readfirstlane(tid >> 6);
#define FRESH_TID() do { tid = threadIdx.x; asm volatile("" : "+v"(tid)); lane = tid & 63; wave = __builtin_amdgcn_readfirstlane(tid >> 6); } while (0)
    const int G = gridDim.x, bid0 = blockIdx.x;
    int bid = bid0;
    unsigned char* const ws = args.ws;
#define x_in       (args.in[0])
#define norm_mix   (args.in[1])
#define norm_ffn   (args.in[2])
#define w_in       (args.in[3])
#define gate_bias  (args.in[4])
#define head_gain  (args.in[5])
#define w_out      (args.in[6])
#define pool_w     (args.in[7])
#define pool_scale (args.in[8])
#define w_gu       (args.in[9])
#define w_dn       (args.in[10])
#define final_norm (args.in[11])
#define Win_t   ((bf16_t*)(ws + WS_WIN))
#define Wout_t  ((bf16_t*)(ws + WS_WOUT))
#define Wpool_t ((bf16_t*)(ws + WS_WPOOL))
#define Wgu_t   ((bf16_t*)(ws + WS_WGU))
#define Wdn_t   ((bf16_t*)(ws + WS_WDN))
#define Wg      ((bf16_t*)(ws + WS_WG))
#define ssq     ((ssq_t*)(ws + WS_SSQ))
#define gates   ((float*)(ws + WS_GATES))
#define decay   ((float*)(ws + WS_DECAY))
#define GT      ((float*)(ws + WS_GT))
#define A8      ((unsigned char*)(ws + WS_A8))
#define RS8     ((float*)(ws + WS_RS8))
#define SBW     ((float*)(ws + WS_SB))
#define xb      ((bf16_t*)(ws + WS_XB))
#define BIG     ((bf16_t*)(ws + WS_BIG))
#define ST      ((bf16_t*)(ws + WS_ST))

    for (int u = tid; u < (LDS_BYTES - LDSCTL_OFF) / 4; u += NT) ((LAS unsigned*)(lds + LDSCTL_OFF))[u] = 0u;
    __syncthreads();
    XcdBarrier bar; bar.bar = (unsigned*)(ws + WS_CTL) + CW_BAR; bar.x = 0; bar.st = nullptr;
    if (MK_N_LAUNCHES == 1) bar = xcd_barrier_post((unsigned*)(ws + WS_CTL) + CW_BAR, MISC + 8);
    unsigned* const ctl = (unsigned*)(ws + WS_CTL);
    if (MK_N_LAUNCHES == 1) {
        if (tid == 0) { const unsigned x = xb_xcc_id(); MISC[4] = x; MISC[5] = xb_add(&ctl[CW_CENSUS + 64 * x], 1u); }
        __syncthreads();
    }
    const int xcc = (int)MISC[4], xrank = (int)MISC[5];
    int xmode = 0;

    const int lo = args.ph_lo, hi = args.ph_hi;
    int ph = 0;
#define IN_PH() (lo <= ph && ph < hi)
#define BEGIN_PH() FRESH_TID()
#if PROBE_PH >= 0
#define LAS_REP_PTR(op, row, h, ch) (LAST_REP() ? (op) : (u32x4*)args.out + ((size_t)(row) * 128 + (h) * 16 + (ch)))
#define REPS() ((ph == PROBE_PH) ? PROBE_REP : 1)
#define LAST_REP() (rep_ + 1 == REPS())
#else
#define LAS_REP_PTR(op, row, h, ch) (op)
#define REPS() 1
#define LAST_REP() true
#endif
#define END_PH() do { if (lo <= ph && ph + 1 < hi) xcd_barrier(bar); ++ph; } while (0)
#define END_PH_X() do { if (lo <= ph && ph + 1 < hi) { if (xmode) xcc_local_barrier(ctl, (unsigned)xcc, (unsigned)(G / 8)); else xcd_barrier(bar); } ++ph; } while (0)

    if (IN_PH()) for (int rep_ = 0; rep_ < REPS(); ++rep_) { BEGIN_PH();
        LAS unsigned* scr = (LAS unsigned*)(lds + RING_OFF + wave * 8448);
        const int gw = bid * NWAVES + wave, NGW = G * NWAVES;
        if (G == 256) { if (bid < GU_ITEMS) quant_gu_item(args, ws, lds, 0, bid, tid); }
        else for (int it = bid; it < 4 * GU_ITEMS; it += G) { quant_gu_item(args, ws, lds, it / GU_ITEMS, it % GU_ITEMS, tid); __syncthreads(); }
        __syncthreads();
        convert_items(args, ws, scr, lane, 0, (G == 256) ? CV_P0 : CV_END, gw, NGW);
        for (int e = bid * NT + tid; e < 2 * 16 * D; e += G * NT) { const int l = e / (16 * D), rem = e % (16 * D), k = rem >> 4, j = rem & 15;
            Wg[(size_t)l * 16 * D + j * D + k] = f2bf(w_in[(size_t)l * D * NIN + (size_t)k * NIN + NQKVO + j] * norm_mix[(2 * l) * D + k]); }
        for (int m = 2 * gw; m < M; m += 2 * NGW) {
            const f32x4* xr = (const f32x4*)(x_in + (size_t)m * D) + lane; f32x4 v[8]; float s0 = 0.f, s1 = 0.f;
#pragma unroll
            for (int j = 0; j < 8; ++j) v[j] = xr[64 * j];
#pragma unroll
            for (int j = 0; j < 4; ++j) { s0 += (v[j][0] * v[j][0] + v[j][1] * v[j][1]) + (v[j][2] * v[j][2] + v[j][3] * v[j][3]);
                                          s1 += (v[j + 4][0] * v[j + 4][0] + v[j + 4][1] * v[j + 4][1]) + (v[j + 4][2] * v[j + 4][2] + v[j + 4][3] * v[j + 4][3]); }
            s0 = wave_sum(s0); s1 = wave_sum(s1);
#pragma unroll
            for (int j = 0; j < 8; ++j) { u32x2 w; w.x = cvt_pk_bf16(v[j][0], v[j][1]); w.y = cvt_pk_bf16(v[j][2], v[j][3]); ((u32x2*)(xb + (size_t)m * D))[64 * j + lane] = w; }
            if (lane < 32) ssq[(size_t)m * 16 + lane] = (lane == 0) ? s0 : (lane == 16) ? s1 : 0.f;
        }
    }
    END_PH();
    if (MK_N_LAUNCHES == 1 && lo == 0 && (G & 7) == 0 && BATCH == 8) {
        if (tid == 0) { unsigned ok = 1u;
#pragma unroll
            for (int j = 0; j < 8; ++j) ok &= (xb_ld(&ctl[CW_CENSUS + 64 * j]) == (unsigned)(G / 8)) ? 1u : 0u;
            MISC[6] = ok; }
        __syncthreads();
        xmode = (int)MISC[6];
        if (xmode) bid = xcc + 8 * xrank;
    }
    const int gq = G / 8;
    const int it0 = xmode ? 64 * xcc + xrank : bid, its = xmode ? gq : G, itn = xmode ? 64 * xcc + 64 : NBLK;
    const int rb0 = xmode ? 32 * xcc + xrank : bid, rbn = xmode ? 32 * xcc + 32 : M / 64;
#if PROBE_BARS > 0
    if (MK_N_LAUNCHES == 1) for (int i_ = 0; i_ < PROBE_BARS; ++i_) xcd_barrier(bar);
#endif

    for (int layer = 0; layer < DEPTH; ++layer) {
        const int slot = layer >> 1;
        ssq_t* ssq_a = ssq + (size_t)(2 * layer) * M * 16;
        ssq_t* ssq_b = ssq_a + (size_t)M * 16;
        ssq_t* ssq_c = ssq_b + (size_t)M * 16;
        if ((layer & 1) == 0) {
            if (IN_PH()) for (int rep_ = 0; rep_ < REPS(); ++rep_) { BEGIN_PH();
                {
                    const bf16_t* wgb = Wg + (size_t)slot * 16 * D;
                    LAS float* red = (LAS float*)lds;
                    const int rbk = wave & 3, kh = wave >> 2, fr = lane & 15, fq = lane >> 4;
#if defined(PROBE_GATES)
                    for (int grep_ = 0; grep_ < 3; ++grep_)
#endif
                    for (int rb = rb0; rb < rbn; rb += its) {
                        const bf16_t* ap = xb + (size_t)(rb * 64 + rbk * 16 + fr) * D + kh * 512 + 8 * fq;
                        const bf16_t* bp = wgb + (size_t)fr * D + kh * 512 + 8 * fq;
                        f32x4 ga = (f32x4){0.f, 0.f, 0.f, 0.f};
#pragma unroll
                        for (int ks = 0; ks < 16; ++ks) ga = __builtin_amdgcn_mfma_f32_16x16x32_bf16(*(const bf16x8*)(ap + 32 * ks), *(const bf16x8*)(bp + 32 * ks), ga, 0, 0, 0);
                        if (kh == 1) *(LAS f32x4*)(red + (rbk * 64 + lane) * 4) = ga;
                        __syncthreads();
                        if (kh == 0) {
                            ga += *(const LAS f32x4*)(red + (rbk * 64 + lane) * 4);
                            const float gb = gate_bias[slot * 16 + fr];
#pragma unroll
                            for (int r = 0; r < 4; ++r) { const int row = rb * 64 + rbk * 16 + 4 * fq + r; const float gv = ga[r] * rstd_of(ssq_a + (size_t)row * 16) + gb;
                                gates[(size_t)row * 16 + fr] = SOFTCAP * tanhf(gv * (1.0f / SOFTCAP)); }
                        }
                        __syncthreads();
                    }
                }
                pg8::Gemm g{xb, Win_t + (size_t)slot * NQKVO * D}; pg8::Order S; S.init(M, NQKVO, G, bid, ssq_a, rtab);
                pg8::EpiProj E{BIG, rtab};
                pg8::gemm_phase<pg8::EpiProj, true, D, D, D, 0>(lds + RING_OFF, g, S, E);
            }
            END_PH_X();
            if (IN_PH()) for (int rep_ = 0; rep_ < REPS(); ++rep_) { BEGIN_PH();
                LAS unsigned char* kimg = lds;
                LAS unsigned char* vimg = lds + 49152;
                LAS float* wtab = (LAS float*)(lds + TAB_OFF);
                const int hh = lane >> 5, l31 = lane & 31, g16 = (lane >> 4) & 1, q4 = (lane & 15) >> 2, p4 = lane & 3;
                const int troffK = (8 * hh + q4) * 192 + (16 * g16 + 4 * p4) * 2, troffV = (8 * hh + q4) * 320 + (16 * g16 + 4 * p4) * 2;
                bf16x8 a_one; { const short o = (l31 == 0) ? (short)0x3F80 : (short)0; for (int j = 0; j < 8; ++j) a_one[j] = o; }
                const int vt = wave >> 1, dt = wave & 1;
                for (int item = it0; item < itn; item += its) {
                    const int b = item >> 6, h = (item >> 3) & 7, blk = item & 7, row0 = b * SEQ + blk * BLK;
                    __syncthreads();
                    { float lf[4], ig[4];
#pragma unroll
                      for (int e = 0; e < 4; ++e) { const float* gp = gates + (size_t)(row0 + 4 * lane + e) * 16; lf[e] = log_sigmoidf(gp[8 + h]); ig[e] = gp[h]; }
                      const float p0 = lf[0], p1 = p0 + lf[1], p2 = p1 + lf[2], p3 = p2 + lf[3];
                      float sc = p3;
#pragma unroll
                      for (int o = 1; o < 64; o <<= 1) { const float t = __shfl_up(sc, o); if (lane >= o) sc += t; }
                      const float ex = sc - p3, bl = __shfl(sc, 63);
                      if (wave == 0) { *(LAS f32x4*)(wtab + 4 * lane) = (f32x4){__expf(bl - (ex + p0) + ig[0]), __expf(bl - (ex + p1) + ig[1]), __expf(bl - (ex + p2) + ig[2]), __expf(bl - (ex + p3) + ig[3])};
                                       *(f32x4*)(GT + (size_t)item * 512 + 4 * lane) = (f32x4){ex + p0, ex + p1, ex + p2, ex + p3};
                                       *(f32x4*)(GT + (size_t)item * 512 + 256 + 4 * lane) = (f32x4){ig[0] - (ex + p0), ig[1] - (ex + p1), ig[2] - (ex + p2), ig[3] - (ex + p3)};
                                       if (lane == 0) decay[item] = __expf(bl); } }
#pragma unroll
                    for (int i = 0; i < 4; ++i) { const int id = i * NT + tid, r = id >> 3, ch = id & 7; *(LAS u32x4*)(kimg + r * 192 + ch * 16) = *(const u32x4*)(BIG + (size_t)(row0 + r) * NQKVO + 512 + h * DK + ch * 8); }
#pragma unroll
                    for (int i = 0; i < 8; ++i) { const int id = i * NT + tid, r = id >> 4, ch = id & 15; *(LAS u32x4*)(vimg + r * 320 + ch * 16) = *(const u32x4*)(BIG + (size_t)(row0 + r) * NQKVO + 1024 + h * DV + ch * 8); }
                    __syncthreads();
                    f32x16 acc = zero16(), accn = zero16();
#pragma unroll 4
                    for (int ks = 0; ks < 16; ++ks) {
                        const bf16x8 kf = tr_pair(kimg + troffK + ks * 16 * 192 + dt * 64, 4 * 192);
                        const f32x4 w0 = *(const LAS f32x4*)(wtab + 16 * ks + 8 * hh), w1 = *(const LAS f32x4*)(wtab + 16 * ks + 8 * hh + 4);
                        const u32x4 kb = __builtin_bit_cast(u32x4, kf);
                        u32x4 ksc; ksc.x = pack2(bflo(kb.x) * w0[0], bfhi(kb.x) * w0[1]); ksc.y = pack2(bflo(kb.y) * w0[2], bfhi(kb.y) * w0[3]);
                        ksc.z = pack2(bflo(kb.z) * w1[0], bfhi(kb.z) * w1[1]); ksc.w = pack2(bflo(kb.w) * w1[2], bfhi(kb.w) * w1[3]);
                        const bf16x8 kfs = __builtin_bit_cast(bf16x8, ksc);
                        const bf16x8 vf = tr_pair(vimg + troffV + ks * 16 * 320 + vt * 64, 4 * 320);
                        acc = MFMA32(kfs, vf, acc);
                        if (vt == 0) accn = MFMA32(kfs, a_one, accn);
                    }
                    bf16_t* st = ST + (size_t)item * STE;
#pragma unroll
                    for (int g4 = 0; g4 < 4; ++g4) { u32x2 pk; pk.x = pack2(acc[4 * g4], acc[4 * g4 + 1]); pk.y = pack2(acc[4 * g4 + 2], acc[4 * g4 + 3]);
                        *(u32x2*)(st + (size_t)(32 * vt + l31) * 64 + 32 * dt + 8 * g4 + 4 * hh) = pk; }
                    if (vt == 0 && l31 == 0) {
#pragma unroll
                        for (int g4 = 0; g4 < 4; ++g4) { u32x2 pk; pk.x = pack2(accn[4 * g4], accn[4 * g4 + 1]); pk.y = pack2(accn[4 * g4 + 2], accn[4 * g4 + 3]);
                            *(u32x2*)(st + 128 * 64 + 32 * dt + 8 * g4 + 4 * hh) = pk; }
                    }
                }
            }
            END_PH_X();
            if (IN_PH()) for (int rep_ = 0; rep_ < REPS(); ++rep_) { BEGIN_PH();
                LAS unsigned char* vimg = lds;
                LAS unsigned char* cimg = lds + 81920;
                LAS float* btab = (LAS float*)(lds + 100608);
                LAS float* ctab = btab + 256;
                const int st = (wave < 4) ? 7 - wave : wave - 4;
                for (int item = it0; item < itn; item += its) {
                    FRESH_TID();
                    const int hh = lane >> 5, l31 = lane & 31, g16 = (lane >> 4) & 1, q4 = (lane & 15) >> 2, p4 = lane & 3;
                    const int troff = (4 * hh + q4) * 320 + (16 * g16 + 4 * p4) * 2;
                    bf16x8 a_one; { const short o = (l31 == 0) ? (short)0x3F80 : (short)0; for (int j = 0; j < 8; ++j) a_one[j] = o; }
                    const int b = item >> 6, h = (item >> 3) & 7, blk = item & 7, row0 = b * SEQ + blk * BLK;
                    u32x4 vv[8];
#pragma unroll
                    for (int i = 0; i < 8; ++i) { const int id = i * NT + tid, r = id >> 4, ch = id & 15; vv[i] = *(const u32x4*)(BIG + (size_t)(row0 + r) * NQKVO + 1024 + h * DV + ch * 8); }
                    f32x4 tb = (f32x4){0.f, 0.f, 0.f, 0.f};
                    if (tid < 128) tb = *(const f32x4*)(GT + (size_t)item * 512 + 4 * tid);
                    u32x4 uu[2][7]; float dj[7];
#pragma unroll
                    for (int j = 0; j < 7; ++j) { dj[j] = 0.f; uu[0][j] = (u32x4){0u, 0u, 0u, 0u}; uu[1][j] = (u32x4){0u, 0u, 0u, 0u};
                        if (j < blk) { dj[j] = decay[item - blk + j]; const bf16_t* up = ST + (size_t)(item - blk + j) * STE + tid * 8; uu[0][j] = *(const u32x4*)up; uu[1][j] = *(const u32x4*)(up + NT * 8); } }
                    unsigned un[7];
#pragma unroll
                    for (int j = 0; j < 7; ++j) { un[j] = 0u; if (j < blk && tid < 32) un[j] = ((const unsigned*)(ST + (size_t)(item - blk + j) * STE + 8192))[tid]; }
                    __syncthreads();
#pragma unroll
                    for (int i = 0; i < 8; ++i) { const int id = i * NT + tid, r = id >> 4, ch = id & 15; *(LAS u32x4*)(vimg + r * 320 + ch * 16) = vv[i]; }
                    if (tid < 128) *(LAS f32x4*)(btab + 4 * tid) = tb;
#pragma unroll
                    for (int cc = 0; cc < 2; ++cc) { const int chunk = cc * NT + tid; float a8[8];
#pragma unroll
                        for (int e = 0; e < 8; ++e) a8[e] = 0.f;
#pragma unroll
                        for (int j = 0; j < 7; ++j) { const u32x4 u = uu[cc][j]; const float d = dj[j];
                            if (j < blk) {
                            a8[0] = d * a8[0] + bflo(u.x); a8[1] = d * a8[1] + bfhi(u.x); a8[2] = d * a8[2] + bflo(u.y); a8[3] = d * a8[3] + bfhi(u.y);
                            a8[4] = d * a8[4] + bflo(u.z); a8[5] = d * a8[5] + bfhi(u.z); a8[6] = d * a8[6] + bflo(u.w); a8[7] = d * a8[7] + bfhi(u.w); } }
                        u32x4 o; o.x = pack2(a8[0], a8[1]); o.y = pack2(a8[2], a8[3]); o.z = pack2(a8[4], a8[5]); o.w = pack2(a8[6], a8[7]);
                        *(LAS u32x4*)(cimg + (chunk >> 3) * 144 + (chunk & 7) * 16) = o; }
                    if (tid < 32) { float n0 = 0.f, n1 = 0.f;
#pragma unroll
                        for (int j = 0; j < 7; ++j) if (j < blk) { n0 = dj[j] * n0 + bflo(un[j]); n1 = dj[j] * n1 + bfhi(un[j]); }
                        *(LAS unsigned*)(cimg + 128 * 144 + tid * 4) = pack2(n0, n1); }
                    __syncthreads();
                    const float bs = btab[32 * st + l31], eb = __expf(bs);
                    bf16x8 qf[4];
                    { const bf16_t* qp = BIG + (size_t)(row0 + 32 * st + l31) * NQKVO + h * DK + 8 * hh;
#pragma unroll
                      for (int ks = 0; ks < 4; ++ks) qf[ks] = *(const bf16x8*)(qp + 16 * ks); }
                    u32x4 ov[8];
#pragma unroll
                    for (int i = 0; i < 8; ++i) { const int id = i * 64 + lane, rho = id >> 4, ch = id & 15; ov[i] = *(const u32x4*)(BIG + (size_t)(row0 + 32 * st + rho) * NQKVO + 2048 + h * DV + ch * 8); }
                    f32x16 acc[5];
#pragma unroll
                    for (int v5 = 0; v5 < 5; ++v5) acc[v5] = zero16();
                    bf16x8 kn[4];
                    { const bf16_t* kp = BIG + (size_t)(row0 + l31) * NQKVO + 512 + h * DK + 8 * hh;
#pragma unroll
                      for (int ks = 0; ks < 4; ++ks) kn[ks] = *(const bf16x8*)(kp + 16 * ks); }
                    for (int rt = 0; rt <= st; ++rt) {
                        f32x16 X = zero16();
#pragma unroll
                        for (int ks = 0; ks < 4; ++ks) X = MFMA32(kn[ks], qf[ks], X);
                        if (rt < st) { const bf16_t* kp = BIG + (size_t)(row0 + 32 * (rt + 1) + l31) * NQKVO + 512 + h * DK + 8 * hh;
#pragma unroll
                            for (int ks = 0; ks < 4; ++ks) kn[ks] = *(const bf16x8*)(kp + 16 * ks); }
#pragma unroll
                        for (int g4 = 0; g4 < 4; ++g4) {
                            const f32x4 cr = *(const LAS f32x4*)(ctab + 32 * rt + 8 * g4 + 4 * hh);
#pragma unroll
                            for (int e = 0; e < 4; ++e) { float pv = X[4 * g4 + e] * __expf(bs + cr[e]); if (rt == st && (8 * g4 + 4 * hh + e) > l31) pv = 0.f; X[4 * g4 + e] = pv; }
                        }
#pragma unroll
                        for (int sp = 0; sp < 2; ++sp) {
                            u32x4 pk; pk.x = pack2(X[8 * sp + 0], X[8 * sp + 1]); pk.y = pack2(X[8 * sp + 2], X[8 * sp + 3]); pk.z = pack2(X[8 * sp + 4], X[8 * sp + 5]); pk.w = pack2(X[8 * sp + 6], X[8 * sp + 7]);
                            const bf16x8 pf = __builtin_bit_cast(bf16x8, pk);
#pragma unroll
                            for (int v4 = 0; v4 < 4; ++v4) acc[v4] = MFMA32(tr_pair(vimg + troff + (32 * rt + 16 * sp) * 320 + v4 * 64, 8 * 320), pf, acc[v4]);
                            acc[4] = MFMA32(a_one, pf, acc[4]);
                        }
                    }
                    {   bf16x8 qs[4];
#pragma unroll
                        for (int ks = 0; ks < 4; ++ks) { const u32x4 qb = __builtin_bit_cast(u32x4, qf[ks]); u32x4 o; o.x = pack2(bflo(qb.x) * eb, bfhi(qb.x) * eb); o.y = pack2(bflo(qb.y) * eb, bfhi(qb.y) * eb);
                            o.z = pack2(bflo(qb.z) * eb, bfhi(qb.z) * eb); o.w = pack2(bflo(qb.w) * eb, bfhi(qb.w) * eb); qs[ks] = __builtin_bit_cast(bf16x8, o); }
#pragma unroll
                        for (int v5 = 0; v5 < 5; ++v5) {
                            const int vrow = (v5 < 4) ? 32 * v5 + l31 : 128;
#pragma unroll
                            for (int ks = 0; ks < 4; ++ks) {
                                u32x4 cf = *(const LAS u32x4*)(cimg + vrow * 144 + (16 * ks + 8 * hh) * 2);
                                if (v5 == 4 && l31 != 0) cf = (u32x4){0u, 0u, 0u, 0u};
                                acc[v5] = MFMA32(__builtin_bit_cast(bf16x8, cf), qs[ks], acc[v5]);
                            }
                        }
                    }
                    const float den = __shfl(acc[4][0], l31), dd = fmaxf(fabsf(den), 1.0f);
                    float ss = 0.f;
#pragma unroll
                    for (int v4 = 0; v4 < 4; ++v4)
#pragma unroll
                        for (int r = 0; r < 16; ++r) ss += acc[v4][r] * acc[v4][r];
                    ss += __shfl_xor(ss, 32);
                    const float idd = 1.0f / dd; const float scale = idd / sqrtf(ss * idd * idd * (1.0f / DV) + EPS);
                    __syncthreads();
                    LAS unsigned char* wl = vimg + wave * 8704;
#pragma unroll
                    for (int v4 = 0; v4 < 4; ++v4)
#pragma unroll
                        for (int g4 = 0; g4 < 4; ++g4) { u32x2 pk; pk.x = pack2(acc[v4][4 * g4] * scale, acc[v4][4 * g4 + 1] * scale); pk.y = pack2(acc[v4][4 * g4 + 2] * scale, acc[v4][4 * g4 + 3] * scale);
                            *(LAS u32x2*)(wl + l31 * 272 + (32 * v4 + 8 * g4 + 4 * hh) * 2) = pk; }
#pragma unroll
                    for (int i = 0; i < 8; ++i) { const int id = i * 64 + lane, rho = id >> 4, ch = id & 15;
                        const u32x4 hv = *(const LAS u32x4*)(wl + rho * 272 + ch * 16);
                        u32x4* op = (u32x4*)(BIG + (size_t)(row0 + 32 * st + rho) * NQKVO + 2048 + h * DV + ch * 8); const u32x4 o4 = ov[i];
                        u32x4 w4; w4.x = pack2(bflo(hv.x) * bflo(o4.x), bfhi(hv.x) * bfhi(o4.x)); w4.y = pack2(bflo(hv.y) * bflo(o4.y), bfhi(hv.y) * bfhi(o4.y));
                        w4.z = pack2(bflo(hv.z) * bflo(o4.z), bfhi(hv.z) * bfhi(o4.z)); w4.w = pack2(bflo(hv.w) * bflo(o4.w), bfhi(hv.w) * bfhi(o4.w));
                        *(LAS_REP_PTR(op, row0 + 32 * st + rho, h, ch)) = w4; }
                }
            }
            END_PH_X();
        }
        if (IN_PH()) for (int rep_ = 0; rep_ < REPS(); ++rep_) { BEGIN_PH();
            pg8::Order S; S.init(M, D, G, bid, nullptr, rtab);
            pg8::EpiRes E{xb, LAST_REP() ? xb : (bf16_t*)args.out, LAST_REP() ? ssq_b : (ssq_t*)(args.out + 8 * 1024 * 1024) + (size_t)rep_ * M * 16};
            if ((layer & 1) == 0) { pg8::Gemm g{BIG + 2048, Wout_t + (size_t)slot * D * D}; pg8::gemm_phase<pg8::EpiRes, false, NQKVO, D, D, 0>(lds + RING_OFF, g, S, E); }
            else {
                pg8::Unit u;
                for (int ui = 0; S.next(ui, u); ++ui) {
                    LAS float* hn = (LAS float*)lds;
                    LAS float* rsv = hn + 79 * 256;
                    const int gi = u.pn, w = 2 << gi, R0 = u.pm * 256, bb = R0 / SEQ, t0 = R0 % SEQ;
                    const int c16 = tid & 31, rp = tid >> 5;
                    const int c4 = tid & 63, tg = tid >> 6;
                    for (int tb = 0; tb < 4; ++tb) {
                        const int ts = t0 + 64 * tb;
                        __syncthreads();
                        if (tid < 79) { const int t = ts - 15 + tid; rsv[tid] = (t >= 0) ? rstd_of(ssq_a + (size_t)(bb * SEQ + t) * 16) : 0.f; }
                        u32x4 xv[5];
#pragma unroll
                        for (int ps = 0; ps < 5; ++ps) { const int rho = rp + 16 * ps, t = ts - 15 + rho; xv[ps] = (u32x4){0u, 0u, 0u, 0u};
                            if (rho < 79 && t >= 0) xv[ps] = *(const u32x4*)(xb + (size_t)(bb * SEQ + t) * D + 256 * gi + 8 * c16); }
                        __syncthreads();
#pragma unroll
                        for (int ps = 0; ps < 5; ++ps) { const int rho = rp + 16 * ps;
                            if (rho < 79) { const float r = rsv[rho]; LAS f32x4* dst = (LAS f32x4*)(hn + rho * 256 + 8 * c16);
                                dst[0] = (f32x4){bflo(xv[ps].x) * r, bfhi(xv[ps].x) * r, bflo(xv[ps].y) * r, bfhi(xv[ps].y) * r};
                                dst[1] = (f32x4){bflo(xv[ps].z) * r, bfhi(xv[ps].z) * r, bflo(xv[ps].w) * r, bfhi(xv[ps].w) * r}; } }
                        __syncthreads();
                        { const int tt0 = 8 * tg; f32x4 sw = (f32x4){0.f, 0.f, 0.f, 0.f};
                          for (int j = 1; j < w; ++j) sw += *(const LAS f32x4*)(hn + (15 + tt0 - j) * 256 + 4 * c4);
#pragma unroll
                          for (int tt = tt0; tt < tt0 + 8; ++tt) {
                              const f32x4 v = *(const LAS f32x4*)(hn + (15 + tt) * 256 + 4 * c4); sw += v;
                              const int tpos = ts + tt; const float inv = 1.0f / (float)((tpos + 1 < w) ? tpos + 1 : w);
                              u32x2 o; o.x = pack2(sw[0] * inv - v[0], sw[1] * inv - v[1]); o.y = pack2(sw[2] * inv - v[2], sw[3] * inv - v[3]);
                              *(u32x2*)(BIG + (size_t)(R0 + 64 * tb + tt) * D + 256 * gi + 4 * c4) = o;
                              sw -= *(const LAS f32x4*)(hn + (15 + tt - w + 1) * 256 + 4 * c4);
                          } }
                    }
                }
                VM_WAIT(); __syncthreads();
                pg8::Gemm g{BIG, Wpool_t + (size_t)slot * D * 256}; pg8::gemm_phase<pg8::EpiRes, false, D, 256, 256, 256>(lds + RING_OFF, g, S, E);
            }
        }
        END_PH_X();
        if (IN_PH()) for (int rep_ = 0; rep_ < REPS(); ++rep_) { BEGIN_PH();
            const int m0 = xmode ? xcc * SEQ + xrank * NWAVES + wave : bid * NWAVES + wave, ms = its * NWAVES, mn = xmode ? xcc * SEQ + SEQ : M;
            for (int mb = m0; mb < mn; mb += 4 * ms) {
                u32x4 ra[4], rb[4];
#pragma unroll
                for (int r = 0; r < 4; ++r) { const int m = mb + r * ms; ra[r] = (u32x4){0u, 0u, 0u, 0u}; rb[r] = ra[r];
                    if (m < mn) { ra[r] = ((const u32x4*)(xb + (size_t)m * D))[lane]; rb[r] = ((const u32x4*)(xb + (size_t)m * D))[64 + lane]; } }
#pragma unroll
                for (int r = 0; r < 4; ++r) { const int m = mb + r * ms; if (m < mn) {
                    const u32x4 a = ra[r], b2 = rb[r];
                    float v[16] = {bflo(a.x), bfhi(a.x), bflo(a.y), bfhi(a.y), bflo(a.z), bfhi(a.z), bflo(a.w), bfhi(a.w), bflo(b2.x), bfhi(b2.x), bflo(b2.y), bfhi(b2.y), bflo(b2.z), bfhi(b2.z), bflo(b2.w), bfhi(b2.w)};
                    float sq = 0.f, am = 0.f;
#pragma unroll
                    for (int j = 0; j < 16; ++j) { sq += v[j] * v[j]; am = fmaxf(am, fabsf(v[j])); }
                    sq = wave_sum(sq);
#pragma unroll
                    for (int o = 1; o < 64; o <<= 1) am = fmaxf(am, __shfl_xor(am, o));
                    const float inv = am > 0.f ? 127.0f / am : 0.f;
                    unsigned q[16];
#pragma unroll
                    for (int j = 0; j < 16; ++j) q[j] = (unsigned)__float2int_rn(v[j] * inv) & 255u;
                    u32x2 w0, w1; w0.x = q[0] | (q[1] << 8) | (q[2] << 16) | (q[3] << 24); w0.y = q[4] | (q[5] << 8) | (q[6] << 16) | (q[7] << 24);
                    w1.x = q[8] | (q[9] << 8) | (q[10] << 16) | (q[11] << 24); w1.y = q[12] | (q[13] << 8) | (q[14] << 16) | (q[15] << 24);
                    ((u32x2*)(A8 + (size_t)m * D))[lane] = w0; ((u32x2*)(A8 + (size_t)m * D))[64 + lane] = w1;
                    if (lane == 0) RS8[m] = am * (1.0f / 127.0f) / sqrtf(sq * (1.0f / D) + EPS);
                } }
            }
        }
        END_PH_X();
        if (IN_PH()) for (int rep_ = 0; rep_ < REPS(); ++rep_) { BEGIN_PH();
            if (G == 256 && bid >= 128 && LAST_REP()) {
                if (layer < 3 && bid - 128 < GU_ITEMS) quant_gu_item(args, ws, lds, layer + 1, bid - 128, tid);
                __syncthreads();
                const int lo_ = (layer == 0) ? CV_P0 : (layer == 1) ? CV_T0 : (layer == 2) ? CV_T1 : CV_T2, hi_ = (layer == 0) ? CV_T0 : (layer == 1) ? CV_T1 : (layer == 2) ? CV_T2 : CV_END;
                convert_items(args, ws, (LAS unsigned*)(lds + RING_OFF + wave * 8448), lane, lo_, hi_, (bid - 128) * NWAVES + wave, 128 * NWAVES);
                __syncthreads();
            }
            pg8::Gemm g{(const bf16_t*)A8, (const bf16_t*)(ws + WS_WGU + (size_t)layer * GU * D)}; pg8::Order S; S.init(M, GU, G, bid, nullptr, rtab); S.wgm = GU_WGM; S.rowscale = RS8;
            pg8::EpiGU8 E{BIG, rtab, SBW + (size_t)layer * GU};
            pg8::gemm_phase<pg8::EpiGU8, true, D / 2, D / 2, D / 2, 0, false, true>(lds + RING_OFF, g, S, E);
        }
        END_PH();
        if (IN_PH()) for (int rep_ = 0; rep_ < REPS(); ++rep_) { BEGIN_PH();
            pg8::Gemm g{BIG, Wdn_t + (size_t)layer * D * FF}; pg8::Order S; S.init(M, D, G, bid, nullptr, rtab);
            pg8::EpiRes E{xb, LAST_REP() ? xb : (bf16_t*)args.out, LAST_REP() ? ssq_c : (ssq_t*)(args.out + 8 * 1024 * 1024) + (size_t)rep_ * M * 16};
            pg8::gemm_phase<pg8::EpiRes, false, FF, FF, FF, 0>(lds + RING_OFF, g, S, E);
        }
        END_PH_X();
    }
    if (IN_PH()) for (int rep_ = 0; rep_ < REPS(); ++rep_) { BEGIN_PH();
        const int m0 = xmode ? xcc * SEQ + xrank * NWAVES + wave : bid * NWAVES + wave, ms = its * NWAVES, mn = xmode ? xcc * SEQ + SEQ : M;
        for (int m = m0; m < mn; m += ms) {
            const u32x4 a = ((const u32x4*)(xb + (size_t)m * D))[lane], b2 = ((const u32x4*)(xb + (size_t)m * D))[64 + lane];
            float v[16] = {bflo(a.x), bfhi(a.x), bflo(a.y), bfhi(a.y), bflo(a.z), bfhi(a.z), bflo(a.w), bfhi(a.w), bflo(b2.x), bfhi(b2.x), bflo(b2.y), bfhi(b2.y), bflo(b2.z), bfhi(b2.z), bflo(b2.w), bfhi(b2.w)};
            float sq = 0.f;
#pragma unroll
            for (int j = 0; j < 16; ++j) sq += v[j] * v[j];
            const float rs = 1.0f / sqrtf(wave_sum(sq) * (1.0f / D) + EPS);
#pragma unroll
            for (int hpart = 0; hpart < 2; ++hpart)
#pragma unroll
                for (int q = 0; q < 2; ++q) { const int col = hpart * 512 + lane * 8 + q * 4; const f32x4 gn = *(const f32x4*)(final_norm + col);
                    f32x4 o; o[0] = v[hpart * 8 + q * 4 + 0] * rs * gn[0]; o[1] = v[hpart * 8 + q * 4 + 1] * rs * gn[1]; o[2] = v[hpart * 8 + q * 4 + 2] * rs * gn[2]; o[3] = v[hpart * 8 + q * 4 + 3] * rs * gn[3];
                    *(f32x4*)(args.out + (size_t)m * D + col) = o; }
        }
    }
#undef IN_PH
#undef END_PH
}

extern "C" void kernel_launch(void* const* d_in, const int* in_sizes, int n_in, void* d_out, int out_size, void* d_ws, size_t ws_size, hipStream_t stream) {
    static int grid = 0;
    if (grid == 0) {
        if (n_in != 12 || in_sizes[0] != M * D || out_size != M * D || ws_size < WS_END) { fprintf(stderr, "kernel_launch: unexpected shapes / workspace (n_in %d, ws %zu, need %zu)\n", n_in, ws_size, (size_t)WS_END); grid = -1; return; }
        int dev = 0, cus = 0, per_cu = 0;
        if (hipGetDevice(&dev) != hipSuccess || hipDeviceGetAttribute(&cus, hipDeviceAttributeMultiprocessorCount, dev) != hipSuccess) { grid = -1; return; }
        if (hipFuncSetAttribute((const void*)fwd_kernel, hipFuncAttributeMaxDynamicSharedMemorySize, LDS_BYTES) != hipSuccess) { fprintf(stderr, "kernel_launch: hipFuncSetAttribute failed\n"); grid = -1; return; }
        if (hipOccupancyMaxActiveBlocksPerMultiprocessor(&per_cu, (const void*)fwd_kernel, NT, LDS_BYTES) != hipSuccess || per_cu < 1) { fprintf(stderr, "kernel_launch: occupancy query says %d blocks per CU\n", per_cu); grid = -1; (void)hipGetLastError(); return; }
        grid = cus;
    }
    if (grid < 0) return;
    Args a{};
    for (int i = 0; i < 12; ++i) a.in[i] = (const float*)d_in[i];
    a.out = (float*)d_out; a.ws = (unsigned char*)d_ws;
#if MK_N_LAUNCHES == 1
    (void)hipMemsetAsync((char*)d_ws + WS_CTL, 0, CTL_ZERO_BYTES, stream);
    a.ph_lo = 0; a.ph_hi = N_PHASES;
    void* kargs[] = {&a};
    hipError_t e = hipLaunchCooperativeKernel((const void*)fwd_kernel, dim3(grid), dim3(NT), kargs, LDS_BYTES, stream);
    if (e != hipSuccess) fprintf(stderr, "cooperative launch failed: %s (grid %d)\n", hipGetErrorString(e), grid);
#else
    for (int p = 0; p < N_PHASES; ++p) {
        a.ph_lo = p; a.ph_hi = p + 1;
        hipLaunchKernelGGL(fwd_kernel, dim3(grid), dim3(NT), LDS_BYTES, stream, a);
    }
#endif
}
```

```cpp
#include <hip/hip_runtime.h>
#include <cstdio>
#include <cstdint>

#ifndef MK_N_LAUNCHES
#define MK_N_LAUNCHES 1
#endif

#ifndef PROBE_PH
#define PROBE_PH (-1)
#endif
#define PROBE_REP 3
#define GU_WGM 8
#define PROBE_BARS 0

#define LAS __attribute__((address_space(3)))
typedef unsigned short bf16_t;
typedef short bf16x8 __attribute__((ext_vector_type(8)));
typedef float f32x4 __attribute__((ext_vector_type(4)));
typedef float f32x2 __attribute__((ext_vector_type(2)));
typedef unsigned u32x4 __attribute__((ext_vector_type(4)));
typedef unsigned u32x2 __attribute__((ext_vector_type(2)));
typedef int i32x4 __attribute__((ext_vector_type(4)));
typedef float ssq_t;
__device__ __forceinline__ float ssq_val(const ssq_t* p) { const f32x4* q = (const f32x4*)p; const f32x4 a = q[0], b = q[1], c = q[2], d = q[3];
    return ((a[0] + a[1]) + (a[2] + a[3])) + ((b[0] + b[1]) + (b[2] + b[3])) + ((c[0] + c[1]) + (c[2] + c[3])) + ((d[0] + d[1]) + (d[2] + d[3])); }

constexpr int BATCH = 8, SEQ = 2048, D = 1024, DEPTH = 4, M = BATCH * SEQ;
constexpr int NH = 8, DK = 64, DV = 128, NQKVO = 3072, NIN = 3088, FF = 2816, GU = 2 * FF, CH = 64, NCH = SEQ / CH;
constexpr int BLK = 256, NBLK = BATCH * NH * (SEQ / BLK);
constexpr int NITEM = NBLK;
constexpr int STE = (DV + 1) * DK;
constexpr float EPS = 1e-6f, SOFTCAP = 15.0f;

__device__ __forceinline__ unsigned cvt_pk_bf16(float lo, float hi) { unsigned r; asm volatile("v_cvt_pk_bf16_f32 %0, %1, %2" : "=v"(r) : "v"(lo), "v"(hi)); return r; }
__device__ __forceinline__ float bf2f(unsigned short u) { return __uint_as_float((unsigned)u << 16); }
__device__ __forceinline__ float bflo(unsigned u) { return __uint_as_float(u << 16); }
__device__ __forceinline__ float bfhi(unsigned u) { return __uint_as_float(u & 0xffff0000u); }
__device__ __forceinline__ unsigned short f2bf(float f) { unsigned u = __float_as_uint(f); return (unsigned short)((u + 0x7fffu + ((u >> 16) & 1u)) >> 16); }


typedef short s16x4 __attribute__((ext_vector_type(4)));
typedef float f32x16 __attribute__((ext_vector_type(16)));
__device__ __forceinline__ unsigned pack2(float a, float b) { typedef __bf16 bf2 __attribute__((ext_vector_type(2))); f32x2 v = {a, b}; bf2 r = __builtin_convertvector(v, bf2); return __builtin_bit_cast(unsigned, r); }
__device__ __forceinline__ bf16x8 tr_pair(LAS unsigned char* p, int delta) {
    const s16x4 lo = __builtin_amdgcn_ds_read_tr16_b64_v4i16((LAS s16x4*)p), hi = __builtin_amdgcn_ds_read_tr16_b64_v4i16((LAS s16x4*)(p + delta));
    return __builtin_shufflevector(lo, hi, 0, 1, 2, 3, 4, 5, 6, 7);
}
#define MFMA32(a, b, c) __builtin_amdgcn_mfma_f32_32x32x16_bf16((a), (b), (c), 0, 0, 0)
__device__ __forceinline__ f32x16 zero16() { f32x16 z; for (int i = 0; i < 16; ++i) z[i] = 0.f; return z; }

namespace pg8 {
constexpr int BM = 256, BK = 64, HALF = 128, HTB = HALF * BK * 2, STAGE_BYTES = 8 * HTB, NXCD = 8, WGM = 8;
static_assert(8 % WGM == 0 && 8 % GU_WGM == 0, "XCC-local mode: a unit-order row group must not span two batch elements");
__host__ __device__ __forceinline__ int lds_byte(int r, int c) { const int st = (r >> 4) * 2 + (c >> 5), rr = r & 15, cc = c & 31, ob = rr * 64 + cc * 2; return st * 1024 + (ob ^ (((ob >> 9) & 1) << 5)); }
__host__ __device__ __forceinline__ void stage_rc(int b, int& R, int& C) { const int st = b / 1024, sb = b % 1024, swz = sb ^ (((sb >> 9) & 1) << 5); R = (st >> 1) * 16 + swz / 64; C = (st & 1) * 32 + (swz % 64) / 2; }
__host__ __device__ __forceinline__ int perm32(int rho) { const int n = rho >> 4, i = rho & 15; return 8 * (i >> 2) + 4 * n + (i & 3); }

struct Unit { int pm, pn, idx, hm; };
struct Gemm { const bf16_t* A; const bf16_t* Bt; };

struct Order {
    int nM, nN, nwg, G, c, nsplit, wgm;
    const ssq_t* ssq;
    LAS float* tab;
    const float* rowscale;
    __device__ __forceinline__ void init(int M_, int N, int G_, int c_, const ssq_t* ssq_, LAS float* tab_) { nM = M_ / BM; nN = N / BM; nwg = nM * nN; G = G_; c = c_; ssq = ssq_; tab = tab_; nsplit = 0; wgm = WGM; rowscale = nullptr; }
    __device__ __forceinline__ void split_tail(int ns) { if (G == 256 && nM == 64 && ns == 2) { nsplit = ns; nN -= ns; nwg = nM * nN; } }
    __device__ __forceinline__ bool next(int i, Unit& u) const {
        const long L = (long)i * G + c;
        const bool tail = L >= nwg;
        if (tail && (nsplit == 0 || L >= nwg + G)) return false;
        int wgid = tail ? 0 : (int)L; { const int q = nwg / NXCD, r = nwg % NXCD, xcd = wgid % NXCD, off = wgid / NXCD; wgid = (xcd < r ? xcd * (q + 1) : r * (q + 1) + (xcd - r) * q) + off; }
        const int nig = wgm * nN, gid = wgid / nig, fm = gid * wgm, gsz = (nM - fm) < wgm ? (nM - fm) : wgm;
        const int x = c & 7, j = c >> 3;
        const int pm = tail ? 8 * x + (j & 7) : fm + ((wgid % nig) % gsz);
        const int pn = tail ? nN + ((j >> 3) & 1) : (wgid % nig) / gsz;
        const int hm = tail ? (j >> 4) : -1;
        u.pm = pm; u.pn = pn; u.idx = i; u.hm = hm; return true;
    }
    __device__ __forceinline__ void a_ready(const Unit& u) const {
        int t_ = threadIdx.x; asm volatile("" : "+v"(t_));
        if (rowscale != nullptr) { if (t_ < 256) tab[(u.idx & 1) * 256 + t_] = rowscale[u.pm * BM + (u.hm > 0 ? HALF : 0) + t_]; }
        else if (ssq != nullptr && t_ < 256) {
            const float s = ssq_val(ssq + (size_t)(u.pm * BM + (u.hm > 0 ? HALF : 0) + t_) * 16);
            tab[(u.idx & 1) * 256 + t_] = __builtin_amdgcn_rsqf(s * (1.0f / D) + EPS);
        }
    }
    __device__ __forceinline__ void done(const Unit&) const {}
};

__device__ __forceinline__ float sigmoidf_fast(float x) { return __builtin_amdgcn_rcpf(1.0f + __expf(-x)); }

struct EpiProj {
    static constexpr bool PERM = true, HAS_INIT = false;
    bf16_t* O; const LAS float* tab;
    __device__ __forceinline__ void operator()(const f32x4 (&acc)[2][2][4][2], const Unit& u, int wr, int wc, int fr, int fq) const {
        const LAS float* t = tab + (u.idx & 1) * 256;
        const bool sig = u.pn >= 8;
        const int row0 = u.pm * BM + wr * 64 + fr, col0 = u.pn * BM + wc * 32 + 8 * fq;
#pragma unroll
        for (int ai = 0; ai < 2; ++ai)
#pragma unroll
            for (int m = 0; m < 4; ++m) {
                const float rs = t[ai * HALF + wr * 64 + m * 16 + fr];
                bf16_t* rowp = O + (size_t)(row0 + ai * HALF + m * 16) * NQKVO + col0;
#pragma unroll
                for (int bj = 0; bj < 2; ++bj) {
                    f32x4 v0 = acc[ai][bj][m][0] * rs, v1 = acc[ai][bj][m][1] * rs;
                    if (sig) {
#pragma unroll
                        for (int i = 0; i < 4; ++i) { v0[i] = sigmoidf_fast(v0[i]); v1[i] = sigmoidf_fast(v1[i]); }
                    }
                    u32x4 w; w.x = cvt_pk_bf16(v0[0], v0[1]); w.y = cvt_pk_bf16(v0[2], v0[3]); w.z = cvt_pk_bf16(v1[0], v1[1]); w.w = cvt_pk_bf16(v1[2], v1[3]);
                    *(u32x4*)(rowp + bj * HALF) = w;
                }
            }
    }
};
struct EpiGU {
    static constexpr bool PERM = true, HAS_INIT = false;
    bf16_t* H; const LAS float* tab;
    __device__ __forceinline__ void operator()(const f32x4 (&acc)[2][2][4][2], const Unit& u, int wr, int wc, int fr, int fq) const {
        const LAS float* t = tab + (u.idx & 1) * 256;
        const int row0 = u.pm * BM + (u.hm > 0 ? HALF : 0) + wr * 64 + fr, col0 = u.pn * HALF + wc * 32 + 8 * fq;
#pragma unroll
        for (int ai = 0; ai < 2; ++ai) { if (ai == 1 && u.hm >= 0) break;
#pragma unroll
            for (int m = 0; m < 4; ++m) {
                const float rs = t[ai * HALF + wr * 64 + m * 16 + fr];
                const float c1 = rs * -1.4426950408889634f, rs2 = rs * rs;
                float hv[8];
#pragma unroll
                for (int n = 0; n < 2; ++n)
#pragma unroll
                    for (int i = 0; i < 4; ++i) { const float g = acc[ai][0][m][n][i], uu = acc[ai][1][m][n][i]; hv[n * 4 + i] = (g * uu) * (rs2 * __builtin_amdgcn_rcpf(1.0f + __builtin_amdgcn_exp2f(g * c1))); }
                u32x4 w; w.x = cvt_pk_bf16(hv[0], hv[1]); w.y = cvt_pk_bf16(hv[2], hv[3]); w.z = cvt_pk_bf16(hv[4], hv[5]); w.w = cvt_pk_bf16(hv[6], hv[7]);
                *(u32x4*)(H + (size_t)(row0 + ai * HALF + m * 16) * FF + col0) = w;
            }
        }
    }
};
struct EpiGU8 {
    static constexpr bool PERM = true, HAS_INIT = false;
    bf16_t* H; const LAS float* tab; const float* colscale;
    __device__ __forceinline__ void operator()(const i32x4 (&acc)[2][2][4][2], const Unit& u, int wr, int wc, int fr, int fq) const {
        const LAS float* t = tab + (u.idx & 1) * 256;
        const int row0 = u.pm * BM + wr * 64 + fr, col0 = u.pn * HALF + wc * 32 + 8 * fq;
        const float* cs = colscale + u.pn * BM + wc * 32 + 8 * fq;
        const f32x4 sg0 = *(const f32x4*)cs, sg1 = *(const f32x4*)(cs + 4), su0 = *(const f32x4*)(cs + HALF), su1 = *(const f32x4*)(cs + HALF + 4);
#pragma unroll
        for (int ai = 0; ai < 2; ++ai)
#pragma unroll
            for (int m = 0; m < 4; ++m) {
                const float rs = t[ai * HALF + wr * 64 + m * 16 + fr];
                float hv[8];
#pragma unroll
                for (int n = 0; n < 2; ++n)
#pragma unroll
                    for (int i = 0; i < 4; ++i) { const float g = (float)acc[ai][0][m][n][i] * (rs * (n ? sg1[i] : sg0[i])), uu = (float)acc[ai][1][m][n][i] * (rs * (n ? su1[i] : su0[i]));
                        hv[n * 4 + i] = (g * uu) * __builtin_amdgcn_rcpf(1.0f + __builtin_amdgcn_exp2f(g * -1.4426950408889634f)); }
                u32x4 w; w.x = cvt_pk_bf16(hv[0], hv[1]); w.y = cvt_pk_bf16(hv[2], hv[3]); w.z = cvt_pk_bf16(hv[4], hv[5]); w.w = cvt_pk_bf16(hv[6], hv[7]);
                *(u32x4*)(H + (size_t)(row0 + ai * HALF + m * 16) * FF + col0) = w;
            }
    }
};
struct EpiRes {
    static constexpr bool PERM = true, HAS_INIT = true;
    bf16_t* xb; bf16_t* xo; ssq_t* ssq_out;
    __device__ __forceinline__ void init_load(u32x4 (&t)[2][4][2], const Unit& u, int wr, int wc, int fr, int fq) const {
        const int row0 = u.pm * BM + wr * 64 + fr, col0 = u.pn * BM + wc * 32 + 8 * fq;
#pragma unroll
        for (int ai = 0; ai < 2; ++ai)
#pragma unroll
            for (int m = 0; m < 4; ++m)
#pragma unroll
                for (int bj = 0; bj < 2; ++bj) t[ai][m][bj] = *(const u32x4*)(xb + (size_t)(row0 + ai * HALF + m * 16) * D + col0 + bj * HALF);
    }
    __device__ __forceinline__ void init_cvt(f32x4 (&acc)[2][2][4][2], const u32x4 (&t)[2][4][2]) const {
#pragma unroll
        for (int ai = 0; ai < 2; ++ai)
#pragma unroll
            for (int m = 0; m < 4; ++m)
#pragma unroll
                for (int bj = 0; bj < 2; ++bj) { const u32x4 v = t[ai][m][bj];
                    acc[ai][bj][m][0] = (f32x4){bflo(v.x), bfhi(v.x), bflo(v.y), bfhi(v.y)}; acc[ai][bj][m][1] = (f32x4){bflo(v.z), bfhi(v.z), bflo(v.w), bfhi(v.w)}; }
    }
    __device__ __forceinline__ void init(f32x4 (&acc)[2][2][4][2], const Unit& u, int wr, int wc, int fr, int fq) const { u32x4 t[2][4][2]; init_load(t, u, wr, wc, fr, fq); init_cvt(acc, t); }
    __device__ __forceinline__ void operator()(const f32x4 (&acc)[2][2][4][2], const Unit& u, int wr, int wc, int fr, int fq) const {
        const int row0 = u.pm * BM + wr * 64 + fr, col0 = u.pn * BM + wc * 32 + 8 * fq;
#pragma unroll
        for (int ai = 0; ai < 2; ++ai)
#pragma unroll
            for (int m = 0; m < 4; ++m) {
                const int row = row0 + ai * HALF + m * 16; float ss = 0.f;
#pragma unroll
                for (int bj = 0; bj < 2; ++bj) {
                    const f32x4 v0 = acc[ai][bj][m][0], v1 = acc[ai][bj][m][1];
                    u32x4 w; w.x = cvt_pk_bf16(v0[0], v0[1]); w.y = cvt_pk_bf16(v0[2], v0[3]); w.z = cvt_pk_bf16(v1[0], v1[1]); w.w = cvt_pk_bf16(v1[2], v1[3]);
                    *(u32x4*)(xo + (size_t)row * D + col0 + bj * HALF) = w;
                    ss += ((v0[0] * v0[0] + v0[1] * v0[1]) + (v0[2] * v0[2] + v0[3] * v0[3])) + ((v1[0] * v1[0] + v1[1] * v1[1]) + (v1[2] * v1[2] + v1[3] * v1[3]));
                }
                ss += __shfl_xor(ss, 16); ss += __shfl_xor(ss, 32);
                if (fq == 0) ssq_out[(size_t)row * 16 + u.pn * 4 + wc] = ss;
            }
    }
};

template <bool I8> struct AccOf { typedef f32x4 type; };
template <> struct AccOf<true> { typedef i32x4 type; };
template <bool I8> __device__ __forceinline__ typename AccOf<I8>::type mma16(const bf16x8& b, const bf16x8& a, typename AccOf<I8>::type c) {
    if constexpr (I8) return __builtin_amdgcn_mfma_i32_16x16x64_i8(__builtin_bit_cast(i32x4, b), __builtin_bit_cast(i32x4, a), c, 0, 0, 0);
    else return __builtin_amdgcn_mfma_f32_16x16x32_bf16(b, a, c, 0, 0, 0);
}
template <class Epi, bool ALIGN_EPI, int LDA, int LDB, int KLEN, int ACOL, bool HALFU = false, bool I8 = false>
__device__ __forceinline__ void gemm_phase(LAS unsigned char* lds, const Gemm g, const Order& S, const Epi& E) {
    int tid_ = threadIdx.x; asm volatile("" : "+v"(tid_));
    const int tid = tid_, wid = __builtin_amdgcn_readfirstlane(tid >> 6), lane = tid & 63, wr = wid >> 2, wc = wid & 3, fr = lane & 15, fq = lane >> 4;
    constexpr int nt = KLEN / BK;
    unsigned voffA[2], voffB[2];
#pragma unroll
    for (int i = 0; i < 2; ++i) {
        const int R = i * 64 + (tid >> 3), C = 8 * ((tid & 7) ^ ((R >> 1) & 7)); const int Rb = Epi::PERM ? ((R & ~31) + perm32(R & 31)) : R;
        voffA[i] = (unsigned)(R * LDA + C) * 2u; voffB[i] = (unsigned)(Rb * LDB + C) * 2u; }
    constexpr size_t kstep = (size_t)(BK * 2);
    constexpr size_t hstepA = (size_t)HALF * LDA * 2, tstepA = 2 * hstepA, hstepB = (size_t)HALF * LDB * 2, tstepB = 2 * hstepB;
    constexpr size_t pnstepA = (size_t)ACOL * 2;
    const unsigned ldsw = (unsigned)wid * 1024u;
    const int sw0 = 16 * (fq ^ ((fr >> 1) & 7)), aoff0 = (wr * 64 + fr) * 128 + sw0, aoff1 = aoff0 ^ 64, boff0 = (wc * 32 + fr) * 128 + sw0, boff1 = boff0 ^ 64;
#define PG8_SA(b, h) (((b) * 2 + (h)) * HTB)
#define PG8_SB(b, h) ((4 + (b) * 2 + (h)) * HTB)
#define PG8_STAGE(bufoff, gbase, voff) do { _Pragma("unroll") for (int _i = 0; _i < 2; ++_i) \
        __builtin_amdgcn_global_load_lds((const unsigned*)((const char*)(gbase) + (voff)[_i]), (LAS unsigned*)(lds + (bufoff) + ldsw + _i * 8192), 16, 0, 0); } while (0)
#define PG8_LDA(dst, b, h) do { _Pragma("unroll") for (int m = 0; m < 4; ++m) _Pragma("unroll") for (int k = 0; k < 2; ++k) dst[m][k] = *(const LAS bf16x8*)(lds + PG8_SA(b, h) + (k ? aoff1 : aoff0) + m * 2048); } while (0)
#define PG8_LDB(dst, b, h) do { _Pragma("unroll") for (int n = 0; n < 2; ++n) _Pragma("unroll") for (int k = 0; k < 2; ++k) dst[n][k] = *(const LAS bf16x8*)(lds + PG8_SB(b, h) + (k ? boff1 : boff0) + n * 2048); } while (0)
#define PG8_MMA(ai, bj, At, Bt) do { __builtin_amdgcn_s_setprio(1); _Pragma("unroll") for (int m = 0; m < 4; ++m) _Pragma("unroll") for (int n = 0; n < 2; ++n) _Pragma("unroll") for (int k = 0; k < 2; ++k) \
        acc[ai][bj][m][n] = mma16<I8>(Bt[n][k], At[m][k], acc[ai][bj][m][n]); __builtin_amdgcn_s_setprio(0); } while (0)
#define PG8_WAIT_V(n) asm volatile("s_waitcnt vmcnt(" #n ")" ::: "memory")
#define PG8_WAIT_L(n) asm volatile("s_waitcnt lgkmcnt(" #n ")" ::: "memory")
#define PG8_BAR __builtin_amdgcn_s_barrier()
#define PG8_SCHED __builtin_amdgcn_sched_barrier(0)
    Unit cur, nxt; int ui = 0;
    if (!S.next(0, cur)) return;
    typedef typename AccOf<I8>::type acc_t;
    acc_t acc[2][2][4][2];
    u32x4 xt[Epi::HAS_INIT ? 2 : 1][4][2];
    if constexpr (Epi::HAS_INIT) E.init_load(xt, cur, wr, wc, fr, fq);
    else {
#pragma unroll
    for (int a = 0; a < 2; ++a)
#pragma unroll
        for (int b = 0; b < 2; ++b)
#pragma unroll
            for (int m = 0; m < 4; ++m)
#pragma unroll
                for (int n = 0; n < 2; ++n) acc[a][b][m][n] = acc_t{};
    }
    bf16x8 At[4][2], B0[2][2], B1[2][2];
    const char* cA = (const char*)g.A + (size_t)cur.pm * tstepA + (size_t)cur.pn * pnstepA + ((HALFU && cur.hm > 0) ? hstepA : 0); const char* cB = (const char*)g.Bt + (size_t)cur.pn * tstepB;
    S.a_ready(cur);
    PG8_STAGE(PG8_SB(0, 0), cB, voffB); PG8_STAGE(PG8_SB(0, 1), cB + hstepB, voffB); PG8_STAGE(PG8_SA(0, 0), cA, voffA); PG8_STAGE(PG8_SA(0, 1), cA + hstepA, voffA);
    if constexpr (Epi::HAS_INIT) E.init_cvt(acc, xt);
    if (wr == 1) PG8_BAR;
    PG8_WAIT_V(2); PG8_BAR;
    PG8_STAGE(PG8_SB(1, 0), cB + kstep, voffB); PG8_STAGE(PG8_SA(1, 0), cA + kstep, voffA); PG8_STAGE(PG8_SB(1, 1), cB + hstepB + kstep, voffB);
    PG8_WAIT_V(6); PG8_BAR;
    for (;;) {
        const bool has_next = S.next(ui + 1, nxt);
        const char* nA = has_next ? (const char*)g.A + (size_t)nxt.pm * tstepA + (size_t)nxt.pn * pnstepA + ((HALFU && nxt.hm > 0) ? hstepA : 0) : cA;
        const bool full = !HALFU || cur.hm < 0;
        const char* nB = has_next ? (const char*)g.Bt + (size_t)nxt.pn * tstepB : cB;
#pragma unroll 1
        for (int t = 0; t < nt; t += 2) {
            const bool last = (t == nt - 2);
            const char* a1 = cA + (size_t)(t + 1) * kstep;
            const char* a2 = last ? nA : cA + (size_t)(t + 2) * kstep; const char* b2 = last ? nB : cB + (size_t)(t + 2) * kstep;
            const char* a3 = a2 + kstep; const char* b3 = b2 + kstep;
            if (last && has_next) S.a_ready(nxt);
            PG8_LDB(B0, 0, 0); PG8_LDB(B1, 0, 1); PG8_SCHED; PG8_LDA(At, 0, 0); PG8_STAGE(PG8_SA(1, 1), a1 + hstepA, voffA);
            PG8_WAIT_V(8); PG8_WAIT_L(0); PG8_BAR; PG8_MMA(0, 0, At, B0); PG8_MMA(0, 1, At, B1); PG8_BAR; PG8_SCHED;
            PG8_LDA(At, 0, 1); PG8_STAGE(PG8_SB(0, 0), b2, voffB); PG8_STAGE(PG8_SB(0, 1), b2 + hstepB, voffB); PG8_STAGE(PG8_SA(0, 0), a2, voffA);
            PG8_WAIT_V(8); PG8_WAIT_L(0); PG8_BAR; if (full) { PG8_MMA(1, 0, At, B0); PG8_MMA(1, 1, At, B1); } PG8_BAR; PG8_SCHED;
            PG8_LDB(B0, 1, 0); PG8_LDB(B1, 1, 1); PG8_SCHED; PG8_LDA(At, 1, 0); PG8_STAGE(PG8_SA(0, 1), a2 + hstepA, voffA);
            PG8_WAIT_V(8); PG8_WAIT_L(0); PG8_BAR; PG8_MMA(0, 0, At, B0); PG8_MMA(0, 1, At, B1); PG8_BAR; PG8_SCHED;
            PG8_LDA(At, 1, 1); PG8_STAGE(PG8_SB(1, 0), b3, voffB); PG8_STAGE(PG8_SB(1, 1), b3 + hstepB, voffB); PG8_STAGE(PG8_SA(1, 0), a3, voffA);
            PG8_WAIT_V(8); PG8_WAIT_L(0); PG8_BAR; if (full) { PG8_MMA(1, 0, At, B0); PG8_MMA(1, 1, At, B1); } PG8_BAR; PG8_SCHED;
        }
        if constexpr (ALIGN_EPI) { if (wr == 0) PG8_BAR; }
        E(acc, cur, wr, wc, fr, fq);
#if defined(PROBE_EPI2)
        E(acc, cur, wr, wc, fr, fq); E(acc, cur, wr, wc, fr, fq);
#endif
        S.done(cur);
        if (!has_next) break;
        if constexpr (Epi::HAS_INIT) E.init(acc, nxt, wr, wc, fr, fq);
        else {
#pragma unroll
        for (int a = 0; a < 2; ++a)
#pragma unroll
            for (int b = 0; b < 2; ++b)
#pragma unroll
                for (int m = 0; m < 4; ++m)
#pragma unroll
                    for (int n = 0; n < 2; ++n) acc[a][b][m][n] = acc_t{};
        }
        cur = nxt; cA = nA; cB = nB; ++ui;
        if constexpr (ALIGN_EPI) { if (wr == 1) PG8_BAR; }
    }
    PG8_WAIT_V(0);
    if constexpr (!ALIGN_EPI) { if (wr == 0) PG8_BAR; }
    PG8_BAR;
#undef PG8_SA
#undef PG8_SB
#undef PG8_STAGE
#undef PG8_LDA
#undef PG8_LDB
#undef PG8_MMA
#undef PG8_WAIT_V
#undef PG8_WAIT_L
#undef PG8_BAR
#undef PG8_SCHED
}
}

constexpr size_t MiB = 1u << 20;
constexpr size_t WS_CTL = 0, CTL_ZERO_BYTES = 1 * MiB;
constexpr size_t SZ_WIN = (size_t)NQKVO * D * 2, SZ_WOUT = (size_t)D * D * 2, SZ_WPOOL = (size_t)D * 256 * 2, SZ_WGU = (size_t)GU * D * 2, SZ_WDN = (size_t)D * FF * 2, SZ_WG = (size_t)16 * D * 2;
constexpr size_t WS_WIN = 1 * MiB;
constexpr size_t WS_WOUT = WS_WIN + 2 * SZ_WIN;
constexpr size_t WS_WPOOL = WS_WOUT + 2 * SZ_WOUT;
constexpr size_t WS_WGU = WS_WPOOL + 2 * SZ_WPOOL;
constexpr size_t WS_WDN = WS_WGU + 4 * SZ_WGU;
constexpr size_t WS_WG = WS_WDN + 4 * SZ_WDN;
constexpr size_t WS_SSQ = WS_WG + 2 * SZ_WG;
constexpr size_t SZ_SSQ = (size_t)M * 16 * 4;
constexpr size_t WS_GATES = WS_SSQ + 9 * SZ_SSQ;
constexpr size_t WS_DECAY = WS_GATES + (size_t)M * 16 * 4;
constexpr size_t WS_GT = WS_DECAY + 4096;
constexpr size_t WS_XB = ((WS_GT + (size_t)512 * 512 * 4 + MiB - 1) / MiB) * MiB;
constexpr size_t WS_BIG = WS_XB + (size_t)M * D * 2;
constexpr size_t WS_ST = WS_BIG + (size_t)M * NQKVO * 2;
constexpr size_t WS_A8 = ((WS_ST + (size_t)NITEM * STE * 2 + 4095) / 4096) * 4096;
constexpr size_t WS_RS8 = WS_A8 + (size_t)M * D;
constexpr size_t WS_SB = WS_RS8 + (size_t)M * 4;
constexpr size_t WS_END = WS_SB + (size_t)4 * GU * 4;
static_assert(WS_END <= 352 * MiB, "d_ws map must fit the guaranteed workspace");
static_assert((size_t)M * FF * 2 <= (size_t)M * NQKVO * 2, "H overlays q|k|v|o");

constexpr int CW_BAR = 4096;
constexpr int CW_CENSUS = 8192;
constexpr int CW_XL_SUB = 9216, CW_XL_GEN = 10240;
constexpr int RING_OFF = 0, RING_BYTES = 131072;
constexpr int LDSCTL_OFF = RING_BYTES, MISC_OFF = LDSCTL_OFF + 320;
constexpr int RSTD_OFF = RING_BYTES + 1024;
constexpr int TAB_OFF = RING_BYTES + 3072;
constexpr int LDS_BYTES = 147456;
constexpr int NWAVES = 8, NT = NWAVES * 64;

#define VM_WAIT() asm volatile("s_waitcnt vmcnt(0)" ::: "memory")
#define LDS_WAIT() asm volatile("s_waitcnt lgkmcnt(0)" ::: "memory")

#define XB_TMO      128
#define XB_XCNT(j)  (256  + 64 * (j))
#define XB_XSUB(j)  (1280 + 64 * (j))
#define XB_XGEN(j)  (2304 + 64 * (j))
#define XB_TOP      3328
#define XB_TOPGEN   3392
#define XCD_BAR_WORDS 3456
#define XB_SPIN_CAP (1u << 18)
__device__ __forceinline__ unsigned xb_ld(unsigned* p)              { return __hip_atomic_load(p, __ATOMIC_RELAXED, __HIP_MEMORY_SCOPE_AGENT); }
__device__ __forceinline__ unsigned xb_add(unsigned* p, unsigned v) { return __hip_atomic_fetch_add(p, v, __ATOMIC_RELAXED, __HIP_MEMORY_SCOPE_AGENT); }
__device__ __forceinline__ unsigned xb_xcc_id() { return (unsigned)__builtin_amdgcn_s_getreg((3 << 11) | 20) & 0xFu; }
#define XB_SPIN(cond, bar) do { unsigned _sp = 0; while (cond) { __builtin_amdgcn_s_sleep(1); \
    if ((++_sp & 255u) == 0u) { if (xb_ld(&(bar)[XB_TMO])) break; if (_sp > XB_SPIN_CAP) { atomicAdd(&(bar)[XB_TMO], 1u); break; } } } } while (0)
struct XcdBarrier { unsigned* bar; unsigned x; volatile LAS unsigned* st; };
__device__ __forceinline__ XcdBarrier xcd_barrier_post(unsigned* bar, volatile LAS unsigned* st) {
    XcdBarrier b; b.bar = bar; b.x = xb_xcc_id(); b.st = st;
    if (threadIdx.x == 0) (void)xb_add(&bar[XB_XCNT(b.x)], 1u);
    return b;
}
__device__ __forceinline__ void xcd_barrier_complete(unsigned* bar, unsigned x, unsigned& nloc, unsigned& nx) {
    const unsigned G = gridDim.x * gridDim.y * gridDim.z;
    unsigned sum, cnt, mine, sp = 0u;
    for (;;) {
        sum = 0u; cnt = 0u; mine = 0u;
#pragma unroll
        for (unsigned j = 0; j < 16; ++j) { const unsigned c = xb_ld(&bar[XB_XCNT(j)]); sum += c; cnt += (c > 0u) ? 1u : 0u; mine = (j == x) ? c : mine; }
        if (sum == G) break;
        __builtin_amdgcn_s_sleep(1);
        if ((++sp & 255u) == 0u) { if (xb_ld(&bar[XB_TMO])) break; if (sp > XB_SPIN_CAP) { atomicAdd(&bar[XB_TMO], 1u); break; } }
    }
    nloc = mine > 0u ? mine : 1u; nx = cnt > 0u ? cnt : 1u;
}
__device__ __forceinline__ void xcd_barrier(const XcdBarrier& b) {
    asm volatile("s_waitcnt vmcnt(0)" ::: "memory");
    __syncthreads();
    if (threadIdx.x == 0) {
        unsigned* bar = b.bar;
        __builtin_amdgcn_s_waitcnt(0);
        unsigned nloc = b.st[0], nx = b.st[1];
        if (nloc == 0u) { xcd_barrier_complete(bar, b.x, nloc, nx); b.st[0] = nloc; b.st[1] = nx; }
        const unsigned old = xb_add(&bar[XB_XSUB(b.x)], 1u);
        const unsigned gen = old / nloc;
        if (old + 1u == (gen + 1u) * nloc) {
            __builtin_amdgcn_fence(__ATOMIC_RELEASE, "agent");
            asm volatile("s_waitcnt vmcnt(0)" ::: "memory");
            const unsigned og = xb_add(&bar[XB_TOP], 1u);
            const unsigned tg = og / nx;
            if (og + 1u == (tg + 1u) * nx) xb_add(&bar[XB_TOPGEN], 1u);
            else XB_SPIN(xb_ld(&bar[XB_TOPGEN]) == tg, bar);
            __builtin_amdgcn_fence(__ATOMIC_ACQUIRE, "agent");
            xb_add(&bar[XB_XGEN(b.x)], 1u);
            asm volatile("s_waitcnt vmcnt(0)" ::: "memory");
        } else {
            XB_SPIN(xb_ld(&bar[XB_XGEN(b.x)]) == gen, bar);
            __builtin_amdgcn_fence(__ATOMIC_ACQUIRE, "agent");
            asm volatile("s_waitcnt vmcnt(0)" ::: "memory");
        }
    }
    __syncthreads();
}

__device__ __forceinline__ void xcc_local_barrier(unsigned* ctl, unsigned x, unsigned nloc) {
    asm volatile("s_waitcnt vmcnt(0)" ::: "memory");
    __syncthreads();
    if (threadIdx.x == 0) {
        const unsigned old = xb_add(&ctl[CW_XL_SUB + 64 * x], 1u);
        const unsigned gen = old / nloc;
        if (old + 1u == (gen + 1u) * nloc) xb_add(&ctl[CW_XL_GEN + 64 * x], 1u);
        else XB_SPIN(xb_ld(&ctl[CW_XL_GEN + 64 * x]) == gen, ctl + CW_BAR);
        __builtin_amdgcn_fence(__ATOMIC_ACQUIRE, "agent");
        asm volatile("s_waitcnt vmcnt(0)" ::: "memory");
    }
    __syncthreads();
}

__device__ __forceinline__ float wave_sum(float v) {
#pragma unroll
    for (int o = 1; o < 64; o <<= 1) v += __shfl_xor(v, o);
    return v;
}
__device__ __forceinline__ float log_sigmoidf(float x) { return fminf(x, 0.f) - log1pf(expf(-fabsf(x))); }
__device__ __forceinline__ float rstd_of(const ssq_t* ssq_row) { return 1.0f / sqrtf(ssq_val(ssq_row) * (1.0f / D) + EPS); }

__device__ __forceinline__ void tr_item64(const float* W, int ldW, int k0, int c0, bf16_t* WT, int ldT, int r0, const float* kg, const float* cg, float mul, LAS unsigned* scr, int lane) {
    const int n4 = lane & 15, kq = lane >> 4;
    f32x4 cm = (f32x4){mul, mul, mul, mul}; if (cg) cm = *(const f32x4*)(cg + c0 + 4 * n4) * mul;
    f32x4 va[8], vb[8];
#pragma unroll
    for (int i = 0; i < 8; ++i) { const int kp = kq + 4 * i; const float* p = W + (size_t)(k0 + 2 * kp) * ldW + c0 + 4 * n4; va[i] = *(const f32x4*)p; vb[i] = *(const f32x4*)(p + ldW); }
#pragma unroll
    for (int i = 0; i < 8; ++i) { const int kp = kq + 4 * i; const float g0 = kg ? kg[k0 + 2 * kp] : 1.0f, g1 = kg ? kg[k0 + 2 * kp + 1] : 1.0f;
#pragma unroll
        for (int e = 0; e < 4; ++e) scr[kp * 65 + 4 * n4 + e] = pack2(va[i][e] * cm[e] * g0, vb[i][e] * cm[e] * g1); }
    LDS_WAIT(); asm volatile("" ::: "memory");
    const int j = lane & 7, nl = lane >> 3;
#pragma unroll
    for (int it = 0; it < 8; ++it) { const int n = nl + 8 * it; u32x4 o; o.x = scr[(4 * j + 0) * 65 + n]; o.y = scr[(4 * j + 1) * 65 + n]; o.z = scr[(4 * j + 2) * 65 + n]; o.w = scr[(4 * j + 3) * 65 + n];
        *(u32x4*)(WT + (size_t)(r0 + n) * ldT + k0 + 8 * j) = o; }
    LDS_WAIT(); asm volatile("" ::: "memory");
}

struct Args;
constexpr int I_IN = 16 * 48, I_OUT = 16 * 16, I_POOL = 4 * 4 * 4, I_GU = 16 * 88, I_DN = 44 * 16;
constexpr int CV_P0 = I_IN + I_OUT, CV_T0 = CV_P0 + I_DN + I_POOL + I_OUT, CV_T1 = CV_T0 + I_DN + I_IN, CV_T2 = CV_T1 + I_DN + I_POOL, CV_END = CV_T2 + I_DN;
constexpr int GU_ITEMS = GU / 64;
struct Args { const float* in[12]; float* out; unsigned char* ws; int ph_lo, ph_hi; };

enum { JT_GU = 0, JT_DN = 1, JT_IN = 2, JT_OUT = 3, JT_POOL = 4 };
__device__ __forceinline__ void convert_one(const Args& args, unsigned char* ws, LAS unsigned* scr, int lane, int type, int l, int r) {
    const float* const* in = args.in;
    if (type == JT_GU) { const int kb = r / 88, nb = r % 88, r0 = nb * 64, pn = r0 >> 8, j = r0 & 255; const int c0 = (j < 128) ? pn * 128 + j : FF + pn * 128 + (j - 128);
        tr_item64(in[9] + (size_t)l * D * GU, GU, kb * 64, c0, (bf16_t*)(ws + WS_WGU) + (size_t)l * GU * D, D, r0, in[2] + l * D, nullptr, 1.0f, scr, lane); }
    else if (type == JT_DN) { const int kb = r / 16, nb = r % 16;
        tr_item64(in[10] + (size_t)l * FF * D, D, kb * 64, nb * 64, (bf16_t*)(ws + WS_WDN) + (size_t)l * D * FF, FF, nb * 64, nullptr, nullptr, 1.0f, scr, lane); }
    else if (type == JT_IN) { const int kb = r / 48, nb = r % 48, r0 = nb * 64;
        tr_item64(in[3] + (size_t)l * D * NIN, NIN, kb * 64, r0, (bf16_t*)(ws + WS_WIN) + (size_t)l * NQKVO * D, D, r0, in[1] + (2 * l) * D, nullptr, (r0 >= 512 && r0 < 1024) ? 0.125f : 1.0f, scr, lane); }
    else if (type == JT_OUT) { const int kb = r / 16, nb = r % 16;
        tr_item64(in[6] + (size_t)l * D * D, D, kb * 64, nb * 64, (bf16_t*)(ws + WS_WOUT) + (size_t)l * D * D, D, nb * 64, in[5] + l * D, nullptr, 1.0f, scr, lane); }
    else { const int gi = r / 16, r2 = r % 16, kb = r2 / 4, nb = r2 % 4;
        tr_item64(in[7] + (size_t)(l * 4 + gi) * 256 * 256, 256, kb * 64, nb * 64, (bf16_t*)(ws + WS_WPOOL) + (size_t)l * D * 256 + (size_t)gi * 256 * 256, 256, nb * 64,
                  in[1] + (2 * l + 1) * D + gi * 256, in[8] + l * D + gi * 256, 1.0f, scr, lane); }
}
__device__ __forceinline__ void convert_items(const Args& args, unsigned char* ws, LAS unsigned* scr, int lane, int lo, int hi, int w, int nw) {
    for (int it = lo + w; it < hi; it += nw) {
        int r = it;
#define CV_JOB(T, L, N) if (r < (N)) { convert_one(args, ws, scr, lane, T, L, r); continue; } r -= (N);
        CV_JOB(JT_IN, 0, I_IN) CV_JOB(JT_OUT, 0, I_OUT)
        CV_JOB(JT_DN, 0, I_DN) CV_JOB(JT_POOL, 0, I_POOL) CV_JOB(JT_OUT, 1, I_OUT)
        CV_JOB(JT_DN, 1, I_DN) CV_JOB(JT_IN, 1, I_IN)
        CV_JOB(JT_DN, 2, I_DN) CV_JOB(JT_POOL, 1, I_POOL)
        CV_JOB(JT_DN, 3, I_DN)
#undef CV_JOB
    }
}
constexpr int N_PHASES = 24;

__device__ __forceinline__ void quant_gu_item(const Args& args, unsigned char* ws, LAS unsigned char* lds, int layer, int nb, int tid) {
    const int lane = tid & 63, wave = __builtin_amdgcn_readfirstlane(tid >> 6);
    const float* W = args.in[9] + (size_t)layer * D * GU; const float* kg = args.in[2] + layer * D;
    const int r0 = nb * 64, pn = r0 >> 8, jt = r0 & 255, c0 = (jt < 128) ? pn * 128 + jt : FF + pn * 128 + (jt - 128);
    LAS float* part = (LAS float*)(lds + 69632); LAS float* sc = part + 512;
    const int n4 = tid & 15, kq = tid >> 4;
    f32x4 v[32];
#pragma unroll
    for (int j = 0; j < 32; ++j) v[j] = *(const f32x4*)(W + (size_t)(kq * 32 + j) * GU + c0 + 4 * n4);
    f32x4 mx = (f32x4){0.f, 0.f, 0.f, 0.f};
#pragma unroll
    for (int a = 0; a < 8; ++a) { const f32x4 g4 = *(const f32x4*)(kg + kq * 32 + 4 * a);
#pragma unroll
        for (int i = 0; i < 4; ++i) { v[4 * a + i] = v[4 * a + i] * g4[i];
#pragma unroll
            for (int e = 0; e < 4; ++e) mx[e] = fmaxf(mx[e], fabsf(v[4 * a + i][e])); } }
#pragma unroll
    for (int e = 0; e < 4; ++e) { mx[e] = fmaxf(mx[e], __shfl_xor(mx[e], 16)); mx[e] = fmaxf(mx[e], __shfl_xor(mx[e], 32)); }
    if (lane < 16) *(LAS f32x4*)(part + wave * 64 + 4 * n4) = mx;
    __syncthreads();
    if (tid < 64) { float m = 0.f;
#pragma unroll
        for (int w = 0; w < 8; ++w) m = fmaxf(m, part[w * 64 + tid]);
        sc[tid] = m > 0.f ? 127.0f / m : 0.f; ((float*)(ws + WS_SB))[(size_t)layer * GU + r0 + tid] = m * (1.0f / 127.0f); }
    __syncthreads();
    LAS unsigned* scr = (LAS unsigned*)(lds + wave * 8448);
    const f32x4 isc = *(const LAS f32x4*)(sc + 4 * n4);
#pragma unroll
    for (int a = 0; a < 8; ++a)
#pragma unroll
        for (int e = 0; e < 4; ++e) { const float is = isc[e];
            const unsigned q0 = (unsigned)__float2int_rn(v[4 * a][e] * is) & 255u, q1 = (unsigned)__float2int_rn(v[4 * a + 1][e] * is) & 255u,
                           q2 = (unsigned)__float2int_rn(v[4 * a + 2][e] * is) & 255u, q3 = (unsigned)__float2int_rn(v[4 * a + 3][e] * is) & 255u;
            scr[((kq & 3) * 8 + a) * 65 + 4 * n4 + e] = q0 | (q1 << 8) | (q2 << 16) | (q3 << 24); }
    LDS_WAIT(); asm volatile("" ::: "memory");
    unsigned char* B8 = ws + WS_WGU + ((size_t)layer * GU + r0) * D + wave * 128;
    const int j8 = lane & 7, nl = lane >> 3;
#pragma unroll
    for (int it = 0; it < 8; ++it) { const int n = nl + 8 * it; u32x4 o; o.x = scr[(4 * j8 + 0) * 65 + n]; o.y = scr[(4 * j8 + 1) * 65 + n]; o.z = scr[(4 * j8 + 2) * 65 + n]; o.w = scr[(4 * j8 + 3) * 65 + n];
        *(u32x4*)(B8 + (size_t)n * D + 16 * j8) = o; }
    LDS_WAIT(); asm volatile("" ::: "memory");
}

__global__ void __launch_bounds__(NT, 2) fwd_kernel(Args args) {
    extern __shared__ __attribute__((aligned(16))) unsigned char lds_raw[];
    LAS unsigned char* lds = (LAS unsigned char*)lds_raw;
    volatile LAS unsigned* MISC = (volatile LAS unsigned*)(lds + MISC_OFF);
    LAS float* rtab = (LAS float*)(lds + RSTD_OFF);
    int tid = threadIdx.x, lane = tid & 63, wave = __builtin_amdgcn_readfirstlane(tid >> 6);
#define FRESH_TID() do { tid = threadIdx.x; asm volatile("" : "+v"(tid)); lane = tid & 63; wave = __builtin_amdgcn_readfirstlane(tid >> 6); } while (0)
    const int G = gridDim.x, bid0 = blockIdx.x;
    int bid = bid0;
    unsigned char* const ws = args.ws;
#define x_in       (args.in[0])
#define norm_mix   (args.in[1])
#define norm_ffn   (args.in[2])
#define w_in       (args.in[3])
#define gate_bias  (args.in[4])
#define head_gain  (args.in[5])
#define w_out      (args.in[6])
#define pool_w     (args.in[7])
#define pool_scale (args.in[8])
#define w_gu       (args.in[9])
#define w_dn       (args.in[10])
#define final_norm (args.in[11])
#define Win_t   ((bf16_t*)(ws + WS_WIN))
#define Wout_t  ((bf16_t*)(ws + WS_WOUT))
#define Wpool_t ((bf16_t*)(ws + WS_WPOOL))
#define Wgu_t   ((bf16_t*)(ws + WS_WGU))
#define Wdn_t   ((bf16_t*)(ws + WS_WDN))
#define Wg      ((bf16_t*)(ws + WS_WG))
#define ssq     ((ssq_t*)(ws + WS_SSQ))
#define gates   ((float*)(ws + WS_GATES))
#define decay   ((float*)(ws + WS_DECAY))
#define GT      ((float*)(ws + WS_GT))
#define A8      ((unsigned char*)(ws + WS_A8))
#define RS8     ((float*)(ws + WS_RS8))
#define SBW     ((float*)(ws + WS_SB))
#define xb      ((bf16_t*)(ws + WS_XB))
#define BIG     ((bf16_t*)(ws + WS_BIG))
#define ST      ((bf16_t*)(ws + WS_ST))

    for (int u = tid; u < (LDS_BYTES - LDSCTL_OFF) / 4; u += NT) ((LAS unsigned*)(lds + LDSCTL_OFF))[u] = 0u;
    __syncthreads();
    XcdBarrier bar; bar.bar = (unsigned*)(ws + WS_CTL) + CW_BAR; bar.x = 0; bar.st = nullptr;
    if (MK_N_LAUNCHES == 1) bar = xcd_barrier_post((unsigned*)(ws + WS_CTL) + CW_BAR, MISC + 8);
    unsigned* const ctl = (unsigned*)(ws + WS_CTL);
    if (MK_N_LAUNCHES == 1) {
        if (tid == 0) { const unsigned x = xb_xcc_id(); MISC[4] = x; MISC[5] = xb_add(&ctl[CW_CENSUS + 64 * x], 1u); }
        __syncthreads();
    }
    const int xcc = (int)MISC[4], xrank = (int)MISC[5];
    int xmode = 0;

    const int lo = args.ph_lo, hi = args.ph_hi;
    int ph = 0;
#define IN_PH() (lo <= ph && ph < hi)
#define BEGIN_PH() FRESH_TID()
#if PROBE_PH >= 0
#define LAS_REP_PTR(op, row, h, ch) (LAST_REP() ? (op) : (u32x4*)args.out + ((size_t)(row) * 128 + (h) * 16 + (ch)))
#define REPS() ((ph == PROBE_PH) ? PROBE_REP : 1)
#define LAST_REP() (rep_ + 1 == REPS())
#else
#define LAS_REP_PTR(op, row, h, ch) (op)
#define REPS() 1
#define LAST_REP() true
#endif
#define END_PH() do { if (lo <= ph && ph + 1 < hi) xcd_barrier(bar); ++ph; } while (0)
#define END_PH_X() do { if (lo <= ph && ph + 1 < hi) { if (xmode) xcc_local_barrier(ctl, (unsigned)xcc, (unsigned)(G / 8)); else xcd_barrier(bar); } ++ph; } while (0)

    if (IN_PH()) for (int rep_ = 0; rep_ < REPS(); ++rep_) { BEGIN_PH();
        LAS unsigned* scr = (LAS unsigned*)(lds + RING_OFF + wave * 8448);
        const int gw = bid * NWAVES + wave, NGW = G * NWAVES;
        if (G == 256) { if (bid < GU_ITEMS) quant_gu_item(args, ws, lds, 0, bid, tid); }
        else for (int it = bid; it < 4 * GU_ITEMS; it += G) { quant_gu_item(args, ws, lds, it / GU_ITEMS, it % GU_ITEMS, tid); __syncthreads(); }
        __syncthreads();
        convert_items(args, ws, scr, lane, 0, (G == 256) ? CV_P0 : CV_END, gw, NGW);
        for (int e = bid * NT + tid; e < 2 * 16 * D; e += G * NT) { const int l = e / (16 * D), rem = e % (16 * D), k = rem >> 4, j = rem & 15;
            Wg[(size_t)l * 16 * D + j * D + k] = f2bf(w_in[(size_t)l * D * NIN + (size_t)k * NIN + NQKVO + j] * norm_mix[(2 * l) * D + k]); }
        for (int m = 2 * gw; m < M; m += 2 * NGW) {
            const f32x4* xr = (const f32x4*)(x_in + (size_t)m * D) + lane; f32x4 v[8]; float s0 = 0.f, s1 = 0.f;
#pragma unroll
            for (int j = 0; j < 8; ++j) v[j] = xr[64 * j];
#pragma unroll
            for (int j = 0; j < 4; ++j) { s0 += (v[j][0] * v[j][0] + v[j][1] * v[j][1]) + (v[j][2] * v[j][2] + v[j][3] * v[j][3]);
                                          s1 += (v[j + 4][0] * v[j + 4][0] + v[j + 4][1] * v[j + 4][1]) + (v[j + 4][2] * v[j + 4][2] + v[j + 4][3] * v[j + 4][3]); }
            s0 = wave_sum(s0); s1 = wave_sum(s1);
#pragma unroll
            for (int j = 0; j < 8; ++j) { u32x2 w; w.x = cvt_pk_bf16(v[j][0], v[j][1]); w.y = cvt_pk_bf16(v[j][2], v[j][3]); ((u32x2*)(xb + (size_t)m * D))[64 * j + lane] = w; }
            if (lane < 32) ssq[(size_t)m * 16 + lane] = (lane == 0) ? s0 : (lane == 16) ? s1 : 0.f;
        }
    }
    END_PH();
    if (MK_N_LAUNCHES == 1 && lo == 0 && (G & 7) == 0 && BATCH == 8) {
        if (tid == 0) { unsigned ok = 1u;
#pragma unroll
            for (int j = 0; j < 8; ++j) ok &= (xb_ld(&ctl[CW_CENSUS + 64 * j]) == (unsigned)(G / 8)) ? 1u : 0u;
            MISC[6] = ok; }
        __syncthreads();
        xmode = (int)MISC[6];
        if (xmode) bid = xcc + 8 * xrank;
    }
    const int gq = G / 8;
    const int it0 = xmode ? 64 * xcc + xrank : bid, its = xmode ? gq : G, itn = xmode ? 64 * xcc + 64 : NBLK;
    const int rb0 = xmode ? 32 * xcc + xrank : bid, rbn = xmode ? 32 * xcc + 32 : M / 64;
#if PROBE_BARS > 0
    if (MK_N_LAUNCHES == 1) for (int i_ = 0; i_ < PROBE_BARS; ++i_) xcd_barrier(bar);
#endif

    for (int layer = 0; layer < DEPTH; ++layer) {
        const int slot = layer >> 1;
        ssq_t* ssq_a = ssq + (size_t)(2 * layer) * M * 16;
        ssq_t* ssq_b = ssq_a + (size_t)M * 16;
        ssq_t* ssq_c = ssq_b + (size_t)M * 16;
        if ((layer & 1) == 0) {
            if (IN_PH()) for (int rep_ = 0; rep_ < REPS(); ++rep_) { BEGIN_PH();
                {
                    const bf16_t* wgb = Wg + (size_t)slot * 16 * D;
                    LAS float* red = (LAS float*)lds;
                    const int rbk = wave & 3, kh = wave >> 2, fr = lane & 15, fq = lane >> 4;
#if defined(PROBE_GATES)
                    for (int grep_ = 0; grep_ < 3; ++grep_)
#endif
                    for (int rb = rb0; rb < rbn; rb += its) {
                        const bf16_t* ap = xb + (size_t)(rb * 64 + rbk * 16 + fr) * D + kh * 512 + 8 * fq;
                        const bf16_t* bp = wgb + (size_t)fr * D + kh * 512 + 8 * fq;
                        f32x4 ga = (f32x4){0.f, 0.f, 0.f, 0.f};
#pragma unroll
                        for (int ks = 0; ks < 16; ++ks) ga = __builtin_amdgcn_mfma_f32_16x16x32_bf16(*(const bf16x8*)(ap + 32 * ks), *(const bf16x8*)(bp + 32 * ks), ga, 0, 0, 0);
                        if (kh == 1) *(LAS f32x4*)(red + (rbk * 64 + lane) * 4) = ga;
                        __syncthreads();
                        if (kh == 0) {
                            ga += *(const LAS f32x4*)(red + (rbk * 64 + lane) * 4);
                            const float gb = gate_bias[slot * 16 + fr];
#pragma unroll
                            for (int r = 0; r < 4; ++r) { const int row = rb * 64 + rbk * 16 + 4 * fq + r; const float gv = ga[r] * rstd_of(ssq_a + (size_t)row * 16) + gb;
                                gates[(size_t)row * 16 + fr] = SOFTCAP * tanhf(gv * (1.0f / SOFTCAP)); }
                        }
                        __syncthreads();
                    }
                }
                pg8::Gemm g{xb, Win_t + (size_t)slot * NQKVO * D}; pg8::Order S; S.init(M, NQKVO, G, bid, ssq_a, rtab);
                pg8::EpiProj E{BIG, rtab};
                pg8::gemm_phase<pg8::EpiProj, true, D, D, D, 0>(lds + RING_OFF, g, S, E);
            }
            END_PH_X();
            if (IN_PH()) for (int rep_ = 0; rep_ < REPS(); ++rep_) { BEGIN_PH();
                LAS unsigned char* kimg = lds;
                LAS unsigned char* vimg = lds + 49152;
                LAS float* wtab = (LAS float*)(lds + TAB_OFF);
                const int hh = lane >> 5, l31 = lane & 31, g16 = (lane >> 4) & 1, q4 = (lane & 15) >> 2, p4 = lane & 3;
                const int troffK = (8 * hh + q4) * 192 + (16 * g16 + 4 * p4) * 2, troffV = (8 * hh + q4) * 320 + (16 * g16 + 4 * p4) * 2;
                bf16x8 a_one; { const short o = (l31 == 0) ? (short)0x3F80 : (short)0; for (int j = 0; j < 8; ++j) a_one[j] = o; }
                const int vt = wave >> 1, dt = wave & 1;
                for (int item = it0; item < itn; item += its) {
                    const int b = item >> 6, h = (item >> 3) & 7, blk = item & 7, row0 = b * SEQ + blk * BLK;
                    __syncthreads();
                    { float lf[4], ig[4];
#pragma unroll
                      for (int e = 0; e < 4; ++e) { const float* gp = gates + (size_t)(row0 + 4 * lane + e) * 16; lf[e] = log_sigmoidf(gp[8 + h]); ig[e] = gp[h]; }
                      const float p0 = lf[0], p1 = p0 + lf[1], p2 = p1 + lf[2], p3 = p2 + lf[3];
                      float sc = p3;
#pragma unroll
                      for (int o = 1; o < 64; o <<= 1) { const float t = __shfl_up(sc, o); if (lane >= o) sc += t; }
                      const float ex = sc - p3, bl = __shfl(sc, 63);
                      if (wave == 0) { *(LAS f32x4*)(wtab + 4 * lane) = (f32x4){__expf(bl - (ex + p0) + ig[0]), __expf(bl - (ex + p1) + ig[1]), __expf(bl - (ex + p2) + ig[2]), __expf(bl - (ex + p3) + ig[3])};
                                       *(f32x4*)(GT + (size_t)item * 512 + 4 * lane) = (f32x4){ex + p0, ex + p1, ex + p2, ex + p3};
                                       *(f32x4*)(GT + (size_t)item * 512 + 256 + 4 * lane) = (f32x4){ig[0] - (ex + p0), ig[1] - (ex + p1), ig[2] - (ex + p2), ig[3] - (ex + p3)};
                                       if (lane == 0) decay[item] = __expf(bl); } }
#pragma unroll
                    for (int i = 0; i < 4; ++i) { const int id = i * NT + tid, r = id >> 3, ch = id & 7; *(LAS u32x4*)(kimg + r * 192 + ch * 16) = *(const u32x4*)(BIG + (size_t)(row0 + r) * NQKVO + 512 + h * DK + ch * 8); }
#pragma unroll
                    for (int i = 0; i < 8; ++i) { const int id = i * NT + tid, r = id >> 4, ch = id & 15; *(LAS u32x4*)(vimg + r * 320 + ch * 16) = *(const u32x4*)(BIG + (size_t)(row0 + r) * NQKVO + 1024 + h * DV + ch * 8); }
                    __syncthreads();
                    f32x16 acc = zero16(), accn = zero16();
#pragma unroll 4
                    for (int ks = 0; ks < 16; ++ks) {
                        const bf16x8 kf = tr_pair(kimg + troffK + ks * 16 * 192 + dt * 64, 4 * 192);
                        const f32x4 w0 = *(const LAS f32x4*)(wtab + 16 * ks + 8 * hh), w1 = *(const LAS f32x4*)(wtab + 16 * ks + 8 * hh + 4);
                        const u32x4 kb = __builtin_bit_cast(u32x4, kf);
                        u32x4 ksc; ksc.x = pack2(bflo(kb.x) * w0[0], bfhi(kb.x) * w0[1]); ksc.y = pack2(bflo(kb.y) * w0[2], bfhi(kb.y) * w0[3]);
                        ksc.z = pack2(bflo(kb.z) * w1[0], bfhi(kb.z) * w1[1]); ksc.w = pack2(bflo(kb.w) * w1[2], bfhi(kb.w) * w1[3]);
                        const bf16x8 kfs = __builtin_bit_cast(bf16x8, ksc);
                        const bf16x8 vf = tr_pair(vimg + troffV + ks * 16 * 320 + vt * 64, 4 * 320);
                        acc = MFMA32(kfs, vf, acc);
                        if (vt == 0) accn = MFMA32(kfs, a_one, accn);
                    }
                    bf16_t* st = ST + (size_t)item * STE;
#pragma unroll
                    for (int g4 = 0; g4 < 4; ++g4) { u32x2 pk; pk.x = pack2(acc[4 * g4], acc[4 * g4 + 1]); pk.y = pack2(acc[4 * g4 + 2], acc[4 * g4 + 3]);
                        *(u32x2*)(st + (size_t)(32 * vt + l31) * 64 + 32 * dt + 8 * g4 + 4 * hh) = pk; }
                    if (vt == 0 && l31 == 0) {
#pragma unroll
                        for (int g4 = 0; g4 < 4; ++g4) { u32x2 pk; pk.x = pack2(accn[4 * g4], accn[4 * g4 + 1]); pk.y = pack2(accn[4 * g4 + 2], accn[4 * g4 + 3]);
                            *(u32x2*)(st + 128 * 64 + 32 * dt + 8 * g4 + 4 * hh) = pk; }
                    }
                }
            }
            END_PH_X();
            if (IN_PH()) for (int rep_ = 0; rep_ < REPS(); ++rep_) { BEGIN_PH();
                LAS unsigned char* vimg = lds;
                LAS unsigned char* cimg = lds + 81920;
                LAS float* btab = (LAS float*)(lds + 100608);
                LAS float* ctab = btab + 256;
                const int st = (wave < 4) ? 7 - wave : wave - 4;
                for (int item = it0; item < itn; item += its) {
                    FRESH_TID();
                    const int hh = lane >> 5, l31 = lane & 31, g16 = (lane >> 4) & 1, q4 = (lane & 15) >> 2, p4 = lane & 3;
                    const int troff = (4 * hh + q4) * 320 + (16 * g16 + 4 * p4) * 2;
                    bf16x8 a_one; { const short o = (l31 == 0) ? (short)0x3F80 : (short)0; for (int j = 0; j < 8; ++j) a_one[j] = o; }
                    const int b = item >> 6, h = (item >> 3) & 7, blk = item & 7, row0 = b * SEQ + blk * BLK;
                    u32x4 vv[8];
#pragma unroll
                    for (int i = 0; i < 8; ++i) { const int id = i * NT + tid, r = id >> 4, ch = id & 15; vv[i] = *(const u32x4*)(BIG + (size_t)(row0 + r) * NQKVO + 1024 + h * DV + ch * 8); }
                    f32x4 tb = (f32x4){0.f, 0.f, 0.f, 0.f};
                    if (tid < 128) tb = *(const f32x4*)(GT + (size_t)item * 512 + 4 * tid);
                    u32x4 uu[2][7]; float dj[7];
#pragma unroll
                    for (int j = 0; j < 7; ++j) { dj[j] = 0.f; uu[0][j] = (u32x4){0u, 0u, 0u, 0u}; uu[1][j] = (u32x4){0u, 0u, 0u, 0u};
                        if (j < blk) { dj[j] = decay[item - blk + j]; const bf16_t* up = ST + (size_t)(item - blk + j) * STE + tid * 8; uu[0][j] = *(const u32x4*)up; uu[1][j] = *(const u32x4*)(up + NT * 8); } }
                    unsigned un[7];
#pragma unroll
                    for (int j = 0; j < 7; ++j) { un[j] = 0u; if (j < blk && tid < 32) un[j] = ((const unsigned*)(ST + (size_t)(item - blk + j) * STE + 8192))[tid]; }
                    __syncthreads();
#pragma unroll
                    for (int i = 0; i < 8; ++i) { const int id = i * NT + tid, r = id >> 4, ch = id & 15; *(LAS u32x4*)(vimg + r * 320 + ch * 16) = vv[i]; }
                    if (tid < 128) *(LAS f32x4*)(btab + 4 * tid) = tb;
#pragma unroll
                    for (int cc = 0; cc < 2; ++cc) { const int chunk = cc * NT + tid; float a8[8];
#pragma unroll
                        for (int e = 0; e < 8; ++e) a8[e] = 0.f;
#pragma unroll
                        for (int j = 0; j < 7; ++j) { const u32x4 u = uu[cc][j]; const float d = dj[j];
                            if (j < blk) {
                            a8[0] = d * a8[0] + bflo(u.x); a8[1] = d * a8[1] + bfhi(u.x); a8[2] = d * a8[2] + bflo(u.y); a8[3] = d * a8[3] + bfhi(u.y);
                            a8[4] = d * a8[4] + bflo(u.z); a8[5] = d * a8[5] + bfhi(u.z); a8[6] = d * a8[6] + bflo(u.w); a8[7] = d * a8[7] + bfhi(u.w); } }
                        u32x4 o; o.x = pack2(a8[0], a8[1]); o.y = pack2(a8[2], a8[3]); o.z = pack2(a8[4], a8[5]); o.w = pack2(a8[6], a8[7]);
                        *(LAS u32x4*)(cimg + (chunk >> 3) * 144 + (chunk & 7) * 16) = o; }
                    if (tid < 32) { float n0 = 0.f, n1 = 0.f;
#pragma unroll
                        for (int j = 0; j < 7; ++j) if (j < blk) { n0 = dj[j] * n0 + bflo(un[j]); n1 = dj[j] * n1 + bfhi(un[j]); }
                        *(LAS unsigned*)(cimg + 128 * 144 + tid * 4) = pack2(n0, n1); }
                    __syncthreads();
                    const float bs = btab[32 * st + l31], eb = __expf(bs);
                    bf16x8 qf[4];
                    { const bf16_t* qp = BIG + (size_t)(row0 + 32 * st + l31) * NQKVO + h * DK + 8 * hh;
#pragma unroll
                      for (int ks = 0; ks < 4; ++ks) qf[ks] = *(const bf16x8*)(qp + 16 * ks); }
                    u32x4 ov[8];
#pragma unroll
                    for (int i = 0; i < 8; ++i) { const int id = i * 64 + lane, rho = id >> 4, ch = id & 15; ov[i] = *(const u32x4*)(BIG + (size_t)(row0 + 32 * st + rho) * NQKVO + 2048 + h * DV + ch * 8); }
                    f32x16 acc[5];
#pragma unroll
                    for (int v5 = 0; v5 < 5; ++v5) acc[v5] = zero16();
                    bf16x8 kn[4];
                    { const bf16_t* kp = BIG + (size_t)(row0 + l31) * NQKVO + 512 + h * DK + 8 * hh;
#pragma unroll
                      for (int ks = 0; ks < 4; ++ks) kn[ks] = *(const bf16x8*)(kp + 16 * ks); }
                    for (int rt = 0; rt <= st; ++rt) {
                        f32x16 X = zero16();
#pragma unroll
                        for (int ks = 0; ks < 4; ++ks) X = MFMA32(kn[ks], qf[ks], X);
                        if (rt < st) { const bf16_t* kp = BIG + (size_t)(row0 + 32 * (rt + 1) + l31) * NQKVO + 512 + h * DK + 8 * hh;
#pragma unroll
                            for (int ks = 0; ks < 4; ++ks) kn[ks] = *(const bf16x8*)(kp + 16 * ks); }
#pragma unroll
                        for (int g4 = 0; g4 < 4; ++g4) {
                            const f32x4 cr = *(const LAS f32x4*)(ctab + 32 * rt + 8 * g4 + 4 * hh);
#pragma unroll
                            for (int e = 0; e < 4; ++e) { float pv = X[4 * g4 + e] * __expf(bs + cr[e]); if (rt == st && (8 * g4 + 4 * hh + e) > l31) pv = 0.f; X[4 * g4 + e] = pv; }
                        }
#pragma unroll
                        for (int sp = 0; sp < 2; ++sp) {
                            u32x4 pk; pk.x = pack2(X[8 * sp + 0], X[8 * sp + 1]); pk.y = pack2(X[8 * sp + 2], X[8 * sp + 3]); pk.z = pack2(X[8 * sp + 4], X[8 * sp + 5]); pk.w = pack2(X[8 * sp + 6], X[8 * sp + 7]);
                            const bf16x8 pf = __builtin_bit_cast(bf16x8, pk);
#pragma unroll
                            for (int v4 = 0; v4 < 4; ++v4) acc[v4] = MFMA32(tr_pair(vimg + troff + (32 * rt + 16 * sp) * 320 + v4 * 64, 8 * 320), pf, acc[v4]);
                            acc[4] = MFMA32(a_one, pf, acc[4]);
                        }
                    }
                    {   bf16x8 qs[4];
#pragma unroll
                        for (int ks = 0; ks < 4; ++ks) { const u32x4 qb = __builtin_bit_cast(u32x4, qf[ks]); u32x4 o; o.x = pack2(bflo(qb.x) * eb, bfhi(qb.x) * eb); o.y = pack2(bflo(qb.y) * eb, bfhi(qb.y) * eb);
                            o.z = pack2(bflo(qb.z) * eb, bfhi(qb.z) * eb); o.w = pack2(bflo(qb.w) * eb, bfhi(qb.w) * eb); qs[ks] = __builtin_bit_cast(bf16x8, o); }
#pragma unroll
                        for (int v5 = 0; v5 < 5; ++v5) {
                            const int vrow = (v5 < 4) ? 32 * v5 + l31 : 128;
#pragma unroll
                            for (int ks = 0; ks < 4; ++ks) {
                                u32x4 cf = *(const LAS u32x4*)(cimg + vrow * 144 + (16 * ks + 8 * hh) * 2);
                                if (v5 == 4 && l31 != 0) cf = (u32x4){0u, 0u, 0u, 0u};
                                acc[v5] = MFMA32(__builtin_bit_cast(bf16x8, cf), qs[ks], acc[v5]);
                            }
                        }
                    }
                    const float den = __shfl(acc[4][0], l31), dd = fmaxf(fabsf(den), 1.0f);
                    float ss = 0.f;
#pragma unroll
                    for (int v4 = 0; v4 < 4; ++v4)
#pragma unroll
                        for (int r = 0; r < 16; ++r) ss += acc[v4][r] * acc[v4][r];
                    ss += __shfl_xor(ss, 32);
                    const float idd = 1.0f / dd; const float scale = idd / sqrtf(ss * idd * idd * (1.0f / DV) + EPS);
                    __syncthreads();
                    LAS unsigned char* wl = vimg + wave * 8704;
#pragma unroll
                    for (int v4 = 0; v4 < 4; ++v4)
#pragma unroll
                        for (int g4 = 0; g4 < 4; ++g4) { u32x2 pk; pk.x = pack2(acc[v4][4 * g4] * scale, acc[v4][4 * g4 + 1] * scale); pk.y = pack2(acc[v4][4 * g4 + 2] * scale, acc[v4][4 * g4 + 3] * scale);
                            *(LAS u32x2*)(wl + l31 * 272 + (32 * v4 + 8 * g4 + 4 * hh) * 2) = pk; }
#pragma unroll
                    for (int i = 0; i < 8; ++i) { const int id = i * 64 + lane, rho = id >> 4, ch = id & 15;
                        const u32x4 hv = *(const LAS u32x4*)(wl + rho * 272 + ch * 16);
                        u32x4* op = (u32x4*)(BIG + (size_t)(row0 + 32 * st + rho) * NQKVO + 2048 + h * DV + ch * 8); const u32x4 o4 = ov[i];
                        u32x4 w4; w4.x = pack2(bflo(hv.x) * bflo(o4.x), bfhi(hv.x) * bfhi(o4.x)); w4.y = pack2(bflo(hv.y) * bflo(o4.y), bfhi(hv.y) * bfhi(o4.y));
                        w4.z = pack2(bflo(hv.z) * bflo(o4.z), bfhi(hv.z) * bfhi(o4.z)); w4.w = pack2(bflo(hv.w) * bflo(o4.w), bfhi(hv.w) * bfhi(o4.w));
                        *(LAS_REP_PTR(op, row0 + 32 * st + rho, h, ch)) = w4; }
                }
            }
            END_PH_X();
        }
        if (IN_PH()) for (int rep_ = 0; rep_ < REPS(); ++rep_) { BEGIN_PH();
            pg8::Order S; S.init(M, D, G, bid, nullptr, rtab);
            pg8::EpiRes E{xb, LAST_REP() ? xb : (bf16_t*)args.out, LAST_REP() ? ssq_b : (ssq_t*)(args.out + 8 * 1024 * 1024) + (size_t)rep_ * M * 16};
            if ((layer & 1) == 0) { pg8::Gemm g{BIG + 2048, Wout_t + (size_t)slot * D * D}; pg8::gemm_phase<pg8::EpiRes, false, NQKVO, D, D, 0>(lds + RING_OFF, g, S, E); }
            else {
                pg8::Unit u;
                for (int ui = 0; S.next(ui, u); ++ui) {
                    LAS float* hn = (LAS float*)lds;
                    LAS float* rsv = hn + 79 * 256;
                    const int gi = u.pn, w = 2 << gi, R0 = u.pm * 256, bb = R0 / SEQ, t0 = R0 % SEQ;
                    const int c16 = tid & 31, rp = tid >> 5;
                    const int c4 = tid & 63, tg = tid >> 6;
                    for (int tb = 0; tb < 4; ++tb) {
                        const int ts = t0 + 64 * tb;
                        __syncthreads();
                        if (tid < 79) { const int t = ts - 15 + tid; rsv[tid] = (t >= 0) ? rstd_of(ssq_a + (size_t)(bb * SEQ + t) * 16) : 0.f; }
                        u32x4 xv[5];
#pragma unroll
                        for (int ps = 0; ps < 5; ++ps) { const int rho = rp + 16 * ps, t = ts - 15 + rho; xv[ps] = (u32x4){0u, 0u, 0u, 0u};
                            if (rho < 79 && t >= 0) xv[ps] = *(const u32x4*)(xb + (size_t)(bb * SEQ + t) * D + 256 * gi + 8 * c16); }
                        __syncthreads();
#pragma unroll
                        for (int ps = 0; ps < 5; ++ps) { const int rho = rp + 16 * ps;
                            if (rho < 79) { const float r = rsv[rho]; LAS f32x4* dst = (LAS f32x4*)(hn + rho * 256 + 8 * c16);
                                dst[0] = (f32x4){bflo(xv[ps].x) * r, bfhi(xv[ps].x) * r, bflo(xv[ps].y) * r, bfhi(xv[ps].y) * r};
                                dst[1] = (f32x4){bflo(xv[ps].z) * r, bfhi(xv[ps].z) * r, bflo(xv[ps].w) * r, bfhi(xv[ps].w) * r}; } }
                        __syncthreads();
                        { const int tt0 = 8 * tg; f32x4 sw = (f32x4){0.f, 0.f, 0.f, 0.f};
                          for (int j = 1; j < w; ++j) sw += *(const LAS f32x4*)(hn + (15 + tt0 - j) * 256 + 4 * c4);
#pragma unroll
                          for (int tt = tt0; tt < tt0 + 8; ++tt) {
                              const f32x4 v = *(const LAS f32x4*)(hn + (15 + tt) * 256 + 4 * c4); sw += v;
                              const int tpos = ts + tt; const float inv = 1.0f / (float)((tpos + 1 < w) ? tpos + 1 : w);
                              u32x2 o; o.x = pack2(sw[0] * inv - v[0], sw[1] * inv - v[1]); o.y = pack2(sw[2] * inv - v[2], sw[3] * inv - v[3]);
                              *(u32x2*)(BIG + (size_t)(R0 + 64 * tb + tt) * D + 256 * gi + 4 * c4) = o;
                              sw -= *(const LAS f32x4*)(hn + (15 + tt - w + 1) * 256 + 4 * c4);
                          } }
                    }
                }
                VM_WAIT(); __syncthreads();
                pg8::Gemm g{BIG, Wpool_t + (size_t)slot * D * 256}; pg8::gemm_phase<pg8::EpiRes, false, D, 256, 256, 256>(lds + RING_OFF, g, S, E);
            }
        }
        END_PH_X();
        if (IN_PH()) for (int rep_ = 0; rep_ < REPS(); ++rep_) { BEGIN_PH();
            const int m0 = xmode ? xcc * SEQ + xrank * NWAVES + wave : bid * NWAVES + wave, ms = its * NWAVES, mn = xmode ? xcc * SEQ + SEQ : M;
            for (int mb = m0; mb < mn; mb += 4 * ms) {
                u32x4 ra[4], rb[4];
#pragma unroll
                for (int r = 0; r < 4; ++r) { const int m = mb + r * ms; ra[r] = (u32x4){0u, 0u, 0u, 0u}; rb[r] = ra[r];
                    if (m < mn) { ra[r] = ((const u32x4*)(xb + (size_t)m * D))[lane]; rb[r] = ((const u32x4*)(xb + (size_t)m * D))[64 + lane]; } }
#pragma unroll
                for (int r = 0; r < 4; ++r) { const int m = mb + r * ms; if (m < mn) {
                    const u32x4 a = ra[r], b2 = rb[r];
                    float v[16] = {bflo(a.x), bfhi(a.x), bflo(a.y), bfhi(a.y), bflo(a.z), bfhi(a.z), bflo(a.w), bfhi(a.w), bflo(b2.x), bfhi(b2.x), bflo(b2.y), bfhi(b2.y), bflo(b2.z), bfhi(b2.z), bflo(b2.w), bfhi(b2.w)};
                    float sq = 0.f, am = 0.f;
#pragma unroll
                    for (int j = 0; j < 16; ++j) { sq += v[j] * v[j]; am = fmaxf(am, fabsf(v[j])); }
                    sq = wave_sum(sq);
#pragma unroll
                    for (int o = 1; o < 64; o <<= 1) am = fmaxf(am, __shfl_xor(am, o));
                    const float inv = am > 0.f ? 127.0f / am : 0.f;
                    unsigned q[16];
#pragma unroll
                    for (int j = 0; j < 16; ++j) q[j] = (unsigned)__float2int_rn(v[j] * inv) & 255u;
                    u32x2 w0, w1; w0.x = q[0] | (q[1] << 8) | (q[2] << 16) | (q[3] << 24); w0.y = q[4] | (q[5] << 8) | (q[6] << 16) | (q[7] << 24);
                    w1.x = q[8] | (q[9] << 8) | (q[10] << 16) | (q[11] << 24); w1.y = q[12] | (q[13] << 8) | (q[14] << 16) | (q[15] << 24);
                    ((u32x2*)(A8 + (size_t)m * D))[lane] = w0; ((u32x2*)(A8 + (size_t)m * D))[64 + lane] = w1;
                    if (lane == 0) RS8[m] = am * (1.0f / 127.0f) / sqrtf(sq * (1.0f / D) + EPS);
                } }
            }
        }
        END_PH_X();
        if (IN_PH()) for (int rep_ = 0; rep_ < REPS(); ++rep_) { BEGIN_PH();
            if (G == 256 && bid >= 128 && LAST_REP()) {
                if (layer < 3 && bid - 128 < GU_ITEMS) quant_gu_item(args, ws, lds, layer + 1, bid - 128, tid);
                __syncthreads();
                const int lo_ = (layer == 0) ? CV_P0 : (layer == 1) ? CV_T0 : (layer == 2) ? CV_T1 : CV_T2, hi_ = (layer == 0) ? CV_T0 : (layer == 1) ? CV_T1 : (layer == 2) ? CV_T2 : CV_END;
                convert_items(args, ws, (LAS unsigned*)(lds + RING_OFF + wave * 8448), lane, lo_, hi_, (bid - 128) * NWAVES + wave, 128 * NWAVES);
                __syncthreads();
            }
            pg8::Gemm g{(const bf16_t*)A8, (const bf16_t*)(ws + WS_WGU + (size_t)layer * GU * D)}; pg8::Order S; S.init(M, GU, G, bid, nullptr, rtab); S.wgm = GU_WGM; S.rowscale = RS8;
            pg8::EpiGU8 E{BIG, rtab, SBW + (size_t)layer * GU};
            pg8::gemm_phase<pg8::EpiGU8, true, D / 2, D / 2, D / 2, 0, false, true>(lds + RING_OFF, g, S, E);
        }
        END_PH();
        if (IN_PH()) for (int rep_ = 0; rep_ < REPS(); ++rep_) { BEGIN_PH();
            pg8::Gemm g{BIG, Wdn_t + (size_t)layer * D * FF}; pg8::Order S; S.init(M, D, G, bid, nullptr, rtab);
            pg8::EpiRes E{xb, LAST_REP() ? xb : (bf16_t*)args.out, LAST_REP() ? ssq_c : (ssq_t*)(args.out + 8 * 1024 * 1024) + (size_t)rep_ * M * 16};
            pg8::gemm_phase<pg8::EpiRes, false, FF, FF, FF, 0>(lds + RING_OFF, g, S, E);
        }
        END_PH_X();
    }
    if (IN_PH()) for (int rep_ = 0; rep_ < REPS(); ++rep_) { BEGIN_PH();
        const int m0 = xmode ? xcc * SEQ + xrank * NWAVES + wave : bid * NWAVES + wave, ms = its * NWAVES, mn = xmode ? xcc * SEQ + SEQ : M;
        for (int m = m0; m < mn; m += ms) {
            const u32x4 a = ((const u32x4*)(xb + (size_t)m * D))[lane], b2 = ((const u32x4*)(xb + (size_t)m * D))[64 + lane];
            float v[16] = {bflo(a.x), bfhi(a.x), bflo(a.y), bfhi(a.y), bflo(a.z), bfhi(a.z), bflo(a.w), bfhi(a.w), bflo(b2.x), bfhi(b2.x), bflo(b2.y), bfhi(b2.y), bflo(b2.z), bfhi(b2.z), bflo(b2.w), bfhi(b2.w)};
            float sq = 0.f;
#pragma unroll
            for (int j = 0; j < 16; ++j) sq += v[j] * v[j];
            const float rs = 1.0f / sqrtf(wave_sum(sq) * (1.0f / D) + EPS);
#pragma unroll
            for (int hpart = 0; hpart < 2; ++hpart)
#pragma unroll
                for (int q = 0; q < 2; ++q) { const int col = hpart * 512 + lane * 8 + q * 4; const f32x4 gn = *(const f32x4*)(final_norm + col);
                    f32x4 o; o[0] = v[hpart * 8 + q * 4 + 0] * rs * gn[0]; o[1] = v[hpart * 8 + q * 4 + 1] * rs * gn[1]; o[2] = v[hpart * 8 + q * 4 + 2] * rs * gn[2]; o[3] = v[hpart * 8 + q * 4 + 3] * rs * gn[3];
                    *(f32x4*)(args.out + (size_t)m * D + col) = o; }
        }
    }
#undef IN_PH
#undef END_PH
}

extern "C" void kernel_launch(void* const* d_in, const int* in_sizes, int n_in, void* d_out, int out_size, void* d_ws, size_t ws_size, hipStream_t stream) {
    static int grid = 0;
    if (grid == 0) {
        if (n_in != 12 || in_sizes[0] != M * D || out_size != M * D || ws_size < WS_END) { fprintf(stderr, "kernel_launch: unexpected shapes / workspace (n_in %d, ws %zu, need %zu)\n", n_in, ws_size, (size_t)WS_END); grid = -1; return; }
        int dev = 0, cus = 0, per_cu = 0;
        if (hipGetDevice(&dev) != hipSuccess || hipDeviceGetAttribute(&cus, hipDeviceAttributeMultiprocessorCount, dev) != hipSuccess) { grid = -1; return; }
        if (hipFuncSetAttribute((const void*)fwd_kernel, hipFuncAttributeMaxDynamicSharedMemorySize, LDS_BYTES) != hipSuccess) { fprintf(stderr, "kernel_launch: hipFuncSetAttribute failed\n"); grid = -1; return; }
        if (hipOccupancyMaxActiveBlocksPerMultiprocessor(&per_cu, (const void*)fwd_kernel, NT, LDS_BYTES) != hipSuccess || per_cu < 1) { fprintf(stderr, "kernel_launch: occupancy query says %d blocks per CU\n", per_cu); grid = -1; (void)hipGetLastError(); return; }
        grid = cus;
    }
    if (grid < 0) return;
    Args a{};
    for (int i = 0; i < 12; ++i) a.in[i] = (const float*)d_in[i];
    a.out = (float*)d_out; a.ws = (unsigned char*)d_ws;
#if MK_N_LAUNCHES == 1
    (void)hipMemsetAsync((char*)d_ws + WS_CTL, 0, CTL_ZERO_BYTES, stream);
    a.ph_lo = 0; a.ph_hi = N_PHASES;
    void* kargs[] = {&a};
    hipError_t e = hipLaunchCooperativeKernel((const void*)fwd_kernel, dim3(grid), dim3(NT), kargs, LDS_BYTES, stream);
    if (e != hipSuccess) fprintf(stderr, "cooperative launch failed: %s (grid %d)\n", hipGetErrorString(e), grid);
#else
    for (int p = 0; p < N_PHASES; ++p) {
        a.ph_lo = p; a.ph_hi = p + 1;
        hipLaunchKernelGGL(fwd_kernel, dim3(grid), dim3(NT), LDS_BYTES, stream, a);
    }
#endif
}
```
